# Optimizing an MI355X kernel written in HIP

```python
import jax, jax.numpy as jnp
from jax import lax
import numpy as np

D_MODEL = 2048
BATCH = 4
SEQ = 4096
DEPTH = 1

MIX_WIDTH = D_MODEL
RWKV_WIDTH = MIX_WIDTH // 2
POOL_WIDTH = MIX_WIDTH - RWKV_WIDTH
RWKV_HEAD_SIZE = 64
RWKV_HEADS = RWKV_WIDTH // RWKV_HEAD_SIZE
DECAY_LORA = 64
ICLR_LORA = 64
GATE_LORA = 160
POOL_WINDOWS = (2, 4, 8, 16)
POOL_GROUPS = len(POOL_WINDOWS)
POOL_GROUP_WIDTH = POOL_WIDTH // POOL_GROUPS
SHIFT_WIDTH = 3 * RWKV_WIDTH + DECAY_LORA + ICLR_LORA + GATE_LORA
IN_COLS = SHIFT_WIDTH + POOL_WIDTH
N_EXPERTS = 32
TOP_K = 4
D_FF_EXPERT = D_MODEL
SWIGLU_LIMIT = 7.0
SWIGLU_ALPHA = 1.702
MOE_BLOCK = 128
LN_EPS = 1e-5
GN_EPS = 64e-5
DEEPNORM_ALPHA = (2 * DEPTH) ** 0.25
DEEPNORM_BETA = (8 * DEPTH) ** -0.25

kernel_name = 'hybrid_rwkv7_pool_moe_deepnorm'


def _layer_norm(x, w, b, eps=LN_EPS):
    xf = x.astype(jnp.float32)
    mu = xf.mean(-1, keepdims=True)
    var = jnp.square(xf - mu).mean(-1, keepdims=True)
    return (xf - mu) * lax.rsqrt(var + eps) * w + b


def _wkv7(r, decay, k, v, a, b):
    def step(S, inp):
        r_t, w_t, k_t, v_t, a_t, b_t = inp
        sa = jnp.einsum('bhij,bhj->bhi', S, a_t)
        S = (S * w_t[:, :, None, :] + sa[..., None] * b_t[:, :, None, :]
             + v_t[..., None] * k_t[:, :, None, :])
        return S, jnp.einsum('bhij,bhj->bhi', S, r_t)
    bsz, _, heads, n = r.shape
    s0 = jnp.zeros((bsz, heads, n, n), jnp.float32)
    seq_first = tuple(jnp.swapaxes(z, 0, 1) for z in (r, decay, k, v, a, b))
    _, y = lax.scan(step, s0, seq_first)
    return jnp.swapaxes(y, 0, 1)


def _rwkv7_group(p, mu_shift, w0, w2_decay, a0, a2_iclr, g2_gate, k_k, k_a, r_k, lnx_w, lnx_b):
    bsz, t, _ = p.shape
    prev = jnp.pad(p[:, :-1], ((0, 0), (1, 0), (0, 0)))
    p = p + (prev - p) * mu_shift
    r, k, v, xw, xa, xg = jnp.split(p, [RWKV_WIDTH, 2 * RWKV_WIDTH, 3 * RWKV_WIDTH,
                                        3 * RWKV_WIDTH + DECAY_LORA,
                                        3 * RWKV_WIDTH + DECAY_LORA + ICLR_LORA], axis=-1)
    w_logit = -jax.nn.softplus(-(w0 + jnp.tanh(xw) @ w2_decay)) - 0.5
    decay = jnp.exp(-jnp.exp(w_logit))
    a = jax.nn.sigmoid(a0 + xa @ a2_iclr)
    g = jax.nn.sigmoid(xg) @ g2_gate
    heads = lambda z: z.reshape(bsz, t, RWKV_HEADS, RWKV_HEAD_SIZE)
    kk = heads(k * k_k)
    kk = kk * lax.rsqrt(jnp.maximum(jnp.sum(kk * kk, -1, keepdims=True), 1e-24))
    k = k * (1.0 + (a - 1.0) * k_a)
    r_h, k_h, v_h, a_h = heads(r), heads(k), heads(v), heads(a)
    y = _wkv7(r_h, heads(decay), k_h, v_h, -kk, kk * a_h)
    y = _layer_norm(y, lnx_w, lnx_b, GN_EPS)
    y = y + jnp.sum(r_h * k_h * r_k, -1, keepdims=True) * v_h
    return y.reshape(bsz, t, RWKV_WIDTH) * g


def _pool_group(p, w_pool, pool_scale):
    bsz, t, _ = p.shape
    c = jnp.cumsum(p, axis=1)
    t_idx = jnp.arange(t)
    outs = []
    for gi, win in enumerate(POOL_WINDOWS):
        sl = slice(gi * POOL_GROUP_WIDTH, (gi + 1) * POOL_GROUP_WIDTH)
        cg = c[..., sl]
        c_lag = jnp.pad(cg[:, :t - win], ((0, 0), (win, 0), (0, 0)))
        count = jnp.minimum(t_idx + 1, win).astype(jnp.float32)[None, :, None]
        outs.append((cg - c_lag) / count - p[..., sl])
    pooled = jnp.stack(outs, axis=2)
    mixed = jnp.einsum('btgc,gcd->btgd', pooled, w_pool)
    return mixed.reshape(bsz, t, POOL_WIDTH) * pool_scale


def _moe(h, router_w, router_b, w1_exp, b1_exp, w2_exp, b2_exp):
    bsz, t, d = h.shape
    n_tok = bsz * t
    n_asg = n_tok * TOP_K
    n_blocks = -(-n_asg // MOE_BLOCK) + N_EXPERTS
    xf = h.reshape(n_tok, d)
    logits = (xf @ router_w + router_b).astype(jnp.float32)
    top_logits, top_idx = lax.top_k(logits, TOP_K)
    gates = jax.nn.softmax(top_logits, axis=-1)
    expert_of = top_idx.reshape(n_asg)
    order = jnp.argsort(expert_of, stable=True)
    sorted_expert = expert_of[order]
    sorted_token = order // TOP_K
    counts = jnp.bincount(expert_of, length=N_EXPERTS)
    padded = (counts + MOE_BLOCK - 1) // MOE_BLOCK * MOE_BLOCK
    start = jnp.cumsum(counts) - counts
    padded_end = jnp.cumsum(padded)
    padded_start = padded_end - padded
    dest = padded_start[sorted_expert] + jnp.arange(n_asg) - start[sorted_expert]
    slot_token = jnp.full((n_blocks * MOE_BLOCK,), n_tok, jnp.int32).at[dest].set(sorted_token)
    block_expert = jnp.minimum(
        jnp.searchsorted(padded_end, jnp.arange(n_blocks) * MOE_BLOCK, side='right'),
        N_EXPERTS - 1)
    x_slots = jnp.concatenate([xf, jnp.zeros((1, d), xf.dtype)])[slot_token]
    x_slots = x_slots.reshape(n_blocks, MOE_BLOCK, d)

    def expert_block(args):
        xb, e = args
        hb = xb @ w1_exp[e] + b1_exp[e]
        x_glu = jnp.minimum(hb[:, 0::2], SWIGLU_LIMIT)
        x_lin = jnp.clip(hb[:, 1::2], -SWIGLU_LIMIT, SWIGLU_LIMIT)
        act = x_glu * jax.nn.sigmoid(SWIGLU_ALPHA * x_glu) * (x_lin + 1.0)
        return act @ w2_exp[e] + b2_exp[e]

    y_slots = lax.map(expert_block, (x_slots, block_expert)).reshape(-1, d)
    y_asg = y_slots[dest].astype(jnp.float32) * gates.reshape(n_asg)[order][:, None]
    y = jax.ops.segment_sum(y_asg, sorted_token, num_segments=n_tok)
    return y.reshape(bsz, t, d).astype(h.dtype)


def setup_inputs(seed: int = 0) -> dict:
    key = jax.random.key(seed)
    ks = jax.random.split(key, 26)
    nrm = lambda k, shape, s: s * jax.random.normal(k, shape, jnp.float32)
    L = DEPTH
    return {
        'x': nrm(ks[0], (BATCH, SEQ, D_MODEL), 1.0),
        'w_in': nrm(ks[1], (L, D_MODEL, IN_COLS), D_MODEL ** -0.5),
        'mu_shift': jax.random.uniform(ks[2], (L, SHIFT_WIDTH), jnp.float32),
        'w0': jax.random.uniform(ks[3], (L, RWKV_WIDTH), jnp.float32, -6.0, -0.5),
        'w2_decay': nrm(ks[4], (L, DECAY_LORA, RWKV_WIDTH), 0.5 * DECAY_LORA ** -0.5),
        'a0': nrm(ks[5], (L, RWKV_WIDTH), 0.5),
        'a2_iclr': nrm(ks[6], (L, ICLR_LORA, RWKV_WIDTH), 0.5 * ICLR_LORA ** -0.5),
        'g2_gate': nrm(ks[7], (L, GATE_LORA, RWKV_WIDTH), GATE_LORA ** -0.5),
        'k_k': 0.85 + nrm(ks[8], (L, RWKV_WIDTH), 0.05),
        'k_a': 1.0 + nrm(ks[9], (L, RWKV_WIDTH), 0.05),
        'r_k': nrm(ks[10], (L, RWKV_HEADS, RWKV_HEAD_SIZE), 0.1),
        'lnx_w': 1.0 + nrm(ks[11], (L, RWKV_HEADS, RWKV_HEAD_SIZE), 0.05),
        'lnx_b': nrm(ks[12], (L, RWKV_HEADS, RWKV_HEAD_SIZE), 0.02),
        'w_pool': nrm(ks[13], (L, POOL_GROUPS, POOL_GROUP_WIDTH, POOL_GROUP_WIDTH), POOL_GROUP_WIDTH ** -0.5),
        'pool_scale': 1.0 + nrm(ks[14], (L, POOL_WIDTH), 0.05),
        'w_out': nrm(ks[15], (L, MIX_WIDTH, D_MODEL), DEEPNORM_BETA * MIX_WIDTH ** -0.5),
        'ln1_w': 1.0 + nrm(ks[16], (L, D_MODEL), 0.05),
        'ln1_b': nrm(ks[17], (L, D_MODEL), 0.02),
        'router_w': nrm(ks[18], (L, D_MODEL, N_EXPERTS), D_MODEL ** -0.5),
        'router_b': nrm(ks[19], (L, N_EXPERTS), 0.01),
        'w1_exp': nrm(ks[20], (L, N_EXPERTS, D_MODEL, 2 * D_FF_EXPERT), D_MODEL ** -0.5),
        'b1_exp': nrm(ks[21], (L, N_EXPERTS, 2 * D_FF_EXPERT), 0.01),
        'w2_exp': nrm(ks[22], (L, N_EXPERTS, D_FF_EXPERT, D_MODEL), DEEPNORM_BETA * D_FF_EXPERT ** -0.5),
        'b2_exp': nrm(ks[23], (L, N_EXPERTS, D_MODEL), 0.01),
        'ln2_w': 1.0 + nrm(ks[24], (L, D_MODEL), 0.05),
        'ln2_b': nrm(ks[25], (L, D_MODEL), 0.02),
    }


def reference(x, w_in, mu_shift, w0, w2_decay, a0, a2_iclr, g2_gate, k_k, k_a, r_k,
              lnx_w, lnx_b, w_pool, pool_scale, w_out, ln1_w, ln1_b, router_w, router_b,
              w1_exp, b1_exp, w2_exp, b2_exp, ln2_w, ln2_b):
    h = x
    for l in range(DEPTH):
        proj = (h @ w_in[l]).astype(jnp.float32)
        y_rwkv = _rwkv7_group(proj[..., :SHIFT_WIDTH], mu_shift[l], w0[l], w2_decay[l],
                              a0[l], a2_iclr[l], g2_gate[l], k_k[l], k_a[l], r_k[l],
                              lnx_w[l], lnx_b[l])
        y_pool = _pool_group(proj[..., SHIFT_WIDTH:], w_pool[l], pool_scale[l])
        mix = jnp.concatenate([y_rwkv, y_pool], axis=-1).astype(h.dtype) @ w_out[l]
        h = _layer_norm(DEEPNORM_ALPHA * h + mix, ln1_w[l], ln1_b[l]).astype(x.dtype)
        ffn = _moe(h, router_w[l], router_b[l], w1_exp[l], b1_exp[l], w2_exp[l], b2_exp[l])
        h = _layer_norm(DEEPNORM_ALPHA * h + ffn, ln2_w[l], ln2_b[l]).astype(x.dtype)
    return h
```

```cpp
#include <hip/hip_runtime.h>
#include <stdint.h>
#include <stdio.h>

constexpr int D = 2048, BATCH = 4, SEQ = 4096, M = BATCH * SEQ;
constexpr int RW = 1024, PW = 1024, NH = 16;
constexpr int DL = 64, IL = 64, GL = 160;
constexpr int SHIFT_W = 3 * RW + DL + IL + GL;
constexpr int IN_COLS = SHIFT_W + PW;
constexpr int NE = 32, TOPK = 4, DFF = 2048;
constexpr int NASG = M * TOPK;
constexpr int NSLOT_MAX = NASG + NE * 256;
constexpr int NTILE64 = NSLOT_MAX / 64;
constexpr float LN_EPS = 1e-5f, GN_EPS = 64e-5f;
constexpr float ALPHA = 1.189207115002721f;

__device__ __forceinline__ float wave_sum(float v) {
#pragma unroll
    for (int o = 1; o < 64; o <<= 1) v += __shfl_xor(v, o);
    return v;
}
__device__ __forceinline__ float block_sum256(float v, float* red) {
    v = wave_sum(v);
    __syncthreads();
    if ((threadIdx.x & 63) == 0) red[threadIdx.x >> 6] = v;
    __syncthreads();
    return red[0] + red[1] + red[2] + red[3];
}

struct GArgs {
    const float* A; int lda; const int* rowmap;
    const float* B; int ldb; size_t b_estride;
    const float* bias; size_t bias_estride;
    const int* tile_expert;
    float* C; int ldc; int M, N, K; int mode;
};
__global__ __launch_bounds__(256) void k_gemm(GArgs g) {
    __shared__ float As[16][68];
    __shared__ float Bs[16][68];
    const int tm = blockIdx.y, tn = blockIdx.x;
    int e = 0;
    if (g.tile_expert) { e = g.tile_expert[tm]; if (e < 0) return; }
    const float* B = g.B + (size_t)e * g.b_estride;
    const int tid = threadIdx.x, tx = tid & 15, ty = tid >> 4;
    const int ar = tid >> 2, ak = (tid & 3) * 4;
    const int grow_l = tm * 64 + ar;
    int srow = -1;
    if (grow_l < g.M) srow = g.rowmap ? g.rowmap[grow_l] : grow_l;
    const float* Ap = srow >= 0 ? g.A + (size_t)srow * g.lda : nullptr;
    const int bk = tid >> 4, bn = (tid & 15) * 4;
    const int gn_l = tn * 64 + bn;
    float acc[4][4];
#pragma unroll
    for (int i = 0; i < 4; ++i)
#pragma unroll
        for (int j = 0; j < 4; ++j) acc[i][j] = 0.f;
    for (int k0 = 0; k0 < g.K; k0 += 16) {
        float4 av = make_float4(0.f, 0.f, 0.f, 0.f);
        if (Ap) av = *(const float4*)(Ap + k0 + ak);
        As[ak + 0][ar] = av.x; As[ak + 1][ar] = av.y; As[ak + 2][ar] = av.z; As[ak + 3][ar] = av.w;
        float4 bv = make_float4(0.f, 0.f, 0.f, 0.f);
        if (gn_l + 3 < g.N) bv = *(const float4*)(B + (size_t)(k0 + bk) * g.ldb + gn_l);
        Bs[bk][bn + 0] = bv.x; Bs[bk][bn + 1] = bv.y; Bs[bk][bn + 2] = bv.z; Bs[bk][bn + 3] = bv.w;
        __syncthreads();
#pragma unroll
        for (int kk = 0; kk < 16; ++kk) {
            float a[4], b[4];
#pragma unroll
            for (int i = 0; i < 4; ++i) a[i] = As[kk][ty * 4 + i];
#pragma unroll
            for (int j = 0; j < 4; ++j) b[j] = Bs[kk][tx * 4 + j];
#pragma unroll
            for (int i = 0; i < 4; ++i)
#pragma unroll
                for (int j = 0; j < 4; ++j) acc[i][j] += a[i] * b[j];
        }
        __syncthreads();
    }
    const int gn = tn * 64 + tx * 4;
    if (gn + 3 >= g.N) return;
    float bias[4] = {0.f, 0.f, 0.f, 0.f};
    if (g.bias) {
#pragma unroll
        for (int j = 0; j < 4; ++j) bias[j] = g.bias[(size_t)e * g.bias_estride + gn + j];
    }
#pragma unroll
    for (int i = 0; i < 4; ++i) {
        const int grow = tm * 64 + ty * 4 + i;
        if (grow >= g.M) continue;
        float v[4];
#pragma unroll
        for (int j = 0; j < 4; ++j) v[j] = acc[i][j] + bias[j];
        if (g.mode == 0) {
            *(float4*)(g.C + (size_t)grow * g.ldc + gn) = make_float4(v[0], v[1], v[2], v[3]);
        } else {
#pragma unroll
            for (int p = 0; p < 2; ++p) {
                float xg = fminf(v[2 * p], 7.0f);
                float xl = fminf(fmaxf(v[2 * p + 1], -7.0f), 7.0f);
                float act = xg * (1.0f / (1.0f + expf(-1.702f * xg))) * (xl + 1.0f);
                g.C[(size_t)grow * g.ldc + gn / 2 + p] = act;
            }
        }
    }
}

struct PrepArgs {
    const float *PROJ, *mu, *w0, *w2d, *a0, *a2, *g2, *k_k, *k_a, *r_k;
    float *R, *W, *K, *V, *KK, *BB, *G, *BONUS;
};
__global__ __launch_bounds__(256) void k_prep(PrepArgs p) {
    __shared__ float s_xw[64], s_xa[64], s_xg[160];
    const int m = blockIdx.x, t = m % SEQ, tid = threadIdx.x;
    const float* pr = p.PROJ + (size_t)m * IN_COLS;
    const float* pp = pr - IN_COLS;
    auto sh = [&](int c) -> float { const float cur = pr[c]; const float prev = t > 0 ? pp[c] : 0.f; return cur + (prev - cur) * p.mu[c]; };
    for (int i = tid; i < 288; i += 256) {
        const float v = sh(3072 + i);
        if (i < 64) s_xw[i] = tanhf(v);
        else if (i < 128) s_xa[i - 64] = v;
        else s_xg[i - 128] = 1.0f / (1.0f + expf(-v));
    }
    __syncthreads();
    for (int c = tid; c < 1024; c += 256) {
        const float r = sh(c), k = sh(1024 + c), v = sh(2048 + c);
        float wl = p.w0[c];
        for (int i = 0; i < 64; ++i) wl += s_xw[i] * p.w2d[i * 1024 + c];
        float al = p.a0[c];
        for (int i = 0; i < 64; ++i) al += s_xa[i] * p.a2[i * 1024 + c];
        float g = 0.f;
        for (int i = 0; i < 160; ++i) g += s_xg[i] * p.g2[i * 1024 + c];
        const float z = -wl;
        const float sp = fmaxf(z, 0.f) + log1pf(expf(-fabsf(z)));
        const float wlog = -sp - 0.5f;
        const float dec = expf(-expf(wlog));
        const float a = 1.0f / (1.0f + expf(-al));
        float kk = k * p.k_k[c];
        const float ss = wave_sum(kk * kk);
        kk = kk * rsqrtf(fmaxf(ss, 1e-24f));
        const float k2 = k * (1.0f + (a - 1.0f) * p.k_a[c]);
        const float bon = wave_sum(r * k2 * p.r_k[c]);
        const size_t o = (size_t)m * 1024 + c;
        p.R[o] = r; p.W[o] = dec; p.K[o] = k2; p.V[o] = v; p.KK[o] = kk; p.BB[o] = kk * a; p.G[o] = g;
        if ((tid & 63) == 0) p.BONUS[m * 16 + (c >> 6)] = bon;
    }
}

__global__ __launch_bounds__(256) void k_pool(const float* PROJ, const float* w_pool, const float* pool_scale, float* MIXIN) {
    __shared__ float s_p[1024];
    const int m = blockIdx.x, t = m % SEQ, tid = threadIdx.x;
    for (int c = tid; c < 1024; c += 256) {
        const int g = c >> 8, win = 2 << g;
        const int n = (t + 1) < win ? (t + 1) : win;
        float sum = 0.f;
        for (int s = 0; s < n; ++s) sum += PROJ[(size_t)(m - s) * IN_COLS + SHIFT_W + c];
        s_p[c] = sum / (float)n - PROJ[(size_t)m * IN_COLS + SHIFT_W + c];
    }
    __syncthreads();
    for (int g = 0; g < 4; ++g) {
        float acc = 0.f;
        const float* wp = w_pool + (size_t)g * 256 * 256 + tid;
        for (int c = 0; c < 256; ++c) acc += s_p[g * 256 + c] * wp[(size_t)c * 256];
        MIXIN[(size_t)m * 2048 + 1024 + g * 256 + tid] = acc * pool_scale[g * 256 + tid];
    }
}

__global__ __launch_bounds__(64) void k_scan(const float* __restrict__ R, const float* __restrict__ W, const float* __restrict__ K, const float* __restrict__ V,
                                             const float* __restrict__ KK, const float* __restrict__ BB, float* __restrict__ Y) {
    const int b = blockIdx.x / NH, h = blockIdx.x % NH, i = threadIdx.x;
    float S[64];
#pragma unroll
    for (int j = 0; j < 64; ++j) S[j] = 0.f;
    for (int t = 0; t < SEQ; ++t) {
        const size_t base = ((size_t)b * SEQ + t) * 1024 + h * 64;
        const float v = V[base + i];
        float sa = 0.f;
#pragma unroll
        for (int j = 0; j < 64; ++j) sa -= S[j] * KK[base + j];
        float y = 0.f;
#pragma unroll
        for (int j = 0; j < 64; ++j) {
            S[j] = S[j] * W[base + j] + sa * BB[base + j] + v * K[base + j];
            y += S[j] * R[base + j];
        }
        Y[base + i] = y;
    }
}

__global__ __launch_bounds__(256) void k_post(const float* Y, const float* V, const float* G, const float* BONUS, const float* lnx_w, const float* lnx_b, float* MIXIN) {
    const int m = blockIdx.x, tid = threadIdx.x;
    for (int c = tid; c < 1024; c += 256) {
        const size_t o = (size_t)m * 1024 + c;
        const float y = Y[o];
        const float mean = wave_sum(y) * (1.0f / 64.0f);
        const float d = y - mean;
        const float var = wave_sum(d * d) * (1.0f / 64.0f);
        float yn = d * rsqrtf(var + GN_EPS) * lnx_w[c] + lnx_b[c];
        yn += BONUS[m * 16 + (c >> 6)] * V[o];
        MIXIN[(size_t)m * 2048 + c] = yn * G[o];
    }
}

__global__ __launch_bounds__(256) void k_ln1_router(const float* x, const float* MIX, const float* ln_w, const float* ln_b, const float* router_w, const float* router_b,
                                                     float* H, int* TOPI, float* GATE, int* POS, int* cnt) {
    __shared__ float s_h[2048];
    __shared__ float s_part[8][32];
    __shared__ float red[8];
    const int m = blockIdx.x, tid = threadIdx.x;
    float v[8]; float s = 0.f;
#pragma unroll
    for (int q = 0; q < 8; ++q) { const int c = tid + 256 * q; v[q] = ALPHA * x[(size_t)m * D + c] + MIX[(size_t)m * D + c]; s += v[q]; }
    const float mean = block_sum256(s, red) * (1.0f / D);
    float s2 = 0.f;
#pragma unroll
    for (int q = 0; q < 8; ++q) { v[q] -= mean; s2 += v[q] * v[q]; }
    const float var = block_sum256(s2, red) * (1.0f / D);
    const float rstd = rsqrtf(var + LN_EPS);
#pragma unroll
    for (int q = 0; q < 8; ++q) { const int c = tid + 256 * q; const float h = v[q] * rstd * ln_w[c] + ln_b[c]; s_h[c] = h; H[(size_t)m * D + c] = h; }
    __syncthreads();
    {
        const int e = tid & 31, part = tid >> 5;
        float acc = 0.f;
        for (int c = part * 256; c < part * 256 + 256; ++c) acc += s_h[c] * router_w[c * 32 + e];
        s_part[part][e] = acc;
    }
    __syncthreads();
    if (tid == 0) {
        float lg[32];
#pragma unroll
        for (int e = 0; e < 32; ++e) { float a = router_b[e]; for (int p = 0; p < 8; ++p) a += s_part[p][e]; lg[e] = a; }
        int idx[4]; float val[4];
        unsigned used = 0u;
#pragma unroll
        for (int k = 0; k < 4; ++k) {
            float best = -3.0e38f; int bi = 0;
#pragma unroll
            for (int e = 0; e < 32; ++e) { const bool ok = !((used >> e) & 1u) && lg[e] > best; best = ok ? lg[e] : best; bi = ok ? e : bi; }
            used |= 1u << bi; idx[k] = bi; val[k] = best;
        }
        float ex[4], se = 0.f;
#pragma unroll
        for (int k = 0; k < 4; ++k) { ex[k] = expf(val[k] - val[0]); se += ex[k]; }
#pragma unroll
        for (int k = 0; k < 4; ++k) {
            TOPI[m * 4 + k] = idx[k]; GATE[m * 4 + k] = ex[k] / se;
            POS[m * 4 + k] = atomicAdd(&cnt[idx[k]], 1);
        }
    }
}

__global__ void k_offsets(const int* cnt, int* pstart, int* tile_expert) {
    __shared__ int ps[NE + 1];
    if (threadIdx.x == 0) {
        int acc = 0;
        for (int e = 0; e < NE; ++e) { ps[e] = acc; pstart[e] = acc; acc += (cnt[e] + 255) / 256 * 256; }
        ps[NE] = acc; pstart[NE] = acc;
    }
    __syncthreads();
    for (int t = threadIdx.x; t < NTILE64; t += blockDim.x) {
        const int row = t * 64; int e = -1;
        if (row < ps[NE]) { for (int q = 0; q < NE; ++q) if (row >= ps[q] && row < ps[q + 1]) e = q; }
        tile_expert[t] = e;
    }
}

__global__ void k_scatter(const int* TOPI, const int* POS, const int* pstart, int* slot_tok, int* SLOT_OF) {
    const int a = blockIdx.x * blockDim.x + threadIdx.x;
    if (a >= NASG) return;
    const int slot = pstart[TOPI[a]] + POS[a];
    slot_tok[slot] = a >> 2; SLOT_OF[a] = slot;
}

__global__ __launch_bounds__(256) void k_final(const float* H, const float* YS, const int* SLOT_OF, const float* GATE, const float* ln_w, const float* ln_b, float* out) {
    __shared__ float red[8];
    const int m = blockIdx.x, tid = threadIdx.x;
    int sl[4]; float gt[4];
#pragma unroll
    for (int k = 0; k < 4; ++k) { sl[k] = SLOT_OF[m * 4 + k]; gt[k] = GATE[m * 4 + k]; }
    float v[8]; float s = 0.f;
#pragma unroll
    for (int q = 0; q < 8; ++q) {
        const int c = tid + 256 * q; float f = 0.f;
#pragma unroll
        for (int k = 0; k < 4; ++k) f += gt[k] * YS[(size_t)sl[k] * D + c];
        v[q] = ALPHA * H[(size_t)m * D + c] + f; s += v[q];
    }
    const float mean = block_sum256(s, red) * (1.0f / D);
    float s2 = 0.f;
#pragma unroll
    for (int q = 0; q < 8; ++q) { v[q] -= mean; s2 += v[q] * v[q]; }
    const float var = block_sum256(s2, red) * (1.0f / D);
    const float rstd = rsqrtf(var + LN_EPS);
#pragma unroll
    for (int q = 0; q < 8; ++q) { const int c = tid + 256 * q; out[(size_t)m * D + c] = v[q] * rstd * ln_w[c] + ln_b[c]; }
}

extern "C" void kernel_launch(void* const* d_in, const int* in_sizes, int n_in, void* d_out, int out_size, void* d_ws, size_t ws_size, hipStream_t stream) {
    const float* x = (const float*)d_in[0];      const float* w_in = (const float*)d_in[1];   const float* mu = (const float*)d_in[2];
    const float* w0 = (const float*)d_in[3];     const float* w2d = (const float*)d_in[4];    const float* a0 = (const float*)d_in[5];
    const float* a2 = (const float*)d_in[6];     const float* g2 = (const float*)d_in[7];     const float* k_k = (const float*)d_in[8];
    const float* k_a = (const float*)d_in[9];    const float* r_k = (const float*)d_in[10];   const float* lnx_w = (const float*)d_in[11];
    const float* lnx_b = (const float*)d_in[12]; const float* w_pool = (const float*)d_in[13]; const float* pool_scale = (const float*)d_in[14];
    const float* w_out = (const float*)d_in[15]; const float* ln1_w = (const float*)d_in[16]; const float* ln1_b = (const float*)d_in[17];
    const float* router_w = (const float*)d_in[18]; const float* router_b = (const float*)d_in[19];
    const float* w1 = (const float*)d_in[20];    const float* b1 = (const float*)d_in[21];    const float* w2 = (const float*)d_in[22];
    const float* b2 = (const float*)d_in[23];    const float* ln2_w = (const float*)d_in[24]; const float* ln2_b = (const float*)d_in[25];
    float* out = (float*)d_out;

    char* ws = (char*)d_ws; size_t off = 0;
    auto take = [&](size_t bytes) { char* p = ws + off; off += (bytes + 255) & ~(size_t)255; return p; };
    int* cnt = (int*)take(256);
    int* pstart = (int*)take(256);
    int* tile_expert = (int*)take(NTILE64 * 4);
    int* slot_tok = (int*)take((size_t)NSLOT_MAX * 4);
    int* TOPI = (int*)take((size_t)NASG * 4);
    float* GATE = (float*)take((size_t)NASG * 4);
    int* POS = (int*)take((size_t)NASG * 4);
    int* SLOT_OF = (int*)take((size_t)NASG * 4);
    float* BONUS = (float*)take((size_t)M * 16 * 4);
    float* PROJ = (float*)take((size_t)M * IN_COLS * 4);
    float* R = (float*)take((size_t)M * 1024 * 4); float* W = (float*)take((size_t)M * 1024 * 4); float* K = (float*)take((size_t)M * 1024 * 4);
    float* V = (float*)take((size_t)M * 1024 * 4); float* KK = (float*)take((size_t)M * 1024 * 4); float* BB = (float*)take((size_t)M * 1024 * 4);
    float* G = (float*)take((size_t)M * 1024 * 4); float* Y = (float*)take((size_t)M * 1024 * 4);
    float* MIXIN = (float*)take((size_t)M * D * 4);
    float* MIX = (float*)take((size_t)M * D * 4);
    float* H = (float*)take((size_t)M * D * 4);
    float* ACT = (float*)take((size_t)NSLOT_MAX * DFF * 4);
    float* YS = (float*)take((size_t)NSLOT_MAX * D * 4);
    if (off > ws_size) { fprintf(stderr, "kernel_launch: workspace too small: need %zu, have %zu\n", off, ws_size); return; }

    hipMemsetAsync(cnt, 0, 256, stream);
    hipMemsetAsync(slot_tok, 0xFF, (size_t)NSLOT_MAX * 4, stream);

    { GArgs g{}; g.A = x; g.lda = D; g.rowmap = nullptr; g.B = w_in; g.ldb = IN_COLS; g.b_estride = 0; g.bias = nullptr; g.bias_estride = 0; g.tile_expert = nullptr;
      g.C = PROJ; g.ldc = IN_COLS; g.M = M; g.N = IN_COLS; g.K = D; g.mode = 0;
      hipLaunchKernelGGL(k_gemm, dim3((IN_COLS + 63) / 64, M / 64), dim3(256), 0, stream, g); }
    { PrepArgs p{}; p.PROJ = PROJ; p.mu = mu; p.w0 = w0; p.w2d = w2d; p.a0 = a0; p.a2 = a2; p.g2 = g2; p.k_k = k_k; p.k_a = k_a; p.r_k = r_k;
      p.R = R; p.W = W; p.K = K; p.V = V; p.KK = KK; p.BB = BB; p.G = G; p.BONUS = BONUS;
      hipLaunchKernelGGL(k_prep, dim3(M), dim3(256), 0, stream, p); }
    hipLaunchKernelGGL(k_pool, dim3(M), dim3(256), 0, stream, PROJ, w_pool, pool_scale, MIXIN);
    hipLaunchKernelGGL(k_scan, dim3(BATCH * NH), dim3(64), 0, stream, R, W, K, V, KK, BB, Y);
    hipLaunchKernelGGL(k_post, dim3(M), dim3(256), 0, stream, Y, V, G, BONUS, lnx_w, lnx_b, MIXIN);
    { GArgs g{}; g.A = MIXIN; g.lda = D; g.rowmap = nullptr; g.B = w_out; g.ldb = D; g.b_estride = 0; g.bias = nullptr; g.bias_estride = 0; g.tile_expert = nullptr;
      g.C = MIX; g.ldc = D; g.M = M; g.N = D; g.K = D; g.mode = 0;
      hipLaunchKernelGGL(k_gemm, dim3(D / 64, M / 64), dim3(256), 0, stream, g); }
    hipLaunchKernelGGL(k_ln1_router, dim3(M), dim3(256), 0, stream, x, MIX, ln1_w, ln1_b, router_w, router_b, H, TOPI, GATE, POS, cnt);
    hipLaunchKernelGGL(k_offsets, dim3(1), dim3(256), 0, stream, cnt, pstart, tile_expert);
    hipLaunchKernelGGL(k_scatter, dim3(NASG / 256), dim3(256), 0, stream, TOPI, POS, pstart, slot_tok, SLOT_OF);
    { GArgs g{}; g.A = H; g.lda = D; g.rowmap = slot_tok; g.B = w1; g.ldb = 2 * DFF; g.b_estride = (size_t)D * 2 * DFF; g.bias = b1; g.bias_estride = 2 * DFF; g.tile_expert = tile_expert;
      g.C = ACT; g.ldc = DFF; g.M = NSLOT_MAX; g.N = 2 * DFF; g.K = D; g.mode = 1;
      hipLaunchKernelGGL(k_gemm, dim3(2 * DFF / 64, NTILE64), dim3(256), 0, stream, g); }
    { GArgs g{}; g.A = ACT; g.lda = DFF; g.rowmap = nullptr; g.B = w2; g.ldb = D; g.b_estride = (size_t)DFF * D; g.bias = b2; g.bias_estride = D; g.tile_expert = tile_expert;
      g.C = YS; g.ldc = D; g.M = NSLOT_MAX; g.N = D; g.K = DFF; g.mode = 0;
      hipLaunchKernelGGL(k_gemm, dim3(D / 64, NTILE64), dim3(256), 0, stream, g); }
    hipLaunchKernelGGL(k_final, dim3(M), dim3(256), 0, stream, H, YS, SLOT_OF, GATE, ln2_w, ln2_b, out);
}
```

```cpp
#include <hip/hip_runtime.h>
#include <stdint.h>
#include <stdio.h>

#ifndef MK_N_LAUNCHES
#define MK_N_LAUNCHES 1
#endif

constexpr int D = 2048, BATCH = 4, SEQ = 4096, M = BATCH * SEQ;
constexpr int RW = 1024, PW = 1024, NH = 16;
constexpr int SHIFT_W = 3360, IN_COLS = 4384, IN_PAD = 4608;
constexpr int LK = 384;
constexpr int NE = 32, DFF = 2048;
constexpr int NASG = M * 4;
constexpr int NSLOT_MAX = NASG + NE * 256;
constexpr float LN_EPS = 1e-5f, GN_EPS = 64e-5f;
constexpr float ALPHA = 1.189207115002721f;
constexpr int NWG = 256, NWAVES = 8, NTHR = 512;
constexpr int NPHASE = 13;

#define GAS __attribute__((address_space(1)))
#define LAS __attribute__((address_space(3)))
typedef unsigned short bf16;
typedef unsigned v4u __attribute__((ext_vector_type(4)));
typedef unsigned v2u __attribute__((ext_vector_type(2)));
typedef float f32x4 __attribute__((ext_vector_type(4)));
typedef short bf16x8 __attribute__((ext_vector_type(8)));
typedef GAS unsigned gu32;
#define RLX_AGENT __ATOMIC_RELAXED, __HIP_MEMORY_SCOPE_AGENT
#define LDS_WAIT() asm volatile("s_waitcnt lgkmcnt(0)" ::: "memory")
#define VM_WAIT() asm volatile("s_waitcnt vmcnt(0)" ::: "memory")

__device__ __forceinline__ unsigned f2bf(float f) { unsigned u = __builtin_bit_cast(unsigned, f); return (u + 0x7fffu + ((u >> 16) & 1u)) >> 16; }
__device__ __forceinline__ unsigned pk2(float lo, float hi) { return f2bf(lo) | (f2bf(hi) << 16); }
__device__ __forceinline__ float bflo(unsigned w) { return __builtin_bit_cast(float, w << 16); }
__device__ __forceinline__ float bfhi(unsigned w) { return __builtin_bit_cast(float, w & 0xffff0000u); }
__device__ __forceinline__ float wave_sum(float v) {
#pragma unroll
    for (int o = 1; o < 64; o <<= 1) v += __shfl_xor(v, o);
    return v;
}
template <int CTRL> __device__ __forceinline__ float dpp_mov(float x) { return __builtin_bit_cast(float, __builtin_amdgcn_update_dpp(0, __builtin_bit_cast(int, x), CTRL, 0xF, 0xF, true)); }
__device__ __forceinline__ float row16_sum(float x) {
    x += dpp_mov<0xB1>(x);
    x += dpp_mov<0x4E>(x);
    x += dpp_mov<0x141>(x);
    x += dpp_mov<0x140>(x);
    return x;
}

namespace pg8 {
typedef unsigned short bf16_t;
typedef unsigned u32x4 __attribute__((ext_vector_type(4)));
constexpr int BM = 256, BK = 64, HALF = 128, HTB = HALF * BK * 2, STAGE_BYTES = 8 * HTB, NXCD = 8, WGM = 8;
__host__ __device__ __forceinline__ int lds_byte(int r, int c) { const int st = (r >> 4) * 2 + (c >> 5), rr = r & 15, cc = c & 31, ob = rr * 64 + cc * 2; return st * 1024 + (ob ^ (((ob >> 9) & 1) << 5)); }
__host__ __device__ __forceinline__ void stage_rc(int b, int& R, int& C) { const int st = b / 1024, sb = b % 1024, swz = sb ^ (((sb >> 9) & 1) << 5); R = (st >> 1) * 16 + swz / 64; C = (st & 1) * 32 + (swz % 64) / 2; }
__host__ __device__ __forceinline__ int perm32(int rho) { const int n = rho >> 4, i = rho & 15; return 8 * (i >> 2) + 4 * n + (i & 3); }
struct Unit { int pm, pn; };
struct Gemm { const bf16_t* A; const bf16_t* Bt; int lda, K; };
__device__ __forceinline__ unsigned cvt_pk_bf16(float lo, float hi) { unsigned r; asm volatile("v_cvt_pk_bf16_f32 %0, %1, %2" : "=v"(r) : "v"(lo), "v"(hi)); return r; }

struct GridOrder {
    int nM, nN, nwg, G, c; size_t a_tstep, a_pnstep, b_tstep;
    __device__ void init(int nM_, int nN_, int G_, int c_, size_t a_tstep_, size_t a_pnstep_, size_t b_tstep_) { nM = nM_; nN = nN_; nwg = nM * nN; G = G_; c = c_; a_tstep = a_tstep_; a_pnstep = a_pnstep_; b_tstep = b_tstep_; }
    __device__ bool next(int i, Unit& u) const {
        const long L = (long)i * G + c; if (L >= nwg) return false;
        int wgid = (int)L; { const int q = nwg / NXCD, r = nwg % NXCD, xcd = wgid % NXCD, off = wgid / NXCD; wgid = (xcd < r ? xcd * (q + 1) : r * (q + 1) + (xcd - r) * q) + off; }
        const int nig = WGM * nN, gid = wgid / nig, fm = gid * WGM, gsz = (nM - fm) < WGM ? (nM - fm) : WGM;
        u.pm = fm + ((wgid % nig) % gsz); u.pn = (wgid % nig) / gsz; return true;
    }
    __device__ __forceinline__ size_t aoff(const Unit& u) const { return (size_t)u.pm * a_tstep + (size_t)u.pn * a_pnstep; }
    __device__ __forceinline__ size_t boff(const Unit& u) const { return (size_t)u.pn * b_tstep; }
};
struct MoeOrder {
    const LAS int* ps; int ntile, npan, cprime; size_t a_tstep, b_tstep;
    __device__ bool next(int i, Unit& u) const {
        const int U = i * NWG + cprime; const int p = U / ntile; if (p >= npan) return false;
        const int row = p * 256; int e = 0;
#pragma unroll 1
        for (int q = 1; q < NE; ++q) e = (row >= ps[q]) ? q : e;
        u.pm = p; u.pn = e * ntile + (U % ntile); return true;
    }
    __device__ __forceinline__ size_t aoff(const Unit& u) const { return (size_t)u.pm * a_tstep; }
    __device__ __forceinline__ size_t boff(const Unit& u) const { return (size_t)u.pn * b_tstep; }
};

template <class Epi, class Sched, bool ALIGN_EPI, bool SP2>
__device__ __forceinline__ void gemm_phase(LAS unsigned char* lds, const Gemm g, const Sched& S, const Epi& E) {
    const int tid = threadIdx.x, wid = __builtin_amdgcn_readfirstlane(tid >> 6), lane = tid & 63, wr = wid >> 2, wc = wid & 3, fr = lane & 15, fq = lane >> 4;
    const int K = g.K, nt = K / BK;
    unsigned voffA[2], voffB[2];
#pragma unroll
    for (int i = 0; i < 2; ++i) { int R, C; stage_rc(tid * 16 + i * 8192, R, C); const int Rb = Epi::PERM ? ((R & ~31) + perm32(R & 31)) : R;
        voffA[i] = (unsigned)(R * g.lda + C) * 2u; voffB[i] = (unsigned)(Rb * K + C) * 2u; }
    const size_t kstep = (size_t)(BK * 2);
    const size_t hstepA = (size_t)HALF * g.lda * 2, hstepB = (size_t)HALF * K * 2;
    const unsigned ldsw = (unsigned)wid * 1024u;
    const int aoff = lds_byte(wr * 64 + fr, fq * 8), boff = lds_byte(wc * 32 + fr, fq * 8);
#define PG8_SA(b, h) (((b) * 2 + (h)) * HTB)
#define PG8_SB(b, h) ((4 + (b) * 2 + (h)) * HTB)
#define PG8_STAGE(bufoff, gbase, voff) do { _Pragma("unroll") for (int _i = 0; _i < 2; ++_i) \
        __builtin_amdgcn_global_load_lds((const unsigned*)((const char*)(gbase) + (voff)[_i]), (LAS unsigned*)(lds + (bufoff) + ldsw + _i * 8192), 16, 0, 0); } while (0)
#define PG8_LDA(dst, b, h) do { _Pragma("unroll") for (int m = 0; m < 4; ++m) _Pragma("unroll") for (int k = 0; k < 2; ++k) dst[m][k] = *(const LAS bf16x8*)(lds + PG8_SA(b, h) + aoff + m * 2048 + k * 1024); } while (0)
#define PG8_LDB(dst, b, h) do { _Pragma("unroll") for (int n = 0; n < 2; ++n) _Pragma("unroll") for (int k = 0; k < 2; ++k) dst[n][k] = *(const LAS bf16x8*)(lds + PG8_SB(b, h) + boff + n * 2048 + k * 1024); } while (0)
#define PG8_MMA(ai, bj, At, Bt) do { __builtin_amdgcn_s_setprio(1); _Pragma("unroll") for (int m = 0; m < 4; ++m) _Pragma("unroll") for (int n = 0; n < 2; ++n) _Pragma("unroll") for (int k = 0; k < 2; ++k) \
        acc[ai][bj][m][n] = __builtin_amdgcn_mfma_f32_16x16x32_bf16(Bt[n][k], At[m][k], acc[ai][bj][m][n], 0, 0, 0); __builtin_amdgcn_s_setprio(0); } while (0)
#define PG8_WAIT_V(n) asm volatile("s_waitcnt vmcnt(" #n ")" ::: "memory")
#define PG8_WAIT_L(n) asm volatile("s_waitcnt lgkmcnt(" #n ")" ::: "memory")
#define PG8_BAR __builtin_amdgcn_s_barrier()
#define PG8_SCHED __builtin_amdgcn_sched_barrier(0)
    Unit cur, nxt; int ui = 0;
    if (!S.next(0, cur)) return;
    f32x4 acc[2][2][4][2];
#pragma unroll
    for (int a = 0; a < 2; ++a)
#pragma unroll
        for (int b = 0; b < 2; ++b)
#pragma unroll
            for (int m = 0; m < 4; ++m)
#pragma unroll
                for (int n = 0; n < 2; ++n) acc[a][b][m][n] = (f32x4){0.f, 0.f, 0.f, 0.f};
    bf16x8 At[4][2], B0[2][2], B1[2][2];
    const char* cA = (const char*)g.A + S.aoff(cur); const char* cB = (const char*)g.Bt + S.boff(cur);
    if constexpr (SP2) {
        PG8_STAGE(PG8_SB(0, 0), cB, voffB); PG8_STAGE(PG8_SB(0, 1), cB + hstepB, voffB); PG8_STAGE(PG8_SA(0, 0), cA, voffA); PG8_STAGE(PG8_SA(0, 1), cA + hstepA, voffA);
        if (wr == 1) PG8_BAR;
        PG8_WAIT_V(2); PG8_BAR;
        PG8_STAGE(PG8_SB(1, 0), cB + kstep, voffB); PG8_STAGE(PG8_SA(1, 0), cA + kstep, voffA); PG8_STAGE(PG8_SB(1, 1), cB + hstepB + kstep, voffB);
        PG8_WAIT_V(6); PG8_BAR;
    } else {
        PG8_STAGE(PG8_SB(0, 0), cB, voffB); PG8_STAGE(PG8_SA(0, 0), cA, voffA); PG8_STAGE(PG8_SB(0, 1), cB + hstepB, voffB); PG8_STAGE(PG8_SA(0, 1), cA + hstepA, voffA);
        if (wr == 1) PG8_BAR;
        PG8_WAIT_V(4); PG8_BAR;
        PG8_STAGE(PG8_SB(1, 0), cB + kstep, voffB); PG8_STAGE(PG8_SA(1, 0), cA + kstep, voffA); PG8_STAGE(PG8_SB(1, 1), cB + hstepB + kstep, voffB);
        PG8_WAIT_V(6); PG8_BAR;
    }
    for (;;) {
        const bool has_next = S.next(ui + 1, nxt);
        const char* nA = has_next ? (const char*)g.A + S.aoff(nxt) : cA; const char* nB = has_next ? (const char*)g.Bt + S.boff(nxt) : cB;
        for (int t = 0; t < nt; t += 2) {
            const bool last = (t == nt - 2);
            const char* a1 = cA + (size_t)(t + 1) * kstep;
            const char* a2 = last ? nA : cA + (size_t)(t + 2) * kstep; const char* b2 = last ? nB : cB + (size_t)(t + 2) * kstep;
            const char* a3 = a2 + kstep; const char* b3 = b2 + kstep;
            if constexpr (SP2) {
            PG8_LDB(B0, 0, 0); PG8_LDB(B1, 0, 1); PG8_SCHED; PG8_LDA(At, 0, 0); PG8_STAGE(PG8_SA(1, 1), a1 + hstepA, voffA);
            PG8_WAIT_V(8); PG8_WAIT_L(0); PG8_BAR; PG8_MMA(0, 0, At, B0); PG8_MMA(0, 1, At, B1); PG8_BAR; PG8_SCHED;
            PG8_LDA(At, 0, 1); PG8_STAGE(PG8_SB(0, 0), b2, voffB); PG8_STAGE(PG8_SB(0, 1), b2 + hstepB, voffB); PG8_STAGE(PG8_SA(0, 0), a2, voffA);
            PG8_WAIT_V(8); PG8_WAIT_L(0); PG8_BAR; PG8_MMA(1, 0, At, B0); PG8_MMA(1, 1, At, B1); PG8_BAR; PG8_SCHED;
            PG8_LDB(B0, 1, 0); PG8_LDB(B1, 1, 1); PG8_SCHED; PG8_LDA(At, 1, 0); PG8_STAGE(PG8_SA(0, 1), a2 + hstepA, voffA);
            PG8_WAIT_V(8); PG8_WAIT_L(0); PG8_BAR; PG8_MMA(0, 0, At, B0); PG8_MMA(0, 1, At, B1); PG8_BAR; PG8_SCHED;
            PG8_LDA(At, 1, 1); PG8_STAGE(PG8_SB(1, 0), b3, voffB); PG8_STAGE(PG8_SB(1, 1), b3 + hstepB, voffB); PG8_STAGE(PG8_SA(1, 0), a3, voffA);
            PG8_WAIT_V(8); PG8_WAIT_L(0); PG8_BAR; PG8_MMA(1, 0, At, B0); PG8_MMA(1, 1, At, B1); PG8_BAR; PG8_SCHED;
            } else {
            PG8_LDB(B0, 0, 0); PG8_SCHED; PG8_LDA(At, 0, 0); PG8_STAGE(PG8_SA(1, 1), a1 + hstepA, voffA);
            PG8_WAIT_L(8); PG8_BAR; PG8_WAIT_L(0); PG8_MMA(0, 0, At, B0); PG8_BAR; PG8_SCHED;
            PG8_LDB(B1, 0, 1); PG8_STAGE(PG8_SB(0, 0), b2, voffB);
            PG8_BAR; PG8_WAIT_L(0); PG8_MMA(0, 1, At, B1); PG8_BAR;
            PG8_LDA(At, 0, 1); PG8_STAGE(PG8_SA(0, 0), a2, voffA);
            PG8_BAR; PG8_WAIT_L(0); PG8_MMA(1, 0, At, B0); PG8_BAR; PG8_SCHED;
            PG8_STAGE(PG8_SB(0, 1), b2 + hstepB, voffB);
            PG8_WAIT_V(6); PG8_BAR; PG8_MMA(1, 1, At, B1); PG8_BAR;
            PG8_LDB(B0, 1, 0); PG8_SCHED; PG8_LDA(At, 1, 0); PG8_STAGE(PG8_SA(0, 1), a2 + hstepA, voffA);
            PG8_WAIT_L(8); PG8_BAR; PG8_WAIT_L(0); PG8_MMA(0, 0, At, B0); PG8_BAR; PG8_SCHED;
            PG8_LDB(B1, 1, 1); PG8_STAGE(PG8_SB(1, 0), b3, voffB);
            PG8_BAR; PG8_WAIT_L(0); PG8_MMA(0, 1, At, B1); PG8_BAR;
            PG8_LDA(At, 1, 1); PG8_STAGE(PG8_SA(1, 0), a3, voffA);
            PG8_BAR; PG8_WAIT_L(0); PG8_MMA(1, 0, At, B0); PG8_BAR; PG8_SCHED;
            PG8_STAGE(PG8_SB(1, 1), b3 + hstepB, voffB);
            PG8_WAIT_V(6); PG8_BAR; PG8_MMA(1, 1, At, B1); PG8_BAR;
            }
        }
        if constexpr (ALIGN_EPI) { if (wr == 0) PG8_BAR; }
        E(acc, cur, wr, wc, fr, fq);
        if (!has_next) break;
#pragma unroll
        for (int a = 0; a < 2; ++a)
#pragma unroll
            for (int b = 0; b < 2; ++b)
#pragma unroll
                for (int m = 0; m < 4; ++m)
#pragma unroll
                    for (int n = 0; n < 2; ++n) acc[a][b][m][n] = (f32x4){0.f, 0.f, 0.f, 0.f};
        cur = nxt; cA = nA; cB = nB; ++ui;
        if constexpr (ALIGN_EPI) { if (wr == 1) PG8_BAR; }
    }
    PG8_WAIT_V(0);
    if constexpr (!ALIGN_EPI) { if (wr == 0) PG8_BAR; }
    PG8_BAR;
#undef PG8_SA
#undef PG8_SB
#undef PG8_STAGE
#undef PG8_LDA
#undef PG8_LDB
#undef PG8_MMA
#undef PG8_WAIT_V
#undef PG8_WAIT_L
#undef PG8_BAR
#undef PG8_SCHED
}

struct EpiF32 {
    static constexpr bool PERM = false;
    float* C; int ldc;
    __device__ __forceinline__ void operator()(const f32x4 (&acc)[2][2][4][2], const Unit& u, int wr, int wc, int fr, int fq) const {
        const int row0 = u.pm * BM + wr * 64 + fr, col0 = u.pn * BM + wc * 32 + 4 * fq;
#pragma unroll
        for (int ai = 0; ai < 2; ++ai)
#pragma unroll
            for (int m = 0; m < 4; ++m) { float* rowp = C + (size_t)(row0 + ai * HALF + m * 16) * ldc + col0;
#pragma unroll
                for (int bj = 0; bj < 2; ++bj)
#pragma unroll
                    for (int n = 0; n < 2; ++n) *(f32x4*)(rowp + bj * HALF + n * 16) = acc[ai][bj][m][n]; }
    }
};
struct EpiPool {
    static constexpr bool PERM = true;
    bf16_t* O; const float* scale;
    __device__ __forceinline__ void operator()(const f32x4 (&acc)[2][2][4][2], const Unit& u, int wr, int wc, int fr, int fq) const {
        const int row0 = u.pm * BM + wr * 64 + fr, col0 = u.pn * BM + wc * 32 + 8 * fq;
        f32x4 sv[2][2];
#pragma unroll
        for (int bj = 0; bj < 2; ++bj)
#pragma unroll
            for (int n = 0; n < 2; ++n) sv[bj][n] = *(const f32x4*)(scale + col0 + bj * HALF + 4 * n);
#pragma unroll
        for (int ai = 0; ai < 2; ++ai)
#pragma unroll
            for (int m = 0; m < 4; ++m) { bf16_t* rowp = O + (size_t)(row0 + ai * HALF + m * 16) * 2048 + 1024 + col0;
#pragma unroll
                for (int bj = 0; bj < 2; ++bj) { const f32x4 v0 = acc[ai][bj][m][0] * sv[bj][0], v1 = acc[ai][bj][m][1] * sv[bj][1];
                    u32x4 w; w.x = cvt_pk_bf16(v0[0], v0[1]); w.y = cvt_pk_bf16(v0[2], v0[3]); w.z = cvt_pk_bf16(v1[0], v1[1]); w.w = cvt_pk_bf16(v1[2], v1[3]);
                    *(u32x4*)(rowp + bj * HALF) = w; } }
    }
};
struct EpiSwiglu {
    static constexpr bool PERM = true;
    bf16_t* O; const float* b1;
    __device__ __forceinline__ void operator()(const f32x4 (&acc)[2][2][4][2], const Unit& u, int wr, int wc, int fr, int fq) const {
        const int e = u.pn >> 4, nt = u.pn & 15;
        const int row0 = u.pm * BM + wr * 64 + fr, col0 = nt * BM + wc * 32 + 8 * fq;
        const float* bp = b1 + (size_t)e * 4096 + col0;
        f32x4 bv[2][2];
#pragma unroll
        for (int bj = 0; bj < 2; ++bj)
#pragma unroll
            for (int n = 0; n < 2; ++n) bv[bj][n] = *(const f32x4*)(bp + bj * HALF + 4 * n);
#pragma unroll
        for (int ai = 0; ai < 2; ++ai)
#pragma unroll
            for (int m = 0; m < 4; ++m) { bf16_t* rowp = O + (size_t)(row0 + ai * HALF + m * 16) * 2048 + (col0 >> 1);
#pragma unroll
                for (int bj = 0; bj < 2; ++bj) { const f32x4 v0 = acc[ai][bj][m][0] + bv[bj][0], v1 = acc[ai][bj][m][1] + bv[bj][1];
                    float a[4];
#pragma unroll
                    for (int p = 0; p < 4; ++p) { const float hg = p < 2 ? v0[2 * p] : v1[2 * p - 4], hl = p < 2 ? v0[2 * p + 1] : v1[2 * p - 3];
                        const float xg = fminf(hg, 7.0f), xl = fminf(fmaxf(hl, -7.0f), 7.0f);
                        a[p] = xg * __builtin_amdgcn_rcpf(1.0f + __expf(-1.702f * xg)) * (xl + 1.0f); }
                    v2u w; w.x = cvt_pk_bf16(a[0], a[1]); w.y = cvt_pk_bf16(a[2], a[3]);
                    *(v2u*)(rowp + bj * (HALF / 2)) = w; } }
    }
};
struct EpiBias16 {
    static constexpr bool PERM = true;
    bf16_t* O; const float* b2;
    __device__ __forceinline__ void operator()(const f32x4 (&acc)[2][2][4][2], const Unit& u, int wr, int wc, int fr, int fq) const {
        const int e = u.pn >> 3, nt = u.pn & 7;
        const int row0 = u.pm * BM + wr * 64 + fr, col0 = nt * BM + wc * 32 + 8 * fq;
        const float* bp = b2 + (size_t)e * 2048 + col0;
        f32x4 bv[2][2];
#pragma unroll
        for (int bj = 0; bj < 2; ++bj)
#pragma unroll
            for (int n = 0; n < 2; ++n) bv[bj][n] = *(const f32x4*)(bp + bj * HALF + 4 * n);
#pragma unroll
        for (int ai = 0; ai < 2; ++ai)
#pragma unroll
            for (int m = 0; m < 4; ++m) { bf16_t* rowp = O + (size_t)(row0 + ai * HALF + m * 16) * 2048 + col0;
#pragma unroll
                for (int bj = 0; bj < 2; ++bj) { const f32x4 v0 = acc[ai][bj][m][0] + bv[bj][0], v1 = acc[ai][bj][m][1] + bv[bj][1];
                    u32x4 w; w.x = cvt_pk_bf16(v0[0], v0[1]); w.y = cvt_pk_bf16(v0[2], v0[3]); w.z = cvt_pk_bf16(v1[0], v1[1]); w.w = cvt_pk_bf16(v1[2], v1[3]);
                    *(u32x4*)(rowp + bj * HALF) = w; } }
    }
};
}

#define XB_TMO      128
#define XB_XCNT(j)  (256  + 64 * (j))
#define XB_XSUB(j)  (1280 + 64 * (j))
#define XB_XGEN(j)  (2304 + 64 * (j))
#define XB_TOP      3328
#define XB_TOPGEN   3392
#define XCD_BAR_WORDS 3456
#define XB_SPIN_CAP (1u << 22)
__device__ __forceinline__ unsigned xb_ld(unsigned* p)              { return __hip_atomic_load(p, __ATOMIC_RELAXED, __HIP_MEMORY_SCOPE_AGENT); }
__device__ __forceinline__ unsigned xb_add(unsigned* p, unsigned v) { return __hip_atomic_fetch_add(p, v, __ATOMIC_RELAXED, __HIP_MEMORY_SCOPE_AGENT); }
__device__ __forceinline__ unsigned xb_xcc_id() { return (unsigned)__builtin_amdgcn_s_getreg((3 << 11) | 20) & 0xFu; }
#define XB_SPIN(cond, bar) do { unsigned _sp = 0; while (cond) { __builtin_amdgcn_s_sleep(1); \
    if ((++_sp & 255u) == 0u) { if (xb_ld(&(bar)[XB_TMO])) break; if (_sp > XB_SPIN_CAP) { atomicAdd(&(bar)[XB_TMO], 1u); break; } } } } while (0)
struct XcdBarrier { unsigned* bar; unsigned x; volatile LAS unsigned* st; };
__device__ __forceinline__ XcdBarrier xcd_barrier_post(unsigned* bar, volatile LAS unsigned* st) {
    XcdBarrier b; b.bar = bar; b.x = xb_xcc_id(); b.st = st;
    if (threadIdx.x == 0) (void)xb_add(&bar[XB_XCNT(b.x)], 1u);
    return b;
}
__device__ __forceinline__ void xcd_barrier_complete(unsigned* bar, unsigned x, unsigned& nloc, unsigned& nx) {
    const unsigned G = gridDim.x * gridDim.y * gridDim.z;
    unsigned sum, cnt, mine, sp = 0u;
    for (;;) {
        sum = 0u; cnt = 0u; mine = 0u;
#pragma unroll
        for (unsigned j = 0; j < 16; ++j) { const unsigned c = xb_ld(&bar[XB_XCNT(j)]); sum += c; cnt += (c > 0u) ? 1u : 0u; mine = (j == x) ? c : mine; }
        if (sum == G) break;
        __builtin_amdgcn_s_sleep(1);
        if ((++sp & 255u) == 0u) { if (xb_ld(&bar[XB_TMO])) break; if (sp > XB_SPIN_CAP) { atomicAdd(&bar[XB_TMO], 1u); break; } }
    }
    nloc = mine > 0u ? mine : 1u; nx = cnt > 0u ? cnt : 1u;
}
__device__ __forceinline__ void xcd_barrier(const XcdBarrier& b) {
    asm volatile("s_waitcnt vmcnt(0)" ::: "memory");
    __syncthreads();
    if (threadIdx.x == 0) {
        unsigned* bar = b.bar;
        __builtin_amdgcn_s_waitcnt(0);
        unsigned nloc = b.st[0], nx = b.st[1];
        if (nloc == 0u) { xcd_barrier_complete(bar, b.x, nloc, nx); b.st[0] = nloc; b.st[1] = nx; }
        const unsigned old = xb_add(&bar[XB_XSUB(b.x)], 1u);
        const unsigned gen = old / nloc;
        if (old + 1u == (gen + 1u) * nloc) {
            __builtin_amdgcn_fence(__ATOMIC_RELEASE, "agent");
            asm volatile("s_waitcnt vmcnt(0)" ::: "memory");
            const unsigned og = xb_add(&bar[XB_TOP], 1u);
            const unsigned tg = og / nx;
            if (og + 1u == (tg + 1u) * nx) xb_add(&bar[XB_TOPGEN], 1u);
            else XB_SPIN(xb_ld(&bar[XB_TOPGEN]) == tg, bar);
            __builtin_amdgcn_fence(__ATOMIC_ACQUIRE, "agent");
            xb_add(&bar[XB_XGEN(b.x)], 1u);
            asm volatile("s_waitcnt vmcnt(0)" ::: "memory");
        } else {
            XB_SPIN(xb_ld(&bar[XB_XGEN(b.x)]) == gen, bar);
            __builtin_amdgcn_fence(__ATOMIC_ACQUIRE, "agent");
            asm volatile("s_waitcnt vmcnt(0)" ::: "memory");
        }
    }
    __syncthreads();
}

constexpr size_t al256(size_t x) { return (x + 255) & ~(size_t)255; }
constexpr size_t WS_CTL = 0, CTL_BYTES = 1u << 20;
constexpr int CW_BAR = 4096;
constexpr int CW_CNT = 16384;
constexpr size_t WS_SLOTTOK = WS_CTL + CTL_BYTES;
constexpr size_t WS_TOPI = WS_SLOTTOK + al256((size_t)NSLOT_MAX * 4);
constexpr size_t WS_GATE = WS_TOPI + (size_t)NASG * 4;
constexpr size_t WS_POS = WS_GATE + (size_t)NASG * 4;
constexpr size_t WS_SLOTOF = WS_POS + (size_t)NASG * 4;
constexpr size_t WS_BONUS = WS_SLOTOF + (size_t)NASG * 4;
constexpr size_t WS_XB = WS_BONUS + (size_t)M * 16 * 4;
constexpr size_t WS_WINT = WS_XB + (size_t)M * D * 2;
constexpr size_t WS_WOUTT = WS_WINT + (size_t)IN_PAD * D * 2;
constexpr size_t WS_LORAT = WS_WOUTT + (size_t)D * D * 2;
constexpr size_t WS_WPOOLT = WS_LORAT + (size_t)3072 * LK * 2;
constexpr size_t WS_PROJ = WS_WPOOLT + (size_t)1024 * 256 * 2;
constexpr size_t WS_LIN = WS_PROJ + (size_t)M * IN_PAD * 4;
constexpr size_t WS_POOLED = WS_LIN + (size_t)M * LK * 2;
constexpr size_t WS_WDEC = WS_POOLED + (size_t)M * 1024 * 2;
constexpr size_t SZ_F1K = (size_t)M * 1024 * 4;
constexpr size_t WS_LOUT = WS_WDEC + SZ_F1K  , WS_R = WS_LOUT + 3 * SZ_F1K, WS_K2 = WS_R + SZ_F1K, WS_V = WS_K2 + SZ_F1K, WS_KK = WS_V + SZ_F1K, WS_BB = WS_KK + SZ_F1K, WS_Y = WS_BB + SZ_F1K;
constexpr size_t WS_MIXIN = WS_Y + SZ_F1K;
constexpr size_t WS_MIX = WS_MIXIN + (size_t)M * D * 2;
constexpr size_t WS_H = WS_MIX + (size_t)M * D * 4;
constexpr size_t WS_HB = WS_H + (size_t)M * D * 4;
constexpr size_t WS_XS = WS_HB + (size_t)M * D * 2;
constexpr size_t WS_W1T = WS_XS + (size_t)NSLOT_MAX * D * 2;
constexpr size_t WS_W2T = WS_W1T + (size_t)NE * 4096 * D * 2;
constexpr size_t WS_ACT = WS_W2T + (size_t)NE * 2048 * DFF * 2;
constexpr size_t WS_YS = WS_ACT + (size_t)NSLOT_MAX * DFF * 2;
constexpr size_t WS_END = WS_YS + (size_t)NSLOT_MAX * D * 2;

constexpr int RING_BYTES = 131072;
constexpr int LDSCTL_OFF = RING_BYTES;
constexpr int LDS_BYTES = 147456;

struct Args { const float* in[26]; float* out; unsigned char* ws; int ph_lo, ph_hi; };

__device__ __forceinline__ void transpose_item(const float* W, int K, int N, bf16* WT, size_t row_off, LAS float* scr, int item, int lane) {
    const int nblk = N / 32, kb = item / nblk, nb = item % nblk, k0 = 64 * kb, n0 = 32 * nb;
#pragma unroll 8
    for (int i = 0; i < 32; ++i) { const int kk = 2 * i + (lane >> 5); scr[kk * 33 + (lane & 31)] = W[(size_t)(k0 + kk) * N + n0 + (lane & 31)]; }
    LDS_WAIT(); asm volatile("" ::: "memory");
    const int c = lane & 7;
#pragma unroll
    for (int j = 0; j < 4; ++j) { const int n = (lane >> 3) + 8 * j; const LAS float* s = scr + (8 * c) * 33 + n;
        v4u o; o.x = pk2(s[0 * 33], s[1 * 33]); o.y = pk2(s[2 * 33], s[3 * 33]); o.z = pk2(s[4 * 33], s[5 * 33]); o.w = pk2(s[6 * 33], s[7 * 33]);
        *(GAS v4u*)(WT + (row_off + n0 + n) * (size_t)K + k0 + 8 * c) = o; }
    LDS_WAIT(); asm volatile("" ::: "memory");
}

__global__ void __launch_bounds__(NTHR, 2) mk_fwd(Args args) {
    extern __shared__ __attribute__((aligned(16))) unsigned char lds_raw[];
    LAS unsigned char* lds = (LAS unsigned char*)lds_raw;
    volatile LAS unsigned* MISC = (volatile LAS unsigned*)(lds + LDSCTL_OFF);
    LAS int* PS = (LAS int*)(lds + LDSCTL_OFF + 256);
    const int tid = threadIdx.x, lane = tid & 63, wave = __builtin_amdgcn_readfirstlane(tid >> 6);
    const int G = gridDim.x, bx = blockIdx.x;
    const int vcu = (bx % 8) * (G / 8) + bx / 8;
    const int gw = vcu * NWAVES + wave, NGW = G * NWAVES;
    unsigned char* ws = args.ws;
    gu32* ctl = (gu32*)(ws + WS_CTL);
    const float* x = args.in[0]; const float* w_in = args.in[1]; const float* mu = args.in[2]; const float* w0 = args.in[3]; const float* w2d = args.in[4];
    const float* a0 = args.in[5]; const float* a2 = args.in[6]; const float* g2 = args.in[7]; const float* k_k = args.in[8]; const float* k_a = args.in[9];
    const float* r_k = args.in[10]; const float* lnx_w = args.in[11]; const float* lnx_b = args.in[12]; const float* w_pool = args.in[13]; const float* pool_scale = args.in[14];
    const float* w_out = args.in[15]; const float* ln1_w = args.in[16]; const float* ln1_b = args.in[17]; const float* router_w = args.in[18]; const float* router_b = args.in[19];
    const float* w1 = args.in[20]; const float* b1 = args.in[21]; const float* w2 = args.in[22]; const float* b2 = args.in[23]; const float* ln2_w = args.in[24]; const float* ln2_b = args.in[25];
    float* out = args.out;
    int* cnt = (int*)(ws + WS_CTL) + CW_CNT;
    int* slot_tok = (int*)(ws + WS_SLOTTOK); int* TOPI = (int*)(ws + WS_TOPI); float* GATE = (float*)(ws + WS_GATE); int* POS = (int*)(ws + WS_POS); int* SLOT_OF = (int*)(ws + WS_SLOTOF);
    float* BONUS = (float*)(ws + WS_BONUS);
    bf16* XB = (bf16*)(ws + WS_XB); bf16* WINT = (bf16*)(ws + WS_WINT); bf16* WOUTT = (bf16*)(ws + WS_WOUTT); bf16* LORAT = (bf16*)(ws + WS_LORAT); bf16* WPOOLT = (bf16*)(ws + WS_WPOOLT);
    float* PROJ = (float*)(ws + WS_PROJ); bf16* LIN = (bf16*)(ws + WS_LIN); bf16* POOLED = (bf16*)(ws + WS_POOLED);
    float* WDEC = (float*)(ws + WS_WDEC); float* LOUT = (float*)(ws + WS_LOUT); float* Rr = (float*)(ws + WS_R); float* K2 = (float*)(ws + WS_K2);
    float* Vv = (float*)(ws + WS_V); float* KK = (float*)(ws + WS_KK); float* BB = (float*)(ws + WS_BB); float* Yy = (float*)(ws + WS_Y);
    bf16* MIXIN = (bf16*)(ws + WS_MIXIN); float* MIX = (float*)(ws + WS_MIX); float* H = (float*)(ws + WS_H); bf16* HB = (bf16*)(ws + WS_HB);
    bf16* XS = (bf16*)(ws + WS_XS); bf16* W1T = (bf16*)(ws + WS_W1T); bf16* W2T = (bf16*)(ws + WS_W2T); bf16* ACT = (bf16*)(ws + WS_ACT); bf16* YS = (bf16*)(ws + WS_YS);

    for (int u = tid; u < (LDS_BYTES - LDSCTL_OFF) / 4; u += NTHR) ((LAS unsigned*)(lds + LDSCTL_OFF))[u] = 0u;
    __syncthreads();
    XcdBarrier bar; bar.bar = (unsigned*)(ctl + CW_BAR); bar.x = 0; bar.st = nullptr;
    if (MK_N_LAUNCHES == 1) bar = xcd_barrier_post((unsigned*)(ctl + CW_BAR), MISC + 8);
    const int lo = args.ph_lo, hi = args.ph_hi;
#ifndef PHASE_MASK
#define PHASE_MASK 0xFFFF
#endif
#define IN(k) (((PHASE_MASK >> (k)) & 1) && lo <= (k) && (k) < hi)
#define SEAM(k) do { if (IN(k) && IN((k) + 1)) xcd_barrier(bar); } while (0)

    if (IN(0)) {
        LAS float* scr = (LAS float*)(lds + wave * 16384);
        for (size_t i = (size_t)gw * 64 + lane; i < (size_t)M * D / 8; i += (size_t)NGW * 64) {
            const f32x4 a = *(const GAS f32x4*)(x + i * 8), b = *(const GAS f32x4*)(x + i * 8 + 4);
            v4u o; o.x = pk2(a.x, a.y); o.y = pk2(a.z, a.w); o.z = pk2(b.x, b.y); o.w = pk2(b.z, b.w);
            *(GAS v4u*)(XB + i * 8) = o;
        }
        constexpr int I_IN = (D / 64) * (IN_COLS / 32), I_OUT = (D / 64) * (D / 32);
        for (int it = gw; it < I_IN + I_OUT; it += NGW) {
            if (it < I_IN) transpose_item(w_in, D, IN_COLS, WINT, 0, scr, it, lane);
            else transpose_item(w_out, D, D, WOUTT, 0, scr, it - I_IN, lane);
        }
        for (size_t i = (size_t)gw * 64 + lane; i < (size_t)(IN_PAD - IN_COLS) * D / 8; i += (size_t)NGW * 64) *(GAS v4u*)(WINT + (size_t)IN_COLS * D + i * 8) = (v4u){0u, 0u, 0u, 0u};
        for (int i = gw * 64 + lane; i < 3072 * LK; i += NGW * 64) {
            const int n = i / LK, k = i % LK; float v = 0.f;
            if (n < 1024) { if (k < 64) v = w2d[k * 1024 + n]; }
            else if (n < 2048) { if (k >= 64 && k < 128) v = a2[(k - 64) * 1024 + (n - 1024)]; }
            else { if (k >= 128 && k < 288) v = g2[(k - 128) * 1024 + (n - 2048)]; }
            LORAT[i] = (bf16)f2bf(v);
        }
        for (int i = gw * 64 + lane; i < 1024 * 256; i += NGW * 64) {
            const int n = i >> 8, c = i & 255, g = n >> 8, d = n & 255;
            WPOOLT[i] = (bf16)f2bf(w_pool[((size_t)g * 256 + c) * 256 + d]);
        }
    }
    SEAM(0);

    if (IN(1)) {
        pg8::Gemm g{XB, WINT, D, D}; pg8::GridOrder S; S.init(M / 256, IN_PAD / 256, G, bx, (size_t)256 * D * 2, 0, (size_t)256 * D * 2);
        pg8::EpiF32 E{PROJ, IN_PAD};
        pg8::gemm_phase<pg8::EpiF32, pg8::GridOrder, true, true>(lds, g, S, E);
    }
    SEAM(1);

    if (IN(2)) {
        for (int m = gw; m < M; m += NGW) {
            const int t = m % SEQ;
            const float* pr = PROJ + (size_t)m * IN_PAD; const float* pp = pr - IN_PAD;
#pragma unroll
            for (int q = 0; q < 6; ++q) {
                const int i = lane + 64 * q; float v = 0.f;
                if (i < 288) { const int c = 3072 + i; const float cur = pr[c], prev = t > 0 ? pp[c] : 0.f; const float s = cur + (prev - cur) * mu[c];
                    v = i < 64 ? tanhf(s) : (i < 128 ? s : 1.0f / (1.0f + __expf(-s))); }
                LIN[(size_t)m * LK + i] = (bf16)f2bf(v);
            }
#pragma unroll
            for (int q = 0; q < 4; ++q) {
                const int c = 4 * lane + 256 * q, win = 2 << q; const int n = (t + 1) < win ? (t + 1) : win;
                const f32x4 cur = *(const GAS f32x4*)(pr + SHIFT_W + c); f32x4 sum = cur;
                for (int s = 1; s < n; ++s) sum += *(const GAS f32x4*)(pr - (size_t)s * IN_PAD + SHIFT_W + c);
                const float inv = 1.0f / (float)n; const f32x4 pv = sum * inv - cur;
                v2u o; o.x = pk2(pv.x, pv.y); o.y = pk2(pv.z, pv.w);
                *(GAS v2u*)(POOLED + (size_t)m * 1024 + c) = o;
            }
        }
    }
    SEAM(2);

    if (IN(3)) {
        { pg8::Gemm g{LIN, LORAT, LK, LK}; pg8::GridOrder S; S.init(M / 256, 12, G, bx, (size_t)256 * LK * 2, 0, (size_t)256 * LK * 2);
          pg8::EpiF32 E{LOUT, 3072};
          pg8::gemm_phase<pg8::EpiF32, pg8::GridOrder, true, true>(lds, g, S, E); }
        { pg8::Gemm g{POOLED, WPOOLT, 1024, 256}; pg8::GridOrder S; S.init(M / 256, 4, G, bx, (size_t)256 * 1024 * 2, (size_t)256 * 2, (size_t)256 * 256 * 2);
          pg8::EpiPool E{MIXIN, pool_scale};
          pg8::gemm_phase<pg8::EpiPool, pg8::GridOrder, true, true>(lds, g, S, E); }
    }
    SEAM(3);

    if (IN(4)) {
        for (int m = gw; m < M; m += NGW) {
            const int t = m % SEQ;
            const float* pr = PROJ + (size_t)m * IN_PAD; const float* pp = pr - IN_PAD;
#pragma unroll
            for (int q = 0; q < 4; ++q) {
                const int c = 4 * lane + 256 * q; const size_t o = (size_t)m * 1024 + c;
                f32x4 r = *(const GAS f32x4*)(pr + c), k = *(const GAS f32x4*)(pr + 1024 + c), v = *(const GAS f32x4*)(pr + 2048 + c);
                f32x4 rp = (f32x4){0.f, 0.f, 0.f, 0.f}, kp = rp, vp = rp;
                if (t > 0) { rp = *(const GAS f32x4*)(pp + c); kp = *(const GAS f32x4*)(pp + 1024 + c); vp = *(const GAS f32x4*)(pp + 2048 + c); }
                r = r + (rp - r) * *(const GAS f32x4*)(mu + c); k = k + (kp - k) * *(const GAS f32x4*)(mu + 1024 + c); v = v + (vp - v) * *(const GAS f32x4*)(mu + 2048 + c);
                const f32x4 wl = *(const GAS f32x4*)(LOUT + (size_t)m * 3072 + c) + *(const GAS f32x4*)(w0 + c);
                const f32x4 al = *(const GAS f32x4*)(LOUT + (size_t)m * 3072 + 1024 + c) + *(const GAS f32x4*)(a0 + c);
                f32x4 a, dec;
#pragma unroll
                for (int j = 0; j < 4; ++j) { const float z = -wl[j]; const float sp = fmaxf(z, 0.f) + __logf(1.0f + __expf(-fabsf(z))); dec[j] = __expf(-__expf(-sp - 0.5f)); a[j] = 1.0f / (1.0f + __expf(-al[j])); }
                *(GAS f32x4*)(WDEC + o) = dec;
                f32x4 kk = k * *(const GAS f32x4*)(k_k + c);
                const float ss = row16_sum(kk.x * kk.x + kk.y * kk.y + kk.z * kk.z + kk.w * kk.w);
                kk = kk * __builtin_amdgcn_rsqf(fmaxf(ss, 1e-24f));
                const f32x4 k2 = k * (1.0f + (a - 1.0f) * *(const GAS f32x4*)(k_a + c));
                const f32x4 rk = *(const GAS f32x4*)(r_k + c);
                const float bon = row16_sum(r.x * k2.x * rk.x + r.y * k2.y * rk.y + r.z * k2.z * rk.z + r.w * k2.w * rk.w);
                *(GAS f32x4*)(Rr + o) = r; *(GAS f32x4*)(K2 + o) = k2; *(GAS f32x4*)(Vv + o) = v; *(GAS f32x4*)(KK + o) = kk; *(GAS f32x4*)(BB + o) = kk * a;
                if ((lane & 15) == 0) BONUS[m * 16 + (c >> 6)] = bon;
            }
        }
    }
    SEAM(4);

    if (IN(5)) {
        const int xcd_i = bx % 8, slot_i = bx / 8;
        if (slot_i < 16) {
            const int sid = xcd_i * 16 + slot_i, hd = sid >> 1, half = sid & 1, b = hd >> 4, h = hd & 15;
            LAS float* OPS = (LAS float*)lds;
            LAS float* VVs = (LAS float*)(lds + 81920);
            LAS float* YBs = (LAS float*)(lds + 81920 + 8192);
            const int r4 = lane >> 4, jq = lane & 15;
            const int tl = tid >> 4, j4 = (tid & 15) * 4;
            const int vt = tid >> 3, vi4 = (tid & 7) * 4;
            const size_t gbase = ((size_t)b * SEQ) * 1024 + h * 64;
            const float* arr[5] = {KK, WDEC, BB, K2, Rr};
            f32x4 st[5]; f32x4 sv = (f32x4){0.f, 0.f, 0.f, 0.f};
#pragma unroll
            for (int a = 0; a < 5; ++a) st[a] = *(const GAS f32x4*)(arr[a] + gbase + (size_t)tl * 1024 + j4);
            if (tid < 256) sv = *(const GAS f32x4*)(Vv + gbase + (size_t)vt * 1024 + half * 32 + vi4);
#pragma unroll
            for (int a = 0; a < 5; ++a) *(LAS f32x4*)(OPS + (a * 32 + tl) * 64 + j4) = st[a];
            if (tid < 256) *(LAS f32x4*)(VVs + vt * 32 + vi4) = sv;
            __syncthreads();
            float S0 = 0.f, S1 = 0.f, S2 = 0.f, S3 = 0.f;
            for (int c = 0; c < SEQ / 32; ++c) {
                const int buf = c & 1;
                if (c + 1 < SEQ / 32) {
                    const size_t gb = gbase + (size_t)(c + 1) * 32 * 1024;
#pragma unroll
                    for (int a = 0; a < 5; ++a) st[a] = *(const GAS f32x4*)(arr[a] + gb + (size_t)tl * 1024 + j4);
                    if (tid < 256) sv = *(const GAS f32x4*)(Vv + gb + (size_t)vt * 1024 + half * 32 + vi4);
                }
                const LAS float* ob = OPS + buf * (5 * 32 * 64) + 4 * jq;
                const LAS float* vb = VVs + buf * 1024 + 4 * wave + r4;
                LAS float* yb = YBs + buf * 1024 + 4 * wave + r4;
#pragma unroll 4
                for (int t = 0; t < 32; ++t) {
                    const f32x4 a4 = *(const LAS f32x4*)(ob + (0 * 32 + t) * 64), w4 = *(const LAS f32x4*)(ob + (1 * 32 + t) * 64), b4 = *(const LAS f32x4*)(ob + (2 * 32 + t) * 64),
                                k4 = *(const LAS f32x4*)(ob + (3 * 32 + t) * 64), q4 = *(const LAS f32x4*)(ob + (4 * 32 + t) * 64);
                    const float v = vb[t * 32];
                    float p = S0 * a4.x; p += S1 * a4.y; p += S2 * a4.z; p += S3 * a4.w;
                    const float sa = -row16_sum(p);
                    S0 = S0 * w4.x + (sa * b4.x + v * k4.x); S1 = S1 * w4.y + (sa * b4.y + v * k4.y); S2 = S2 * w4.z + (sa * b4.z + v * k4.z); S3 = S3 * w4.w + (sa * b4.w + v * k4.w);
                    float y = S0 * q4.x; y += S1 * q4.y; y += S2 * q4.z; y += S3 * q4.w;
                    y = row16_sum(y);
                    if (jq == 0) yb[t * 32] = y;
                }
                if (c + 1 < SEQ / 32) {
                    const int nb = buf ^ 1;
#pragma unroll
                    for (int a = 0; a < 5; ++a) *(LAS f32x4*)(OPS + nb * (5 * 32 * 64) + (a * 32 + tl) * 64 + j4) = st[a];
                    if (tid < 256) *(LAS f32x4*)(VVs + nb * 1024 + vt * 32 + vi4) = sv;
                }
                __syncthreads();
                if (tid < 256) *(GAS f32x4*)(Yy + gbase + (size_t)(c * 32 + vt) * 1024 + half * 32 + vi4) = *(const LAS f32x4*)(YBs + buf * 1024 + vt * 32 + vi4);
            }
        } else {
            LAS float* scr = (LAS float*)(lds + wave * 16384);
            const int cw = (xcd_i * 16 + slot_i - 16) * NWAVES + wave;
            constexpr int I1 = (D / 64) * (4096 / 32), I2 = (DFF / 64) * (D / 32), IPE = I1 + I2;
            for (int it = cw; it < NE * IPE; it += 128 * NWAVES) {
                const int e = it / IPE, r = it % IPE;
                if (r < I1) transpose_item(w1 + (size_t)e * D * 4096, D, 4096, W1T, (size_t)e * 4096, scr, r, lane);
                else transpose_item(w2 + (size_t)e * DFF * D, DFF, D, W2T, (size_t)e * 2048, scr, r - I1, lane);
            }
        }
    }
    SEAM(5);

    if (IN(6)) {
        for (int m = gw; m < M; m += NGW) {
#pragma unroll
            for (int q = 0; q < 4; ++q) {
                const int c = 4 * lane + 256 * q; const size_t o = (size_t)m * 1024 + c;
                const f32x4 y = *(const GAS f32x4*)(Yy + o);
                const float mean = row16_sum(y.x + y.y + y.z + y.w) * (1.0f / 64.0f);
                const f32x4 d = y - mean;
                const float var = row16_sum(d.x * d.x + d.y * d.y + d.z * d.z + d.w * d.w) * (1.0f / 64.0f);
                const float rstd = __builtin_amdgcn_rsqf(var + GN_EPS);
                f32x4 yn = d * rstd * *(const GAS f32x4*)(lnx_w + c) + *(const GAS f32x4*)(lnx_b + c);
                yn = yn + BONUS[m * 16 + (c >> 6)] * *(const GAS f32x4*)(Vv + o);
                yn = yn * *(const GAS f32x4*)(LOUT + (size_t)m * 3072 + 2048 + c);
                v2u ov; ov.x = pk2(yn.x, yn.y); ov.y = pk2(yn.z, yn.w);
                *(GAS v2u*)(MIXIN + (size_t)m * 2048 + c) = ov;
            }
        }
    }
    SEAM(6);

    if (IN(7)) {
        pg8::Gemm g{MIXIN, WOUTT, D, D}; pg8::GridOrder S; S.init(M / 256, D / 256, G, bx, (size_t)256 * D * 2, 0, (size_t)256 * D * 2);
        pg8::EpiF32 E{MIX, D};
        pg8::gemm_phase<pg8::EpiF32, pg8::GridOrder, true, true>(lds, g, S, E);
    }
    SEAM(7);

    if (IN(8)) {
        LAS float* s_h = (LAS float*)lds;
        LAS float* s_part = (LAS float*)(lds + 65536);
        const int e = tid & 31, part = tid >> 5;
        float wreg[128];
#pragma unroll
        for (int i = 0; i < 128; ++i) wreg[i] = router_w[(size_t)(part * 128 + i) * 32 + e];
        for (int m0 = vcu * 8; m0 < M; m0 += G * 8) {
            const int m = m0 + wave;
            {
                f32x4 v[8]; float s = 0.f;
#pragma unroll
                for (int q = 0; q < 8; ++q) { const int c = 4 * lane + 256 * q; v[q] = ALPHA * *(const GAS f32x4*)(x + (size_t)m * D + c) + *(const GAS f32x4*)(MIX + (size_t)m * D + c); s += (v[q].x + v[q].y) + (v[q].z + v[q].w); }
                const float mean = wave_sum(s) * (1.0f / D); float s2 = 0.f;
#pragma unroll
                for (int q = 0; q < 8; ++q) { v[q] = v[q] - mean; s2 += (v[q].x * v[q].x + v[q].y * v[q].y) + (v[q].z * v[q].z + v[q].w * v[q].w); }
                const float rstd = 1.0f / sqrtf(wave_sum(s2) * (1.0f / D) + LN_EPS);
#pragma unroll
                for (int q = 0; q < 8; ++q) { const int c = 4 * lane + 256 * q;
                    const f32x4 hv = v[q] * rstd * *(const GAS f32x4*)(ln1_w + c) + *(const GAS f32x4*)(ln1_b + c);
                    *(GAS f32x4*)(H + (size_t)m * D + c) = hv; *(LAS f32x4*)(s_h + wave * 2048 + c) = hv;
                    v2u ov; ov.x = pk2(hv.x, hv.y); ov.y = pk2(hv.z, hv.w); *(GAS v2u*)(HB + (size_t)m * D + c) = ov; }
            }
            __syncthreads();
#pragma unroll 1
            for (int tk = 0; tk < 8; ++tk) {
                const LAS float* hp = s_h + tk * 2048 + part * 128; float acc = 0.f;
#pragma unroll
                for (int i = 0; i < 32; ++i) { const f32x4 hv = *(const LAS f32x4*)(hp + 4 * i); acc += hv.x * wreg[4 * i]; acc += hv.y * wreg[4 * i + 1]; acc += hv.z * wreg[4 * i + 2]; acc += hv.w * wreg[4 * i + 3]; }
                s_part[(tk * 16 + part) * 32 + e] = acc;
            }
            __syncthreads();
            {
                float lg = -3.0e38f;
                if (lane < 32) { lg = router_b[lane];
#pragma unroll
                    for (int p = 0; p < 16; ++p) lg += s_part[(wave * 16 + p) * 32 + lane]; }
                int idx[4]; float val[4];
#pragma unroll
                for (int k = 0; k < 4; ++k) {
                    float best = lg; int bi = lane;
#pragma unroll
                    for (int o = 1; o < 64; o <<= 1) { const float ob = __shfl_xor(best, o); const int oi = __shfl_xor(bi, o); const bool take = (ob > best) || (ob == best && oi < bi); best = take ? ob : best; bi = take ? oi : bi; }
                    idx[k] = bi; val[k] = best; if (lane == bi) lg = -3.0e38f;
                }
                if (lane == 0) {
                    float ex[4], se = 0.f;
#pragma unroll
                    for (int k = 0; k < 4; ++k) { ex[k] = __expf(val[k] - val[0]); se += ex[k]; }
                    const float inv = 1.0f / se;
#pragma unroll
                    for (int k = 0; k < 4; ++k) { TOPI[m * 4 + k] = idx[k]; GATE[m * 4 + k] = ex[k] * inv; POS[m * 4 + k] = atomicAdd(&cnt[idx[k]], 1); }
                }
            }
            __syncthreads();
        }
    }
    SEAM(8);

    if (IN(9) || IN(10) || IN(11)) {
        if (tid == 0) { int acc = 0; for (int e = 0; e < NE; ++e) { PS[e] = acc; acc += (__hip_atomic_load(&cnt[e], RLX_AGENT) + 255) / 256 * 256; } PS[NE] = acc; }
        __syncthreads();
    }
    if (IN(9)) {
        for (int a = gw; a < NASG; a += NGW) {
            const int e = TOPI[a], slot = PS[e] + POS[a], tok = a >> 2;
            if (lane == 0) { slot_tok[slot] = tok; SLOT_OF[a] = slot; }
            const GAS v4u* src = (const GAS v4u*)(HB + (size_t)tok * D); GAS v4u* dst = (GAS v4u*)(XS + (size_t)slot * D);
#pragma unroll
            for (int q = 0; q < 4; ++q) dst[lane + 64 * q] = src[lane + 64 * q];
        }
    }
    SEAM(9);

    if (IN(10)) {
        pg8::Gemm g{XS, W1T, D, D}; pg8::MoeOrder S; S.ps = PS; S.ntile = 16; S.npan = PS[NE] / 256; S.cprime = vcu; S.a_tstep = (size_t)256 * D * 2; S.b_tstep = (size_t)256 * D * 2;
        pg8::EpiSwiglu E{ACT, b1};
        pg8::gemm_phase<pg8::EpiSwiglu, pg8::MoeOrder, true, true>(lds, g, S, E);
    }
    SEAM(10);

    if (IN(11)) {
        pg8::Gemm g{ACT, W2T, DFF, DFF}; pg8::MoeOrder S; S.ps = PS; S.ntile = 8; S.npan = PS[NE] / 256; S.cprime = vcu; S.a_tstep = (size_t)256 * DFF * 2; S.b_tstep = (size_t)256 * DFF * 2;
        pg8::EpiBias16 E{YS, b2};
        pg8::gemm_phase<pg8::EpiBias16, pg8::MoeOrder, true, true>(lds, g, S, E);
    }
    SEAM(11);

    if (IN(12)) {
        for (int m = gw; m < M; m += NGW) {
            int sl[4]; float gt[4];
#pragma unroll
            for (int k = 0; k < 4; ++k) { sl[k] = SLOT_OF[m * 4 + k]; gt[k] = GATE[m * 4 + k]; }
            f32x4 v[8]; float s = 0.f;
#pragma unroll
            for (int q = 0; q < 8; ++q) { const int c = 4 * lane + 256 * q; f32x4 f = (f32x4){0.f, 0.f, 0.f, 0.f};
#pragma unroll
                for (int k = 0; k < 4; ++k) { const v2u yv = *(const GAS v2u*)(YS + (size_t)sl[k] * D + c); f += gt[k] * (f32x4){bflo(yv.x), bfhi(yv.x), bflo(yv.y), bfhi(yv.y)}; }
                v[q] = ALPHA * *(const GAS f32x4*)(H + (size_t)m * D + c) + f; s += (v[q].x + v[q].y) + (v[q].z + v[q].w); }
            const float mean = wave_sum(s) * (1.0f / D); float s2 = 0.f;
#pragma unroll
            for (int q = 0; q < 8; ++q) { v[q] = v[q] - mean; s2 += (v[q].x * v[q].x + v[q].y * v[q].y) + (v[q].z * v[q].z + v[q].w * v[q].w); }
            const float rstd = 1.0f / sqrtf(wave_sum(s2) * (1.0f / D) + LN_EPS);
#pragma unroll
            for (int q = 0; q < 8; ++q) { const int c = 4 * lane + 256 * q; *(GAS f32x4*)(out + (size_t)m * D + c) = v[q] * rstd * *(const GAS f32x4*)(ln2_w + c) + *(const GAS f32x4*)(ln2_b + c); }
        }
    }
#undef IN
#undef SEAM
}

extern "C" void kernel_launch(void* const* d_in, const int* in_sizes, int n_in, void* d_out, int out_size, void* d_ws, size_t ws_size, hipStream_t stream) {
    static int grid = 0;
    if (grid == 0) {
        if (n_in != 26 || out_size != M * D || ws_size < WS_END) { fprintf(stderr, "kernel_launch: unexpected problem (n_in %d, out %d, ws %zu < %zu)\n", n_in, out_size, ws_size, (size_t)WS_END); grid = -1; return; }
        int dev = 0, cus = 0, per_cu = 0;
        if (hipGetDevice(&dev) != hipSuccess || hipDeviceGetAttribute(&cus, hipDeviceAttributeMultiprocessorCount, dev) != hipSuccess) { grid = -1; return; }
        if (hipFuncSetAttribute((const void*)mk_fwd, hipFuncAttributeMaxDynamicSharedMemorySize, LDS_BYTES) != hipSuccess) { fprintf(stderr, "kernel_launch: hipFuncSetAttribute failed\n"); grid = -1; return; }
        if (hipOccupancyMaxActiveBlocksPerMultiprocessor(&per_cu, (const void*)mk_fwd, NTHR, LDS_BYTES) != hipSuccess || per_cu < 1) fprintf(stderr, "kernel_launch: occupancy query reports %d\n", per_cu);
        (void)hipGetLastError();
        if (cus != NWG) { fprintf(stderr, "kernel_launch: built for %d CUs, device has %d\n", NWG, cus); grid = -1; return; }
        grid = NWG;
    }
    if (grid < 0) return;
    (void)hipMemsetAsync((char*)d_ws + WS_CTL, 0, CTL_BYTES, stream);
    (void)hipMemsetAsync((char*)d_ws + WS_SLOTTOK, 0xFF, (size_t)NSLOT_MAX * 4, stream);
    Args a{};
    for (int i = 0; i < 26; ++i) a.in[i] = (const float*)d_in[i];
    a.out = (float*)d_out; a.ws = (unsigned char*)d_ws;
    if (MK_N_LAUNCHES == 1) { a.ph_lo = 0; a.ph_hi = NPHASE; hipLaunchKernelGGL(mk_fwd, dim3(grid), dim3(NTHR), LDS_BYTES, stream, a); }
    else { for (int p = 0; p < NPHASE; ++p) { a.ph_lo = p; a.ph_hi = p + 1; hipLaunchKernelGGL(mk_fwd, dim3(grid), dim3(NTHR), LDS_BYTES, stream, a); } }
}
```

```cpp
#include <hip/hip_runtime.h>
#include <stdint.h>
#include <stdio.h>

#ifndef DUP_MASK
#define DUP_MASK 0
#endif
#ifndef MK_N_LAUNCHES
#define MK_N_LAUNCHES 1
#endif

constexpr int D = 2048, BATCH = 4, SEQ = 4096, M = BATCH * SEQ;
constexpr int RW = 1024, PW = 1024, NH = 16;
constexpr int SHIFT_W = 3360, IN_COLS = 4384, IN_PAD = 4608;
constexpr int LK = 384;
constexpr int NE = 32, DFF = 2048;
constexpr int NASG = M * 4;
constexpr int NSLOT_MAX = NASG + NE * 256;
constexpr float LN_EPS = 1e-5f, GN_EPS = 64e-5f;
constexpr float ALPHA = 1.189207115002721f;
constexpr int NWG = 256, NWAVES = 8, NTHR = 512;
constexpr int NPHASE = 13;

#define GAS __attribute__((address_space(1)))
#define LAS __attribute__((address_space(3)))
typedef unsigned short bf16;
typedef unsigned v4u __attribute__((ext_vector_type(4)));
typedef unsigned v2u __attribute__((ext_vector_type(2)));
typedef float f32x4 __attribute__((ext_vector_type(4)));
typedef short bf16x8 __attribute__((ext_vector_type(8)));
typedef GAS unsigned gu32;
#define RLX_AGENT __ATOMIC_RELAXED, __HIP_MEMORY_SCOPE_AGENT
#define LDS_WAIT() asm volatile("s_waitcnt lgkmcnt(0)" ::: "memory")
#define VM_WAIT() asm volatile("s_waitcnt vmcnt(0)" ::: "memory")

__device__ __forceinline__ unsigned f2bf(float f) { unsigned u = __builtin_bit_cast(unsigned, f); return (u + 0x7fffu + ((u >> 16) & 1u)) >> 16; }
__device__ __forceinline__ unsigned pk2(float lo, float hi) { return f2bf(lo) | (f2bf(hi) << 16); }
__device__ __forceinline__ float bflo(unsigned w) { return __builtin_bit_cast(float, w << 16); }
__device__ __forceinline__ float bfhi(unsigned w) { return __builtin_bit_cast(float, w & 0xffff0000u); }
__device__ __forceinline__ float wave_sum(float v) {
#pragma unroll
    for (int o = 1; o < 64; o <<= 1) v += __shfl_xor(v, o);
    return v;
}
template <int CTRL> __device__ __forceinline__ float dpp_mov(float x) { return __builtin_bit_cast(float, __builtin_amdgcn_update_dpp(0, __builtin_bit_cast(int, x), CTRL, 0xF, 0xF, true)); }
__device__ __forceinline__ float row16_sum(float x) {
    x += dpp_mov<0xB1>(x);
    x += dpp_mov<0x4E>(x);
    x += dpp_mov<0x141>(x);
    x += dpp_mov<0x140>(x);
    return x;
}

namespace pg8 {
typedef unsigned short bf16_t;
typedef unsigned u32x4 __attribute__((ext_vector_type(4)));
constexpr int BM = 256, BK = 64, HALF = 128, HTB = HALF * BK * 2, STAGE_BYTES = 8 * HTB, NXCD = 8, WGM = 8;
__host__ __device__ __forceinline__ int lds_byte(int r, int c) { const int st = (r >> 4) * 2 + (c >> 5), rr = r & 15, cc = c & 31, ob = rr * 64 + cc * 2; return st * 1024 + (ob ^ (((ob >> 9) & 1) << 5)); }
__host__ __device__ __forceinline__ void stage_rc(int b, int& R, int& C) { const int st = b / 1024, sb = b % 1024, swz = sb ^ (((sb >> 9) & 1) << 5); R = (st >> 1) * 16 + swz / 64; C = (st & 1) * 32 + (swz % 64) / 2; }
__host__ __device__ __forceinline__ int perm32(int rho) { const int n = rho >> 4, i = rho & 15; return 8 * (i >> 2) + 4 * n + (i & 3); }
struct Unit { int pm, pn; };
struct Gemm { const bf16_t* A; const bf16_t* Bt; int lda, K; };
__device__ __forceinline__ unsigned cvt_pk_bf16(float lo, float hi) { unsigned r; asm volatile("v_cvt_pk_bf16_f32 %0, %1, %2" : "=v"(r) : "v"(lo), "v"(hi)); return r; }

struct GridOrder {
    int nM, nN, nwg, G, c; size_t a_tstep, a_pnstep, b_tstep;
    __device__ void init(int nM_, int nN_, int G_, int c_, size_t a_tstep_, size_t a_pnstep_, size_t b_tstep_) { nM = nM_; nN = nN_; nwg = nM * nN; G = G_; c = c_; a_tstep = a_tstep_; a_pnstep = a_pnstep_; b_tstep = b_tstep_; }
    __device__ bool next(int i, Unit& u) const {
        const long L = (long)i * G + c; if (L >= nwg) return false;
        int wgid = (int)L; { const int q = nwg / NXCD, r = nwg % NXCD, xcd = wgid % NXCD, off = wgid / NXCD; wgid = (xcd < r ? xcd * (q + 1) : r * (q + 1) + (xcd - r) * q) + off; }
        const int nig = WGM * nN, gid = wgid / nig, fm = gid * WGM, gsz = (nM - fm) < WGM ? (nM - fm) : WGM;
        u.pm = fm + ((wgid % nig) % gsz); u.pn = (wgid % nig) / gsz; return true;
    }
    __device__ __forceinline__ size_t aoff(const Unit& u) const { return (size_t)u.pm * a_tstep + (size_t)u.pn * a_pnstep; }
    __device__ __forceinline__ size_t boff(const Unit& u) const { return (size_t)u.pn * b_tstep; }
};
struct MoeOrder {
    const LAS int* ps; int ntile, npan, cprime; size_t a_tstep, b_tstep;
    __device__ bool next(int i, Unit& u) const {
        const int U = i * NWG + cprime; const int p = U / ntile; if (p >= npan) return false;
        const int row = p * 256; int e = 0;
#pragma unroll 1
        for (int q = 1; q < NE; ++q) e = (row >= ps[q]) ? q : e;
        u.pm = p; u.pn = e * ntile + (U % ntile); return true;
    }
    __device__ __forceinline__ size_t aoff(const Unit& u) const { return (size_t)u.pm * a_tstep; }
    __device__ __forceinline__ size_t boff(const Unit& u) const { return (size_t)u.pn * b_tstep; }
};

template <class Epi, class Sched, bool ALIGN_EPI, bool SP2>
__device__ __forceinline__ void gemm_phase(LAS unsigned char* lds, const Gemm g, const Sched& S, const Epi& E) {
    int tid_ = threadIdx.x; asm volatile("" : "+v"(tid_));
    const int tid = tid_, wid = __builtin_amdgcn_readfirstlane(tid >> 6), lane = tid & 63, wr = wid >> 2, wc = wid & 3, fr = lane & 15, fq = lane >> 4;
    const int K = g.K, nt = K / BK;
    unsigned voffA[2], voffB[2];
#pragma unroll
    for (int i = 0; i < 2; ++i) { int R, C; stage_rc(tid * 16 + i * 8192, R, C); const int Rb = Epi::PERM ? ((R & ~31) + perm32(R & 31)) : R;
        voffA[i] = (unsigned)(R * g.lda + C) * 2u; voffB[i] = (unsigned)(Rb * K + C) * 2u; }
    const size_t kstep = (size_t)(BK * 2);
    const size_t hstepA = (size_t)HALF * g.lda * 2, hstepB = (size_t)HALF * K * 2;
    const unsigned ldsw = (unsigned)wid * 1024u;
    const int aoff = lds_byte(wr * 64 + fr, fq * 8), boff = lds_byte(wc * 32 + fr, fq * 8);
#define PG8_SA(b, h) (((b) * 2 + (h)) * HTB)
#define PG8_SB(b, h) ((4 + (b) * 2 + (h)) * HTB)
#define PG8_STAGE(bufoff, gbase, voff) do { _Pragma("unroll") for (int _i = 0; _i < 2; ++_i) \
        __builtin_amdgcn_global_load_lds((const unsigned*)((const char*)(gbase) + (voff)[_i]), (LAS unsigned*)(lds + (bufoff) + ldsw + _i * 8192), 16, 0, 0); } while (0)
#define PG8_LDA(dst, b, h) do { _Pragma("unroll") for (int m = 0; m < 4; ++m) _Pragma("unroll") for (int k = 0; k < 2; ++k) dst[m][k] = *(const LAS bf16x8*)(lds + PG8_SA(b, h) + aoff + m * 2048 + k * 1024); } while (0)
#define PG8_LDB(dst, b, h) do { _Pragma("unroll") for (int n = 0; n < 2; ++n) _Pragma("unroll") for (int k = 0; k < 2; ++k) dst[n][k] = *(const LAS bf16x8*)(lds + PG8_SB(b, h) + boff + n * 2048 + k * 1024); } while (0)
#define PG8_MMA(ai, bj, At, Bt) do { __builtin_amdgcn_s_setprio(1); _Pragma("unroll") for (int m = 0; m < 4; ++m) _Pragma("unroll") for (int n = 0; n < 2; ++n) _Pragma("unroll") for (int k = 0; k < 2; ++k) \
        acc[ai][bj][m][n] = __builtin_amdgcn_mfma_f32_16x16x32_bf16(Bt[n][k], At[m][k], acc[ai][bj][m][n], 0, 0, 0); __builtin_amdgcn_s_setprio(0); } while (0)
#define PG8_WAIT_V(n) asm volatile("s_waitcnt vmcnt(" #n ")" ::: "memory")
#define PG8_WAIT_L(n) asm volatile("s_waitcnt lgkmcnt(" #n ")" ::: "memory")
#define PG8_BAR __builtin_amdgcn_s_barrier()
#define PG8_SCHED __builtin_amdgcn_sched_barrier(0)
    Unit cur, nxt; int ui = 0;
    if (!S.next(0, cur)) return;
    f32x4 acc[2][2][4][2];
#pragma unroll
    for (int a = 0; a < 2; ++a)
#pragma unroll
        for (int b = 0; b < 2; ++b)
#pragma unroll
            for (int m = 0; m < 4; ++m)
#pragma unroll
                for (int n = 0; n < 2; ++n) acc[a][b][m][n] = (f32x4){0.f, 0.f, 0.f, 0.f};
    bf16x8 At[4][2], B0[2][2], B1[2][2];
    const char* cA = (const char*)g.A + S.aoff(cur); const char* cB = (const char*)g.Bt + S.boff(cur);
    if constexpr (SP2) {
        PG8_STAGE(PG8_SB(0, 0), cB, voffB); PG8_STAGE(PG8_SB(0, 1), cB + hstepB, voffB); PG8_STAGE(PG8_SA(0, 0), cA, voffA); PG8_STAGE(PG8_SA(0, 1), cA + hstepA, voffA);
        if (wr == 1) PG8_BAR;
        PG8_WAIT_V(2); PG8_BAR;
        PG8_STAGE(PG8_SB(1, 0), cB + kstep, voffB); PG8_STAGE(PG8_SA(1, 0), cA + kstep, voffA); PG8_STAGE(PG8_SB(1, 1), cB + hstepB + kstep, voffB);
        PG8_WAIT_V(6); PG8_BAR;
    } else {
        PG8_STAGE(PG8_SB(0, 0), cB, voffB); PG8_STAGE(PG8_SA(0, 0), cA, voffA); PG8_STAGE(PG8_SB(0, 1), cB + hstepB, voffB); PG8_STAGE(PG8_SA(0, 1), cA + hstepA, voffA);
        if (wr == 1) PG8_BAR;
        PG8_WAIT_V(4); PG8_BAR;
        PG8_STAGE(PG8_SB(1, 0), cB + kstep, voffB); PG8_STAGE(PG8_SA(1, 0), cA + kstep, voffA); PG8_STAGE(PG8_SB(1, 1), cB + hstepB + kstep, voffB);
        PG8_WAIT_V(6); PG8_BAR;
    }
    for (;;) {
        const bool has_next = S.next(ui + 1, nxt);
        const char* nA = has_next ? (const char*)g.A + S.aoff(nxt) : cA; const char* nB = has_next ? (const char*)g.Bt + S.boff(nxt) : cB;
#pragma unroll 1
        for (int t = 0; t < nt; t += 2) {
            const bool last = (t == nt - 2);
            const char* a1 = cA + (size_t)(t + 1) * kstep;
            const char* a2 = last ? nA : cA + (size_t)(t + 2) * kstep; const char* b2 = last ? nB : cB + (size_t)(t + 2) * kstep;
            const char* a3 = a2 + kstep; const char* b3 = b2 + kstep;
            if constexpr (SP2) {
            PG8_LDB(B0, 0, 0); PG8_LDB(B1, 0, 1); PG8_SCHED; PG8_LDA(At, 0, 0); PG8_STAGE(PG8_SA(1, 1), a1 + hstepA, voffA);
            PG8_WAIT_V(8); PG8_WAIT_L(0); PG8_BAR; PG8_MMA(0, 0, At, B0); PG8_MMA(0, 1, At, B1); PG8_BAR; PG8_SCHED;
            PG8_LDA(At, 0, 1); PG8_STAGE(PG8_SB(0, 0), b2, voffB); PG8_STAGE(PG8_SB(0, 1), b2 + hstepB, voffB); PG8_STAGE(PG8_SA(0, 0), a2, voffA);
            PG8_WAIT_V(8); PG8_WAIT_L(0); PG8_BAR; PG8_MMA(1, 0, At, B0); PG8_MMA(1, 1, At, B1); PG8_BAR; PG8_SCHED;
            PG8_LDB(B0, 1, 0); PG8_LDB(B1, 1, 1); PG8_SCHED; PG8_LDA(At, 1, 0); PG8_STAGE(PG8_SA(0, 1), a2 + hstepA, voffA);
            PG8_WAIT_V(8); PG8_WAIT_L(0); PG8_BAR; PG8_MMA(0, 0, At, B0); PG8_MMA(0, 1, At, B1); PG8_BAR; PG8_SCHED;
            PG8_LDA(At, 1, 1); PG8_STAGE(PG8_SB(1, 0), b3, voffB); PG8_STAGE(PG8_SB(1, 1), b3 + hstepB, voffB); PG8_STAGE(PG8_SA(1, 0), a3, voffA);
            PG8_WAIT_V(8); PG8_WAIT_L(0); PG8_BAR; PG8_MMA(1, 0, At, B0); PG8_MMA(1, 1, At, B1); PG8_BAR; PG8_SCHED;
            } else {
            PG8_LDB(B0, 0, 0); PG8_SCHED; PG8_LDA(At, 0, 0); PG8_STAGE(PG8_SA(1, 1), a1 + hstepA, voffA);
            PG8_WAIT_L(8); PG8_BAR; PG8_WAIT_L(0); PG8_MMA(0, 0, At, B0); PG8_BAR; PG8_SCHED;
            PG8_LDB(B1, 0, 1); PG8_STAGE(PG8_SB(0, 0), b2, voffB);
            PG8_BAR; PG8_WAIT_L(0); PG8_MMA(0, 1, At, B1); PG8_BAR;
            PG8_LDA(At, 0, 1); PG8_STAGE(PG8_SA(0, 0), a2, voffA);
            PG8_BAR; PG8_WAIT_L(0); PG8_MMA(1, 0, At, B0); PG8_BAR; PG8_SCHED;
            PG8_STAGE(PG8_SB(0, 1), b2 + hstepB, voffB);
            PG8_WAIT_V(6); PG8_BAR; PG8_MMA(1, 1, At, B1); PG8_BAR;
            PG8_LDB(B0, 1, 0); PG8_SCHED; PG8_LDA(At, 1, 0); PG8_STAGE(PG8_SA(0, 1), a2 + hstepA, voffA);
            PG8_WAIT_L(8); PG8_BAR; PG8_WAIT_L(0); PG8_MMA(0, 0, At, B0); PG8_BAR; PG8_SCHED;
            PG8_LDB(B1, 1, 1); PG8_STAGE(PG8_SB(1, 0), b3, voffB);
            PG8_BAR; PG8_WAIT_L(0); PG8_MMA(0, 1, At, B1); PG8_BAR;
            PG8_LDA(At, 1, 1); PG8_STAGE(PG8_SA(1, 0), a3, voffA);
            PG8_BAR; PG8_WAIT_L(0); PG8_MMA(1, 0, At, B0); PG8_BAR; PG8_SCHED;
            PG8_STAGE(PG8_SB(1, 1), b3 + hstepB, voffB);
            PG8_WAIT_V(6); PG8_BAR; PG8_MMA(1, 1, At, B1); PG8_BAR;
            }
        }
        if constexpr (ALIGN_EPI) { if (wr == 0) PG8_BAR; }
        E(acc, cur, wr, wc, fr, fq);
        if (!has_next) break;
#pragma unroll
        for (int a = 0; a < 2; ++a)
#pragma unroll
            for (int b = 0; b < 2; ++b)
#pragma unroll
                for (int m = 0; m < 4; ++m)
#pragma unroll
                    for (int n = 0; n < 2; ++n) acc[a][b][m][n] = (f32x4){0.f, 0.f, 0.f, 0.f};
        cur = nxt; cA = nA; cB = nB; ++ui;
        if constexpr (ALIGN_EPI) { if (wr == 1) PG8_BAR; }
    }
    PG8_WAIT_V(0);
    if constexpr (!ALIGN_EPI) { if (wr == 0) PG8_BAR; }
    PG8_BAR;
#undef PG8_SA
#undef PG8_SB
#undef PG8_STAGE
#undef PG8_LDA
#undef PG8_LDB
#undef PG8_MMA
#undef PG8_WAIT_V
#undef PG8_WAIT_L
#undef PG8_BAR
#undef PG8_SCHED
}

struct EpiF32 {
    static constexpr bool PERM = false;
    float* C; int ldc;
    __device__ __forceinline__ void operator()(const f32x4 (&acc)[2][2][4][2], const Unit& u, int wr, int wc, int fr, int fq) const {
        const int row0 = u.pm * BM + wr * 64 + fr, col0 = u.pn * BM + wc * 32 + 4 * fq;
#pragma unroll
        for (int ai = 0; ai < 2; ++ai)
#pragma unroll
            for (int m = 0; m < 4; ++m) { float* rowp = C + (size_t)(row0 + ai * HALF + m * 16) * ldc + col0;
#pragma unroll
                for (int bj = 0; bj < 2; ++bj)
#pragma unroll
                    for (int n = 0; n < 2; ++n) *(f32x4*)(rowp + bj * HALF + n * 16) = acc[ai][bj][m][n]; }
    }
};
struct EpiPool {
    static constexpr bool PERM = true;
    bf16_t* O; const float* scale;
    __device__ __forceinline__ void operator()(const f32x4 (&acc)[2][2][4][2], const Unit& u, int wr, int wc, int fr, int fq) const {
        const int row0 = u.pm * BM + wr * 64 + fr; int col0 = u.pn * BM + wc * 32 + 8 * fq;
        asm volatile("" : "+v"(col0));
        f32x4 sv[2][2];
#pragma unroll
        for (int bj = 0; bj < 2; ++bj)
#pragma unroll
            for (int n = 0; n < 2; ++n) sv[bj][n] = *(const f32x4*)(scale + col0 + bj * HALF + 4 * n);
#pragma unroll
        for (int ai = 0; ai < 2; ++ai)
#pragma unroll
            for (int m = 0; m < 4; ++m) { bf16_t* rowp = O + (size_t)(row0 + ai * HALF + m * 16) * 2048 + 1024 + col0;
#pragma unroll
                for (int bj = 0; bj < 2; ++bj) { const f32x4 v0 = acc[ai][bj][m][0] * sv[bj][0], v1 = acc[ai][bj][m][1] * sv[bj][1];
                    u32x4 w; w.x = cvt_pk_bf16(v0[0], v0[1]); w.y = cvt_pk_bf16(v0[2], v0[3]); w.z = cvt_pk_bf16(v1[0], v1[1]); w.w = cvt_pk_bf16(v1[2], v1[3]);
                    *(u32x4*)(rowp + bj * HALF) = w; } }
    }
};
struct EpiSwiglu {
    static constexpr bool PERM = true;
    bf16_t* O; const float* b1;
    __device__ __forceinline__ void operator()(const f32x4 (&acc)[2][2][4][2], const Unit& u, int wr, int wc, int fr, int fq) const {
        const int e = u.pn >> 4, nt = u.pn & 15;
        const int row0 = u.pm * BM + wr * 64 + fr; int col0 = nt * BM + wc * 32 + 8 * fq;
        asm volatile("" : "+v"(col0));
        const float* bp = b1 + (size_t)e * 4096 + col0;
        f32x4 bv[2][2];
#pragma unroll
        for (int bj = 0; bj < 2; ++bj)
#pragma unroll
            for (int n = 0; n < 2; ++n) bv[bj][n] = *(const f32x4*)(bp + bj * HALF + 4 * n);
#pragma unroll
        for (int ai = 0; ai < 2; ++ai)
#pragma unroll
            for (int m = 0; m < 4; ++m) { bf16_t* rowp = O + (size_t)(row0 + ai * HALF + m * 16) * 2048 + (col0 >> 1);
#pragma unroll
                for (int bj = 0; bj < 2; ++bj) { const f32x4 v0 = acc[ai][bj][m][0] + bv[bj][0], v1 = acc[ai][bj][m][1] + bv[bj][1];
                    float a[4];
#pragma unroll
                    for (int p = 0; p < 4; ++p) { const float hg = p < 2 ? v0[2 * p] : v1[2 * p - 4], hl = p < 2 ? v0[2 * p + 1] : v1[2 * p - 3];
                        const float xg = fminf(hg, 7.0f), xl = fminf(fmaxf(hl, -7.0f), 7.0f);
                        a[p] = xg * __builtin_amdgcn_rcpf(1.0f + __expf(-1.702f * xg)) * (xl + 1.0f); }
                    v2u w; w.x = cvt_pk_bf16(a[0], a[1]); w.y = cvt_pk_bf16(a[2], a[3]);
                    *(v2u*)(rowp + bj * (HALF / 2)) = w; } }
    }
};
struct EpiBias16 {
    static constexpr bool PERM = true;
    bf16_t* O; const float* b2;
    __device__ __forceinline__ void operator()(const f32x4 (&acc)[2][2][4][2], const Unit& u, int wr, int wc, int fr, int fq) const {
        const int e = u.pn >> 3, nt = u.pn & 7;
        const int row0 = u.pm * BM + wr * 64 + fr; int col0 = nt * BM + wc * 32 + 8 * fq;
        asm volatile("" : "+v"(col0));
        const float* bp = b2 + (size_t)e * 2048 + col0;
        f32x4 bv[2][2];
#pragma unroll
        for (int bj = 0; bj < 2; ++bj)
#pragma unroll
            for (int n = 0; n < 2; ++n) bv[bj][n] = *(const f32x4*)(bp + bj * HALF + 4 * n);
#pragma unroll
        for (int ai = 0; ai < 2; ++ai)
#pragma unroll
            for (int m = 0; m < 4; ++m) { bf16_t* rowp = O + (size_t)(row0 + ai * HALF + m * 16) * 2048 + col0;
#pragma unroll
                for (int bj = 0; bj < 2; ++bj) { const f32x4 v0 = acc[ai][bj][m][0] + bv[bj][0], v1 = acc[ai][bj][m][1] + bv[bj][1];
                    u32x4 w; w.x = cvt_pk_bf16(v0[0], v0[1]); w.y = cvt_pk_bf16(v0[2], v0[3]); w.z = cvt_pk_bf16(v1[0], v1[1]); w.w = cvt_pk_bf16(v1[2], v1[3]);
                    *(u32x4*)(rowp + bj * HALF) = w; } }
    }
};
}

#define XB_TMO      128
#define XB_XCNT(j)  (256  + 64 * (j))
#define XB_XSUB(j)  (1280 + 64 * (j))
#define XB_XGEN(j)  (2304 + 64 * (j))
#define XB_TOP      3328
#define XB_TOPGEN   3392
#define XCD_BAR_WORDS 3456
#define XB_SPIN_CAP (1u << 22)
__device__ __forceinline__ unsigned xb_ld(unsigned* p)              { return __hip_atomic_load(p, __ATOMIC_RELAXED, __HIP_MEMORY_SCOPE_AGENT); }
__device__ __forceinline__ unsigned xb_add(unsigned* p, unsigned v) { return __hip_atomic_fetch_add(p, v, __ATOMIC_RELAXED, __HIP_MEMORY_SCOPE_AGENT); }
__device__ __forceinline__ unsigned xb_xcc_id() { return (unsigned)__builtin_amdgcn_s_getreg((3 << 11) | 20) & 0xFu; }
#define XB_SPIN(cond, bar) do { unsigned _sp = 0; while (cond) { __builtin_amdgcn_s_sleep(1); \
    if ((++_sp & 255u) == 0u) { if (xb_ld(&(bar)[XB_TMO])) break; if (_sp > XB_SPIN_CAP) { atomicAdd(&(bar)[XB_TMO], 1u); break; } } } } while (0)
struct XcdBarrier { unsigned* bar; unsigned x; volatile LAS unsigned* st; };
__device__ __forceinline__ XcdBarrier xcd_barrier_post(unsigned* bar, volatile LAS unsigned* st) {
    XcdBarrier b; b.bar = bar; b.x = xb_xcc_id(); b.st = st;
    if (threadIdx.x == 0) (void)xb_add(&bar[XB_XCNT(b.x)], 1u);
    return b;
}
__device__ __forceinline__ void xcd_barrier_complete(unsigned* bar, unsigned x, unsigned& nloc, unsigned& nx) {
    const unsigned G = gridDim.x * gridDim.y * gridDim.z;
    unsigned sum, cnt, mine, sp = 0u;
    for (;;) {
        sum = 0u; cnt = 0u; mine = 0u;
#pragma unroll
        for (unsigned j = 0; j < 16; ++j) { const unsigned c = xb_ld(&bar[XB_XCNT(j)]); sum += c; cnt += (c > 0u) ? 1u : 0u; mine = (j == x) ? c : mine; }
        if (sum == G) break;
        __builtin_amdgcn_s_sleep(1);
        if ((++sp & 255u) == 0u) { if (xb_ld(&bar[XB_TMO])) break; if (sp > XB_SPIN_CAP) { atomicAdd(&bar[XB_TMO], 1u); break; } }
    }
    nloc = mine > 0u ? mine : 1u; nx = cnt > 0u ? cnt : 1u;
}
__device__ __forceinline__ void xcd_barrier(const XcdBarrier& b) {
    asm volatile("s_waitcnt vmcnt(0)" ::: "memory");
    __syncthreads();
    if (threadIdx.x == 0) {
        unsigned* bar = b.bar;
        __builtin_amdgcn_s_waitcnt(0);
        unsigned nloc = b.st[0], nx = b.st[1];
        if (nloc == 0u) { xcd_barrier_complete(bar, b.x, nloc, nx); b.st[0] = nloc; b.st[1] = nx; }
        const unsigned old = xb_add(&bar[XB_XSUB(b.x)], 1u);
        const unsigned gen = old / nloc;
        if (old + 1u == (gen + 1u) * nloc) {
            __builtin_amdgcn_fence(__ATOMIC_RELEASE, "agent");
            asm volatile("s_waitcnt vmcnt(0)" ::: "memory");
            const unsigned og = xb_add(&bar[XB_TOP], 1u);
            const unsigned tg = og / nx;
            if (og + 1u == (tg + 1u) * nx) xb_add(&bar[XB_TOPGEN], 1u);
            else XB_SPIN(xb_ld(&bar[XB_TOPGEN]) == tg, bar);
            __builtin_amdgcn_fence(__ATOMIC_ACQUIRE, "agent");
            xb_add(&bar[XB_XGEN(b.x)], 1u);
            asm volatile("s_waitcnt vmcnt(0)" ::: "memory");
        } else {
            XB_SPIN(xb_ld(&bar[XB_XGEN(b.x)]) == gen, bar);
            __builtin_amdgcn_fence(__ATOMIC_ACQUIRE, "agent");
            asm volatile("s_waitcnt vmcnt(0)" ::: "memory");
        }
    }
    __syncthreads();
}

constexpr size_t al256(size_t x) { return (x + 255) & ~(size_t)255; }
constexpr size_t WS_CTL = 0, CTL_BYTES = 1u << 20;
constexpr int CW_BAR = 4096;
constexpr int CW_CNT = 16384;
constexpr size_t WS_SLOTTOK = WS_CTL + CTL_BYTES;
constexpr size_t WS_TOPI = WS_SLOTTOK + al256((size_t)NSLOT_MAX * 4);
constexpr size_t WS_GATE = WS_TOPI + (size_t)NASG * 4;
constexpr size_t WS_POS = WS_GATE + (size_t)NASG * 4;
constexpr size_t WS_SLOTOF = WS_POS + (size_t)NASG * 4;
constexpr size_t WS_BONUS = WS_SLOTOF + (size_t)NASG * 4;
constexpr size_t WS_XB = WS_BONUS + (size_t)M * 16 * 4;
constexpr size_t WS_WINT = WS_XB + (size_t)M * D * 2;
constexpr size_t WS_WOUTT = WS_WINT + (size_t)IN_PAD * D * 2;
constexpr size_t WS_LORAT = WS_WOUTT + (size_t)D * D * 2;
constexpr size_t WS_WPOOLT = WS_LORAT + (size_t)3072 * LK * 2;
constexpr size_t WS_PROJ = WS_WPOOLT + (size_t)1024 * 256 * 2;
constexpr size_t WS_LIN = WS_PROJ + (size_t)M * IN_PAD * 4;
constexpr size_t WS_POOLED = WS_LIN + (size_t)M * LK * 2;
constexpr size_t WS_WDEC = WS_POOLED + (size_t)M * 1024 * 2;
constexpr size_t SZ_F1K = (size_t)M * 1024 * 4;
constexpr size_t WS_LOUT = WS_WDEC + SZ_F1K  , WS_R = WS_LOUT + 3 * SZ_F1K, WS_K2 = WS_R + SZ_F1K, WS_V = WS_K2 + SZ_F1K, WS_KK = WS_V + SZ_F1K, WS_BB = WS_KK + SZ_F1K, WS_Y = WS_BB + SZ_F1K;
constexpr size_t WS_MIXIN = WS_Y + SZ_F1K;
constexpr size_t WS_MIX = WS_MIXIN + (size_t)M * D * 2;
constexpr size_t WS_H = WS_MIX + (size_t)M * D * 4;
constexpr size_t WS_HB = WS_H + (size_t)M * D * 4;
constexpr size_t WS_XS = WS_HB + (size_t)M * D * 2;
constexpr size_t WS_W1T = WS_XS + (size_t)NSLOT_MAX * D * 2;
constexpr size_t WS_W2T = WS_W1T + (size_t)NE * 4096 * D * 2;
constexpr size_t WS_ACT = WS_W2T + (size_t)NE * 2048 * DFF * 2;
constexpr size_t WS_YS = WS_ACT + (size_t)NSLOT_MAX * DFF * 2;
constexpr size_t WS_END = WS_YS + (size_t)NSLOT_MAX * D * 2;

constexpr int RING_BYTES = 131072;
constexpr int LDSCTL_OFF = 139264;
constexpr int LDS_BYTES = 147456;

struct Args { const float* in[26]; float* out; unsigned char* ws; int ph_lo, ph_hi, dup, pad; };

__device__ __forceinline__ void transpose_item(const float* W, int K, int N, bf16* WT, size_t row_off, LAS float* scr, int item, int lane) {
    const int nblk = N / 64, kb = item / nblk, nb = item % nblk, k0 = 64 * kb, n0 = 64 * nb;
    const int r = lane >> 4, c4 = (lane & 15) * 4;
    f32x4 v[16];
#pragma unroll
    for (int i = 0; i < 16; ++i) v[i] = *(const GAS f32x4*)(W + (size_t)(k0 + 4 * i + r) * N + n0 + c4);
#pragma unroll
    for (int i = 0; i < 16; ++i) { LAS float* d = scr + (4 * i + r) * 65 + c4; d[0] = v[i].x; d[1] = v[i].y; d[2] = v[i].z; d[3] = v[i].w; }
    LDS_WAIT(); asm volatile("" ::: "memory");
    const int c = lane & 7;
#pragma unroll
    for (int p = 0; p < 8; ++p) { const int n = (lane >> 3) + 8 * p; const LAS float* q = scr + (8 * c) * 65 + n;
        v4u o; o.x = pk2(q[0 * 65], q[1 * 65]); o.y = pk2(q[2 * 65], q[3 * 65]); o.z = pk2(q[4 * 65], q[5 * 65]); o.w = pk2(q[6 * 65], q[7 * 65]);
        *(GAS v4u*)(WT + (row_off + n0 + n) * (size_t)K + k0 + 8 * c) = o; }
    LDS_WAIT(); asm volatile("" ::: "memory");
}

__global__ void __launch_bounds__(NTHR, 2) mk_fwd(Args args) {
    extern __shared__ __attribute__((aligned(16))) unsigned char lds_raw[];
    LAS unsigned char* lds = (LAS unsigned char*)lds_raw;
    volatile LAS unsigned* MISC = (volatile LAS unsigned*)(lds + LDSCTL_OFF);
    LAS int* PS = (LAS int*)(lds + LDSCTL_OFF + 256);
    const int tid = threadIdx.x, lane = tid & 63, wave = __builtin_amdgcn_readfirstlane(tid >> 6);
    const int G = gridDim.x, bx = blockIdx.x;
    const int vcu = (bx % 8) * (G / 8) + bx / 8;
    const int gw = vcu * NWAVES + wave, NGW = G * NWAVES;
    unsigned char* ws = args.ws;
    gu32* ctl = (gu32*)(ws + WS_CTL);
    const float* x = args.in[0]; const float* w_in = args.in[1]; const float* mu = args.in[2]; const float* w0 = args.in[3]; const float* w2d = args.in[4];
    const float* a0 = args.in[5]; const float* a2 = args.in[6]; const float* g2 = args.in[7]; const float* k_k = args.in[8]; const float* k_a = args.in[9];
    const float* r_k = args.in[10]; const float* lnx_w = args.in[11]; const float* lnx_b = args.in[12]; const float* w_pool = args.in[13]; const float* pool_scale = args.in[14];
    const float* w_out = args.in[15]; const float* ln1_w = args.in[16]; const float* ln1_b = args.in[17]; const float* router_w = args.in[18]; const float* router_b = args.in[19];
    const float* w1 = args.in[20]; const float* b1 = args.in[21]; const float* w2 = args.in[22]; const float* b2 = args.in[23]; const float* ln2_w = args.in[24]; const float* ln2_b = args.in[25];
    float* out = args.out;
    int* CNTWG = (int*)(ws + WS_CTL) + CW_CNT;
    int* slot_tok = (int*)(ws + WS_SLOTTOK); int* TOPI = (int*)(ws + WS_TOPI); float* GATE = (float*)(ws + WS_GATE); int* POS = (int*)(ws + WS_POS); int* SLOT_OF = (int*)(ws + WS_SLOTOF);
    float* BONUS = (float*)(ws + WS_BONUS);
    bf16* XB = (bf16*)(ws + WS_XB); bf16* WINT = (bf16*)(ws + WS_WINT); bf16* WOUTT = (bf16*)(ws + WS_WOUTT); bf16* LORAT = (bf16*)(ws + WS_LORAT); bf16* WPOOLT = (bf16*)(ws + WS_WPOOLT);
    float* PROJ = (float*)(ws + WS_PROJ); bf16* LIN = (bf16*)(ws + WS_LIN); bf16* POOLED = (bf16*)(ws + WS_POOLED);
    float* WDEC = (float*)(ws + WS_WDEC); float* LOUT = (float*)(ws + WS_LOUT); float* Rr = (float*)(ws + WS_R); float* K2 = (float*)(ws + WS_K2);
    float* Vv = (float*)(ws + WS_V); float* KK = (float*)(ws + WS_KK); float* BB = (float*)(ws + WS_BB); float* Yy = (float*)(ws + WS_Y);
    bf16* MIXIN = (bf16*)(ws + WS_MIXIN); float* MIX = (float*)(ws + WS_MIX); float* H = (float*)(ws + WS_H); bf16* HB = (bf16*)(ws + WS_HB);
    bf16* XS = (bf16*)(ws + WS_XS); bf16* W1T = (bf16*)(ws + WS_W1T); bf16* W2T = (bf16*)(ws + WS_W2T); bf16* ACT = (bf16*)(ws + WS_ACT); bf16* YS = (bf16*)(ws + WS_YS);

    for (int u = tid; u < (LDS_BYTES - LDSCTL_OFF) / 4; u += NTHR) ((LAS unsigned*)(lds + LDSCTL_OFF))[u] = 0u;
    __syncthreads();
    XcdBarrier bar; bar.bar = (unsigned*)(ctl + CW_BAR); bar.x = 0; bar.st = nullptr;
    if (MK_N_LAUNCHES == 1) bar = xcd_barrier_post((unsigned*)(ctl + CW_BAR), MISC + 8);
    const int lo = args.ph_lo, hi = args.ph_hi;
#ifndef PHASE_MASK
#define PHASE_MASK 0xFFFF
#endif
#define IN(k) (((PHASE_MASK >> (k)) & 1) && lo <= (k) && (k) < hi)
#define SEAM(k) do { if (IN(k) && IN((k) + 1)) xcd_barrier(bar); } while (0)

    if (IN(0)) {
        LAS float* scr = (LAS float*)(lds + wave * 16640);
        for (size_t i = (size_t)gw * 64 + lane; i < (size_t)M * D / 8; i += (size_t)NGW * 64) {
            const f32x4 a = *(const GAS f32x4*)(x + i * 8), b = *(const GAS f32x4*)(x + i * 8 + 4);
            v4u o; o.x = pk2(a.x, a.y); o.y = pk2(a.z, a.w); o.z = pk2(b.x, b.y); o.w = pk2(b.z, b.w);
            *(GAS v4u*)(XB + i * 8) = o;
        }
        constexpr int I_IN = (D / 64) * (IN_COLS / 64)  , I_OUT = (D / 64) * (D / 64);
        for (int it = gw; it < I_IN + I_OUT; it += NGW) {
            if (it < I_IN) transpose_item(w_in, D, IN_COLS, WINT, 0, scr, it, lane);
            else transpose_item(w_out, D, D, WOUTT, 0, scr, it - I_IN, lane);
        }
        for (int i = gw * 64 + lane; i < 32 * D; i += NGW * 64) { const int nn = 4352 + (i >> 11), k = i & 2047; WINT[(size_t)nn * D + k] = (bf16)f2bf(w_in[(size_t)k * IN_COLS + nn]); }
        for (size_t i = (size_t)gw * 64 + lane; i < (size_t)(IN_PAD - IN_COLS) * D / 8; i += (size_t)NGW * 64) *(GAS v4u*)(WINT + (size_t)IN_COLS * D + i * 8) = (v4u){0u, 0u, 0u, 0u};
        for (int i = gw * 64 + lane; i < 3072 * LK; i += NGW * 64) {
            const int n = i / LK, k = i % LK; float v = 0.f;
            if (n < 1024) { if (k < 64) v = w2d[k * 1024 + n]; }
            else if (n < 2048) { if (k >= 64 && k < 128) v = a2[(k - 64) * 1024 + (n - 1024)]; }
            else { if (k >= 128 && k < 288) v = g2[(k - 128) * 1024 + (n - 2048)]; }
            LORAT[i] = (bf16)f2bf(v);
        }
        for (int i = gw * 64 + lane; i < 1024 * 256; i += NGW * 64) {
            const int n = i >> 8, c = i & 255, g = n >> 8, d = n & 255;
            WPOOLT[i] = (bf16)f2bf(w_pool[((size_t)g * 256 + c) * 256 + d]);
        }
    }
    SEAM(0);

    if (IN(1)) {
        pg8::Gemm g{XB, WINT, D, D}; pg8::GridOrder S; S.init(M / 256, IN_PAD / 256, G, bx, (size_t)256 * D * 2, 0, (size_t)256 * D * 2);
        pg8::EpiF32 E{PROJ, IN_PAD};
        pg8::gemm_phase<pg8::EpiF32, pg8::GridOrder, true, true>(lds, g, S, E);
    }
    SEAM(1);

    if (IN(2)) {
        for (int m = gw; m < M; m += NGW) {
            const int t = m % SEQ;
            const float* pr = PROJ + (size_t)m * IN_PAD; const float* pp = pr - IN_PAD;
#pragma unroll
            for (int q = 0; q < 6; ++q) {
                const int i = lane + 64 * q; float v = 0.f;
                if (i < 288) { const int c = 3072 + i; const float cur = pr[c], prev = t > 0 ? pp[c] : 0.f; const float s = cur + (prev - cur) * mu[c];
                    v = i < 64 ? tanhf(s) : (i < 128 ? s : 1.0f / (1.0f + __expf(-s))); }
                LIN[(size_t)m * LK + i] = (bf16)f2bf(v);
            }
#pragma unroll
            for (int q = 0; q < 4; ++q) {
                const int c = 4 * lane + 256 * q, win = 2 << q; const int n = (t + 1) < win ? (t + 1) : win;
                const f32x4 cur = *(const GAS f32x4*)(pr + SHIFT_W + c); f32x4 sum = cur;
                for (int s = 1; s < n; ++s) sum += *(const GAS f32x4*)(pr - (size_t)s * IN_PAD + SHIFT_W + c);
                const float inv = 1.0f / (float)n; const f32x4 pv = sum * inv - cur;
                v2u o; o.x = pk2(pv.x, pv.y); o.y = pk2(pv.z, pv.w);
                *(GAS v2u*)(POOLED + (size_t)m * 1024 + c) = o;
            }
        }
    }
    SEAM(2);

    if (IN(3)) {
#ifndef NO_LORA
        { pg8::Gemm g{LIN, LORAT, LK, LK}; pg8::GridOrder S; S.init(M / 256, 12, G, bx, (size_t)256 * LK * 2, 0, (size_t)256 * LK * 2);
          pg8::EpiF32 E{LOUT, 3072};
          pg8::gemm_phase<pg8::EpiF32, pg8::GridOrder, true, true>(lds, g, S, E); }
#endif
#ifndef NO_POOL
        { pg8::Gemm g{POOLED, WPOOLT, 1024, 256}; pg8::GridOrder S; S.init(M / 256, 4, G, bx, (size_t)256 * 1024 * 2, (size_t)256 * 2, (size_t)256 * 256 * 2);
          pg8::EpiPool E{MIXIN, pool_scale};
          pg8::gemm_phase<pg8::EpiPool, pg8::GridOrder, true, true>(lds, g, S, E); }
#endif
    }
    SEAM(3);

    if (IN(4)) {
        for (int m = gw; m < M; m += NGW) {
            const int t = m % SEQ;
            const float* pr = PROJ + (size_t)m * IN_PAD; const float* pp = pr - IN_PAD;
#pragma unroll
            for (int q = 0; q < 4; ++q) {
                const int c = 4 * lane + 256 * q; const size_t o = (size_t)m * 1024 + c;
                f32x4 r = *(const GAS f32x4*)(pr + c), k = *(const GAS f32x4*)(pr + 1024 + c), v = *(const GAS f32x4*)(pr + 2048 + c);
                f32x4 rp = (f32x4){0.f, 0.f, 0.f, 0.f}, kp = rp, vp = rp;
                if (t > 0) { rp = *(const GAS f32x4*)(pp + c); kp = *(const GAS f32x4*)(pp + 1024 + c); vp = *(const GAS f32x4*)(pp + 2048 + c); }
                r = r + (rp - r) * *(const GAS f32x4*)(mu + c); k = k + (kp - k) * *(const GAS f32x4*)(mu + 1024 + c); v = v + (vp - v) * *(const GAS f32x4*)(mu + 2048 + c);
                const f32x4 wl = *(const GAS f32x4*)(LOUT + (size_t)m * 3072 + c) + *(const GAS f32x4*)(w0 + c);
                const f32x4 al = *(const GAS f32x4*)(LOUT + (size_t)m * 3072 + 1024 + c) + *(const GAS f32x4*)(a0 + c);
                f32x4 a, dec;
#pragma unroll
                for (int j = 0; j < 4; ++j) { const float z = -wl[j]; const float sp = fmaxf(z, 0.f) + __logf(1.0f + __expf(-fabsf(z))); dec[j] = __expf(-__expf(-sp - 0.5f)); a[j] = 1.0f / (1.0f + __expf(-al[j])); }
                *(GAS f32x4*)(WDEC + o) = dec;
                f32x4 kk = k * *(const GAS f32x4*)(k_k + c);
                const float ss = row16_sum(kk.x * kk.x + kk.y * kk.y + kk.z * kk.z + kk.w * kk.w);
                kk = kk * __builtin_amdgcn_rsqf(fmaxf(ss, 1e-24f));
                const f32x4 k2 = k * (1.0f + (a - 1.0f) * *(const GAS f32x4*)(k_a + c));
                const f32x4 rk = *(const GAS f32x4*)(r_k + c);
                const float bon = row16_sum(r.x * k2.x * rk.x + r.y * k2.y * rk.y + r.z * k2.z * rk.z + r.w * k2.w * rk.w);
                *(GAS f32x4*)(Rr + o) = r; *(GAS f32x4*)(K2 + o) = k2; *(GAS f32x4*)(Vv + o) = v; *(GAS f32x4*)(KK + o) = kk; *(GAS f32x4*)(BB + o) = kk * a;
                if ((lane & 15) == 0) BONUS[m * 16 + (c >> 6)] = bon;
            }
        }
    }
    SEAM(4);

    if (IN(5)) {
        const int xcd_i = bx % 8, slot_i = bx / 8;
        if (slot_i < 16) {
            const int sid = xcd_i * 16 + slot_i, hd = sid >> 1, half = sid & 1, b = hd >> 4, h = hd & 15;
            LAS float* OPS = (LAS float*)lds;
            LAS float* VVs = (LAS float*)(lds + 81920);
            LAS float* YBs = (LAS float*)(lds + 81920 + 8192);
            const int r4 = lane >> 4, jq = lane & 15;
            const int tl = tid >> 4, j4 = (tid & 15) * 4;
            const int vt = tid >> 3, vi4 = (tid & 7) * 4;
            const size_t gbase = ((size_t)b * SEQ) * 1024 + h * 64;
            const float* arr[5] = {KK, WDEC, BB, K2, Rr};
            f32x4 st[5]; f32x4 sv = (f32x4){0.f, 0.f, 0.f, 0.f};
#pragma unroll
            for (int a = 0; a < 5; ++a) st[a] = *(const GAS f32x4*)(arr[a] + gbase + (size_t)tl * 1024 + j4);
            if (tid < 256) sv = *(const GAS f32x4*)(Vv + gbase + (size_t)vt * 1024 + half * 32 + vi4);
#pragma unroll
            for (int a = 0; a < 5; ++a) *(LAS f32x4*)(OPS + (a * 32 + tl) * 64 + j4) = st[a];
            if (tid < 256) *(LAS f32x4*)(VVs + vt * 32 + vi4) = sv;
            __syncthreads();
            float S0 = 0.f, S1 = 0.f, S2 = 0.f, S3 = 0.f;
            for (int c = 0; c < SEQ / 32; ++c) {
                const int buf = c & 1;
                if (c + 1 < SEQ / 32) {
                    const size_t gb = gbase + (size_t)(c + 1) * 32 * 1024;
#pragma unroll
                    for (int a = 0; a < 5; ++a) st[a] = *(const GAS f32x4*)(arr[a] + gb + (size_t)tl * 1024 + j4);
                    if (tid < 256) sv = *(const GAS f32x4*)(Vv + gb + (size_t)vt * 1024 + half * 32 + vi4);
                }
                const LAS float* ob = OPS + buf * (5 * 32 * 64) + 4 * jq;
                const LAS float* vb = VVs + buf * 1024 + 4 * wave + r4;
                LAS float* yb = YBs + buf * 1024 + 4 * wave + r4;
#pragma unroll 4
                for (int t = 0; t < 32; ++t) {
                    const f32x4 a4 = *(const LAS f32x4*)(ob + (0 * 32 + t) * 64), w4 = *(const LAS f32x4*)(ob + (1 * 32 + t) * 64), b4 = *(const LAS f32x4*)(ob + (2 * 32 + t) * 64),
                                k4 = *(const LAS f32x4*)(ob + (3 * 32 + t) * 64), q4 = *(const LAS f32x4*)(ob + (4 * 32 + t) * 64);
                    const float v = vb[t * 32];
                    float p = S0 * a4.x; p += S1 * a4.y; p += S2 * a4.z; p += S3 * a4.w;
                    const float sa = -row16_sum(p);
                    S0 = S0 * w4.x + (sa * b4.x + v * k4.x); S1 = S1 * w4.y + (sa * b4.y + v * k4.y); S2 = S2 * w4.z + (sa * b4.z + v * k4.z); S3 = S3 * w4.w + (sa * b4.w + v * k4.w);
                    float y = S0 * q4.x; y += S1 * q4.y; y += S2 * q4.z; y += S3 * q4.w;
                    y = row16_sum(y);
                    if (jq == 0) yb[t * 32] = y;
                }
                if (c + 1 < SEQ / 32) {
                    const int nb = buf ^ 1;
#pragma unroll
                    for (int a = 0; a < 5; ++a) *(LAS f32x4*)(OPS + nb * (5 * 32 * 64) + (a * 32 + tl) * 64 + j4) = st[a];
                    if (tid < 256) *(LAS f32x4*)(VVs + nb * 1024 + vt * 32 + vi4) = sv;
                }
                __syncthreads();
                if (tid < 256) *(GAS f32x4*)(Yy + gbase + (size_t)(c * 32 + vt) * 1024 + half * 32 + vi4) = *(const LAS f32x4*)(YBs + buf * 1024 + vt * 32 + vi4);
            }
        } else {
            LAS float* scr = (LAS float*)(lds + wave * 16640);
            const int cw = (xcd_i * 16 + slot_i - 16) * NWAVES + wave;
            constexpr int I1 = (D / 64) * (4096 / 64), I2 = (DFF / 64) * (D / 64), IPE = I1 + I2;
            for (int it = cw; it < NE * IPE; it += 128 * NWAVES) {
                const int e = it / IPE, r = it % IPE;
                if (r < I1) transpose_item(w1 + (size_t)e * D * 4096, D, 4096, W1T, (size_t)e * 4096, scr, r, lane);
                else transpose_item(w2 + (size_t)e * DFF * D, DFF, D, W2T, (size_t)e * 2048, scr, r - I1, lane);
            }
        }
    }
    SEAM(5);

    if (IN(6)) {
        for (int m = gw; m < M; m += NGW) {
#pragma unroll
            for (int q = 0; q < 4; ++q) {
                const int c = 4 * lane + 256 * q; const size_t o = (size_t)m * 1024 + c;
                const f32x4 y = *(const GAS f32x4*)(Yy + o);
                const float mean = row16_sum(y.x + y.y + y.z + y.w) * (1.0f / 64.0f);
                const f32x4 d = y - mean;
                const float var = row16_sum(d.x * d.x + d.y * d.y + d.z * d.z + d.w * d.w) * (1.0f / 64.0f);
                const float rstd = __builtin_amdgcn_rsqf(var + GN_EPS);
                f32x4 yn = d * rstd * *(const GAS f32x4*)(lnx_w + c) + *(const GAS f32x4*)(lnx_b + c);
                yn = yn + BONUS[m * 16 + (c >> 6)] * *(const GAS f32x4*)(Vv + o);
                yn = yn * *(const GAS f32x4*)(LOUT + (size_t)m * 3072 + 2048 + c);
                v2u ov; ov.x = pk2(yn.x, yn.y); ov.y = pk2(yn.z, yn.w);
                *(GAS v2u*)(MIXIN + (size_t)m * 2048 + c) = ov;
            }
        }
    }
    SEAM(6);

    if (IN(7)) {
        pg8::Gemm g{MIXIN, WOUTT, D, D}; pg8::GridOrder S; S.init(M / 256, D / 256, G, bx, (size_t)256 * D * 2, 0, (size_t)256 * D * 2);
        pg8::EpiF32 E{MIX, D};
        pg8::gemm_phase<pg8::EpiF32, pg8::GridOrder, true, true>(lds, g, S, E);
    }
    SEAM(7);

    if (IN(8)) {
        LAS float* s_h = (LAS float*)lds;
        LAS float* s_part = (LAS float*)(lds + 65536);
        const int e = tid & 31, part = tid >> 5;
        float wreg[128];
#pragma unroll
        for (int i = 0; i < 128; ++i) wreg[i] = router_w[(size_t)(part * 128 + i) * 32 + e];
        LAS int* lcnt = (LAS int*)(lds + LDSCTL_OFF + 512);
        if (tid < NE) lcnt[tid] = 0;
        __syncthreads();
        for (int m0 = vcu * 8; m0 < M; m0 += G * 8) {
            const int m = m0 + wave;
            {
                f32x4 v[8]; float s = 0.f;
#pragma unroll
                for (int q = 0; q < 8; ++q) { const int c = 4 * lane + 256 * q; v[q] = ALPHA * *(const GAS f32x4*)(x + (size_t)m * D + c) + *(const GAS f32x4*)(MIX + (size_t)m * D + c); s += (v[q].x + v[q].y) + (v[q].z + v[q].w); }
                const float mean = wave_sum(s) * (1.0f / D); float s2 = 0.f;
#pragma unroll
                for (int q = 0; q < 8; ++q) { v[q] = v[q] - mean; s2 += (v[q].x * v[q].x + v[q].y * v[q].y) + (v[q].z * v[q].z + v[q].w * v[q].w); }
                const float rstd = 1.0f / sqrtf(wave_sum(s2) * (1.0f / D) + LN_EPS);
#pragma unroll
                for (int q = 0; q < 8; ++q) { const int c = 4 * lane + 256 * q;
                    const f32x4 hv = v[q] * rstd * *(const GAS f32x4*)(ln1_w + c) + *(const GAS f32x4*)(ln1_b + c);
                    *(GAS f32x4*)(H + (size_t)m * D + c) = hv; *(LAS f32x4*)(s_h + wave * 2048 + c) = hv;
                    v2u ov; ov.x = pk2(hv.x, hv.y); ov.y = pk2(hv.z, hv.w); *(GAS v2u*)(HB + (size_t)m * D + c) = ov; }
            }
            __syncthreads();
#pragma unroll 1
            for (int tk = 0; tk < 8; ++tk) {
                const LAS float* hp = s_h + tk * 2048 + part * 128; float acc = 0.f;
#pragma unroll
                for (int i = 0; i < 32; ++i) { const f32x4 hv = *(const LAS f32x4*)(hp + 4 * i); acc += hv.x * wreg[4 * i]; acc += hv.y * wreg[4 * i + 1]; acc += hv.z * wreg[4 * i + 2]; acc += hv.w * wreg[4 * i + 3]; }
                s_part[(tk * 16 + part) * 32 + e] = acc;
            }
            __syncthreads();
            {
                float lg = -3.0e38f;
                if (lane < 32) { lg = router_b[lane];
#pragma unroll
                    for (int p = 0; p < 16; ++p) lg += s_part[(wave * 16 + p) * 32 + lane]; }
                int idx[4]; float val[4];
#pragma unroll
                for (int k = 0; k < 4; ++k) {
                    float best = lg; int bi = lane;
#pragma unroll
                    for (int o = 1; o < 64; o <<= 1) { const float ob = __shfl_xor(best, o); const int oi = __shfl_xor(bi, o); const bool take = (ob > best) || (ob == best && oi < bi); best = take ? ob : best; bi = take ? oi : bi; }
                    idx[k] = bi; val[k] = best; if (lane == bi) lg = -3.0e38f;
                }
                if (lane == 0) {
                    float ex[4], se = 0.f;
#pragma unroll
                    for (int k = 0; k < 4; ++k) { ex[k] = __expf(val[k] - val[0]); se += ex[k]; }
                    const float inv = 1.0f / se;
#pragma unroll
                    for (int k = 0; k < 4; ++k) { TOPI[m * 4 + k] = idx[k]; GATE[m * 4 + k] = ex[k] * inv; POS[m * 4 + k] = __hip_atomic_fetch_add(lcnt + idx[k], 1, __ATOMIC_RELAXED, __HIP_MEMORY_SCOPE_WORKGROUP); }
                }
            }
            __syncthreads();
        }
        if (tid < NE) CNTWG[vcu * NE + tid] = lcnt[tid];
    }
    SEAM(8);

    if (IN(9) || IN(10) || IN(11)) {
        LAS int* s_t = (LAS int*)lds; LAS int* s_p = s_t + 512;
        LAS int* PSB = (LAS int*)(lds + LDSCTL_OFF + 640);
        { const int e = tid & 31, part = tid >> 5; int tsum = 0, psum = 0;
          for (int w = part * 16; w < part * 16 + 16; ++w) { const int cv = CNTWG[w * NE + e]; tsum += cv; psum += (w < vcu) ? cv : 0; }
          s_t[part * 32 + e] = tsum; s_p[part * 32 + e] = psum; }
        __syncthreads();
        if (tid < NE) { int tsum = 0, psum = 0; for (int p = 0; p < 16; ++p) { tsum += s_t[p * 32 + tid]; psum += s_p[p * 32 + tid]; } s_t[tid] = tsum; PSB[tid] = psum; }
        __syncthreads();
        if (tid == 0) { int acc = 0; for (int e = 0; e < NE; ++e) { PS[e] = acc; acc += (s_t[e] + 255) / 256 * 256; } PS[NE] = acc; }
        __syncthreads();
        if (tid < NE) PSB[tid] += PS[tid];
        __syncthreads();
    }
    if (IN(9)) {
        const LAS int* PSB = (const LAS int*)(lds + LDSCTL_OFF + 640);
        for (int m0 = vcu * 8; m0 < M; m0 += G * 8) {
            const int m = m0 + wave;
            const GAS v4u* src = (const GAS v4u*)(HB + (size_t)m * D);
            v4u rv[4];
#pragma unroll
            for (int q = 0; q < 4; ++q) rv[q] = src[lane + 64 * q];
#pragma unroll
            for (int k = 0; k < 4; ++k) {
                const int a = m * 4 + k, slot = PSB[TOPI[a]] + POS[a];
                if (lane == 0) { slot_tok[slot] = m; SLOT_OF[a] = slot; }
                GAS v4u* dst = (GAS v4u*)(XS + (size_t)slot * D);
#pragma unroll
                for (int q = 0; q < 4; ++q) dst[lane + 64 * q] = rv[q];
            }
        }
    }
    SEAM(9);

    if (IN(10)) {
        pg8::Gemm g{XS, W1T, D, D}; pg8::MoeOrder S; S.ps = PS; S.ntile = 16; S.npan = PS[NE] / 256; S.cprime = vcu; S.a_tstep = (size_t)256 * D * 2; S.b_tstep = (size_t)256 * D * 2;
        pg8::EpiSwiglu E{ACT, b1};
        pg8::gemm_phase<pg8::EpiSwiglu, pg8::MoeOrder, true, true>(lds, g, S, E);
    }
    SEAM(10);

    if (IN(11)) {
        pg8::Gemm g{ACT, W2T, DFF, DFF}; pg8::MoeOrder S; S.ps = PS; S.ntile = 8; S.npan = PS[NE] / 256; S.cprime = vcu; S.a_tstep = (size_t)256 * DFF * 2; S.b_tstep = (size_t)256 * DFF * 2;
        pg8::EpiBias16 E{YS, b2};
        pg8::gemm_phase<pg8::EpiBias16, pg8::MoeOrder, true, true>(lds, g, S, E);
    }
    SEAM(11);

    if (IN(12)) {
        for (int m = gw; m < M; m += NGW) {
            int sl[4]; float gt[4];
#pragma unroll
            for (int k = 0; k < 4; ++k) { sl[k] = SLOT_OF[m * 4 + k]; gt[k] = GATE[m * 4 + k]; }
            f32x4 v[8]; float s = 0.f;
#pragma unroll
            for (int q = 0; q < 8; ++q) { const int c = 4 * lane + 256 * q; f32x4 f = (f32x4){0.f, 0.f, 0.f, 0.f};
#pragma unroll
                for (int k = 0; k < 4; ++k) { const v2u yv = *(const GAS v2u*)(YS + (size_t)sl[k] * D + c); f += gt[k] * (f32x4){bflo(yv.x), bfhi(yv.x), bflo(yv.y), bfhi(yv.y)}; }
                v[q] = ALPHA * *(const GAS f32x4*)(H + (size_t)m * D + c) + f; s += (v[q].x + v[q].y) + (v[q].z + v[q].w); }
            const float mean = wave_sum(s) * (1.0f / D); float s2 = 0.f;
#pragma unroll
            for (int q = 0; q < 8; ++q) { v[q] = v[q] - mean; s2 += (v[q].x * v[q].x + v[q].y * v[q].y) + (v[q].z * v[q].z + v[q].w * v[q].w); }
            const float rstd = 1.0f / sqrtf(wave_sum(s2) * (1.0f / D) + LN_EPS);
#pragma unroll
            for (int q = 0; q < 8; ++q) { const int c = 4 * lane + 256 * q; *(GAS f32x4*)(out + (size_t)m * D + c) = v[q] * rstd * *(const GAS f32x4*)(ln2_w + c) + *(const GAS f32x4*)(ln2_b + c); }
        }
    }
#undef IN
#undef SEAM
}

extern "C" void kernel_launch(void* const* d_in, const int* in_sizes, int n_in, void* d_out, int out_size, void* d_ws, size_t ws_size, hipStream_t stream) {
    static int grid = 0;
    if (grid == 0) {
        if (n_in != 26 || out_size != M * D || ws_size < WS_END) { fprintf(stderr, "kernel_launch: unexpected problem (n_in %d, out %d, ws %zu < %zu)\n", n_in, out_size, ws_size, (size_t)WS_END); grid = -1; return; }
        int dev = 0, cus = 0, per_cu = 0;
        if (hipGetDevice(&dev) != hipSuccess || hipDeviceGetAttribute(&cus, hipDeviceAttributeMultiprocessorCount, dev) != hipSuccess) { grid = -1; return; }
        if (hipFuncSetAttribute((const void*)mk_fwd, hipFuncAttributeMaxDynamicSharedMemorySize, LDS_BYTES) != hipSuccess) { fprintf(stderr, "kernel_launch: hipFuncSetAttribute failed\n"); grid = -1; return; }
        if (hipOccupancyMaxActiveBlocksPerMultiprocessor(&per_cu, (const void*)mk_fwd, NTHR, LDS_BYTES) != hipSuccess || per_cu < 1) fprintf(stderr, "kernel_launch: occupancy query reports %d\n", per_cu);
        (void)hipGetLastError();
        if (cus != NWG) { fprintf(stderr, "kernel_launch: built for %d CUs, device has %d\n", NWG, cus); grid = -1; return; }
        grid = NWG;
    }
    if (grid < 0) return;
    (void)hipMemsetAsync((char*)d_ws + WS_CTL, 0, CTL_BYTES, stream);
    (void)hipMemsetAsync((char*)d_ws + WS_SLOTTOK, 0xFF, (size_t)NSLOT_MAX * 4, stream);
    Args a{};
    for (int i = 0; i < 26; ++i) a.in[i] = (const float*)d_in[i];
    a.out = (float*)d_out; a.ws = (unsigned char*)d_ws; a.dup = DUP_MASK;
    if (MK_N_LAUNCHES == 1) { a.ph_lo = 0; a.ph_hi = NPHASE; hipLaunchKernelGGL(mk_fwd, dim3(grid), dim3(NTHR), LDS_BYTES, stream, a); }
    else { for (int p = 0; p < NPHASE; ++p) for (int rep = 0; rep <= ((DUP_MASK >> p) & 1); ++rep) { a.ph_lo = p; a.ph_hi = p + 1; hipLaunchKernelGGL(mk_fwd, dim3(grid), dim3(NTHR), LDS_BYTES, stream, a); } }
}
```

```cpp
#include <hip/hip_runtime.h>
#include <stdint.h>
#include <stdio.h>

#ifndef DUP_MASK
#define DUP_MASK 0
#endif
#ifndef MK_N_LAUNCHES
#define MK_N_LAUNCHES 1
#endif

constexpr int D = 2048, BATCH = 4, SEQ = 4096, M = BATCH * SEQ;
constexpr int RW = 1024, PW = 1024, NH = 16;
constexpr int SHIFT_W = 3360, IN_COLS = 4384, IN_PAD = 4608;
constexpr int LK = 384;
constexpr int NE = 32, DFF = 2048;
constexpr int NASG = M * 4;
constexpr int NSLOT_MAX = NASG + NE * 256;
constexpr float LN_EPS = 1e-5f, GN_EPS = 64e-5f;
constexpr float ALPHA = 1.189207115002721f;
constexpr int NWG = 256, NWAVES = 8, NTHR = 512;
constexpr int NPHASE = 13;

#define GAS __attribute__((address_space(1)))
#define LAS __attribute__((address_space(3)))
typedef unsigned short bf16;
typedef unsigned v4u __attribute__((ext_vector_type(4)));
typedef unsigned v2u __attribute__((ext_vector_type(2)));
typedef float f32x4 __attribute__((ext_vector_type(4)));
typedef short bf16x8 __attribute__((ext_vector_type(8)));
typedef GAS unsigned gu32;
#define RLX_AGENT __ATOMIC_RELAXED, __HIP_MEMORY_SCOPE_AGENT
#define LDS_WAIT() asm volatile("s_waitcnt lgkmcnt(0)" ::: "memory")
#define VM_WAIT() asm volatile("s_waitcnt vmcnt(0)" ::: "memory")

__device__ __forceinline__ unsigned f2bf(float f) { unsigned u = __builtin_bit_cast(unsigned, f); return (u + 0x7fffu + ((u >> 16) & 1u)) >> 16; }
__device__ __forceinline__ unsigned pk2(float lo, float hi) { return f2bf(lo) | (f2bf(hi) << 16); }
__device__ __forceinline__ float bflo(unsigned w) { return __builtin_bit_cast(float, w << 16); }
__device__ __forceinline__ float bfhi(unsigned w) { return __builtin_bit_cast(float, w & 0xffff0000u); }
__device__ __forceinline__ float wave_sum(float v) {
#pragma unroll
    for (int o = 1; o < 64; o <<= 1) v += __shfl_xor(v, o);
    return v;
}
template <int CTRL> __device__ __forceinline__ float dpp_mov(float x) { return __builtin_bit_cast(float, __builtin_amdgcn_update_dpp(0, __builtin_bit_cast(int, x), CTRL, 0xF, 0xF, true)); }
__device__ __forceinline__ float row16_sum(float x) {
    x += dpp_mov<0xB1>(x);
    x += dpp_mov<0x4E>(x);
    x += dpp_mov<0x141>(x);
    x += dpp_mov<0x140>(x);
    return x;
}

namespace pg8 {
typedef unsigned short bf16_t;
typedef unsigned u32x4 __attribute__((ext_vector_type(4)));
constexpr int BM = 256, BK = 64, HALF = 128, HTB = HALF * BK * 2, STAGE_BYTES = 8 * HTB, NXCD = 8, WGM = 8;
__host__ __device__ __forceinline__ int lds_byte(int r, int c) { const int st = (r >> 4) * 2 + (c >> 5), rr = r & 15, cc = c & 31, ob = rr * 64 + cc * 2; return st * 1024 + (ob ^ (((ob >> 9) & 1) << 5)); }
__host__ __device__ __forceinline__ void stage_rc(int b, int& R, int& C) { const int st = b / 1024, sb = b % 1024, swz = sb ^ (((sb >> 9) & 1) << 5); R = (st >> 1) * 16 + swz / 64; C = (st & 1) * 32 + (swz % 64) / 2; }
__host__ __device__ __forceinline__ int perm32(int rho) { const int n = rho >> 4, i = rho & 15; return 8 * (i >> 2) + 4 * n + (i & 3); }
struct Unit { int pm, pn; };
struct Gemm { const bf16_t* A; const bf16_t* Bt; int lda, K; };
__device__ __forceinline__ unsigned cvt_pk_bf16(float lo, float hi) { unsigned r; asm volatile("v_cvt_pk_bf16_f32 %0, %1, %2" : "=v"(r) : "v"(lo), "v"(hi)); return r; }

struct GridOrder {
    int nM, nN, nwg, G, c; size_t a_tstep, a_pnstep, b_tstep;
    __device__ void init(int nM_, int nN_, int G_, int c_, size_t a_tstep_, size_t a_pnstep_, size_t b_tstep_) { nM = nM_; nN = nN_; nwg = nM * nN; G = G_; c = c_; a_tstep = a_tstep_; a_pnstep = a_pnstep_; b_tstep = b_tstep_; }
    __device__ bool next(int i, Unit& u) const {
        const long L = (long)i * G + c; if (L >= nwg) return false;
        int wgid = (int)L; { const int q = nwg / NXCD, r = nwg % NXCD, xcd = wgid % NXCD, off = wgid / NXCD; wgid = (xcd < r ? xcd * (q + 1) : r * (q + 1) + (xcd - r) * q) + off; }
        const int nig = WGM * nN, gid = wgid / nig, fm = gid * WGM, gsz = (nM - fm) < WGM ? (nM - fm) : WGM;
        u.pm = fm + ((wgid % nig) % gsz); u.pn = (wgid % nig) / gsz; return true;
    }
    __device__ __forceinline__ size_t aoff(const Unit& u) const { return (size_t)u.pm * a_tstep + (size_t)u.pn * a_pnstep; }
    __device__ __forceinline__ size_t boff(const Unit& u) const { return (size_t)u.pn * b_tstep; }
};
struct MoeOrder {
    const LAS int* ps; int ntile, npan, cprime; size_t a_tstep, b_tstep;
    __device__ bool next(int i, Unit& u) const {
        const int U = i * NWG + cprime; const int p = U / ntile; if (p >= npan) return false;
        const int row = p * 256; int e = 0;
#pragma unroll 1
        for (int q = 1; q < NE; ++q) e = (row >= ps[q]) ? q : e;
        u.pm = p; u.pn = e * ntile + (U % ntile); return true;
    }
    __device__ __forceinline__ size_t aoff(const Unit& u) const { return (size_t)u.pm * a_tstep; }
    __device__ __forceinline__ size_t boff(const Unit& u) const { return (size_t)u.pn * b_tstep; }
};

template <class Epi, class Sched, bool ALIGN_EPI, bool SP2>
__device__ __forceinline__ void gemm_phase(LAS unsigned char* lds, const Gemm g, const Sched& S, const Epi& E) {
    int tid_ = threadIdx.x; asm volatile("" : "+v"(tid_));
    const int tid = tid_, wid = __builtin_amdgcn_readfirstlane(tid >> 6), lane = tid & 63, wr = wid >> 2, wc = wid & 3, fr = lane & 15, fq = lane >> 4;
    const int K = g.K, nt = K / BK;
    unsigned voffA[2], voffB[2];
#pragma unroll
    for (int i = 0; i < 2; ++i) { int R, C; stage_rc(tid * 16 + i * 8192, R, C); const int Rb = Epi::PERM ? ((R & ~31) + perm32(R & 31)) : R;
        voffA[i] = (unsigned)(R * g.lda + C) * 2u; voffB[i] = (unsigned)(Rb * K + C) * 2u; }
    const size_t kstep = (size_t)(BK * 2);
    const size_t hstepA = (size_t)HALF * g.lda * 2, hstepB = (size_t)HALF * K * 2;
    const unsigned ldsw = (unsigned)wid * 1024u;
    const int aoff = lds_byte(wr * 64 + fr, fq * 8), boff = lds_byte(wc * 32 + fr, fq * 8);
#define PG8_SA(b, h) (((b) * 2 + (h)) * HTB)
#define PG8_SB(b, h) ((4 + (b) * 2 + (h)) * HTB)
#define PG8_STAGE(bufoff, gbase, voff) do { _Pragma("unroll") for (int _i = 0; _i < 2; ++_i) \
        __builtin_amdgcn_global_load_lds((const unsigned*)((const char*)(gbase) + (voff)[_i]), (LAS unsigned*)(lds + (bufoff) + ldsw + _i * 8192), 16, 0, 0); } while (0)
#define PG8_LDA(dst, b, h) do { _Pragma("unroll") for (int m = 0; m < 4; ++m) _Pragma("unroll") for (int k = 0; k < 2; ++k) dst[m][k] = *(const LAS bf16x8*)(lds + PG8_SA(b, h) + aoff + m * 2048 + k * 1024); } while (0)
#define PG8_LDB(dst, b, h) do { _Pragma("unroll") for (int n = 0; n < 2; ++n) _Pragma("unroll") for (int k = 0; k < 2; ++k) dst[n][k] = *(const LAS bf16x8*)(lds + PG8_SB(b, h) + boff + n * 2048 + k * 1024); } while (0)
#define PG8_MMA(ai, bj, At, Bt) do { __builtin_amdgcn_s_setprio(1); _Pragma("unroll") for (int m = 0; m < 4; ++m) _Pragma("unroll") for (int n = 0; n < 2; ++n) _Pragma("unroll") for (int k = 0; k < 2; ++k) \
        acc[ai][bj][m][n] = __builtin_amdgcn_mfma_f32_16x16x32_bf16(Bt[n][k], At[m][k], acc[ai][bj][m][n], 0, 0, 0); __builtin_amdgcn_s_setprio(0); } while (0)
#define PG8_WAIT_V(n) asm volatile("s_waitcnt vmcnt(" #n ")" ::: "memory")
#define PG8_WAIT_L(n) asm volatile("s_waitcnt lgkmcnt(" #n ")" ::: "memory")
#define PG8_BAR __builtin_amdgcn_s_barrier()
#define PG8_SCHED __builtin_amdgcn_sched_barrier(0)
    Unit cur, nxt; int ui = 0;
    if (!S.next(0, cur)) return;
    f32x4 acc[2][2][4][2];
#pragma unroll
    for (int a = 0; a < 2; ++a)
#pragma unroll
        for (int b = 0; b < 2; ++b)
#pragma unroll
            for (int m = 0; m < 4; ++m)
#pragma unroll
                for (int n = 0; n < 2; ++n) acc[a][b][m][n] = (f32x4){0.f, 0.f, 0.f, 0.f};
    bf16x8 At[4][2], B0[2][2], B1[2][2];
    const char* cA = (const char*)g.A + S.aoff(cur); const char* cB = (const char*)g.Bt + S.boff(cur);
    if constexpr (SP2) {
        PG8_STAGE(PG8_SB(0, 0), cB, voffB); PG8_STAGE(PG8_SB(0, 1), cB + hstepB, voffB); PG8_STAGE(PG8_SA(0, 0), cA, voffA); PG8_STAGE(PG8_SA(0, 1), cA + hstepA, voffA);
        if (wr == 1) PG8_BAR;
        PG8_WAIT_V(2); PG8_BAR;
        PG8_STAGE(PG8_SB(1, 0), cB + kstep, voffB); PG8_STAGE(PG8_SA(1, 0), cA + kstep, voffA); PG8_STAGE(PG8_SB(1, 1), cB + hstepB + kstep, voffB);
        PG8_WAIT_V(6); PG8_BAR;
    } else {
        PG8_STAGE(PG8_SB(0, 0), cB, voffB); PG8_STAGE(PG8_SA(0, 0), cA, voffA); PG8_STAGE(PG8_SB(0, 1), cB + hstepB, voffB); PG8_STAGE(PG8_SA(0, 1), cA + hstepA, voffA);
        if (wr == 1) PG8_BAR;
        PG8_WAIT_V(4); PG8_BAR;
        PG8_STAGE(PG8_SB(1, 0), cB + kstep, voffB); PG8_STAGE(PG8_SA(1, 0), cA + kstep, voffA); PG8_STAGE(PG8_SB(1, 1), cB + hstepB + kstep, voffB);
        PG8_WAIT_V(6); PG8_BAR;
    }
    for (;;) {
        const bool has_next = S.next(ui + 1, nxt);
        const char* nA = has_next ? (const char*)g.A + S.aoff(nxt) : cA; const char* nB = has_next ? (const char*)g.Bt + S.boff(nxt) : cB;
#pragma unroll 1
        for (int t = 0; t < nt; t += 2) {
            const bool last = (t == nt - 2);
            const char* a1 = cA + (size_t)(t + 1) * kstep;
            const char* a2 = last ? nA : cA + (size_t)(t + 2) * kstep; const char* b2 = last ? nB : cB + (size_t)(t + 2) * kstep;
            const char* a3 = a2 + kstep; const char* b3 = b2 + kstep;
            if constexpr (SP2) {
            PG8_LDB(B0, 0, 0); PG8_LDB(B1, 0, 1); PG8_SCHED; PG8_LDA(At, 0, 0); PG8_STAGE(PG8_SA(1, 1), a1 + hstepA, voffA);
            PG8_WAIT_V(8); PG8_WAIT_L(0); PG8_BAR; PG8_MMA(0, 0, At, B0); PG8_MMA(0, 1, At, B1); PG8_BAR; PG8_SCHED;
            PG8_LDA(At, 0, 1); PG8_STAGE(PG8_SB(0, 0), b2, voffB); PG8_STAGE(PG8_SB(0, 1), b2 + hstepB, voffB); PG8_STAGE(PG8_SA(0, 0), a2, voffA);
            PG8_WAIT_V(8); PG8_WAIT_L(0); PG8_BAR; PG8_MMA(1, 0, At, B0); PG8_MMA(1, 1, At, B1); PG8_BAR; PG8_SCHED;
            PG8_LDB(B0, 1, 0); PG8_LDB(B1, 1, 1); PG8_SCHED; PG8_LDA(At, 1, 0); PG8_STAGE(PG8_SA(0, 1), a2 + hstepA, voffA);
            PG8_WAIT_V(8); PG8_WAIT_L(0); PG8_BAR; PG8_MMA(0, 0, At, B0); PG8_MMA(0, 1, At, B1); PG8_BAR; PG8_SCHED;
            PG8_LDA(At, 1, 1); PG8_STAGE(PG8_SB(1, 0), b3, voffB); PG8_STAGE(PG8_SB(1, 1), b3 + hstepB, voffB); PG8_STAGE(PG8_SA(1, 0), a3, voffA);
            PG8_WAIT_V(8); PG8_WAIT_L(0); PG8_BAR; PG8_MMA(1, 0, At, B0); PG8_MMA(1, 1, At, B1); PG8_BAR; PG8_SCHED;
            } else {
            PG8_LDB(B0, 0, 0); PG8_SCHED; PG8_LDA(At, 0, 0); PG8_STAGE(PG8_SA(1, 1), a1 + hstepA, voffA);
            PG8_WAIT_L(8); PG8_BAR; PG8_WAIT_L(0); PG8_MMA(0, 0, At, B0); PG8_BAR; PG8_SCHED;
            PG8_LDB(B1, 0, 1); PG8_STAGE(PG8_SB(0, 0), b2, voffB);
            PG8_BAR; PG8_WAIT_L(0); PG8_MMA(0, 1, At, B1); PG8_BAR;
            PG8_LDA(At, 0, 1); PG8_STAGE(PG8_SA(0, 0), a2, voffA);
            PG8_BAR; PG8_WAIT_L(0); PG8_MMA(1, 0, At, B0); PG8_BAR; PG8_SCHED;
            PG8_STAGE(PG8_SB(0, 1), b2 + hstepB, voffB);
            PG8_WAIT_V(6); PG8_BAR; PG8_MMA(1, 1, At, B1); PG8_BAR;
            PG8_LDB(B0, 1, 0); PG8_SCHED; PG8_LDA(At, 1, 0); PG8_STAGE(PG8_SA(0, 1), a2 + hstepA, voffA);
            PG8_WAIT_L(8); PG8_BAR; PG8_WAIT_L(0); PG8_MMA(0, 0, At, B0); PG8_BAR; PG8_SCHED;
            PG8_LDB(B1, 1, 1); PG8_STAGE(PG8_SB(1, 0), b3, voffB);
            PG8_BAR; PG8_WAIT_L(0); PG8_MMA(0, 1, At, B1); PG8_BAR;
            PG8_LDA(At, 1, 1); PG8_STAGE(PG8_SA(1, 0), a3, voffA);
            PG8_BAR; PG8_WAIT_L(0); PG8_MMA(1, 0, At, B0); PG8_BAR; PG8_SCHED;
            PG8_STAGE(PG8_SB(1, 1), b3 + hstepB, voffB);
            PG8_WAIT_V(6); PG8_BAR; PG8_MMA(1, 1, At, B1); PG8_BAR;
            }
        }
        if constexpr (ALIGN_EPI) { if (wr == 0) PG8_BAR; }
        E(acc, cur, wr, wc, fr, fq);
        if (!has_next) break;
#pragma unroll
        for (int a = 0; a < 2; ++a)
#pragma unroll
            for (int b = 0; b < 2; ++b)
#pragma unroll
                for (int m = 0; m < 4; ++m)
#pragma unroll
                    for (int n = 0; n < 2; ++n) acc[a][b][m][n] = (f32x4){0.f, 0.f, 0.f, 0.f};
        cur = nxt; cA = nA; cB = nB; ++ui;
        if constexpr (ALIGN_EPI) { if (wr == 1) PG8_BAR; }
    }
    PG8_WAIT_V(0);
    if constexpr (!ALIGN_EPI) { if (wr == 0) PG8_BAR; }
    PG8_BAR;
#undef PG8_SA
#undef PG8_SB
#undef PG8_STAGE
#undef PG8_LDA
#undef PG8_LDB
#undef PG8_MMA
#undef PG8_WAIT_V
#undef PG8_WAIT_L
#undef PG8_BAR
#undef PG8_SCHED
}

struct EpiF32 {
    static constexpr bool PERM = false;
    float* C; int ldc;
    __device__ __forceinline__ void operator()(const f32x4 (&acc)[2][2][4][2], const Unit& u, int wr, int wc, int fr, int fq) const {
        const int row0 = u.pm * BM + wr * 64 + fr, col0 = u.pn * BM + wc * 32 + 4 * fq;
#pragma unroll
        for (int ai = 0; ai < 2; ++ai)
#pragma unroll
            for (int m = 0; m < 4; ++m) { float* rowp = C + (size_t)(row0 + ai * HALF + m * 16) * ldc + col0;
#pragma unroll
                for (int bj = 0; bj < 2; ++bj)
#pragma unroll
                    for (int n = 0; n < 2; ++n) *(f32x4*)(rowp + bj * HALF + n * 16) = acc[ai][bj][m][n]; }
    }
};
struct EpiPool {
    static constexpr bool PERM = true;
    bf16_t* O; const float* scale;
    __device__ __forceinline__ void operator()(const f32x4 (&acc)[2][2][4][2], const Unit& u, int wr, int wc, int fr, int fq) const {
        const int row0 = u.pm * BM + wr * 64 + fr; int col0 = u.pn * BM + wc * 32 + 8 * fq;
        asm volatile("" : "+v"(col0));
        f32x4 sv[2][2];
#pragma unroll
        for (int bj = 0; bj < 2; ++bj)
#pragma unroll
            for (int n = 0; n < 2; ++n) sv[bj][n] = *(const f32x4*)(scale + col0 + bj * HALF + 4 * n);
#pragma unroll
        for (int ai = 0; ai < 2; ++ai)
#pragma unroll
            for (int m = 0; m < 4; ++m) { bf16_t* rowp = O + (size_t)(row0 + ai * HALF + m * 16) * 2048 + 1024 + col0;
#pragma unroll
                for (int bj = 0; bj < 2; ++bj) { const f32x4 v0 = acc[ai][bj][m][0] * sv[bj][0], v1 = acc[ai][bj][m][1] * sv[bj][1];
                    u32x4 w; w.x = cvt_pk_bf16(v0[0], v0[1]); w.y = cvt_pk_bf16(v0[2], v0[3]); w.z = cvt_pk_bf16(v1[0], v1[1]); w.w = cvt_pk_bf16(v1[2], v1[3]);
                    *(u32x4*)(rowp + bj * HALF) = w; } }
    }
};
struct EpiSwiglu {
    static constexpr bool PERM = true;
    bf16_t* O; const float* b1;
    __device__ __forceinline__ void operator()(const f32x4 (&acc)[2][2][4][2], const Unit& u, int wr, int wc, int fr, int fq) const {
        const int e = u.pn >> 4, nt = u.pn & 15;
        const int row0 = u.pm * BM + wr * 64 + fr; int col0 = nt * BM + wc * 32 + 8 * fq;
        asm volatile("" : "+v"(col0));
        const float* bp = b1 + (size_t)e * 4096 + col0;
        f32x4 bv[2][2];
#pragma unroll
        for (int bj = 0; bj < 2; ++bj)
#pragma unroll
            for (int n = 0; n < 2; ++n) bv[bj][n] = *(const f32x4*)(bp + bj * HALF + 4 * n);
#pragma unroll
        for (int ai = 0; ai < 2; ++ai)
#pragma unroll
            for (int m = 0; m < 4; ++m) { bf16_t* rowp = O + (size_t)(row0 + ai * HALF + m * 16) * 2048 + (col0 >> 1);
#pragma unroll
                for (int bj = 0; bj < 2; ++bj) { const f32x4 v0 = acc[ai][bj][m][0] + bv[bj][0], v1 = acc[ai][bj][m][1] + bv[bj][1];
                    float a[4];
#pragma unroll
                    for (int p = 0; p < 4; ++p) { const float hg = p < 2 ? v0[2 * p] : v1[2 * p - 4], hl = p < 2 ? v0[2 * p + 1] : v1[2 * p - 3];
                        const float xg = fminf(hg, 7.0f), xl = fminf(fmaxf(hl, -7.0f), 7.0f);
                        a[p] = xg * __builtin_amdgcn_rcpf(1.0f + __expf(-1.702f * xg)) * (xl + 1.0f); }
                    v2u w; w.x = cvt_pk_bf16(a[0], a[1]); w.y = cvt_pk_bf16(a[2], a[3]);
                    *(v2u*)(rowp + bj * (HALF / 2)) = w; } }
    }
};
struct EpiBias16 {
    static constexpr bool PERM = true;
    bf16_t* O; const float* b2;
    __device__ __forceinline__ void operator()(const f32x4 (&acc)[2][2][4][2], const Unit& u, int wr, int wc, int fr, int fq) const {
        const int e = u.pn >> 3, nt = u.pn & 7;
        const int row0 = u.pm * BM + wr * 64 + fr; int col0 = nt * BM + wc * 32 + 8 * fq;
        asm volatile("" : "+v"(col0));
        const float* bp = b2 + (size_t)e * 2048 + col0;
        f32x4 bv[2][2];
#pragma unroll
        for (int bj = 0; bj < 2; ++bj)
#pragma unroll
            for (int n = 0; n < 2; ++n) bv[bj][n] = *(const f32x4*)(bp + bj * HALF + 4 * n);
#pragma unroll
        for (int ai = 0; ai < 2; ++ai)
#pragma unroll
            for (int m = 0; m < 4; ++m) { bf16_t* rowp = O + (size_t)(row0 + ai * HALF + m * 16) * 2048 + col0;
#pragma unroll
                for (int bj = 0; bj < 2; ++bj) { const f32x4 v0 = acc[ai][bj][m][0] + bv[bj][0], v1 = acc[ai][bj][m][1] + bv[bj][1];
                    u32x4 w; w.x = cvt_pk_bf16(v0[0], v0[1]); w.y = cvt_pk_bf16(v0[2], v0[3]); w.z = cvt_pk_bf16(v1[0], v1[1]); w.w = cvt_pk_bf16(v1[2], v1[3]);
                    *(u32x4*)(rowp + bj * HALF) = w; } }
    }
};
}

#define XB_TMO      128
#define XB_XCNT(j)  (256  + 64 * (j))
#define XB_XSUB(j)  (1280 + 64 * (j))
#define XB_XGEN(j)  (2304 + 64 * (j))
#define XB_TOP      3328
#define XB_TOPGEN   3392
#define XCD_BAR_WORDS 3456
#define XB_SPIN_CAP (1u << 22)
__device__ __forceinline__ unsigned xb_ld(unsigned* p)              { return __hip_atomic_load(p, __ATOMIC_RELAXED, __HIP_MEMORY_SCOPE_AGENT); }
__device__ __forceinline__ unsigned xb_add(unsigned* p, unsigned v) { return __hip_atomic_fetch_add(p, v, __ATOMIC_RELAXED, __HIP_MEMORY_SCOPE_AGENT); }
__device__ __forceinline__ unsigned xb_xcc_id() { return (unsigned)__builtin_amdgcn_s_getreg((3 << 11) | 20) & 0xFu; }
#define XB_SPIN(cond, bar) do { unsigned _sp = 0; while (cond) { __builtin_amdgcn_s_sleep(1); \
    if ((++_sp & 255u) == 0u) { if (xb_ld(&(bar)[XB_TMO])) break; if (_sp > XB_SPIN_CAP) { atomicAdd(&(bar)[XB_TMO], 1u); break; } } } } while (0)
struct XcdBarrier { unsigned* bar; unsigned x; volatile LAS unsigned* st; };
__device__ __forceinline__ XcdBarrier xcd_barrier_post(unsigned* bar, volatile LAS unsigned* st) {
    XcdBarrier b; b.bar = bar; b.x = xb_xcc_id(); b.st = st;
    if (threadIdx.x == 0) (void)xb_add(&bar[XB_XCNT(b.x)], 1u);
    return b;
}
__device__ __forceinline__ void xcd_barrier_complete(unsigned* bar, unsigned x, unsigned& nloc, unsigned& nx) {
    const unsigned G = gridDim.x * gridDim.y * gridDim.z;
    unsigned sum, cnt, mine, sp = 0u;
    for (;;) {
        sum = 0u; cnt = 0u; mine = 0u;
#pragma unroll
        for (unsigned j = 0; j < 16; ++j) { const unsigned c = xb_ld(&bar[XB_XCNT(j)]); sum += c; cnt += (c > 0u) ? 1u : 0u; mine = (j == x) ? c : mine; }
        if (sum == G) break;
        __builtin_amdgcn_s_sleep(1);
        if ((++sp & 255u) == 0u) { if (xb_ld(&bar[XB_TMO])) break; if (sp > XB_SPIN_CAP) { atomicAdd(&bar[XB_TMO], 1u); break; } }
    }
    nloc = mine > 0u ? mine : 1u; nx = cnt > 0u ? cnt : 1u;
}
__device__ __forceinline__ void xcd_barrier(const XcdBarrier& b) {
    asm volatile("s_waitcnt vmcnt(0)" ::: "memory");
    __syncthreads();
    if (threadIdx.x == 0) {
        unsigned* bar = b.bar;
        __builtin_amdgcn_s_waitcnt(0);
        unsigned nloc = b.st[0], nx = b.st[1];
        if (nloc == 0u) { xcd_barrier_complete(bar, b.x, nloc, nx); b.st[0] = nloc; b.st[1] = nx; }
        const unsigned old = xb_add(&bar[XB_XSUB(b.x)], 1u);
        const unsigned gen = old / nloc;
        if (old + 1u == (gen + 1u) * nloc) {
            __builtin_amdgcn_fence(__ATOMIC_RELEASE, "agent");
            asm volatile("s_waitcnt vmcnt(0)" ::: "memory");
            const unsigned og = xb_add(&bar[XB_TOP], 1u);
            const unsigned tg = og / nx;
            if (og + 1u == (tg + 1u) * nx) xb_add(&bar[XB_TOPGEN], 1u);
            else XB_SPIN(xb_ld(&bar[XB_TOPGEN]) == tg, bar);
            __builtin_amdgcn_fence(__ATOMIC_ACQUIRE, "agent");
            xb_add(&bar[XB_XGEN(b.x)], 1u);
            asm volatile("s_waitcnt vmcnt(0)" ::: "memory");
        } else {
            XB_SPIN(xb_ld(&bar[XB_XGEN(b.x)]) == gen, bar);
            __builtin_amdgcn_fence(__ATOMIC_ACQUIRE, "agent");
            asm volatile("s_waitcnt vmcnt(0)" ::: "memory");
        }
    }
    __syncthreads();
}

constexpr size_t al256(size_t x) { return (x + 255) & ~(size_t)255; }
constexpr size_t WS_CTL = 0, CTL_BYTES = 1u << 20;
constexpr int CW_BAR = 4096;
constexpr int CW_CNT = 16384;
constexpr size_t WS_SLOTTOK = WS_CTL + CTL_BYTES;
constexpr size_t WS_TOPI = WS_SLOTTOK + al256((size_t)NSLOT_MAX * 4);
constexpr size_t WS_GATE = WS_TOPI + (size_t)NASG * 4;
constexpr size_t WS_POS = WS_GATE + (size_t)NASG * 4;
constexpr size_t WS_SLOTOF = WS_POS + (size_t)NASG * 4;
constexpr size_t WS_BONUS = WS_SLOTOF + (size_t)NASG * 4;
constexpr size_t WS_XB = WS_BONUS + (size_t)M * 16 * 4;
constexpr size_t WS_WINT = WS_XB + (size_t)M * D * 2;
constexpr size_t WS_WOUTT = WS_WINT + (size_t)IN_PAD * D * 2;
constexpr size_t WS_LORAT = WS_WOUTT + (size_t)D * D * 2;
constexpr size_t WS_WPOOLT = WS_LORAT + (size_t)3072 * LK * 2;
constexpr size_t WS_PROJ = WS_WPOOLT + (size_t)1024 * 256 * 2;
constexpr size_t WS_LIN = WS_PROJ + (size_t)M * IN_PAD * 4;
constexpr size_t WS_POOLED = WS_LIN + (size_t)M * LK * 2;
constexpr size_t WS_WDEC = WS_POOLED + (size_t)M * 1024 * 2;
constexpr size_t SZ_F1K = (size_t)M * 1024 * 4;
constexpr size_t WS_LOUT = WS_WDEC + SZ_F1K  , WS_R = WS_LOUT + 3 * SZ_F1K, WS_K2 = WS_R + SZ_F1K, WS_V = WS_K2 + SZ_F1K, WS_KK = WS_V + SZ_F1K, WS_BB = WS_KK + SZ_F1K, WS_Y = WS_BB + SZ_F1K;
constexpr size_t WS_MIXIN = WS_Y + SZ_F1K;
constexpr size_t WS_MIX = WS_MIXIN + (size_t)M * D * 2;
constexpr size_t WS_H = WS_MIX + (size_t)M * D * 4;
constexpr size_t WS_HB = WS_H + (size_t)M * D * 4;
constexpr size_t WS_XS = WS_HB + (size_t)M * D * 2;
constexpr size_t WS_W1T = WS_XS + (size_t)NSLOT_MAX * D * 2;
constexpr size_t WS_W2T = WS_W1T + (size_t)NE * 4096 * D * 2;
constexpr size_t WS_ACT = WS_W2T + (size_t)NE * 2048 * DFF * 2;
constexpr size_t WS_YS = WS_ACT + (size_t)NSLOT_MAX * DFF * 2;
constexpr size_t WS_END = WS_YS + (size_t)NSLOT_MAX * D * 2;

constexpr int RING_BYTES = 131072;
constexpr int LDSCTL_OFF = 139264;
constexpr int LDS_BYTES = 147456;

struct Args { const float* in[26]; float* out; unsigned char* ws; int ph_lo, ph_hi, dup, pad; };

__device__ __forceinline__ void transpose_item(const float* W, int K, int N, bf16* WT, size_t row_off, LAS float* scr, int item, int lane) {
    const int nblk = N / 64, kb = item / nblk, nb = item % nblk, k0 = 64 * kb, n0 = 64 * nb;
    const int r = lane >> 4, c4 = (lane & 15) * 4;
    f32x4 v[16];
#pragma unroll
    for (int i = 0; i < 16; ++i) v[i] = *(const GAS f32x4*)(W + (size_t)(k0 + 4 * i + r) * N + n0 + c4);
#pragma unroll
    for (int i = 0; i < 16; ++i) { LAS float* d = scr + (4 * i + r) * 65 + c4; d[0] = v[i].x; d[1] = v[i].y; d[2] = v[i].z; d[3] = v[i].w; }
    LDS_WAIT(); asm volatile("" ::: "memory");
    const int c = lane & 7;
#pragma unroll
    for (int p = 0; p < 8; ++p) { const int n = (lane >> 3) + 8 * p; const LAS float* q = scr + (8 * c) * 65 + n;
        v4u o; o.x = pk2(q[0 * 65], q[1 * 65]); o.y = pk2(q[2 * 65], q[3 * 65]); o.z = pk2(q[4 * 65], q[5 * 65]); o.w = pk2(q[6 * 65], q[7 * 65]);
        *(GAS v4u*)(WT + (row_off + n0 + n) * (size_t)K + k0 + 8 * c) = o; }
    LDS_WAIT(); asm volatile("" ::: "memory");
}

__global__ void __launch_bounds__(NTHR, 2) mk_fwd(Args args) {
    extern __shared__ __attribute__((aligned(16))) unsigned char lds_raw[];
    LAS unsigned char* lds = (LAS unsigned char*)lds_raw;
    volatile LAS unsigned* MISC = (volatile LAS unsigned*)(lds + LDSCTL_OFF);
    LAS int* PS = (LAS int*)(lds + LDSCTL_OFF + 256);
    const int tid = threadIdx.x, lane = tid & 63, wave = __builtin_amdgcn_readfirstlane(tid >> 6);
    const int G = gridDim.x, bx = blockIdx.x;
    const int vcu = (bx % 8) * (G / 8) + bx / 8;
    const int gw = vcu * NWAVES + wave, NGW = G * NWAVES;
    unsigned char* ws = args.ws;
    gu32* ctl = (gu32*)(ws + WS_CTL);
    const float* x = args.in[0]; const float* w_in = args.in[1]; const float* mu = args.in[2]; const float* w0 = args.in[3]; const float* w2d = args.in[4];
    const float* a0 = args.in[5]; const float* a2 = args.in[6]; const float* g2 = args.in[7]; const float* k_k = args.in[8]; const float* k_a = args.in[9];
    const float* r_k = args.in[10]; const float* lnx_w = args.in[11]; const float* lnx_b = args.in[12]; const float* w_pool = args.in[13]; const float* pool_scale = args.in[14];
    const float* w_out = args.in[15]; const float* ln1_w = args.in[16]; const float* ln1_b = args.in[17]; const float* router_w = args.in[18]; const float* router_b = args.in[19];
    const float* w1 = args.in[20]; const float* b1 = args.in[21]; const float* w2 = args.in[22]; const float* b2 = args.in[23]; const float* ln2_w = args.in[24]; const float* ln2_b = args.in[25];
    float* out = args.out;
    int* CNTWG = (int*)(ws + WS_CTL) + CW_CNT;
    int* slot_tok = (int*)(ws + WS_SLOTTOK); int* TOPI = (int*)(ws + WS_TOPI); float* GATE = (float*)(ws + WS_GATE); int* POS = (int*)(ws + WS_POS); int* SLOT_OF = (int*)(ws + WS_SLOTOF);
    float* BONUS = (float*)(ws + WS_BONUS);
    bf16* XB = (bf16*)(ws + WS_XB); bf16* WINT = (bf16*)(ws + WS_WINT); bf16* WOUTT = (bf16*)(ws + WS_WOUTT); bf16* LORAT = (bf16*)(ws + WS_LORAT); bf16* WPOOLT = (bf16*)(ws + WS_WPOOLT);
    float* PROJ = (float*)(ws + WS_PROJ); bf16* LIN = (bf16*)(ws + WS_LIN); bf16* POOLED = (bf16*)(ws + WS_POOLED);
    float* WDEC = (float*)(ws + WS_WDEC); float* LOUT = (float*)(ws + WS_LOUT); float* Rr = (float*)(ws + WS_R); float* K2 = (float*)(ws + WS_K2);
    float* Vv = (float*)(ws + WS_V); float* KK = (float*)(ws + WS_KK); float* BB = (float*)(ws + WS_BB); float* Yy = (float*)(ws + WS_Y);
    bf16* MIXIN = (bf16*)(ws + WS_MIXIN); float* MIX = (float*)(ws + WS_MIX); float* H = (float*)(ws + WS_H); bf16* HB = (bf16*)(ws + WS_HB);
    bf16* XS = (bf16*)(ws + WS_XS); bf16* W1T = (bf16*)(ws + WS_W1T); bf16* W2T = (bf16*)(ws + WS_W2T); bf16* ACT = (bf16*)(ws + WS_ACT); bf16* YS = (bf16*)(ws + WS_YS);

    for (int u = tid; u < (LDS_BYTES - LDSCTL_OFF) / 4; u += NTHR) ((LAS unsigned*)(lds + LDSCTL_OFF))[u] = 0u;
    __syncthreads();
    XcdBarrier bar; bar.bar = (unsigned*)(ctl + CW_BAR); bar.x = 0; bar.st = nullptr;
    if (MK_N_LAUNCHES == 1) bar = xcd_barrier_post((unsigned*)(ctl + CW_BAR), MISC + 8);
    const int lo = args.ph_lo, hi = args.ph_hi;
#ifndef PHASE_MASK
#define PHASE_MASK 0xFFFF
#endif
#define IN(k) (((PHASE_MASK >> (k)) & 1) && lo <= (k) && (k) < hi)
#define SEAM(k) do { if (IN(k) && IN((k) + 1)) xcd_barrier(bar); } while (0)

    if (IN(0)) {
        LAS float* scr = (LAS float*)(lds + wave * 16640);
        for (size_t i = (size_t)gw * 64 + lane; i < (size_t)M * D / 8; i += (size_t)NGW * 64) {
            const f32x4 a = *(const GAS f32x4*)(x + i * 8), b = *(const GAS f32x4*)(x + i * 8 + 4);
            v4u o; o.x = pk2(a.x, a.y); o.y = pk2(a.z, a.w); o.z = pk2(b.x, b.y); o.w = pk2(b.z, b.w);
            *(GAS v4u*)(XB + i * 8) = o;
        }
        constexpr int I_IN = (D / 64) * (IN_COLS / 64)  , I_OUT = (D / 64) * (D / 64);
        for (int it = gw; it < I_IN + I_OUT; it += NGW) {
            if (it < I_IN) transpose_item(w_in, D, IN_COLS, WINT, 0, scr, it, lane);
            else transpose_item(w_out, D, D, WOUTT, 0, scr, it - I_IN, lane);
        }
        for (int i = gw * 64 + lane; i < 32 * D; i += NGW * 64) { const int nn = 4352 + (i >> 11), k = i & 2047; WINT[(size_t)nn * D + k] = (bf16)f2bf(w_in[(size_t)k * IN_COLS + nn]); }
        for (size_t i = (size_t)gw * 64 + lane; i < (size_t)(IN_PAD - IN_COLS) * D / 8; i += (size_t)NGW * 64) *(GAS v4u*)(WINT + (size_t)IN_COLS * D + i * 8) = (v4u){0u, 0u, 0u, 0u};
        for (int i = gw * 64 + lane; i < 3072 * LK; i += NGW * 64) {
            const int n = i / LK, k = i % LK; float v = 0.f;
            if (n < 1024) { if (k < 64) v = w2d[k * 1024 + n]; }
            else if (n < 2048) { if (k >= 64 && k < 128) v = a2[(k - 64) * 1024 + (n - 1024)]; }
            else { if (k >= 128 && k < 288) v = g2[(k - 128) * 1024 + (n - 2048)]; }
            LORAT[i] = (bf16)f2bf(v);
        }
        for (int i = gw * 64 + lane; i < 1024 * 256; i += NGW * 64) {
            const int n = i >> 8, c = i & 255, g = n >> 8, d = n & 255;
            WPOOLT[i] = (bf16)f2bf(w_pool[((size_t)g * 256 + c) * 256 + d]);
        }
    }
    SEAM(0);

    if (IN(1)) {
        pg8::Gemm g{XB, WINT, D, D}; pg8::GridOrder S; S.init(M / 256, IN_PAD / 256, G, bx, (size_t)256 * D * 2, 0, (size_t)256 * D * 2);
        pg8::EpiF32 E{PROJ, IN_PAD};
        pg8::gemm_phase<pg8::EpiF32, pg8::GridOrder, true, true>(lds, g, S, E);
    }
    SEAM(1);

    if (IN(2)) {
        for (int m = gw; m < M; m += NGW) {
            const int t = m % SEQ;
            const float* pr = PROJ + (size_t)m * IN_PAD; const float* pp = pr - IN_PAD;
#pragma unroll
            for (int q = 0; q < 6; ++q) {
                const int i = lane + 64 * q; float v = 0.f;
                if (i < 288) { const int c = 3072 + i; const float cur = pr[c], prev = t > 0 ? pp[c] : 0.f; const float s = cur + (prev - cur) * mu[c];
                    v = i < 64 ? tanhf(s) : (i < 128 ? s : 1.0f / (1.0f + __expf(-s))); }
                LIN[(size_t)m * LK + i] = (bf16)f2bf(v);
            }
#pragma unroll
            for (int q = 0; q < 4; ++q) {
                const int c = 4 * lane + 256 * q, win = 2 << q; const int n = (t + 1) < win ? (t + 1) : win;
                const f32x4 cur = *(const GAS f32x4*)(pr + SHIFT_W + c); f32x4 sum = cur;
                for (int s = 1; s < n; ++s) sum += *(const GAS f32x4*)(pr - (size_t)s * IN_PAD + SHIFT_W + c);
                const float inv = 1.0f / (float)n; const f32x4 pv = sum * inv - cur;
                v2u o; o.x = pk2(pv.x, pv.y); o.y = pk2(pv.z, pv.w);
                *(GAS v2u*)(POOLED + (size_t)m * 1024 + c) = o;
            }
        }
    }
    SEAM(2);

    if (IN(3)) {
#ifndef NO_LORA
        { pg8::Gemm g{LIN, LORAT, LK, LK}; pg8::GridOrder S; S.init(M / 256, 12, G, bx, (size_t)256 * LK * 2, 0, (size_t)256 * LK * 2);
          pg8::EpiF32 E{LOUT, 3072};
          pg8::gemm_phase<pg8::EpiF32, pg8::GridOrder, true, true>(lds, g, S, E); }
#endif
#ifndef NO_POOL
        { pg8::Gemm g{POOLED, WPOOLT, 1024, 256}; pg8::GridOrder S; S.init(M / 256, 4, G, bx, (size_t)256 * 1024 * 2, (size_t)256 * 2, (size_t)256 * 256 * 2);
          pg8::EpiPool E{MIXIN, pool_scale};
          pg8::gemm_phase<pg8::EpiPool, pg8::GridOrder, true, true>(lds, g, S, E); }
#endif
    }
    SEAM(3);

    if (IN(4)) {
        for (int m = gw; m < M; m += NGW) {
            const int t = m % SEQ;
            const float* pr = PROJ + (size_t)m * IN_PAD; const float* pp = pr - IN_PAD;
#pragma unroll
            for (int q = 0; q < 4; ++q) {
                const int c = 4 * lane + 256 * q; const size_t o = (size_t)m * 1024 + c;
                f32x4 r = *(const GAS f32x4*)(pr + c), k = *(const GAS f32x4*)(pr + 1024 + c), v = *(const GAS f32x4*)(pr + 2048 + c);
                f32x4 rp = (f32x4){0.f, 0.f, 0.f, 0.f}, kp = rp, vp = rp;
                if (t > 0) { rp = *(const GAS f32x4*)(pp + c); kp = *(const GAS f32x4*)(pp + 1024 + c); vp = *(const GAS f32x4*)(pp + 2048 + c); }
                r = r + (rp - r) * *(const GAS f32x4*)(mu + c); k = k + (kp - k) * *(const GAS f32x4*)(mu + 1024 + c); v = v + (vp - v) * *(const GAS f32x4*)(mu + 2048 + c);
                const f32x4 wl = *(const GAS f32x4*)(LOUT + (size_t)m * 3072 + c) + *(const GAS f32x4*)(w0 + c);
                const f32x4 al = *(const GAS f32x4*)(LOUT + (size_t)m * 3072 + 1024 + c) + *(const GAS f32x4*)(a0 + c);
                f32x4 a, dec;
#pragma unroll
                for (int j = 0; j < 4; ++j) { const float z = -wl[j]; const float sp = fmaxf(z, 0.f) + __logf(1.0f + __expf(-fabsf(z))); dec[j] = __expf(-__expf(-sp - 0.5f)); a[j] = 1.0f / (1.0f + __expf(-al[j])); }
                *(GAS f32x4*)(WDEC + o) = dec;
                f32x4 kk = k * *(const GAS f32x4*)(k_k + c);
                const float ss = row16_sum(kk.x * kk.x + kk.y * kk.y + kk.z * kk.z + kk.w * kk.w);
                kk = kk * __builtin_amdgcn_rsqf(fmaxf(ss, 1e-24f));
                const f32x4 k2 = k * (1.0f + (a - 1.0f) * *(const GAS f32x4*)(k_a + c));
                const f32x4 rk = *(const GAS f32x4*)(r_k + c);
                const float bon = row16_sum(r.x * k2.x * rk.x + r.y * k2.y * rk.y + r.z * k2.z * rk.z + r.w * k2.w * rk.w);
                *(GAS f32x4*)(Rr + o) = r; *(GAS f32x4*)(K2 + o) = k2; *(GAS f32x4*)(Vv + o) = v; *(GAS f32x4*)(KK + o) = kk; *(GAS f32x4*)(BB + o) = kk * a;
                if ((lane & 15) == 0) BONUS[m * 16 + (c >> 6)] = bon;
            }
        }
    }
    SEAM(4);

    if (IN(5)) {
        const int xcd_i = bx % 8, slot_i = bx / 8;
        if (slot_i < 16) {
            const int sid = xcd_i * 16 + slot_i, hd = sid >> 1, half = sid & 1, b = hd >> 4, h = hd & 15;
            LAS float* OPS = (LAS float*)lds;
            LAS float* VVs = (LAS float*)(lds + 81920);
            LAS float* YBs = (LAS float*)(lds + 81920 + 8192);
            const int r4 = lane >> 4, jq = lane & 15;
            const int tl = tid >> 4, j4 = (tid & 15) * 4;
            const int vt = tid >> 3, vi4 = (tid & 7) * 4;
            const size_t gbase = ((size_t)b * SEQ) * 1024 + h * 64;
            const float* arr[5] = {KK, WDEC, BB, K2, Rr};
            f32x4 st[5]; f32x4 sv = (f32x4){0.f, 0.f, 0.f, 0.f};
#pragma unroll
            for (int a = 0; a < 5; ++a) st[a] = *(const GAS f32x4*)(arr[a] + gbase + (size_t)tl * 1024 + j4);
            if (tid < 256) sv = *(const GAS f32x4*)(Vv + gbase + (size_t)vt * 1024 + half * 32 + vi4);
#pragma unroll
            for (int a = 0; a < 5; ++a) *(LAS f32x4*)(OPS + (a * 32 + tl) * 64 + j4) = st[a];
            if (tid < 256) *(LAS f32x4*)(VVs + vt * 32 + vi4) = sv;
            __syncthreads();
            float S0 = 0.f, S1 = 0.f, S2 = 0.f, S3 = 0.f;
            for (int c = 0; c < SEQ / 32; ++c) {
                const int buf = c & 1;
                if (c + 1 < SEQ / 32) {
                    const size_t gb = gbase + (size_t)(c + 1) * 32 * 1024;
#pragma unroll
                    for (int a = 0; a < 5; ++a) st[a] = *(const GAS f32x4*)(arr[a] + gb + (size_t)tl * 1024 + j4);
                    if (tid < 256) sv = *(const GAS f32x4*)(Vv + gb + (size_t)vt * 1024 + half * 32 + vi4);
                }
                const LAS float* ob = OPS + buf * (5 * 32 * 64) + 4 * jq;
                const LAS float* vb = VVs + buf * 1024 + 4 * wave + r4;
                LAS float* yb = YBs + buf * 1024 + 4 * wave + r4;
                f32x4 a4 = *(const LAS f32x4*)(ob + (0 * 32) * 64), w4 = *(const LAS f32x4*)(ob + (1 * 32) * 64), b4 = *(const LAS f32x4*)(ob + (2 * 32) * 64),
                      k4 = *(const LAS f32x4*)(ob + (3 * 32) * 64), q4 = *(const LAS f32x4*)(ob + (4 * 32) * 64);
                float v = vb[0];
#pragma unroll 8
                for (int t = 0; t < 32; ++t) {
                    const int tn = (t + 1) & 31;
                    const f32x4 a4n = *(const LAS f32x4*)(ob + (0 * 32 + tn) * 64), w4n = *(const LAS f32x4*)(ob + (1 * 32 + tn) * 64), b4n = *(const LAS f32x4*)(ob + (2 * 32 + tn) * 64),
                                k4n = *(const LAS f32x4*)(ob + (3 * 32 + tn) * 64), q4n = *(const LAS f32x4*)(ob + (4 * 32 + tn) * 64);
                    const float vn = vb[tn * 32];
                    float p = S0 * a4.x; p += S1 * a4.y; p += S2 * a4.z; p += S3 * a4.w;
                    const float sa = -row16_sum(p);
                    S0 = S0 * w4.x + (sa * b4.x + v * k4.x); S1 = S1 * w4.y + (sa * b4.y + v * k4.y); S2 = S2 * w4.z + (sa * b4.z + v * k4.z); S3 = S3 * w4.w + (sa * b4.w + v * k4.w);
                    float y = S0 * q4.x; y += S1 * q4.y; y += S2 * q4.z; y += S3 * q4.w;
                    y = row16_sum(y);
                    yb[t * 32] = y;
                    a4 = a4n; w4 = w4n; b4 = b4n; k4 = k4n; q4 = q4n; v = vn;
                }
                if (c + 1 < SEQ / 32) {
                    const int nb = buf ^ 1;
#pragma unroll
                    for (int a = 0; a < 5; ++a) *(LAS f32x4*)(OPS + nb * (5 * 32 * 64) + (a * 32 + tl) * 64 + j4) = st[a];
                    if (tid < 256) *(LAS f32x4*)(VVs + nb * 1024 + vt * 32 + vi4) = sv;
                }
                __syncthreads();
                if (tid < 256) *(GAS f32x4*)(Yy + gbase + (size_t)(c * 32 + vt) * 1024 + half * 32 + vi4) = *(const LAS f32x4*)(YBs + buf * 1024 + vt * 32 + vi4);
            }
        } else {
            LAS float* scr = (LAS float*)(lds + wave * 16640);
            const int cw = (xcd_i * 16 + slot_i - 16) * NWAVES + wave;
            constexpr int I1 = (D / 64) * (4096 / 64), I2 = (DFF / 64) * (D / 64), IPE = I1 + I2;
            for (int it = cw; it < NE * IPE; it += 128 * NWAVES) {
                const int e = it / IPE, r = it % IPE;
                if (r < I1) transpose_item(w1 + (size_t)e * D * 4096, D, 4096, W1T, (size_t)e * 4096, scr, r, lane);
                else transpose_item(w2 + (size_t)e * DFF * D, DFF, D, W2T, (size_t)e * 2048, scr, r - I1, lane);
            }
        }
    }
    SEAM(5);

    if (IN(6)) {
        for (int m = gw; m < M; m += NGW) {
#pragma unroll
            for (int q = 0; q < 4; ++q) {
                const int c = 4 * lane + 256 * q; const size_t o = (size_t)m * 1024 + c;
                const f32x4 y = *(const GAS f32x4*)(Yy + o);
                const float mean = row16_sum(y.x + y.y + y.z + y.w) * (1.0f / 64.0f);
                const f32x4 d = y - mean;
                const float var = row16_sum(d.x * d.x + d.y * d.y + d.z * d.z + d.w * d.w) * (1.0f / 64.0f);
                const float rstd = __builtin_amdgcn_rsqf(var + GN_EPS);
                f32x4 yn = d * rstd * *(const GAS f32x4*)(lnx_w + c) + *(const GAS f32x4*)(lnx_b + c);
                yn = yn + BONUS[m * 16 + (c >> 6)] * *(const GAS f32x4*)(Vv + o);
                yn = yn * *(const GAS f32x4*)(LOUT + (size_t)m * 3072 + 2048 + c);
                v2u ov; ov.x = pk2(yn.x, yn.y); ov.y = pk2(yn.z, yn.w);
                *(GAS v2u*)(MIXIN + (size_t)m * 2048 + c) = ov;
            }
        }
    }
    SEAM(6);

    if (IN(7)) {
        pg8::Gemm g{MIXIN, WOUTT, D, D}; pg8::GridOrder S; S.init(M / 256, D / 256, G, bx, (size_t)256 * D * 2, 0, (size_t)256 * D * 2);
        pg8::EpiF32 E{MIX, D};
        pg8::gemm_phase<pg8::EpiF32, pg8::GridOrder, true, true>(lds, g, S, E);
    }
    SEAM(7);

    if (IN(8)) {
        LAS float* s_h = (LAS float*)lds;
        LAS float* s_part = (LAS float*)(lds + 65536);
        const int e = tid & 31, part = tid >> 5;
        float wreg[128];
#pragma unroll
        for (int i = 0; i < 128; ++i) wreg[i] = router_w[(size_t)(part * 128 + i) * 32 + e];
        LAS int* lcnt = (LAS int*)(lds + LDSCTL_OFF + 512);
        if (tid < NE) lcnt[tid] = 0;
        __syncthreads();
        for (int m0 = vcu * 8; m0 < M; m0 += G * 8) {
            const int m = m0 + wave;
            {
                f32x4 v[8]; float s = 0.f;
#pragma unroll
                for (int q = 0; q < 8; ++q) { const int c = 4 * lane + 256 * q; v[q] = ALPHA * *(const GAS f32x4*)(x + (size_t)m * D + c) + *(const GAS f32x4*)(MIX + (size_t)m * D + c); s += (v[q].x + v[q].y) + (v[q].z + v[q].w); }
                const float mean = wave_sum(s) * (1.0f / D); float s2 = 0.f;
#pragma unroll
                for (int q = 0; q < 8; ++q) { v[q] = v[q] - mean; s2 += (v[q].x * v[q].x + v[q].y * v[q].y) + (v[q].z * v[q].z + v[q].w * v[q].w); }
                const float rstd = 1.0f / sqrtf(wave_sum(s2) * (1.0f / D) + LN_EPS);
#pragma unroll
                for (int q = 0; q < 8; ++q) { const int c = 4 * lane + 256 * q;
                    const f32x4 hv = v[q] * rstd * *(const GAS f32x4*)(ln1_w + c) + *(const GAS f32x4*)(ln1_b + c);
                    *(GAS f32x4*)(H + (size_t)m * D + c) = hv; *(LAS f32x4*)(s_h + wave * 2048 + c) = hv;
                    v2u ov; ov.x = pk2(hv.x, hv.y); ov.y = pk2(hv.z, hv.w); *(GAS v2u*)(HB + (size_t)m * D + c) = ov; }
            }
            __syncthreads();
#pragma unroll 1
            for (int tk = 0; tk < 8; ++tk) {
                const LAS float* hp = s_h + tk * 2048 + part * 128; float acc = 0.f;
#pragma unroll
                for (int i = 0; i < 32; ++i) { const f32x4 hv = *(const LAS f32x4*)(hp + 4 * i); acc += hv.x * wreg[4 * i]; acc += hv.y * wreg[4 * i + 1]; acc += hv.z * wreg[4 * i + 2]; acc += hv.w * wreg[4 * i + 3]; }
                s_part[(tk * 16 + part) * 32 + e] = acc;
            }
            __syncthreads();
            {
                float lg = -3.0e38f;
                if (lane < 32) { lg = router_b[lane];
#pragma unroll
                    for (int p = 0; p < 16; ++p) lg += s_part[(wave * 16 + p) * 32 + lane]; }
                int idx[4]; float val[4];
#pragma unroll
                for (int k = 0; k < 4; ++k) {
                    float best = lg; int bi = lane;
#pragma unroll
                    for (int o = 1; o < 64; o <<= 1) { const float ob = __shfl_xor(best, o); const int oi = __shfl_xor(bi, o); const bool take = (ob > best) || (ob == best && oi < bi); best = take ? ob : best; bi = take ? oi : bi; }
                    idx[k] = bi; val[k] = best; if (lane == bi) lg = -3.0e38f;
                }
                if (lane == 0) {
                    float ex[4], se = 0.f;
#pragma unroll
                    for (int k = 0; k < 4; ++k) { ex[k] = __expf(val[k] - val[0]); se += ex[k]; }
                    const float inv = 1.0f / se;
#pragma unroll
                    for (int k = 0; k < 4; ++k) { TOPI[m * 4 + k] = idx[k]; GATE[m * 4 + k] = ex[k] * inv; POS[m * 4 + k] = __hip_atomic_fetch_add(lcnt + idx[k], 1, __ATOMIC_RELAXED, __HIP_MEMORY_SCOPE_WORKGROUP); }
                }
            }
            __syncthreads();
        }
        if (tid < NE) CNTWG[vcu * NE + tid] = lcnt[tid];
    }
    SEAM(8);

    if (IN(9) || IN(10) || IN(11)) {
        LAS int* s_t = (LAS int*)lds; LAS int* s_p = s_t + 512;
        LAS int* PSB = (LAS int*)(lds + LDSCTL_OFF + 640);
        { const int e = tid & 31, part = tid >> 5; int tsum = 0, psum = 0;
          for (int w = part * 16; w < part * 16 + 16; ++w) { const int cv = CNTWG[w * NE + e]; tsum += cv; psum += (w < vcu) ? cv : 0; }
          s_t[part * 32 + e] = tsum; s_p[part * 32 + e] = psum; }
        __syncthreads();
        if (tid < NE) { int tsum = 0, psum = 0; for (int p = 0; p < 16; ++p) { tsum += s_t[p * 32 + tid]; psum += s_p[p * 32 + tid]; } s_t[tid] = tsum; PSB[tid] = psum; }
        __syncthreads();
        if (tid == 0) { int acc = 0; for (int e = 0; e < NE; ++e) { PS[e] = acc; acc += (s_t[e] + 255) / 256 * 256; } PS[NE] = acc; }
        __syncthreads();
        if (tid < NE) PSB[tid] += PS[tid];
        __syncthreads();
    }
    if (IN(9)) {
        const LAS int* PSB = (const LAS int*)(lds + LDSCTL_OFF + 640);
        for (int m0 = vcu * 8; m0 < M; m0 += G * 8) {
            const int m = m0 + wave;
            const GAS v4u* src = (const GAS v4u*)(HB + (size_t)m * D);
            v4u rv[4];
#pragma unroll
            for (int q = 0; q < 4; ++q) rv[q] = src[lane + 64 * q];
#pragma unroll
            for (int k = 0; k < 4; ++k) {
                const int a = m * 4 + k, slot = PSB[TOPI[a]] + POS[a];
                if (lane == 0) { slot_tok[slot] = m; SLOT_OF[a] = slot; }
                GAS v4u* dst = (GAS v4u*)(XS + (size_t)slot * D);
#pragma unroll
                for (int q = 0; q < 4; ++q) dst[lane + 64 * q] = rv[q];
            }
        }
    }
    SEAM(9);

    if (IN(10)) {
        pg8::Gemm g{XS, W1T, D, D}; pg8::MoeOrder S; S.ps = PS; S.ntile = 16; S.npan = PS[NE] / 256; S.cprime = vcu; S.a_tstep = (size_t)256 * D * 2; S.b_tstep = (size_t)256 * D * 2;
        pg8::EpiSwiglu E{ACT, b1};
        pg8::gemm_phase<pg8::EpiSwiglu, pg8::MoeOrder, true, true>(lds, g, S, E);
    }
    SEAM(10);

    if (IN(11)) {
        pg8::Gemm g{ACT, W2T, DFF, DFF}; pg8::MoeOrder S; S.ps = PS; S.ntile = 8; S.npan = PS[NE] / 256; S.cprime = vcu; S.a_tstep = (size_t)256 * DFF * 2; S.b_tstep = (size_t)256 * DFF * 2;
        pg8::EpiBias16 E{YS, b2};
        pg8::gemm_phase<pg8::EpiBias16, pg8::MoeOrder, true, true>(lds, g, S, E);
    }
    SEAM(11);

    if (IN(12)) {
        for (int m = gw; m < M; m += NGW) {
            int sl[4]; float gt[4];
#pragma unroll
            for (int k = 0; k < 4; ++k) { sl[k] = SLOT_OF[m * 4 + k]; gt[k] = GATE[m * 4 + k]; }
            f32x4 v[8]; float s = 0.f;
#pragma unroll
            for (int q = 0; q < 8; ++q) { const int c = 4 * lane + 256 * q; f32x4 f = (f32x4){0.f, 0.f, 0.f, 0.f};
#pragma unroll
                for (int k = 0; k < 4; ++k) { const v2u yv = *(const GAS v2u*)(YS + (size_t)sl[k] * D + c); f += gt[k] * (f32x4){bflo(yv.x), bfhi(yv.x), bflo(yv.y), bfhi(yv.y)}; }
                v[q] = ALPHA * *(const GAS f32x4*)(H + (size_t)m * D + c) + f; s += (v[q].x + v[q].y) + (v[q].z + v[q].w); }
            const float mean = wave_sum(s) * (1.0f / D); float s2 = 0.f;
#pragma unroll
            for (int q = 0; q < 8; ++q) { v[q] = v[q] - mean; s2 += (v[q].x * v[q].x + v[q].y * v[q].y) + (v[q].z * v[q].z + v[q].w * v[q].w); }
            const float rstd = 1.0f / sqrtf(wave_sum(s2) * (1.0f / D) + LN_EPS);
#pragma unroll
            for (int q = 0; q < 8; ++q) { const int c = 4 * lane + 256 * q; *(GAS f32x4*)(out + (size_t)m * D + c) = v[q] * rstd * *(const GAS f32x4*)(ln2_w + c) + *(const GAS f32x4*)(ln2_b + c); }
        }
    }
#undef IN
#undef SEAM
}

extern "C" void kernel_launch(void* const* d_in, const int* in_sizes, int n_in, void* d_out, int out_size, void* d_ws, size_t ws_size, hipStream_t stream) {
    static int grid = 0;
    if (grid == 0) {
        if (n_in != 26 || out_size != M * D || ws_size < WS_END) { fprintf(stderr, "kernel_launch: unexpected problem (n_in %d, out %d, ws %zu < %zu)\n", n_in, out_size, ws_size, (size_t)WS_END); grid = -1; return; }
        int dev = 0, cus = 0, per_cu = 0;
        if (hipGetDevice(&dev) != hipSuccess || hipDeviceGetAttribute(&cus, hipDeviceAttributeMultiprocessorCount, dev) != hipSuccess) { grid = -1; return; }
        if (hipFuncSetAttribute((const void*)mk_fwd, hipFuncAttributeMaxDynamicSharedMemorySize, LDS_BYTES) != hipSuccess) { fprintf(stderr, "kernel_launch: hipFuncSetAttribute failed\n"); grid = -1; return; }
        if (hipOccupancyMaxActiveBlocksPerMultiprocessor(&per_cu, (const void*)mk_fwd, NTHR, LDS_BYTES) != hipSuccess || per_cu < 1) fprintf(stderr, "kernel_launch: occupancy query reports %d\n", per_cu);
        (void)hipGetLastError();
        if (cus != NWG) { fprintf(stderr, "kernel_launch: built for %d CUs, device has %d\n", NWG, cus); grid = -1; return; }
        grid = NWG;
    }
    if (grid < 0) return;
    (void)hipMemsetAsync((char*)d_ws + WS_CTL, 0, CTL_BYTES, stream);
    (void)hipMemsetAsync((char*)d_ws + WS_SLOTTOK, 0xFF, (size_t)NSLOT_MAX * 4, stream);
    Args a{};
    for (int i = 0; i < 26; ++i) a.in[i] = (const float*)d_in[i];
    a.out = (float*)d_out; a.ws = (unsigned char*)d_ws; a.dup = DUP_MASK;
    if (MK_N_LAUNCHES == 1) { a.ph_lo = 0; a.ph_hi = NPHASE; hipLaunchKernelGGL(mk_fwd, dim3(grid), dim3(NTHR), LDS_BYTES, stream, a); }
    else { for (int p = 0; p < NPHASE; ++p) for (int rep = 0; rep <= ((DUP_MASK >> p) & 1); ++rep) { a.ph_lo = p; a.ph_hi = p + 1; hipLaunchKernelGGL(mk_fwd, dim3(grid), dim3(NTHR), LDS_BYTES, stream, a); } }
}
```

```cpp
#include <hip/hip_runtime.h>
#include <stdint.h>
#include <stdio.h>

#ifndef DUP_MASK
#define DUP_MASK 0
#endif
#ifndef MK_N_LAUNCHES
#define MK_N_LAUNCHES 1
#endif

constexpr int D = 2048, BATCH = 4, SEQ = 4096, M = BATCH * SEQ;
constexpr int RW = 1024, PW = 1024, NH = 16;
constexpr int SHIFT_W = 3360, IN_COLS = 4384, IN_PAD = 4608;
constexpr int LK = 384;
constexpr int NE = 32, DFF = 2048;
constexpr int NASG = M * 4;
constexpr int NSLOT_MAX = NASG + NE * 256;
constexpr float LN_EPS = 1e-5f, GN_EPS = 64e-5f;
constexpr float ALPHA = 1.189207115002721f;
constexpr int NWG = 256, NWAVES = 8, NTHR = 512;
constexpr int NPHASE = 13;

#define GAS __attribute__((address_space(1)))
#define LAS __attribute__((address_space(3)))
typedef unsigned short bf16;
typedef unsigned v4u __attribute__((ext_vector_type(4)));
typedef unsigned v2u __attribute__((ext_vector_type(2)));
typedef float f32x4 __attribute__((ext_vector_type(4)));
typedef short bf16x8 __attribute__((ext_vector_type(8)));
typedef GAS unsigned gu32;
#define RLX_AGENT __ATOMIC_RELAXED, __HIP_MEMORY_SCOPE_AGENT
#define LDS_WAIT() asm volatile("s_waitcnt lgkmcnt(0)" ::: "memory")
#define VM_WAIT() asm volatile("s_waitcnt vmcnt(0)" ::: "memory")

__device__ __forceinline__ unsigned f2bf(float f) { unsigned u = __builtin_bit_cast(unsigned, f); return (u + 0x7fffu + ((u >> 16) & 1u)) >> 16; }
__device__ __forceinline__ unsigned pk2(float lo, float hi) { return f2bf(lo) | (f2bf(hi) << 16); }
__device__ __forceinline__ float bflo(unsigned w) { return __builtin_bit_cast(float, w << 16); }
__device__ __forceinline__ float bfhi(unsigned w) { return __builtin_bit_cast(float, w & 0xffff0000u); }
__device__ __forceinline__ float wave_sum(float v) {
#pragma unroll
    for (int o = 1; o < 64; o <<= 1) v += __shfl_xor(v, o);
    return v;
}
template <int CTRL> __device__ __forceinline__ float dpp_mov(float x) { return __builtin_bit_cast(float, __builtin_amdgcn_update_dpp(0, __builtin_bit_cast(int, x), CTRL, 0xF, 0xF, true)); }
__device__ __forceinline__ float row16_sum(float x) {
    x += dpp_mov<0xB1>(x);
    x += dpp_mov<0x4E>(x);
    x += dpp_mov<0x141>(x);
    x += dpp_mov<0x140>(x);
    return x;
}

namespace pg8 {
typedef unsigned short bf16_t;
typedef unsigned u32x4 __attribute__((ext_vector_type(4)));
constexpr int BM = 256, BK = 64, HALF = 128, HTB = HALF * BK * 2, STAGE_BYTES = 8 * HTB, NXCD = 8, WGM = 8;
__host__ __device__ __forceinline__ int lds_byte(int r, int c) { const int st = (r >> 4) * 2 + (c >> 5), rr = r & 15, cc = c & 31, ob = rr * 64 + cc * 2; return st * 1024 + (ob ^ (((ob >> 9) & 1) << 5)); }
__host__ __device__ __forceinline__ void stage_rc(int b, int& R, int& C) { const int st = b / 1024, sb = b % 1024, swz = sb ^ (((sb >> 9) & 1) << 5); R = (st >> 1) * 16 + swz / 64; C = (st & 1) * 32 + (swz % 64) / 2; }
__host__ __device__ __forceinline__ int perm32(int rho) { const int n = rho >> 4, i = rho & 15; return 8 * (i >> 2) + 4 * n + (i & 3); }
struct Unit { int pm, pn; };
struct Gemm { const bf16_t* A; const bf16_t* Bt; int lda, K; };
__device__ __forceinline__ unsigned cvt_pk_bf16(float lo, float hi) { unsigned r; asm volatile("v_cvt_pk_bf16_f32 %0, %1, %2" : "=v"(r) : "v"(lo), "v"(hi)); return r; }

struct GridOrder {
    int nM, nN, nwg, G, c; size_t a_tstep, a_pnstep, b_tstep;
    __device__ void init(int nM_, int nN_, int G_, int c_, size_t a_tstep_, size_t a_pnstep_, size_t b_tstep_) { nM = nM_; nN = nN_; nwg = nM * nN; G = G_; c = c_; a_tstep = a_tstep_; a_pnstep = a_pnstep_; b_tstep = b_tstep_; }
    __device__ bool next(int i, Unit& u) const {
        const long L = (long)i * G + c; if (L >= nwg) return false;
        int wgid = (int)L; { const int q = nwg / NXCD, r = nwg % NXCD, xcd = wgid % NXCD, off = wgid / NXCD; wgid = (xcd < r ? xcd * (q + 1) : r * (q + 1) + (xcd - r) * q) + off; }
        const int nig = WGM * nN, gid = wgid / nig, fm = gid * WGM, gsz = (nM - fm) < WGM ? (nM - fm) : WGM;
        u.pm = fm + ((wgid % nig) % gsz); u.pn = (wgid % nig) / gsz; return true;
    }
    __device__ __forceinline__ size_t aoff(const Unit& u) const { return (size_t)u.pm * a_tstep + (size_t)u.pn * a_pnstep; }
    __device__ __forceinline__ size_t boff(const Unit& u) const { return (size_t)u.pn * b_tstep; }
};
struct MoeOrder {
    const LAS int* ps; int ntile, npan, cprime; size_t a_tstep, b_tstep;
    __device__ bool next(int i, Unit& u) const {
        const int U = i * NWG + cprime; const int p = U / ntile; if (p >= npan) return false;
        const int row = p * 256; int e = 0;
#pragma unroll 1
        for (int q = 1; q < NE; ++q) e = (row >= ps[q]) ? q : e;
        u.pm = p; u.pn = e * ntile + (U % ntile); return true;
    }
    __device__ __forceinline__ size_t aoff(const Unit& u) const { return (size_t)u.pm * a_tstep; }
    __device__ __forceinline__ size_t boff(const Unit& u) const { return (size_t)u.pn * b_tstep; }
};

template <class Epi, class Sched, bool ALIGN_EPI, bool SP2>
__device__ __forceinline__ void gemm_phase(LAS unsigned char* lds, const Gemm g, const Sched& S, const Epi& E) {
    int tid_ = threadIdx.x; asm volatile("" : "+v"(tid_));
    const int tid = tid_, wid = __builtin_amdgcn_readfirstlane(tid >> 6), lane = tid & 63, wr = wid >> 2, wc = wid & 3, fr = lane & 15, fq = lane >> 4;
    const int K = g.K, nt = K / BK;
    unsigned voffA[2], voffB[2];
#pragma unroll
    for (int i = 0; i < 2; ++i) { int R, C; stage_rc(tid * 16 + i * 8192, R, C); const int Rb = Epi::PERM ? ((R & ~31) + perm32(R & 31)) : R;
        voffA[i] = (unsigned)(R * g.lda + C) * 2u; voffB[i] = (unsigned)(Rb * K + C) * 2u; }
    const size_t kstep = (size_t)(BK * 2);
    const size_t hstepA = (size_t)HALF * g.lda * 2, hstepB = (size_t)HALF * K * 2;
    const unsigned ldsw = (unsigned)wid * 1024u;
    const int aoff = lds_byte(wr * 64 + fr, fq * 8), boff = lds_byte(wc * 32 + fr, fq * 8);
#define PG8_SA(b, h) (((b) * 2 + (h)) * HTB)
#define PG8_SB(b, h) ((4 + (b) * 2 + (h)) * HTB)
#define PG8_STAGE(bufoff, gbase, voff) do { _Pragma("unroll") for (int _i = 0; _i < 2; ++_i) \
        __builtin_amdgcn_global_load_lds((const unsigned*)((const char*)(gbase) + (voff)[_i]), (LAS unsigned*)(lds + (bufoff) + ldsw + _i * 8192), 16, 0, 0); } while (0)
#define PG8_LDA(dst, b, h) do { _Pragma("unroll") for (int m = 0; m < 4; ++m) _Pragma("unroll") for (int k = 0; k < 2; ++k) dst[m][k] = *(const LAS bf16x8*)(lds + PG8_SA(b, h) + aoff + m * 2048 + k * 1024); } while (0)
#define PG8_LDB(dst, b, h) do { _Pragma("unroll") for (int n = 0; n < 2; ++n) _Pragma("unroll") for (int k = 0; k < 2; ++k) dst[n][k] = *(const LAS bf16x8*)(lds + PG8_SB(b, h) + boff + n * 2048 + k * 1024); } while (0)
#define PG8_MMA(ai, bj, At, Bt) do { __builtin_amdgcn_s_setprio(1); _Pragma("unroll") for (int m = 0; m < 4; ++m) _Pragma("unroll") for (int n = 0; n < 2; ++n) _Pragma("unroll") for (int k = 0; k < 2; ++k) \
        acc[ai][bj][m][n] = __builtin_amdgcn_mfma_f32_16x16x32_bf16(Bt[n][k], At[m][k], acc[ai][bj][m][n], 0, 0, 0); __builtin_amdgcn_s_setprio(0); } while (0)
#define PG8_WAIT_V(n) asm volatile("s_waitcnt vmcnt(" #n ")" ::: "memory")
#define PG8_WAIT_L(n) asm volatile("s_waitcnt lgkmcnt(" #n ")" ::: "memory")
#define PG8_BAR __builtin_amdgcn_s_barrier()
#define PG8_SCHED __builtin_amdgcn_sched_barrier(0)
    Unit cur, nxt; int ui = 0;
    if (!S.next(0, cur)) return;
    f32x4 acc[2][2][4][2];
#pragma unroll
    for (int a = 0; a < 2; ++a)
#pragma unroll
        for (int b = 0; b < 2; ++b)
#pragma unroll
            for (int m = 0; m < 4; ++m)
#pragma unroll
                for (int n = 0; n < 2; ++n) acc[a][b][m][n] = (f32x4){0.f, 0.f, 0.f, 0.f};
    bf16x8 At[4][2], B0[2][2], B1[2][2];
    const char* cA = (const char*)g.A + S.aoff(cur); const char* cB = (const char*)g.Bt + S.boff(cur);
    if constexpr (SP2) {
        PG8_STAGE(PG8_SB(0, 0), cB, voffB); PG8_STAGE(PG8_SB(0, 1), cB + hstepB, voffB); PG8_STAGE(PG8_SA(0, 0), cA, voffA); PG8_STAGE(PG8_SA(0, 1), cA + hstepA, voffA);
        if (wr == 1) PG8_BAR;
        PG8_WAIT_V(2); PG8_BAR;
        PG8_STAGE(PG8_SB(1, 0), cB + kstep, voffB); PG8_STAGE(PG8_SA(1, 0), cA + kstep, voffA); PG8_STAGE(PG8_SB(1, 1), cB + hstepB + kstep, voffB);
        PG8_WAIT_V(6); PG8_BAR;
    } else {
        PG8_STAGE(PG8_SB(0, 0), cB, voffB); PG8_STAGE(PG8_SA(0, 0), cA, voffA); PG8_STAGE(PG8_SB(0, 1), cB + hstepB, voffB); PG8_STAGE(PG8_SA(0, 1), cA + hstepA, voffA);
        if (wr == 1) PG8_BAR;
        PG8_WAIT_V(4); PG8_BAR;
        PG8_STAGE(PG8_SB(1, 0), cB + kstep, voffB); PG8_STAGE(PG8_SA(1, 0), cA + kstep, voffA); PG8_STAGE(PG8_SB(1, 1), cB + hstepB + kstep, voffB);
        PG8_WAIT_V(6); PG8_BAR;
    }
    for (;;) {
        const bool has_next = S.next(ui + 1, nxt);
        const char* nA = has_next ? (const char*)g.A + S.aoff(nxt) : cA; const char* nB = has_next ? (const char*)g.Bt + S.boff(nxt) : cB;
#pragma unroll 1
        for (int t = 0; t < nt; t += 2) {
            const bool last = (t == nt - 2);
            const char* a1 = cA + (size_t)(t + 1) * kstep;
            const char* a2 = last ? nA : cA + (size_t)(t + 2) * kstep; const char* b2 = last ? nB : cB + (size_t)(t + 2) * kstep;
            const char* a3 = a2 + kstep; const char* b3 = b2 + kstep;
            if constexpr (SP2) {
            PG8_LDB(B0, 0, 0); PG8_LDB(B1, 0, 1); PG8_SCHED; PG8_LDA(At, 0, 0); PG8_STAGE(PG8_SA(1, 1), a1 + hstepA, voffA);
            PG8_WAIT_V(8); PG8_WAIT_L(0); PG8_BAR; PG8_MMA(0, 0, At, B0); PG8_MMA(0, 1, At, B1); PG8_BAR; PG8_SCHED;
            PG8_LDA(At, 0, 1); PG8_STAGE(PG8_SB(0, 0), b2, voffB); PG8_STAGE(PG8_SB(0, 1), b2 + hstepB, voffB); PG8_STAGE(PG8_SA(0, 0), a2, voffA);
            PG8_WAIT_V(8); PG8_WAIT_L(0); PG8_BAR; PG8_MMA(1, 0, At, B0); PG8_MMA(1, 1, At, B1); PG8_BAR; PG8_SCHED;
            PG8_LDB(B0, 1, 0); PG8_LDB(B1, 1, 1); PG8_SCHED; PG8_LDA(At, 1, 0); PG8_STAGE(PG8_SA(0, 1), a2 + hstepA, voffA);
            PG8_WAIT_V(8); PG8_WAIT_L(0); PG8_BAR; PG8_MMA(0, 0, At, B0); PG8_MMA(0, 1, At, B1); PG8_BAR; PG8_SCHED;
            PG8_LDA(At, 1, 1); PG8_STAGE(PG8_SB(1, 0), b3, voffB); PG8_STAGE(PG8_SB(1, 1), b3 + hstepB, voffB); PG8_STAGE(PG8_SA(1, 0), a3, voffA);
            PG8_WAIT_V(8); PG8_WAIT_L(0); PG8_BAR; PG8_MMA(1, 0, At, B0); PG8_MMA(1, 1, At, B1); PG8_BAR; PG8_SCHED;
            } else {
            PG8_LDB(B0, 0, 0); PG8_SCHED; PG8_LDA(At, 0, 0); PG8_STAGE(PG8_SA(1, 1), a1 + hstepA, voffA);
            PG8_WAIT_L(8); PG8_BAR; PG8_WAIT_L(0); PG8_MMA(0, 0, At, B0); PG8_BAR; PG8_SCHED;
            PG8_LDB(B1, 0, 1); PG8_STAGE(PG8_SB(0, 0), b2, voffB);
            PG8_BAR; PG8_WAIT_L(0); PG8_MMA(0, 1, At, B1); PG8_BAR;
            PG8_LDA(At, 0, 1); PG8_STAGE(PG8_SA(0, 0), a2, voffA);
            PG8_BAR; PG8_WAIT_L(0); PG8_MMA(1, 0, At, B0); PG8_BAR; PG8_SCHED;
            PG8_STAGE(PG8_SB(0, 1), b2 + hstepB, voffB);
            PG8_WAIT_V(6); PG8_BAR; PG8_MMA(1, 1, At, B1); PG8_BAR;
            PG8_LDB(B0, 1, 0); PG8_SCHED; PG8_LDA(At, 1, 0); PG8_STAGE(PG8_SA(0, 1), a2 + hstepA, voffA);
            PG8_WAIT_L(8); PG8_BAR; PG8_WAIT_L(0); PG8_MMA(0, 0, At, B0); PG8_BAR; PG8_SCHED;
            PG8_LDB(B1, 1, 1); PG8_STAGE(PG8_SB(1, 0), b3, voffB);
            PG8_BAR; PG8_WAIT_L(0); PG8_MMA(0, 1, At, B1); PG8_BAR;
            PG8_LDA(At, 1, 1); PG8_STAGE(PG8_SA(1, 0), a3, voffA);
            PG8_BAR; PG8_WAIT_L(0); PG8_MMA(1, 0, At, B0); PG8_BAR; PG8_SCHED;
            PG8_STAGE(PG8_SB(1, 1), b3 + hstepB, voffB);
            PG8_WAIT_V(6); PG8_BAR; PG8_MMA(1, 1, At, B1); PG8_BAR;
            }
        }
        if constexpr (ALIGN_EPI) { if (wr == 0) PG8_BAR; }
        E(acc, cur, wr, wc, fr, fq);
        if (!has_next) break;
#pragma unroll
        for (int a = 0; a < 2; ++a)
#pragma unroll
            for (int b = 0; b < 2; ++b)
#pragma unroll
                for (int m = 0; m < 4; ++m)
#pragma unroll
                    for (int n = 0; n < 2; ++n) acc[a][b][m][n] = (f32x4){0.f, 0.f, 0.f, 0.f};
        cur = nxt; cA = nA; cB = nB; ++ui;
        if constexpr (ALIGN_EPI) { if (wr == 1) PG8_BAR; }
    }
    PG8_WAIT_V(0);
    if constexpr (!ALIGN_EPI) { if (wr == 0) PG8_BAR; }
    PG8_BAR;
#undef PG8_SA
#undef PG8_SB
#undef PG8_STAGE
#undef PG8_LDA
#undef PG8_LDB
#undef PG8_MMA
#undef PG8_WAIT_V
#undef PG8_WAIT_L
#undef PG8_BAR
#undef PG8_SCHED
}

struct EpiF32 {
    static constexpr bool PERM = false;
    float* C; int ldc;
    __device__ __forceinline__ void operator()(const f32x4 (&acc)[2][2][4][2], const Unit& u, int wr, int wc, int fr, int fq) const {
        const int row0 = u.pm * BM + wr * 64 + fr, col0 = u.pn * BM + wc * 32 + 4 * fq;
#pragma unroll
        for (int ai = 0; ai < 2; ++ai)
#pragma unroll
            for (int m = 0; m < 4; ++m) { float* rowp = C + (size_t)(row0 + ai * HALF + m * 16) * ldc + col0;
#pragma unroll
                for (int bj = 0; bj < 2; ++bj)
#pragma unroll
                    for (int n = 0; n < 2; ++n) *(f32x4*)(rowp + bj * HALF + n * 16) = acc[ai][bj][m][n]; }
    }
};
struct EpiPool {
    static constexpr bool PERM = true;
    bf16_t* O; const float* scale;
    __device__ __forceinline__ void operator()(const f32x4 (&acc)[2][2][4][2], const Unit& u, int wr, int wc, int fr, int fq) const {
        const int row0 = u.pm * BM + wr * 64 + fr; int col0 = u.pn * BM + wc * 32 + 8 * fq;
        asm volatile("" : "+v"(col0));
        f32x4 sv[2][2];
#pragma unroll
        for (int bj = 0; bj < 2; ++bj)
#pragma unroll
            for (int n = 0; n < 2; ++n) sv[bj][n] = *(const f32x4*)(scale + col0 + bj * HALF + 4 * n);
#pragma unroll
        for (int ai = 0; ai < 2; ++ai)
#pragma unroll
            for (int m = 0; m < 4; ++m) { bf16_t* rowp = O + (size_t)(row0 + ai * HALF + m * 16) * 2048 + 1024 + col0;
#pragma unroll
                for (int bj = 0; bj < 2; ++bj) { const f32x4 v0 = acc[ai][bj][m][0] * sv[bj][0], v1 = acc[ai][bj][m][1] * sv[bj][1];
                    u32x4 w; w.x = cvt_pk_bf16(v0[0], v0[1]); w.y = cvt_pk_bf16(v0[2], v0[3]); w.z = cvt_pk_bf16(v1[0], v1[1]); w.w = cvt_pk_bf16(v1[2], v1[3]);
                    *(u32x4*)(rowp + bj * HALF) = w; } }
    }
};
struct EpiSwiglu {
    static constexpr bool PERM = true;
    bf16_t* O; const float* b1;
    __device__ __forceinline__ void operator()(const f32x4 (&acc)[2][2][4][2], const Unit& u, int wr, int wc, int fr, int fq) const {
        const int e = u.pn >> 4, nt = u.pn & 15;
        const int row0 = u.pm * BM + wr * 64 + fr; int col0 = nt * BM + wc * 32 + 8 * fq;
        asm volatile("" : "+v"(col0));
        const float* bp = b1 + (size_t)e * 4096 + col0;
        f32x4 bv[2][2];
#pragma unroll
        for (int bj = 0; bj < 2; ++bj)
#pragma unroll
            for (int n = 0; n < 2; ++n) bv[bj][n] = *(const f32x4*)(bp + bj * HALF + 4 * n);
#pragma unroll
        for (int ai = 0; ai < 2; ++ai)
#pragma unroll
            for (int m = 0; m < 4; ++m) { bf16_t* rowp = O + (size_t)(row0 + ai * HALF + m * 16) * 2048 + (col0 >> 1);
#pragma unroll
                for (int bj = 0; bj < 2; ++bj) { const f32x4 v0 = acc[ai][bj][m][0] + bv[bj][0], v1 = acc[ai][bj][m][1] + bv[bj][1];
                    float a[4];
#pragma unroll
                    for (int p = 0; p < 4; ++p) { const float hg = p < 2 ? v0[2 * p] : v1[2 * p - 4], hl = p < 2 ? v0[2 * p + 1] : v1[2 * p - 3];
                        const float xg = fminf(hg, 7.0f), xl = fminf(fmaxf(hl, -7.0f), 7.0f);
                        a[p] = xg * __builtin_amdgcn_rcpf(1.0f + __expf(-1.702f * xg)) * (xl + 1.0f); }
                    v2u w; w.x = cvt_pk_bf16(a[0], a[1]); w.y = cvt_pk_bf16(a[2], a[3]);
                    *(v2u*)(rowp + bj * (HALF / 2)) = w; } }
    }
};
struct EpiBias16 {
    static constexpr bool PERM = true;
    bf16_t* O; const float* b2;
    __device__ __forceinline__ void operator()(const f32x4 (&acc)[2][2][4][2], const Unit& u, int wr, int wc, int fr, int fq) const {
        const int e = u.pn >> 3, nt = u.pn & 7;
        const int row0 = u.pm * BM + wr * 64 + fr; int col0 = nt * BM + wc * 32 + 8 * fq;
        asm volatile("" : "+v"(col0));
        const float* bp = b2 + (size_t)e * 2048 + col0;
        f32x4 bv[2][2];
#pragma unroll
        for (int bj = 0; bj < 2; ++bj)
#pragma unroll
            for (int n = 0; n < 2; ++n) bv[bj][n] = *(const f32x4*)(bp + bj * HALF + 4 * n);
#pragma unroll
        for (int ai = 0; ai < 2; ++ai)
#pragma unroll
            for (int m = 0; m < 4; ++m) { bf16_t* rowp = O + (size_t)(row0 + ai * HALF + m * 16) * 2048 + col0;
#pragma unroll
                for (int bj = 0; bj < 2; ++bj) { const f32x4 v0 = acc[ai][bj][m][0] + bv[bj][0], v1 = acc[ai][bj][m][1] + bv[bj][1];
                    u32x4 w; w.x = cvt_pk_bf16(v0[0], v0[1]); w.y = cvt_pk_bf16(v0[2], v0[3]); w.z = cvt_pk_bf16(v1[0], v1[1]); w.w = cvt_pk_bf16(v1[2], v1[3]);
                    *(u32x4*)(rowp + bj * HALF) = w; } }
    }
};
}

#define XB_TMO      128
#define XB_XCNT(j)  (256  + 64 * (j))
#define XB_XSUB(j)  (1280 + 64 * (j))
#define XB_XGEN(j)  (2304 + 64 * (j))
#define XB_TOP      3328
#define XB_TOPGEN   3392
#define XCD_BAR_WORDS 3456
#define XB_SPIN_CAP (1u << 22)
__device__ __forceinline__ unsigned xb_ld(unsigned* p)              { return __hip_atomic_load(p, __ATOMIC_RELAXED, __HIP_MEMORY_SCOPE_AGENT); }
__device__ __forceinline__ unsigned xb_add(unsigned* p, unsigned v) { return __hip_atomic_fetch_add(p, v, __ATOMIC_RELAXED, __HIP_MEMORY_SCOPE_AGENT); }
__device__ __forceinline__ unsigned xb_xcc_id() { return (unsigned)__builtin_amdgcn_s_getreg((3 << 11) | 20) & 0xFu; }
#define XB_SPIN(cond, bar) do { unsigned _sp = 0; while (cond) { __builtin_amdgcn_s_sleep(1); \
    if ((++_sp & 255u) == 0u) { if (xb_ld(&(bar)[XB_TMO])) break; if (_sp > XB_SPIN_CAP) { atomicAdd(&(bar)[XB_TMO], 1u); break; } } } } while (0)
struct XcdBarrier { unsigned* bar; unsigned x; volatile LAS unsigned* st; };
__device__ __forceinline__ XcdBarrier xcd_barrier_post(unsigned* bar, volatile LAS unsigned* st) {
    XcdBarrier b; b.bar = bar; b.x = xb_xcc_id(); b.st = st;
    if (threadIdx.x == 0) (void)xb_add(&bar[XB_XCNT(b.x)], 1u);
    return b;
}
__device__ __forceinline__ void xcd_barrier_complete(unsigned* bar, unsigned x, unsigned& nloc, unsigned& nx) {
    const unsigned G = gridDim.x * gridDim.y * gridDim.z;
    unsigned sum, cnt, mine, sp = 0u;
    for (;;) {
        sum = 0u; cnt = 0u; mine = 0u;
#pragma unroll
        for (unsigned j = 0; j < 16; ++j) { const unsigned c = xb_ld(&bar[XB_XCNT(j)]); sum += c; cnt += (c > 0u) ? 1u : 0u; mine = (j == x) ? c : mine; }
        if (sum == G) break;
        __builtin_amdgcn_s_sleep(1);
        if ((++sp & 255u) == 0u) { if (xb_ld(&bar[XB_TMO])) break; if (sp > XB_SPIN_CAP) { atomicAdd(&bar[XB_TMO], 1u); break; } }
    }
    nloc = mine > 0u ? mine : 1u; nx = cnt > 0u ? cnt : 1u;
}
__device__ __forceinline__ void xcd_barrier(const XcdBarrier& b) {
    asm volatile("s_waitcnt vmcnt(0)" ::: "memory");
    __syncthreads();
    if (threadIdx.x == 0) {
        unsigned* bar = b.bar;
        __builtin_amdgcn_s_waitcnt(0);
        unsigned nloc = b.st[0], nx = b.st[1];
        if (nloc == 0u) { xcd_barrier_complete(bar, b.x, nloc, nx); b.st[0] = nloc; b.st[1] = nx; }
        const unsigned old = xb_add(&bar[XB_XSUB(b.x)], 1u);
        const unsigned gen = old / nloc;
        if (old + 1u == (gen + 1u) * nloc) {
            __builtin_amdgcn_fence(__ATOMIC_RELEASE, "agent");
            asm volatile("s_waitcnt vmcnt(0)" ::: "memory");
            const unsigned og = xb_add(&bar[XB_TOP], 1u);
            const unsigned tg = og / nx;
            if (og + 1u == (tg + 1u) * nx) xb_add(&bar[XB_TOPGEN], 1u);
            else XB_SPIN(xb_ld(&bar[XB_TOPGEN]) == tg, bar);
            __builtin_amdgcn_fence(__ATOMIC_ACQUIRE, "agent");
            xb_add(&bar[XB_XGEN(b.x)], 1u);
            asm volatile("s_waitcnt vmcnt(0)" ::: "memory");
        } else {
            XB_SPIN(xb_ld(&bar[XB_XGEN(b.x)]) == gen, bar);
            __builtin_amdgcn_fence(__ATOMIC_ACQUIRE, "agent");
            asm volatile("s_waitcnt vmcnt(0)" ::: "memory");
        }
    }
    __syncthreads();
}

constexpr size_t al256(size_t x) { return (x + 255) & ~(size_t)255; }
constexpr size_t WS_CTL = 0, CTL_BYTES = 1u << 20;
constexpr int CW_BAR = 4096;
constexpr int CW_CNT = 16384;
constexpr size_t WS_SLOTTOK = WS_CTL + CTL_BYTES;
constexpr size_t WS_TOPI = WS_SLOTTOK + al256((size_t)NSLOT_MAX * 4);
constexpr size_t WS_GATE = WS_TOPI + (size_t)NASG * 4;
constexpr size_t WS_POS = WS_GATE + (size_t)NASG * 4;
constexpr size_t WS_SLOTOF = WS_POS + (size_t)NASG * 4;
constexpr size_t WS_BONUS = WS_SLOTOF + (size_t)NASG * 4;
constexpr size_t WS_XB = WS_BONUS + (size_t)M * 16 * 4;
constexpr size_t WS_WINT = WS_XB + (size_t)M * D * 2;
constexpr size_t WS_WOUTT = WS_WINT + (size_t)IN_PAD * D * 2;
constexpr size_t WS_LORAT = WS_WOUTT + (size_t)D * D * 2;
constexpr size_t WS_WPOOLT = WS_LORAT + (size_t)3072 * LK * 2;
constexpr size_t WS_PROJ = WS_WPOOLT + (size_t)1024 * 256 * 2;
constexpr size_t WS_LIN = WS_PROJ + (size_t)M * IN_PAD * 4;
constexpr size_t WS_POOLED = WS_LIN + (size_t)M * LK * 2;
constexpr size_t WS_WDEC = WS_POOLED + (size_t)M * 1024 * 2;
constexpr size_t SZ_F1K = (size_t)M * 1024 * 4;
constexpr size_t WS_LOUT = WS_WDEC + SZ_F1K  , WS_R = WS_LOUT + 3 * SZ_F1K, WS_K2 = WS_R + SZ_F1K, WS_V = WS_K2 + SZ_F1K, WS_KK = WS_V + SZ_F1K, WS_BB = WS_KK + SZ_F1K, WS_Y = WS_BB + SZ_F1K;
constexpr size_t WS_MIXIN = WS_Y + SZ_F1K;
constexpr size_t WS_MIX = WS_MIXIN + (size_t)M * D * 2;
constexpr size_t WS_H = WS_MIX + (size_t)M * D * 4;
constexpr size_t WS_HB = WS_H + (size_t)M * D * 4;
constexpr size_t WS_XS = WS_HB + (size_t)M * D * 2;
constexpr size_t WS_W1T = WS_XS + (size_t)NSLOT_MAX * D * 2;
constexpr size_t WS_W2T = WS_W1T + (size_t)NE * 4096 * D * 2;
constexpr size_t WS_ACT = WS_W2T + (size_t)NE * 2048 * DFF * 2;
constexpr size_t WS_YS = WS_ACT + (size_t)NSLOT_MAX * DFF * 2;
constexpr size_t WS_END = WS_YS + (size_t)NSLOT_MAX * D * 2;

constexpr int RING_BYTES = 131072;
constexpr int LDSCTL_OFF = 139264;
constexpr int LDS_BYTES = 147456;

struct Args { const float* in[26]; float* out; unsigned char* ws; int ph_lo, ph_hi, dup, pad; };

__device__ __forceinline__ void tr_load(const float* W, int N, int item, int lane, f32x4 (&v)[16]) {
    const int nblk = N / 64, kb = item / nblk, nb = item % nblk, k0 = 64 * kb, n0 = 64 * nb;
    const int r = lane >> 4, c4 = (lane & 15) * 4;
#pragma unroll
    for (int i = 0; i < 16; ++i) v[i] = *(const GAS f32x4*)(W + (size_t)(k0 + 4 * i + r) * N + n0 + c4);
}
__device__ __forceinline__ void tr_store(const f32x4 (&v)[16], int K, int N, bf16* WT, size_t row_off, LAS float* scr, int item, int lane) {
    const int nblk = N / 64, kb = item / nblk, nb = item % nblk, k0 = 64 * kb, n0 = 64 * nb;
    const int r = lane >> 4, c4 = (lane & 15) * 4;
#pragma unroll
    for (int i = 0; i < 16; ++i) { LAS float* d = scr + (4 * i + r) * 65 + c4; d[0] = v[i].x; d[1] = v[i].y; d[2] = v[i].z; d[3] = v[i].w; }
    LDS_WAIT(); asm volatile("" ::: "memory");
    const int c = lane & 7;
#pragma unroll
    for (int p = 0; p < 8; ++p) { const int n = (lane >> 3) + 8 * p; const LAS float* q = scr + (8 * c) * 65 + n;
        v4u o; o.x = pk2(q[0 * 65], q[1 * 65]); o.y = pk2(q[2 * 65], q[3 * 65]); o.z = pk2(q[4 * 65], q[5 * 65]); o.w = pk2(q[6 * 65], q[7 * 65]);
        *(GAS v4u*)(WT + (row_off + n0 + n) * (size_t)K + k0 + 8 * c) = o; }
    LDS_WAIT(); asm volatile("" ::: "memory");
}
__device__ __forceinline__ void transpose_item(const float* W, int K, int N, bf16* WT, size_t row_off, LAS float* scr, int item, int lane) {
    f32x4 v[16]; tr_load(W, N, item, lane, v); tr_store(v, K, N, WT, row_off, scr, item, lane);
}

__global__ void __launch_bounds__(NTHR, 2) mk_fwd(Args args) {
    extern __shared__ __attribute__((aligned(16))) unsigned char lds_raw[];
    LAS unsigned char* lds = (LAS unsigned char*)lds_raw;
    volatile LAS unsigned* MISC = (volatile LAS unsigned*)(lds + LDSCTL_OFF);
    LAS int* PS = (LAS int*)(lds + LDSCTL_OFF + 256);
    const int tid = threadIdx.x, lane = tid & 63, wave = __builtin_amdgcn_readfirstlane(tid >> 6);
    const int G = gridDim.x, bx = blockIdx.x;
    const int vcu = (bx % 8) * (G / 8) + bx / 8;
    const int gw = vcu * NWAVES + wave, NGW = G * NWAVES;
    unsigned char* ws = args.ws;
    gu32* ctl = (gu32*)(ws + WS_CTL);
    const float* x = args.in[0]; const float* w_in = args.in[1]; const float* mu = args.in[2]; const float* w0 = args.in[3]; const float* w2d = args.in[4];
    const float* a0 = args.in[5]; const float* a2 = args.in[6]; const float* g2 = args.in[7]; const float* k_k = args.in[8]; const float* k_a = args.in[9];
    const float* r_k = args.in[10]; const float* lnx_w = args.in[11]; const float* lnx_b = args.in[12]; const float* w_pool = args.in[13]; const float* pool_scale = args.in[14];
    const float* w_out = args.in[15]; const float* ln1_w = args.in[16]; const float* ln1_b = args.in[17]; const float* router_w = args.in[18]; const float* router_b = args.in[19];
    const float* w1 = args.in[20]; const float* b1 = args.in[21]; const float* w2 = args.in[22]; const float* b2 = args.in[23]; const float* ln2_w = args.in[24]; const float* ln2_b = args.in[25];
    float* out = args.out;
    int* CNTWG = (int*)(ws + WS_CTL) + CW_CNT;
    int* slot_tok = (int*)(ws + WS_SLOTTOK); int* TOPI = (int*)(ws + WS_TOPI); float* GATE = (float*)(ws + WS_GATE); int* POS = (int*)(ws + WS_POS); int* SLOT_OF = (int*)(ws + WS_SLOTOF);
    float* BONUS = (float*)(ws + WS_BONUS);
    bf16* XB = (bf16*)(ws + WS_XB); bf16* WINT = (bf16*)(ws + WS_WINT); bf16* WOUTT = (bf16*)(ws + WS_WOUTT); bf16* LORAT = (bf16*)(ws + WS_LORAT); bf16* WPOOLT = (bf16*)(ws + WS_WPOOLT);
    float* PROJ = (float*)(ws + WS_PROJ); bf16* LIN = (bf16*)(ws + WS_LIN); bf16* POOLED = (bf16*)(ws + WS_POOLED);
    float* WDEC = (float*)(ws + WS_WDEC); float* LOUT = (float*)(ws + WS_LOUT); float* Rr = (float*)(ws + WS_R); float* K2 = (float*)(ws + WS_K2);
    float* Vv = (float*)(ws + WS_V); float* KK = (float*)(ws + WS_KK); float* BB = (float*)(ws + WS_BB); float* Yy = (float*)(ws + WS_Y);
    bf16* MIXIN = (bf16*)(ws + WS_MIXIN); float* MIX = (float*)(ws + WS_MIX); float* H = (float*)(ws + WS_H); bf16* HB = (bf16*)(ws + WS_HB);
    bf16* XS = (bf16*)(ws + WS_XS); bf16* W1T = (bf16*)(ws + WS_W1T); bf16* W2T = (bf16*)(ws + WS_W2T); bf16* ACT = (bf16*)(ws + WS_ACT); bf16* YS = (bf16*)(ws + WS_YS);

    for (int u = tid; u < (LDS_BYTES - LDSCTL_OFF) / 4; u += NTHR) ((LAS unsigned*)(lds + LDSCTL_OFF))[u] = 0u;
    __syncthreads();
    XcdBarrier bar; bar.bar = (unsigned*)(ctl + CW_BAR); bar.x = 0; bar.st = nullptr;
    if (MK_N_LAUNCHES == 1) bar = xcd_barrier_post((unsigned*)(ctl + CW_BAR), MISC + 8);
    const int lo = args.ph_lo, hi = args.ph_hi;
#ifndef PHASE_MASK
#define PHASE_MASK 0xFFFF
#endif
#define IN(k) (((PHASE_MASK >> (k)) & 1) && lo <= (k) && (k) < hi)
#define SEAM(k) do { if (IN(k) && IN((k) + 1)) xcd_barrier(bar); } while (0)

    if (IN(0)) {
        LAS float* scr = (LAS float*)(lds + wave * 16640);
        for (size_t i = (size_t)gw * 64 + lane; i < (size_t)M * D / 8; i += (size_t)NGW * 64) {
            const f32x4 a = *(const GAS f32x4*)(x + i * 8), b = *(const GAS f32x4*)(x + i * 8 + 4);
            v4u o; o.x = pk2(a.x, a.y); o.y = pk2(a.z, a.w); o.z = pk2(b.x, b.y); o.w = pk2(b.z, b.w);
            *(GAS v4u*)(XB + i * 8) = o;
        }
        constexpr int I_IN = (D / 64) * (IN_COLS / 64)  , I_OUT = (D / 64) * (D / 64);
        for (int it = gw; it < I_IN + I_OUT; it += NGW) {
            if (it < I_IN) transpose_item(w_in, D, IN_COLS, WINT, 0, scr, it, lane);
            else transpose_item(w_out, D, D, WOUTT, 0, scr, it - I_IN, lane);
        }
        for (int i = gw * 64 + lane; i < 32 * D; i += NGW * 64) { const int nn = 4352 + (i >> 11), k = i & 2047; WINT[(size_t)nn * D + k] = (bf16)f2bf(w_in[(size_t)k * IN_COLS + nn]); }
        for (size_t i = (size_t)gw * 64 + lane; i < (size_t)(IN_PAD - IN_COLS) * D / 8; i += (size_t)NGW * 64) *(GAS v4u*)(WINT + (size_t)IN_COLS * D + i * 8) = (v4u){0u, 0u, 0u, 0u};
        for (int i = gw * 64 + lane; i < 3072 * LK; i += NGW * 64) {
            const int n = i / LK, k = i % LK; float v = 0.f;
            if (n < 1024) { if (k < 64) v = w2d[k * 1024 + n]; }
            else if (n < 2048) { if (k >= 64 && k < 128) v = a2[(k - 64) * 1024 + (n - 1024)]; }
            else { if (k >= 128 && k < 288) v = g2[(k - 128) * 1024 + (n - 2048)]; }
            LORAT[i] = (bf16)f2bf(v);
        }
        for (int i = gw * 64 + lane; i < 1024 * 256; i += NGW * 64) {
            const int n = i >> 8, c = i & 255, g = n >> 8, d = n & 255;
            WPOOLT[i] = (bf16)f2bf(w_pool[((size_t)g * 256 + c) * 256 + d]);
        }
    }
    SEAM(0);

    if (IN(1)) {
        pg8::Gemm g{XB, WINT, D, D}; pg8::GridOrder S; S.init(M / 256, IN_PAD / 256, G, bx, (size_t)256 * D * 2, 0, (size_t)256 * D * 2);
        pg8::EpiF32 E{PROJ, IN_PAD};
        pg8::gemm_phase<pg8::EpiF32, pg8::GridOrder, true, true>(lds, g, S, E);
    }
    SEAM(1);

    if (IN(2)) {
        for (int m = gw; m < M; m += NGW) {
            const int t = m % SEQ;
            const float* pr = PROJ + (size_t)m * IN_PAD; const float* pp = pr - IN_PAD;
#pragma unroll
            for (int q = 0; q < 6; ++q) {
                const int i = lane + 64 * q; float v = 0.f;
                if (i < 288) { const int c = 3072 + i; const float cur = pr[c], prev = t > 0 ? pp[c] : 0.f; const float s = cur + (prev - cur) * mu[c];
                    v = i < 64 ? tanhf(s) : (i < 128 ? s : 1.0f / (1.0f + __expf(-s))); }
                LIN[(size_t)m * LK + i] = (bf16)f2bf(v);
            }
#pragma unroll
            for (int q = 0; q < 4; ++q) {
                const int c = 4 * lane + 256 * q, win = 2 << q; const int n = (t + 1) < win ? (t + 1) : win;
                const f32x4 cur = *(const GAS f32x4*)(pr + SHIFT_W + c); f32x4 sum = cur;
                for (int s = 1; s < n; ++s) sum += *(const GAS f32x4*)(pr - (size_t)s * IN_PAD + SHIFT_W + c);
                const float inv = 1.0f / (float)n; const f32x4 pv = sum * inv - cur;
                v2u o; o.x = pk2(pv.x, pv.y); o.y = pk2(pv.z, pv.w);
                *(GAS v2u*)(POOLED + (size_t)m * 1024 + c) = o;
            }
        }
    }
    SEAM(2);

    if (IN(3)) {
#ifndef NO_LORA
        { pg8::Gemm g{LIN, LORAT, LK, LK}; pg8::GridOrder S; S.init(M / 256, 12, G, bx, (size_t)256 * LK * 2, 0, (size_t)256 * LK * 2);
          pg8::EpiF32 E{LOUT, 3072};
          pg8::gemm_phase<pg8::EpiF32, pg8::GridOrder, true, true>(lds, g, S, E); }
#endif
#ifndef NO_POOL
        { pg8::Gemm g{POOLED, WPOOLT, 1024, 256}; pg8::GridOrder S; S.init(M / 256, 4, G, bx, (size_t)256 * 1024 * 2, (size_t)256 * 2, (size_t)256 * 256 * 2);
          pg8::EpiPool E{MIXIN, pool_scale};
          pg8::gemm_phase<pg8::EpiPool, pg8::GridOrder, true, true>(lds, g, S, E); }
#endif
    }
    SEAM(3);

    if (IN(4)) {
        for (int m = gw; m < M; m += NGW) {
            const int t = m % SEQ;
            const float* pr = PROJ + (size_t)m * IN_PAD; const float* pp = pr - IN_PAD;
#pragma unroll
            for (int q = 0; q < 4; ++q) {
                const int c = 4 * lane + 256 * q; const size_t o = (size_t)m * 1024 + c;
                f32x4 r = *(const GAS f32x4*)(pr + c), k = *(const GAS f32x4*)(pr + 1024 + c), v = *(const GAS f32x4*)(pr + 2048 + c);
                f32x4 rp = (f32x4){0.f, 0.f, 0.f, 0.f}, kp = rp, vp = rp;
                if (t > 0) { rp = *(const GAS f32x4*)(pp + c); kp = *(const GAS f32x4*)(pp + 1024 + c); vp = *(const GAS f32x4*)(pp + 2048 + c); }
                r = r + (rp - r) * *(const GAS f32x4*)(mu + c); k = k + (kp - k) * *(const GAS f32x4*)(mu + 1024 + c); v = v + (vp - v) * *(const GAS f32x4*)(mu + 2048 + c);
                const f32x4 wl = *(const GAS f32x4*)(LOUT + (size_t)m * 3072 + c) + *(const GAS f32x4*)(w0 + c);
                const f32x4 al = *(const GAS f32x4*)(LOUT + (size_t)m * 3072 + 1024 + c) + *(const GAS f32x4*)(a0 + c);
                f32x4 a, dec;
#pragma unroll
                for (int j = 0; j < 4; ++j) { const float z = -wl[j]; const float sp = fmaxf(z, 0.f) + __logf(1.0f + __expf(-fabsf(z))); dec[j] = __expf(-__expf(-sp - 0.5f)); a[j] = 1.0f / (1.0f + __expf(-al[j])); }
                *(GAS f32x4*)(WDEC + o) = dec;
                f32x4 kk = k * *(const GAS f32x4*)(k_k + c);
                const float ss = row16_sum(kk.x * kk.x + kk.y * kk.y + kk.z * kk.z + kk.w * kk.w);
                kk = kk * __builtin_amdgcn_rsqf(fmaxf(ss, 1e-24f));
                const f32x4 k2 = k * (1.0f + (a - 1.0f) * *(const GAS f32x4*)(k_a + c));
                const f32x4 rk = *(const GAS f32x4*)(r_k + c);
                const float bon = row16_sum(r.x * k2.x * rk.x + r.y * k2.y * rk.y + r.z * k2.z * rk.z + r.w * k2.w * rk.w);
                *(GAS f32x4*)(Rr + o) = r; *(GAS f32x4*)(K2 + o) = k2; *(GAS f32x4*)(Vv + o) = v; *(GAS f32x4*)(KK + o) = kk; *(GAS f32x4*)(BB + o) = kk * a;
                if ((lane & 15) == 0) BONUS[m * 16 + (c >> 6)] = bon;
            }
        }
    }
    SEAM(4);

    if (IN(5)) {
        const int xcd_i = bx % 8, slot_i = bx / 8;
        if (slot_i < 16) {
            const int sid = xcd_i * 16 + slot_i, hd = sid >> 1, half = sid & 1, b = hd >> 4, h = hd & 15;
            LAS float* OPS = (LAS float*)lds;
            LAS float* VVs = (LAS float*)(lds + 81920);
            LAS float* YBs = (LAS float*)(lds + 81920 + 8192);
            const int r4 = lane >> 4, jq = lane & 15;
            const int tl = tid >> 4, j4 = (tid & 15) * 4;
            const int vt = tid >> 3, vi4 = (tid & 7) * 4;
            const size_t gbase = ((size_t)b * SEQ) * 1024 + h * 64;
            const float* arr[5] = {KK, WDEC, BB, K2, Rr};
            f32x4 st[5]; f32x4 sv = (f32x4){0.f, 0.f, 0.f, 0.f};
#pragma unroll
            for (int a = 0; a < 5; ++a) st[a] = *(const GAS f32x4*)(arr[a] + gbase + (size_t)tl * 1024 + j4);
            if (tid < 256) sv = *(const GAS f32x4*)(Vv + gbase + (size_t)vt * 1024 + half * 32 + vi4);
#pragma unroll
            for (int a = 0; a < 5; ++a) *(LAS f32x4*)(OPS + (a * 32 + tl) * 64 + j4) = st[a];
            if (tid < 256) *(LAS f32x4*)(VVs + vt * 32 + vi4) = sv;
            __syncthreads();
            float S0 = 0.f, S1 = 0.f, S2 = 0.f, S3 = 0.f;
            for (int c = 0; c < SEQ / 32; ++c) {
                const int buf = c & 1;
                if (c + 1 < SEQ / 32) {
                    const size_t gb = gbase + (size_t)(c + 1) * 32 * 1024;
#pragma unroll
                    for (int a = 0; a < 5; ++a) st[a] = *(const GAS f32x4*)(arr[a] + gb + (size_t)tl * 1024 + j4);
                    if (tid < 256) sv = *(const GAS f32x4*)(Vv + gb + (size_t)vt * 1024 + half * 32 + vi4);
                }
                const LAS float* ob = OPS + buf * (5 * 32 * 64) + 4 * jq;
                const LAS float* vb = VVs + buf * 1024 + 4 * wave + r4;
                LAS float* yb = YBs + buf * 1024 + 4 * wave + r4;
                f32x4 a4 = *(const LAS f32x4*)(ob + (0 * 32) * 64), w4 = *(const LAS f32x4*)(ob + (1 * 32) * 64), b4 = *(const LAS f32x4*)(ob + (2 * 32) * 64),
                      k4 = *(const LAS f32x4*)(ob + (3 * 32) * 64), q4 = *(const LAS f32x4*)(ob + (4 * 32) * 64);
                float v = vb[0];
#pragma unroll 8
                for (int t = 0; t < 32; ++t) {
                    const int tn = (t + 1) & 31;
                    const f32x4 a4n = *(const LAS f32x4*)(ob + (0 * 32 + tn) * 64), w4n = *(const LAS f32x4*)(ob + (1 * 32 + tn) * 64), b4n = *(const LAS f32x4*)(ob + (2 * 32 + tn) * 64),
                                k4n = *(const LAS f32x4*)(ob + (3 * 32 + tn) * 64), q4n = *(const LAS f32x4*)(ob + (4 * 32 + tn) * 64);
                    const float vn = vb[tn * 32];
                    float p = S0 * a4.x; p += S1 * a4.y; p += S2 * a4.z; p += S3 * a4.w;
                    const float sa = -row16_sum(p);
                    S0 = S0 * w4.x + (sa * b4.x + v * k4.x); S1 = S1 * w4.y + (sa * b4.y + v * k4.y); S2 = S2 * w4.z + (sa * b4.z + v * k4.z); S3 = S3 * w4.w + (sa * b4.w + v * k4.w);
                    float y = S0 * q4.x; y += S1 * q4.y; y += S2 * q4.z; y += S3 * q4.w;
                    y = row16_sum(y);
                    yb[t * 32] = y;
                    a4 = a4n; w4 = w4n; b4 = b4n; k4 = k4n; q4 = q4n; v = vn;
                }
                if (c + 1 < SEQ / 32) {
                    const int nb = buf ^ 1;
#pragma unroll
                    for (int a = 0; a < 5; ++a) *(LAS f32x4*)(OPS + nb * (5 * 32 * 64) + (a * 32 + tl) * 64 + j4) = st[a];
                    if (tid < 256) *(LAS f32x4*)(VVs + nb * 1024 + vt * 32 + vi4) = sv;
                }
                __syncthreads();
                if (tid < 256) *(GAS f32x4*)(Yy + gbase + (size_t)(c * 32 + vt) * 1024 + half * 32 + vi4) = *(const LAS f32x4*)(YBs + buf * 1024 + vt * 32 + vi4);
            }
        } else {
            LAS float* scr = (LAS float*)(lds + wave * 16640);
            const int cw = (xcd_i * 16 + slot_i - 16) * NWAVES + wave;
            constexpr int I1 = (D / 64) * (4096 / 64), I2 = (DFF / 64) * (D / 64), IPE = I1 + I2;
            auto src_of = [&](int it, const float*& Wp, int& N, int& li) { const int e = it / IPE, r = it % IPE; if (r < I1) { Wp = w1 + (size_t)e * D * 4096; N = 4096; li = r; } else { Wp = w2 + (size_t)e * DFF * D; N = D; li = r - I1; } };
            f32x4 va[16], vb2[16];
            int it = cw; const float* Wp; int N, li;
            constexpr int TOT = NE * IPE, STRIDE = 128 * NWAVES;
#define CONV_STEP(cur, nxtbuf) { const int itn = it + STRIDE; const float* Wn; int Nn, lin; \
                src_of(itn < TOT ? itn : it, Wn, Nn, lin); tr_load(Wn, Nn, lin, lane, nxtbuf);     \
                { const int e = it / IPE, r = it % IPE; \
                  if (r < I1) tr_store(cur, D, 4096, W1T, (size_t)e * 4096, scr, li, lane); else tr_store(cur, DFF, D, W2T, (size_t)e * 2048, scr, li, lane); } \
                it = itn; li = lin; }
            if (it < TOT) { src_of(it, Wp, N, li); tr_load(Wp, N, li, lane, va);
                for (;;) { CONV_STEP(va, vb2); if (it >= TOT) break; CONV_STEP(vb2, va); if (it >= TOT) break; } }
#undef CONV_STEP
        }
    }
    SEAM(5);

    if (IN(6)) {
        for (int m = gw; m < M; m += NGW) {
#pragma unroll
            for (int q = 0; q < 4; ++q) {
                const int c = 4 * lane + 256 * q; const size_t o = (size_t)m * 1024 + c;
                const f32x4 y = *(const GAS f32x4*)(Yy + o);
                const float mean = row16_sum(y.x + y.y + y.z + y.w) * (1.0f / 64.0f);
                const f32x4 d = y - mean;
                const float var = row16_sum(d.x * d.x + d.y * d.y + d.z * d.z + d.w * d.w) * (1.0f / 64.0f);
                const float rstd = __builtin_amdgcn_rsqf(var + GN_EPS);
                f32x4 yn = d * rstd * *(const GAS f32x4*)(lnx_w + c) + *(const GAS f32x4*)(lnx_b + c);
                yn = yn + BONUS[m * 16 + (c >> 6)] * *(const GAS f32x4*)(Vv + o);
                yn = yn * *(const GAS f32x4*)(LOUT + (size_t)m * 3072 + 2048 + c);
                v2u ov; ov.x = pk2(yn.x, yn.y); ov.y = pk2(yn.z, yn.w);
                *(GAS v2u*)(MIXIN + (size_t)m * 2048 + c) = ov;
            }
        }
    }
    SEAM(6);

    if (IN(7)) {
        pg8::Gemm g{MIXIN, WOUTT, D, D}; pg8::GridOrder S; S.init(M / 256, D / 256, G, bx, (size_t)256 * D * 2, 0, (size_t)256 * D * 2);
        pg8::EpiF32 E{MIX, D};
        pg8::gemm_phase<pg8::EpiF32, pg8::GridOrder, true, true>(lds, g, S, E);
    }
    SEAM(7);

    if (IN(8)) {
        LAS float* s_h = (LAS float*)lds;
        LAS float* s_part = (LAS float*)(lds + 65536);
        const int e = tid & 31, part = tid >> 5;
        float wreg[128];
#pragma unroll
        for (int i = 0; i < 128; ++i) wreg[i] = router_w[(size_t)(part * 128 + i) * 32 + e];
        LAS int* lcnt = (LAS int*)(lds + LDSCTL_OFF + 512);
        if (tid < NE) lcnt[tid] = 0;
        __syncthreads();
        for (int m0 = vcu * 8; m0 < M; m0 += G * 8) {
            const int m = m0 + wave;
            {
                f32x4 v[8]; float s = 0.f;
#pragma unroll
                for (int q = 0; q < 8; ++q) { const int c = 4 * lane + 256 * q; v[q] = ALPHA * *(const GAS f32x4*)(x + (size_t)m * D + c) + *(const GAS f32x4*)(MIX + (size_t)m * D + c); s += (v[q].x + v[q].y) + (v[q].z + v[q].w); }
                const float mean = wave_sum(s) * (1.0f / D); float s2 = 0.f;
#pragma unroll
                for (int q = 0; q < 8; ++q) { v[q] = v[q] - mean; s2 += (v[q].x * v[q].x + v[q].y * v[q].y) + (v[q].z * v[q].z + v[q].w * v[q].w); }
                const float rstd = 1.0f / sqrtf(wave_sum(s2) * (1.0f / D) + LN_EPS);
#pragma unroll
                for (int q = 0; q < 8; ++q) { const int c = 4 * lane + 256 * q;
                    const f32x4 hv = v[q] * rstd * *(const GAS f32x4*)(ln1_w + c) + *(const GAS f32x4*)(ln1_b + c);
                    *(GAS f32x4*)(H + (size_t)m * D + c) = hv; *(LAS f32x4*)(s_h + wave * 2048 + c) = hv;
                    v2u ov; ov.x = pk2(hv.x, hv.y); ov.y = pk2(hv.z, hv.w); *(GAS v2u*)(HB + (size_t)m * D + c) = ov; }
            }
            __syncthreads();
#pragma unroll 1
            for (int tk = 0; tk < 8; ++tk) {
                const LAS float* hp = s_h + tk * 2048 + part * 128; float acc = 0.f;
#pragma unroll
                for (int i = 0; i < 32; ++i) { const f32x4 hv = *(const LAS f32x4*)(hp + 4 * i); acc += hv.x * wreg[4 * i]; acc += hv.y * wreg[4 * i + 1]; acc += hv.z * wreg[4 * i + 2]; acc += hv.w * wreg[4 * i + 3]; }
                s_part[(tk * 16 + part) * 32 + e] = acc;
            }
            __syncthreads();
            {
                float lg = -3.0e38f;
                if (lane < 32) { lg = router_b[lane];
#pragma unroll
                    for (int p = 0; p < 16; ++p) lg += s_part[(wave * 16 + p) * 32 + lane]; }
                int idx[4]; float val[4];
#pragma unroll
                for (int k = 0; k < 4; ++k) {
                    float best = lg; int bi = lane;
#pragma unroll
                    for (int o = 1; o < 64; o <<= 1) { const float ob = __shfl_xor(best, o); const int oi = __shfl_xor(bi, o); const bool take = (ob > best) || (ob == best && oi < bi); best = take ? ob : best; bi = take ? oi : bi; }
                    idx[k] = bi; val[k] = best; if (lane == bi) lg = -3.0e38f;
                }
                if (lane == 0) {
                    float ex[4], se = 0.f;
#pragma unroll
                    for (int k = 0; k < 4; ++k) { ex[k] = __expf(val[k] - val[0]); se += ex[k]; }
                    const float inv = 1.0f / se;
#pragma unroll
                    for (int k = 0; k < 4; ++k) { TOPI[m * 4 + k] = idx[k]; GATE[m * 4 + k] = ex[k] * inv; POS[m * 4 + k] = __hip_atomic_fetch_add(lcnt + idx[k], 1, __ATOMIC_RELAXED, __HIP_MEMORY_SCOPE_WORKGROUP); }
                }
            }
            __syncthreads();
        }
        if (tid < NE) CNTWG[vcu * NE + tid] = lcnt[tid];
    }
    SEAM(8);

    if (IN(9) || IN(10) || IN(11)) {
        LAS int* s_t = (LAS int*)lds; LAS int* s_p = s_t + 512;
        LAS int* PSB = (LAS int*)(lds + LDSCTL_OFF + 640);
        { const int e = tid & 31, part = tid >> 5; int tsum = 0, psum = 0;
          for (int w = part * 16; w < part * 16 + 16; ++w) { const int cv = CNTWG[w * NE + e]; tsum += cv; psum += (w < vcu) ? cv : 0; }
          s_t[part * 32 + e] = tsum; s_p[part * 32 + e] = psum; }
        __syncthreads();
        if (tid < NE) { int tsum = 0, psum = 0; for (int p = 0; p < 16; ++p) { tsum += s_t[p * 32 + tid]; psum += s_p[p * 32 + tid]; } s_t[tid] = tsum; PSB[tid] = psum; }
        __syncthreads();
        if (tid == 0) { int acc = 0; for (int e = 0; e < NE; ++e) { PS[e] = acc; acc += (s_t[e] + 255) / 256 * 256; } PS[NE] = acc; }
        __syncthreads();
        if (tid < NE) PSB[tid] += PS[tid];
        __syncthreads();
    }
    if (IN(9)) {
        const LAS int* PSB = (const LAS int*)(lds + LDSCTL_OFF + 640);
        for (int m0 = vcu * 8; m0 < M; m0 += G * 8) {
            const int m = m0 + wave;
            const GAS v4u* src = (const GAS v4u*)(HB + (size_t)m * D);
            v4u rv[4];
#pragma unroll
            for (int q = 0; q < 4; ++q) rv[q] = src[lane + 64 * q];
#pragma unroll
            for (int k = 0; k < 4; ++k) {
                const int a = m * 4 + k, slot = PSB[TOPI[a]] + POS[a];
                if (lane == 0) { slot_tok[slot] = m; SLOT_OF[a] = slot; }
                GAS v4u* dst = (GAS v4u*)(XS + (size_t)slot * D);
#pragma unroll
                for (int q = 0; q < 4; ++q) dst[lane + 64 * q] = rv[q];
            }
        }
    }
    SEAM(9);

    if (IN(10)) {
        pg8::Gemm g{XS, W1T, D, D}; pg8::MoeOrder S; S.ps = PS; S.ntile = 16; S.npan = PS[NE] / 256; S.cprime = vcu; S.a_tstep = (size_t)256 * D * 2; S.b_tstep = (size_t)256 * D * 2;
        pg8::EpiSwiglu E{ACT, b1};
        pg8::gemm_phase<pg8::EpiSwiglu, pg8::MoeOrder, true, true>(lds, g, S, E);
    }
    SEAM(10);

    if (IN(11)) {
        pg8::Gemm g{ACT, W2T, DFF, DFF}; pg8::MoeOrder S; S.ps = PS; S.ntile = 8; S.npan = PS[NE] / 256; S.cprime = vcu; S.a_tstep = (size_t)256 * DFF * 2; S.b_tstep = (size_t)256 * DFF * 2;
        pg8::EpiBias16 E{YS, b2};
        pg8::gemm_phase<pg8::EpiBias16, pg8::MoeOrder, true, true>(lds, g, S, E);
    }
    SEAM(11);

    if (IN(12)) {
        for (int m = gw; m < M; m += NGW) {
            int sl[4]; float gt[4];
#pragma unroll
            for (int k = 0; k < 4; ++k) { sl[k] = SLOT_OF[m * 4 + k]; gt[k] = GATE[m * 4 + k]; }
            f32x4 v[8]; float s = 0.f;
#pragma unroll
            for (int q = 0; q < 8; ++q) { const int c = 4 * lane + 256 * q; f32x4 f = (f32x4){0.f, 0.f, 0.f, 0.f};
#pragma unroll
                for (int k = 0; k < 4; ++k) { const v2u yv = *(const GAS v2u*)(YS + (size_t)sl[k] * D + c); f += gt[k] * (f32x4){bflo(yv.x), bfhi(yv.x), bflo(yv.y), bfhi(yv.y)}; }
                v[q] = ALPHA * *(const GAS f32x4*)(H + (size_t)m * D + c) + f; s += (v[q].x + v[q].y) + (v[q].z + v[q].w); }
            const float mean = wave_sum(s) * (1.0f / D); float s2 = 0.f;
#pragma unroll
            for (int q = 0; q < 8; ++q) { v[q] = v[q] - mean; s2 += (v[q].x * v[q].x + v[q].y * v[q].y) + (v[q].z * v[q].z + v[q].w * v[q].w); }
            const float rstd = 1.0f / sqrtf(wave_sum(s2) * (1.0f / D) + LN_EPS);
#pragma unroll
            for (int q = 0; q < 8; ++q) { const int c = 4 * lane + 256 * q; *(GAS f32x4*)(out + (size_t)m * D + c) = v[q] * rstd * *(const GAS f32x4*)(ln2_w + c) + *(const GAS f32x4*)(ln2_b + c); }
        }
    }
#undef IN
#undef SEAM
}

extern "C" void kernel_launch(void* const* d_in, const int* in_sizes, int n_in, void* d_out, int out_size, void* d_ws, size_t ws_size, hipStream_t stream) {
    static int grid = 0;
    if (grid == 0) {
        if (n_in != 26 || out_size != M * D || ws_size < WS_END) { fprintf(stderr, "kernel_launch: unexpected problem (n_in %d, out %d, ws %zu < %zu)\n", n_in, out_size, ws_size, (size_t)WS_END); grid = -1; return; }
        int dev = 0, cus = 0, per_cu = 0;
        if (hipGetDevice(&dev) != hipSuccess || hipDeviceGetAttribute(&cus, hipDeviceAttributeMultiprocessorCount, dev) != hipSuccess) { grid = -1; return; }
        if (hipFuncSetAttribute((const void*)mk_fwd, hipFuncAttributeMaxDynamicSharedMemorySize, LDS_BYTES) != hipSuccess) { fprintf(stderr, "kernel_launch: hipFuncSetAttribute failed\n"); grid = -1; return; }
        if (hipOccupancyMaxActiveBlocksPerMultiprocessor(&per_cu, (const void*)mk_fwd, NTHR, LDS_BYTES) != hipSuccess || per_cu < 1) fprintf(stderr, "kernel_launch: occupancy query reports %d\n", per_cu);
        (void)hipGetLastError();
        if (cus != NWG) { fprintf(stderr, "kernel_launch: built for %d CUs, device has %d\n", NWG, cus); grid = -1; return; }
        grid = NWG;
    }
    if (grid < 0) return;
    (void)hipMemsetAsync((char*)d_ws + WS_CTL, 0, CTL_BYTES, stream);
    (void)hipMemsetAsync((char*)d_ws + WS_SLOTTOK, 0xFF, (size_t)NSLOT_MAX * 4, stream);
    Args a{};
    for (int i = 0; i < 26; ++i) a.in[i] = (const float*)d_in[i];
    a.out = (float*)d_out; a.ws = (unsigned char*)d_ws; a.dup = DUP_MASK;
    if (MK_N_LAUNCHES == 1) { a.ph_lo = 0; a.ph_hi = NPHASE; hipLaunchKernelGGL(mk_fwd, dim3(grid), dim3(NTHR), LDS_BYTES, stream, a); }
    else { for (int p = 0; p < NPHASE; ++p) for (int rep = 0; rep <= ((DUP_MASK >> p) & 1); ++rep) { a.ph_lo = p; a.ph_hi = p + 1; hipLaunchKernelGGL(mk_fwd, dim3(grid), dim3(NTHR), LDS_BYTES, stream, a); } }
}
```

```cpp
#include <hip/hip_runtime.h>
#include <stdint.h>
#include <stdio.h>

#ifndef P5_SCAN_REPS
#define P5_SCAN_REPS 1
#endif
#ifndef P5_CONV_REPS
#define P5_CONV_REPS 1
#endif
#ifndef DUP_MASK
#define DUP_MASK 0
#endif
#ifndef MK_N_LAUNCHES
#define MK_N_LAUNCHES 1
#endif

constexpr int D = 2048, BATCH = 4, SEQ = 4096, M = BATCH * SEQ;
constexpr int RW = 1024, PW = 1024, NH = 16;
constexpr int SHIFT_W = 3360, IN_COLS = 4384, IN_PAD = 4608;
constexpr int LK = 384;
constexpr int NE = 32, DFF = 2048;
constexpr int NASG = M * 4;
constexpr int NSLOT_MAX = NASG + NE * 256;
constexpr float LN_EPS = 1e-5f, GN_EPS = 64e-5f;
constexpr float ALPHA = 1.189207115002721f;
constexpr int NWG = 256, NWAVES = 8, NTHR = 512;
constexpr int NPHASE = 13;

#define GAS __attribute__((address_space(1)))
#define LAS __attribute__((address_space(3)))
typedef unsigned short bf16;
typedef unsigned v4u __attribute__((ext_vector_type(4)));
typedef unsigned v2u __attribute__((ext_vector_type(2)));
typedef float f32x4 __attribute__((ext_vector_type(4)));
typedef short bf16x8 __attribute__((ext_vector_type(8)));
typedef GAS unsigned gu32;
#define RLX_AGENT __ATOMIC_RELAXED, __HIP_MEMORY_SCOPE_AGENT
#define LDS_WAIT() asm volatile("s_waitcnt lgkmcnt(0)" ::: "memory")
#define VM_WAIT() asm volatile("s_waitcnt vmcnt(0)" ::: "memory")

__device__ __forceinline__ unsigned f2bf(float f) { unsigned u = __builtin_bit_cast(unsigned, f); return (u + 0x7fffu + ((u >> 16) & 1u)) >> 16; }
__device__ __forceinline__ unsigned pk2(float lo, float hi) { return f2bf(lo) | (f2bf(hi) << 16); }
__device__ __forceinline__ float bflo(unsigned w) { return __builtin_bit_cast(float, w << 16); }
__device__ __forceinline__ float bfhi(unsigned w) { return __builtin_bit_cast(float, w & 0xffff0000u); }
__device__ __forceinline__ float wave_sum(float v) {
#pragma unroll
    for (int o = 1; o < 64; o <<= 1) v += __shfl_xor(v, o);
    return v;
}
template <int CTRL> __device__ __forceinline__ float dpp_mov(float x) { return __builtin_bit_cast(float, __builtin_amdgcn_update_dpp(0, __builtin_bit_cast(int, x), CTRL, 0xF, 0xF, true)); }
__device__ __forceinline__ float row16_sum(float x) {
    x += dpp_mov<0xB1>(x);
    x += dpp_mov<0x4E>(x);
    x += dpp_mov<0x141>(x);
    x += dpp_mov<0x140>(x);
    return x;
}

namespace pg8 {
typedef unsigned short bf16_t;
typedef unsigned u32x4 __attribute__((ext_vector_type(4)));
typedef int v4i_t __attribute__((ext_vector_type(4)));
typedef int v8i_t __attribute__((ext_vector_type(8)));
constexpr int BM = 256, BK = 64, HALF = 128, HTB = HALF * BK * 2, STAGE_BYTES = 8 * HTB, NXCD = 8, WGM = 8;
__host__ __device__ __forceinline__ int lds_byte(int r, int c) { const int st = (r >> 4) * 2 + (c >> 5), rr = r & 15, cc = c & 31, ob = rr * 64 + cc * 2; return st * 1024 + (ob ^ (((ob >> 9) & 1) << 5)); }
__host__ __device__ __forceinline__ void stage_rc(int b, int& R, int& C) { const int st = b / 1024, sb = b % 1024, swz = sb ^ (((sb >> 9) & 1) << 5); R = (st >> 1) * 16 + swz / 64; C = (st & 1) * 32 + (swz % 64) / 2; }
__host__ __device__ __forceinline__ int perm32(int rho) { const int n = rho >> 4, i = rho & 15; return 8 * (i >> 2) + 4 * n + (i & 3); }
struct Unit { int pm, pn; };
struct Gemm { const bf16_t* A; const bf16_t* Bt; int lda, K; };
__device__ __forceinline__ unsigned cvt_pk_bf16(float lo, float hi) { unsigned r; asm volatile("v_cvt_pk_bf16_f32 %0, %1, %2" : "=v"(r) : "v"(lo), "v"(hi)); return r; }

struct GridOrder {
    int nM, nN, nwg, G, c; size_t a_tstep, a_pnstep, b_tstep;
    __device__ void init(int nM_, int nN_, int G_, int c_, size_t a_tstep_, size_t a_pnstep_, size_t b_tstep_) { nM = nM_; nN = nN_; nwg = nM * nN; G = G_; c = c_; a_tstep = a_tstep_; a_pnstep = a_pnstep_; b_tstep = b_tstep_; }
    __device__ bool next(int i, Unit& u) const {
        const long L = (long)i * G + c; if (L >= nwg) return false;
        int wgid = (int)L; { const int q = nwg / NXCD, r = nwg % NXCD, xcd = wgid % NXCD, off = wgid / NXCD; wgid = (xcd < r ? xcd * (q + 1) : r * (q + 1) + (xcd - r) * q) + off; }
        const int nig = WGM * nN, gid = wgid / nig, fm = gid * WGM, gsz = (nM - fm) < WGM ? (nM - fm) : WGM;
        u.pm = fm + ((wgid % nig) % gsz); u.pn = (wgid % nig) / gsz; return true;
    }
    __device__ __forceinline__ size_t aoff(const Unit& u) const { return (size_t)u.pm * a_tstep + (size_t)u.pn * a_pnstep; }
    __device__ __forceinline__ size_t boff(const Unit& u) const { return (size_t)u.pn * b_tstep; }
};
struct MoeOrder {
    const LAS int* ps; int ntile, npan, cprime; size_t a_tstep, b_tstep;
    __device__ bool next(int i, Unit& u) const {
        const int U = i * NWG + cprime; const int p = U / ntile; if (p >= npan) return false;
        const int row = p * 256; int e = 0;
#pragma unroll 1
        for (int q = 1; q < NE; ++q) e = (row >= ps[q]) ? q : e;
        u.pm = p; u.pn = e * ntile + (U % ntile); return true;
    }
    __device__ __forceinline__ size_t aoff(const Unit& u) const { return (size_t)u.pm * a_tstep; }
    __device__ __forceinline__ size_t boff(const Unit& u) const { return (size_t)u.pn * b_tstep; }
};

template <class Epi, class Sched, bool ALIGN_EPI, bool SP2, bool FP8 = false>
__device__ __forceinline__ void gemm_phase(LAS unsigned char* lds, const Gemm g, const Sched& S, const Epi& E) {
    int tid_ = threadIdx.x; asm volatile("" : "+v"(tid_));
    const int tid = tid_, wid = __builtin_amdgcn_readfirstlane(tid >> 6), lane = tid & 63, wr = wid >> 2, wc = wid & 3, fr = lane & 15, fq = lane >> 4;
    const int K = g.K, nt = K / BK;
    unsigned voffA[2], voffB[2];
#pragma unroll
    for (int i = 0; i < 2; ++i) { int R, C; stage_rc(tid * 16 + i * 8192, R, C); const int Rb = Epi::PERM ? ((R & ~31) + perm32(R & 31)) : R;
        voffA[i] = (unsigned)(R * g.lda + C) * 2u; voffB[i] = (unsigned)(Rb * K + C) * 2u; }
    const size_t kstep = (size_t)(BK * 2);
    const size_t hstepA = (size_t)HALF * g.lda * 2, hstepB = (size_t)HALF * K * 2;
    const unsigned ldsw = (unsigned)wid * 1024u;
    const int aoff = lds_byte(wr * 64 + fr, fq * 8), boff = lds_byte(wc * 32 + fr, fq * 8);
#define PG8_SA(b, h) (((b) * 2 + (h)) * HTB)
#define PG8_SB(b, h) ((4 + (b) * 2 + (h)) * HTB)
#define PG8_STAGE(bufoff, gbase, voff) do { _Pragma("unroll") for (int _i = 0; _i < 2; ++_i) \
        __builtin_amdgcn_global_load_lds((const unsigned*)((const char*)(gbase) + (voff)[_i]), (LAS unsigned*)(lds + (bufoff) + ldsw + _i * 8192), 16, 0, 0); } while (0)
#define PG8_LDA(dst, b, h) do { _Pragma("unroll") for (int m = 0; m < 4; ++m) { if constexpr (FP8) { const v4i_t l_ = *(const LAS v4i_t*)(lds + PG8_SA(b, h) + aoff + m * 2048), h_ = *(const LAS v4i_t*)(lds + PG8_SA(b, h) + aoff + m * 2048 + 1024); dst##8[m] = __builtin_shufflevector(l_, h_, 0, 1, 2, 3, 4, 5, 6, 7); } \
        else { _Pragma("unroll") for (int k = 0; k < 2; ++k) dst[m][k] = *(const LAS bf16x8*)(lds + PG8_SA(b, h) + aoff + m * 2048 + k * 1024); } } } while (0)
#define PG8_LDB(dst, b, h) do { _Pragma("unroll") for (int n = 0; n < 2; ++n) { if constexpr (FP8) { const v4i_t l_ = *(const LAS v4i_t*)(lds + PG8_SB(b, h) + boff + n * 2048), h_ = *(const LAS v4i_t*)(lds + PG8_SB(b, h) + boff + n * 2048 + 1024); dst##8[n] = __builtin_shufflevector(l_, h_, 0, 1, 2, 3, 4, 5, 6, 7); } \
        else { _Pragma("unroll") for (int k = 0; k < 2; ++k) dst[n][k] = *(const LAS bf16x8*)(lds + PG8_SB(b, h) + boff + n * 2048 + k * 1024); } } } while (0)
#define PG8_MMA(ai, bj, At, Bt) do { __builtin_amdgcn_s_setprio(1); _Pragma("unroll") for (int m = 0; m < 4; ++m) _Pragma("unroll") for (int n = 0; n < 2; ++n) { \
        if constexpr (FP8) asm volatile("v_mfma_scale_f32_16x16x128_f8f6f4 %0, %1, %2, %0, %3, %3 op_sel_hi:[0,0,0]" : "+v"(acc[ai][bj][m][n]) : "v"(Bt##8[n]), "v"(At##8[m]), "v"(scale1_)); \
        else { _Pragma("unroll") for (int k = 0; k < 2; ++k) acc[ai][bj][m][n] = __builtin_amdgcn_mfma_f32_16x16x32_bf16(Bt[n][k], At[m][k], acc[ai][bj][m][n], 0, 0, 0); } } \
        __builtin_amdgcn_s_setprio(0); } while (0)
#define PG8_WAIT_V(n) asm volatile("s_waitcnt vmcnt(" #n ")" ::: "memory")
#define PG8_WAIT_L(n) asm volatile("s_waitcnt lgkmcnt(" #n ")" ::: "memory")
#define PG8_BAR __builtin_amdgcn_s_barrier()
#define PG8_SCHED __builtin_amdgcn_sched_barrier(0)
    Unit cur, nxt; int ui = 0;
    if (!S.next(0, cur)) return;
    f32x4 acc[2][2][4][2];
#pragma unroll
    for (int a = 0; a < 2; ++a)
#pragma unroll
        for (int b = 0; b < 2; ++b)
#pragma unroll
            for (int m = 0; m < 4; ++m)
#pragma unroll
                for (int n = 0; n < 2; ++n) acc[a][b][m][n] = (f32x4){0.f, 0.f, 0.f, 0.f};
    int scale1_ = 0x7F7F7F7F; asm volatile("" : "+v"(scale1_));
    bf16x8 At[4][2], B0[2][2], B1[2][2];
    v8i_t At8[4], B08[2], B18[2];
    const char* cA = (const char*)g.A + S.aoff(cur); const char* cB = (const char*)g.Bt + S.boff(cur);
    if constexpr (SP2) {
        PG8_STAGE(PG8_SB(0, 0), cB, voffB); PG8_STAGE(PG8_SB(0, 1), cB + hstepB, voffB); PG8_STAGE(PG8_SA(0, 0), cA, voffA); PG8_STAGE(PG8_SA(0, 1), cA + hstepA, voffA);
        if (wr == 1) PG8_BAR;
        PG8_WAIT_V(2); PG8_BAR;
        PG8_STAGE(PG8_SB(1, 0), cB + kstep, voffB); PG8_STAGE(PG8_SA(1, 0), cA + kstep, voffA); PG8_STAGE(PG8_SB(1, 1), cB + hstepB + kstep, voffB);
        PG8_WAIT_V(6); PG8_BAR;
    } else {
        PG8_STAGE(PG8_SB(0, 0), cB, voffB); PG8_STAGE(PG8_SA(0, 0), cA, voffA); PG8_STAGE(PG8_SB(0, 1), cB + hstepB, voffB); PG8_STAGE(PG8_SA(0, 1), cA + hstepA, voffA);
        if (wr == 1) PG8_BAR;
        PG8_WAIT_V(4); PG8_BAR;
        PG8_STAGE(PG8_SB(1, 0), cB + kstep, voffB); PG8_STAGE(PG8_SA(1, 0), cA + kstep, voffA); PG8_STAGE(PG8_SB(1, 1), cB + hstepB + kstep, voffB);
        PG8_WAIT_V(6); PG8_BAR;
    }
    for (;;) {
        const bool has_next = S.next(ui + 1, nxt);
        const char* nA = has_next ? (const char*)g.A + S.aoff(nxt) : cA; const char* nB = has_next ? (const char*)g.Bt + S.boff(nxt) : cB;
#pragma unroll 1
        for (int t = 0; t < nt; t += 2) {
            const bool last = (t == nt - 2);
            const char* a1 = cA + (size_t)(t + 1) * kstep;
            const char* a2 = last ? nA : cA + (size_t)(t + 2) * kstep; const char* b2 = last ? nB : cB + (size_t)(t + 2) * kstep;
            const char* a3 = a2 + kstep; const char* b3 = b2 + kstep;
            if constexpr (SP2) {
            PG8_LDB(B0, 0, 0); PG8_LDB(B1, 0, 1); PG8_SCHED; PG8_LDA(At, 0, 0); PG8_STAGE(PG8_SA(1, 1), a1 + hstepA, voffA);
            PG8_WAIT_V(8); PG8_WAIT_L(0); PG8_BAR; PG8_MMA(0, 0, At, B0); PG8_MMA(0, 1, At, B1); PG8_BAR; PG8_SCHED;
            PG8_LDA(At, 0, 1); PG8_STAGE(PG8_SB(0, 0), b2, voffB); PG8_STAGE(PG8_SB(0, 1), b2 + hstepB, voffB); PG8_STAGE(PG8_SA(0, 0), a2, voffA);
            PG8_WAIT_V(8); PG8_WAIT_L(0); PG8_BAR; PG8_MMA(1, 0, At, B0); PG8_MMA(1, 1, At, B1); PG8_BAR; PG8_SCHED;
            PG8_LDB(B0, 1, 0); PG8_LDB(B1, 1, 1); PG8_SCHED; PG8_LDA(At, 1, 0); PG8_STAGE(PG8_SA(0, 1), a2 + hstepA, voffA);
            PG8_WAIT_V(8); PG8_WAIT_L(0); PG8_BAR; PG8_MMA(0, 0, At, B0); PG8_MMA(0, 1, At, B1); PG8_BAR; PG8_SCHED;
            PG8_LDA(At, 1, 1); PG8_STAGE(PG8_SB(1, 0), b3, voffB); PG8_STAGE(PG8_SB(1, 1), b3 + hstepB, voffB); PG8_STAGE(PG8_SA(1, 0), a3, voffA);
            PG8_WAIT_V(8); PG8_WAIT_L(0); PG8_BAR; PG8_MMA(1, 0, At, B0); PG8_MMA(1, 1, At, B1); PG8_BAR; PG8_SCHED;
            } else {
            PG8_LDB(B0, 0, 0); PG8_SCHED; PG8_LDA(At, 0, 0); PG8_STAGE(PG8_SA(1, 1), a1 + hstepA, voffA);
            PG8_WAIT_L(8); PG8_BAR; PG8_WAIT_L(0); PG8_MMA(0, 0, At, B0); PG8_BAR; PG8_SCHED;
            PG8_LDB(B1, 0, 1); PG8_STAGE(PG8_SB(0, 0), b2, voffB);
            PG8_BAR; PG8_WAIT_L(0); PG8_MMA(0, 1, At, B1); PG8_BAR;
            PG8_LDA(At, 0, 1); PG8_STAGE(PG8_SA(0, 0), a2, voffA);
            PG8_BAR; PG8_WAIT_L(0); PG8_MMA(1, 0, At, B0); PG8_BAR; PG8_SCHED;
            PG8_STAGE(PG8_SB(0, 1), b2 + hstepB, voffB);
            PG8_WAIT_V(6); PG8_BAR; PG8_MMA(1, 1, At, B1); PG8_BAR;
            PG8_LDB(B0, 1, 0); PG8_SCHED; PG8_LDA(At, 1, 0); PG8_STAGE(PG8_SA(0, 1), a2 + hstepA, voffA);
            PG8_WAIT_L(8); PG8_BAR; PG8_WAIT_L(0); PG8_MMA(0, 0, At, B0); PG8_BAR; PG8_SCHED;
            PG8_LDB(B1, 1, 1); PG8_STAGE(PG8_SB(1, 0), b3, voffB);
            PG8_BAR; PG8_WAIT_L(0); PG8_MMA(0, 1, At, B1); PG8_BAR;
            PG8_LDA(At, 1, 1); PG8_STAGE(PG8_SA(1, 0), a3, voffA);
            PG8_BAR; PG8_WAIT_L(0); PG8_MMA(1, 0, At, B0); PG8_BAR; PG8_SCHED;
            PG8_STAGE(PG8_SB(1, 1), b3 + hstepB, voffB);
            PG8_WAIT_V(6); PG8_BAR; PG8_MMA(1, 1, At, B1); PG8_BAR;
            }
        }
        if constexpr (ALIGN_EPI) { if (wr == 0) PG8_BAR; }
        if constexpr (FP8) asm volatile("s_nop 15\n\ts_nop 15" ::: "memory");
        E(acc, cur, wr, wc, fr, fq);
        if (!has_next) break;
#pragma unroll
        for (int a = 0; a < 2; ++a)
#pragma unroll
            for (int b = 0; b < 2; ++b)
#pragma unroll
                for (int m = 0; m < 4; ++m)
#pragma unroll
                    for (int n = 0; n < 2; ++n) acc[a][b][m][n] = (f32x4){0.f, 0.f, 0.f, 0.f};
        cur = nxt; cA = nA; cB = nB; ++ui;
        if constexpr (ALIGN_EPI) { if (wr == 1) PG8_BAR; }
    }
    PG8_WAIT_V(0);
    if constexpr (!ALIGN_EPI) { if (wr == 0) PG8_BAR; }
    PG8_BAR;
#undef PG8_SA
#undef PG8_SB
#undef PG8_STAGE
#undef PG8_LDA
#undef PG8_LDB
#undef PG8_MMA
#undef PG8_WAIT_V
#undef PG8_WAIT_L
#undef PG8_BAR
#undef PG8_SCHED
}

struct EpiF32 {
    static constexpr bool PERM = false;
    float* C; int ldc;
    __device__ __forceinline__ void operator()(const f32x4 (&acc)[2][2][4][2], const Unit& u, int wr, int wc, int fr, int fq) const {
        const int row0 = u.pm * BM + wr * 64 + fr, col0 = u.pn * BM + wc * 32 + 4 * fq;
#pragma unroll
        for (int ai = 0; ai < 2; ++ai)
#pragma unroll
            for (int m = 0; m < 4; ++m) { float* rowp = C + (size_t)(row0 + ai * HALF + m * 16) * ldc + col0;
#pragma unroll
                for (int bj = 0; bj < 2; ++bj)
#pragma unroll
                    for (int n = 0; n < 2; ++n) *(f32x4*)(rowp + bj * HALF + n * 16) = acc[ai][bj][m][n]; }
    }
};
struct EpiPool {
    static constexpr bool PERM = true;
    bf16_t* O; const float* scale;
    __device__ __forceinline__ void operator()(const f32x4 (&acc)[2][2][4][2], const Unit& u, int wr, int wc, int fr, int fq) const {
        const int row0 = u.pm * BM + wr * 64 + fr; int col0 = u.pn * BM + wc * 32 + 8 * fq;
        asm volatile("" : "+v"(col0));
        f32x4 sv[2][2];
#pragma unroll
        for (int bj = 0; bj < 2; ++bj)
#pragma unroll
            for (int n = 0; n < 2; ++n) sv[bj][n] = *(const f32x4*)(scale + col0 + bj * HALF + 4 * n);
#pragma unroll
        for (int ai = 0; ai < 2; ++ai)
#pragma unroll
            for (int m = 0; m < 4; ++m) { bf16_t* rowp = O + (size_t)(row0 + ai * HALF + m * 16) * 2048 + 1024 + col0;
#pragma unroll
                for (int bj = 0; bj < 2; ++bj) { const f32x4 v0 = acc[ai][bj][m][0] * sv[bj][0], v1 = acc[ai][bj][m][1] * sv[bj][1];
                    u32x4 w; w.x = cvt_pk_bf16(v0[0], v0[1]); w.y = cvt_pk_bf16(v0[2], v0[3]); w.z = cvt_pk_bf16(v1[0], v1[1]); w.w = cvt_pk_bf16(v1[2], v1[3]);
                    *(u32x4*)(rowp + bj * HALF) = w; } }
    }
};
constexpr float XS_SCALE = 8.0f, W_SCALE = 256.0f, ACT_SCALE = 8.0f, DESCALE = 1.0f / 2048.0f;
__device__ __forceinline__ unsigned pk4_fp8(float a, float b, float c, float d) {
    a = fminf(fmaxf(a, -448.f), 448.f); b = fminf(fmaxf(b, -448.f), 448.f); c = fminf(fmaxf(c, -448.f), 448.f); d = fminf(fmaxf(d, -448.f), 448.f);
    int w = 0; w = __builtin_amdgcn_cvt_pk_fp8_f32(a, b, w, false); w = __builtin_amdgcn_cvt_pk_fp8_f32(c, d, w, true); return (unsigned)w;
}
struct EpiSwiglu {
    static constexpr bool PERM = true;
    unsigned char* O; const float* b1;
    __device__ __forceinline__ void operator()(const f32x4 (&acc)[2][2][4][2], const Unit& u, int wr, int wc, int fr, int fq) const {
        const int e = u.pn >> 4, nt = u.pn & 15;
        const int row0 = u.pm * BM + wr * 64 + fr; int col0 = nt * BM + wc * 32 + 8 * fq;
        asm volatile("" : "+v"(col0));
        const float* bp = b1 + (size_t)e * 4096 + col0;
        f32x4 bv[2][2];
#pragma unroll
        for (int bj = 0; bj < 2; ++bj)
#pragma unroll
            for (int n = 0; n < 2; ++n) bv[bj][n] = *(const f32x4*)(bp + bj * HALF + 4 * n);
#pragma unroll
        for (int ai = 0; ai < 2; ++ai)
#pragma unroll
            for (int m = 0; m < 4; ++m) { unsigned char* rowp = O + (size_t)(row0 + ai * HALF + m * 16) * 2048 + (col0 >> 1);
#pragma unroll
                for (int bj = 0; bj < 2; ++bj) { const f32x4 v0 = acc[ai][bj][m][0] * DESCALE + bv[bj][0], v1 = acc[ai][bj][m][1] * DESCALE + bv[bj][1];
                    float a[4];
#pragma unroll
                    for (int p = 0; p < 4; ++p) { const float hg = p < 2 ? v0[2 * p] : v1[2 * p - 4], hl = p < 2 ? v0[2 * p + 1] : v1[2 * p - 3];
                        const float xg = fminf(hg, 7.0f), xl = fminf(fmaxf(hl, -7.0f), 7.0f);
                        a[p] = xg * __builtin_amdgcn_rcpf(1.0f + __expf(-1.702f * xg)) * (xl + 1.0f) * ACT_SCALE; }
                    *(unsigned*)(rowp + bj * (HALF / 2)) = pk4_fp8(a[0], a[1], a[2], a[3]); } }
    }
};
struct EpiBias16 {
    static constexpr bool PERM = true;
    bf16_t* O; const float* b2;
    __device__ __forceinline__ void operator()(const f32x4 (&acc)[2][2][4][2], const Unit& u, int wr, int wc, int fr, int fq) const {
        const int e = u.pn >> 3, nt = u.pn & 7;
        const int row0 = u.pm * BM + wr * 64 + fr; int col0 = nt * BM + wc * 32 + 8 * fq;
        asm volatile("" : "+v"(col0));
        const float* bp = b2 + (size_t)e * 2048 + col0;
        f32x4 bv[2][2];
#pragma unroll
        for (int bj = 0; bj < 2; ++bj)
#pragma unroll
            for (int n = 0; n < 2; ++n) bv[bj][n] = *(const f32x4*)(bp + bj * HALF + 4 * n);
#pragma unroll
        for (int ai = 0; ai < 2; ++ai)
#pragma unroll
            for (int m = 0; m < 4; ++m) { bf16_t* rowp = O + (size_t)(row0 + ai * HALF + m * 16) * 2048 + col0;
#pragma unroll
                for (int bj = 0; bj < 2; ++bj) { const f32x4 v0 = acc[ai][bj][m][0] * DESCALE + bv[bj][0], v1 = acc[ai][bj][m][1] * DESCALE + bv[bj][1];
                    u32x4 w; w.x = cvt_pk_bf16(v0[0], v0[1]); w.y = cvt_pk_bf16(v0[2], v0[3]); w.z = cvt_pk_bf16(v1[0], v1[1]); w.w = cvt_pk_bf16(v1[2], v1[3]);
                    *(u32x4*)(rowp + bj * HALF) = w; } }
    }
};
}

#define XB_TMO      128
#define XB_XCNT(j)  (256  + 64 * (j))
#define XB_XSUB(j)  (1280 + 64 * (j))
#define XB_XGEN(j)  (2304 + 64 * (j))
#define XB_TOP      3328
#define XB_TOPGEN   3392
#define XCD_BAR_WORDS 3456
#define XB_SPIN_CAP (1u << 22)
__device__ __forceinline__ unsigned xb_ld(unsigned* p)              { return __hip_atomic_load(p, __ATOMIC_RELAXED, __HIP_MEMORY_SCOPE_AGENT); }
__device__ __forceinline__ unsigned xb_add(unsigned* p, unsigned v) { return __hip_atomic_fetch_add(p, v, __ATOMIC_RELAXED, __HIP_MEMORY_SCOPE_AGENT); }
__device__ __forceinline__ unsigned xb_xcc_id() { return (unsigned)__builtin_amdgcn_s_getreg((3 << 11) | 20) & 0xFu; }
#define XB_SPIN(cond, bar) do { unsigned _sp = 0; while (cond) { __builtin_amdgcn_s_sleep(1); \
    if ((++_sp & 255u) == 0u) { if (xb_ld(&(bar)[XB_TMO])) break; if (_sp > XB_SPIN_CAP) { atomicAdd(&(bar)[XB_TMO], 1u); break; } } } } while (0)
struct XcdBarrier { unsigned* bar; unsigned x; volatile LAS unsigned* st; };
__device__ __forceinline__ XcdBarrier xcd_barrier_post(unsigned* bar, volatile LAS unsigned* st) {
    XcdBarrier b; b.bar = bar; b.x = xb_xcc_id(); b.st = st;
    if (threadIdx.x == 0) (void)xb_add(&bar[XB_XCNT(b.x)], 1u);
    return b;
}
__device__ __forceinline__ void xcd_barrier_complete(unsigned* bar, unsigned x, unsigned& nloc, unsigned& nx) {
    const unsigned G = gridDim.x * gridDim.y * gridDim.z;
    unsigned sum, cnt, mine, sp = 0u;
    for (;;) {
        sum = 0u; cnt = 0u; mine = 0u;
#pragma unroll
        for (unsigned j = 0; j < 16; ++j) { const unsigned c = xb_ld(&bar[XB_XCNT(j)]); sum += c; cnt += (c > 0u) ? 1u : 0u; mine = (j == x) ? c : mine; }
        if (sum == G) break;
        __builtin_amdgcn_s_sleep(1);
        if ((++sp & 255u) == 0u) { if (xb_ld(&bar[XB_TMO])) break; if (sp > XB_SPIN_CAP) { atomicAdd(&bar[XB_TMO], 1u); break; } }
    }
    nloc = mine > 0u ? mine : 1u; nx = cnt > 0u ? cnt : 1u;
}
__device__ __forceinline__ void xcd_barrier(const XcdBarrier& b) {
    asm volatile("s_waitcnt vmcnt(0)" ::: "memory");
    __syncthreads();
    if (threadIdx.x == 0) {
        unsigned* bar = b.bar;
        __builtin_amdgcn_s_waitcnt(0);
        unsigned nloc = b.st[0], nx = b.st[1];
        if (nloc == 0u) { xcd_barrier_complete(bar, b.x, nloc, nx); b.st[0] = nloc; b.st[1] = nx; }
        const unsigned old = xb_add(&bar[XB_XSUB(b.x)], 1u);
        const unsigned gen = old / nloc;
        if (old + 1u == (gen + 1u) * nloc) {
            __builtin_amdgcn_fence(__ATOMIC_RELEASE, "agent");
            asm volatile("s_waitcnt vmcnt(0)" ::: "memory");
            const unsigned og = xb_add(&bar[XB_TOP], 1u);
            const unsigned tg = og / nx;
            if (og + 1u == (tg + 1u) * nx) xb_add(&bar[XB_TOPGEN], 1u);
            else XB_SPIN(xb_ld(&bar[XB_TOPGEN]) == tg, bar);
            __builtin_amdgcn_fence(__ATOMIC_ACQUIRE, "agent");
            xb_add(&bar[XB_XGEN(b.x)], 1u);
            asm volatile("s_waitcnt vmcnt(0)" ::: "memory");
        } else {
            XB_SPIN(xb_ld(&bar[XB_XGEN(b.x)]) == gen, bar);
            __builtin_amdgcn_fence(__ATOMIC_ACQUIRE, "agent");
            asm volatile("s_waitcnt vmcnt(0)" ::: "memory");
        }
    }
    __syncthreads();
}

constexpr size_t al256(size_t x) { return (x + 255) & ~(size_t)255; }
constexpr size_t WS_CTL = 0, CTL_BYTES = 1u << 20;
constexpr int CW_BAR = 4096;
constexpr int CW_CNT = 16384;
constexpr size_t WS_SLOTTOK = WS_CTL + CTL_BYTES;
constexpr size_t WS_TOPI = WS_SLOTTOK + al256((size_t)NSLOT_MAX * 4);
constexpr size_t WS_GATE = WS_TOPI + (size_t)NASG * 4;
constexpr size_t WS_POS = WS_GATE + (size_t)NASG * 4;
constexpr size_t WS_SLOTOF = WS_POS + (size_t)NASG * 4;
constexpr size_t WS_BONUS = WS_SLOTOF + (size_t)NASG * 4;
constexpr size_t WS_XB = WS_BONUS + (size_t)M * 16 * 4;
constexpr size_t WS_WINT = WS_XB + (size_t)M * D * 2;
constexpr size_t WS_WOUTT = WS_WINT + (size_t)IN_PAD * D * 2;
constexpr size_t WS_LORAT = WS_WOUTT + (size_t)D * D * 2;
constexpr size_t WS_WPOOLT = WS_LORAT + (size_t)3072 * LK * 2;
constexpr size_t WS_PROJ = WS_WPOOLT + (size_t)1024 * 256 * 2;
constexpr size_t WS_LIN = WS_PROJ + (size_t)M * IN_PAD * 4;
constexpr size_t WS_POOLED = WS_LIN + (size_t)M * LK * 2;
constexpr size_t WS_WDEC = WS_POOLED + (size_t)M * 1024 * 2;
constexpr size_t SZ_F1K = (size_t)M * 1024 * 4;
constexpr size_t WS_LOUT = WS_WDEC + SZ_F1K  , WS_R = WS_LOUT + 3 * SZ_F1K, WS_K2 = WS_R + SZ_F1K, WS_V = WS_K2 + SZ_F1K, WS_KK = WS_V + SZ_F1K, WS_BB = WS_KK + SZ_F1K, WS_Y = WS_BB + SZ_F1K;
constexpr size_t WS_MIXIN = WS_Y + SZ_F1K;
constexpr size_t WS_MIX = WS_MIXIN + (size_t)M * D * 2;
constexpr size_t WS_H = WS_MIX + (size_t)M * D * 4;
constexpr size_t WS_HB = WS_H + (size_t)M * D * 4;
constexpr size_t WS_XS = WS_HB + (size_t)M * D;
constexpr size_t WS_W1T = WS_XS + (size_t)NSLOT_MAX * D;
constexpr size_t WS_W2T = WS_W1T + (size_t)NE * 4096 * D;
constexpr size_t WS_ACT = WS_W2T + (size_t)NE * 2048 * DFF;
constexpr size_t WS_YS = WS_ACT + (size_t)NSLOT_MAX * DFF;
constexpr size_t WS_END = WS_YS + (size_t)NSLOT_MAX * D * 2;

constexpr int RING_BYTES = 131072;
constexpr int LDSCTL_OFF = 139264;
constexpr int LDS_BYTES = 147456;

struct Args { const float* in[26]; float* out; unsigned char* ws; int ph_lo, ph_hi, dup, pad; };

__device__ __forceinline__ void tr_load(const float* W, int N, int item, int lane, f32x4 (&v)[16]) {
    const int nblk = N / 64, kb = item / nblk, nb = item % nblk, k0 = 64 * kb, n0 = 64 * nb;
    const int r = lane >> 4, c4 = (lane & 15) * 4;
#pragma unroll
    for (int i = 0; i < 16; ++i) v[i] = *(const GAS f32x4*)(W + (size_t)(k0 + 4 * i + r) * N + n0 + c4);
}
__device__ __forceinline__ void tr_store(const f32x4 (&v)[16], int K, int N, bf16* WT, size_t row_off, LAS float* scr, int item, int lane) {
    const int nblk = N / 64, kb = item / nblk, nb = item % nblk, k0 = 64 * kb, n0 = 64 * nb;
    const int r = lane >> 4, c4 = (lane & 15) * 4;
#pragma unroll
    for (int i = 0; i < 16; ++i) { LAS float* d = scr + (4 * i + r) * 65 + c4; d[0] = v[i].x; d[1] = v[i].y; d[2] = v[i].z; d[3] = v[i].w; }
    LDS_WAIT(); asm volatile("" ::: "memory");
    const int c = lane & 7;
#pragma unroll
    for (int p = 0; p < 8; ++p) { const int n = (lane >> 3) + 8 * p; const LAS float* q = scr + (8 * c) * 65 + n;
        v4u o; o.x = pk2(q[0 * 65], q[1 * 65]); o.y = pk2(q[2 * 65], q[3 * 65]); o.z = pk2(q[4 * 65], q[5 * 65]); o.w = pk2(q[6 * 65], q[7 * 65]);
        *(GAS v4u*)(WT + (row_off + n0 + n) * (size_t)K + k0 + 8 * c) = o; }
    LDS_WAIT(); asm volatile("" ::: "memory");
}
__device__ __forceinline__ void tr_store_fp8(const f32x4 (&v)[16], int K, int N, unsigned char* WT, size_t row_off, LAS float* scr, int item, int lane, float scale) {
    const int nblk = N / 64, kb = item / nblk, nb = item % nblk, k0 = 64 * kb, n0 = 64 * nb;
    const int r = lane >> 4, c4 = (lane & 15) * 4;
#pragma unroll
    for (int i = 0; i < 16; ++i) { LAS float* d = scr + (4 * i + r) * 65 + c4; d[0] = v[i].x * scale; d[1] = v[i].y * scale; d[2] = v[i].z * scale; d[3] = v[i].w * scale; }
    LDS_WAIT(); asm volatile("" ::: "memory");
    const int c = lane & 3;
#pragma unroll
    for (int p = 0; p < 4; ++p) { const int n = (lane >> 2) + 16 * p; const LAS float* q = scr + (16 * c) * 65 + n;
        v4u o; o.x = pg8::pk4_fp8(q[0 * 65], q[1 * 65], q[2 * 65], q[3 * 65]); o.y = pg8::pk4_fp8(q[4 * 65], q[5 * 65], q[6 * 65], q[7 * 65]);
        o.z = pg8::pk4_fp8(q[8 * 65], q[9 * 65], q[10 * 65], q[11 * 65]); o.w = pg8::pk4_fp8(q[12 * 65], q[13 * 65], q[14 * 65], q[15 * 65]);
        *(GAS v4u*)(WT + (row_off + n0 + n) * (size_t)K + k0 + 16 * c) = o; }
    LDS_WAIT(); asm volatile("" ::: "memory");
}
__device__ __forceinline__ void transpose_item(const float* W, int K, int N, bf16* WT, size_t row_off, LAS float* scr, int item, int lane) {
    f32x4 v[16]; tr_load(W, N, item, lane, v); tr_store(v, K, N, WT, row_off, scr, item, lane);
}

__global__ void __launch_bounds__(NTHR, 2) mk_fwd(Args args) {
    extern __shared__ __attribute__((aligned(16))) unsigned char lds_raw[];
    LAS unsigned char* lds = (LAS unsigned char*)lds_raw;
    volatile LAS unsigned* MISC = (volatile LAS unsigned*)(lds + LDSCTL_OFF);
    LAS int* PS = (LAS int*)(lds + LDSCTL_OFF + 256);
    const int tid = threadIdx.x, lane = tid & 63, wave = __builtin_amdgcn_readfirstlane(tid >> 6);
    const int G = gridDim.x, bx = blockIdx.x;
    const int vcu = (bx % 8) * (G / 8) + bx / 8;
    const int gw = vcu * NWAVES + wave, NGW = G * NWAVES;
    unsigned char* ws = args.ws;
    gu32* ctl = (gu32*)(ws + WS_CTL);
    const float* x = args.in[0]; const float* w_in = args.in[1]; const float* mu = args.in[2]; const float* w0 = args.in[3]; const float* w2d = args.in[4];
    const float* a0 = args.in[5]; const float* a2 = args.in[6]; const float* g2 = args.in[7]; const float* k_k = args.in[8]; const float* k_a = args.in[9];
    const float* r_k = args.in[10]; const float* lnx_w = args.in[11]; const float* lnx_b = args.in[12]; const float* w_pool = args.in[13]; const float* pool_scale = args.in[14];
    const float* w_out = args.in[15]; const float* ln1_w = args.in[16]; const float* ln1_b = args.in[17]; const float* router_w = args.in[18]; const float* router_b = args.in[19];
    const float* w1 = args.in[20]; const float* b1 = args.in[21]; const float* w2 = args.in[22]; const float* b2 = args.in[23]; const float* ln2_w = args.in[24]; const float* ln2_b = args.in[25];
    float* out = args.out;
    int* CNTWG = (int*)(ws + WS_CTL) + CW_CNT;
    int* slot_tok = (int*)(ws + WS_SLOTTOK); int* TOPI = (int*)(ws + WS_TOPI); float* GATE = (float*)(ws + WS_GATE); int* POS = (int*)(ws + WS_POS); int* SLOT_OF = (int*)(ws + WS_SLOTOF);
    float* BONUS = (float*)(ws + WS_BONUS);
    bf16* XB = (bf16*)(ws + WS_XB); bf16* WINT = (bf16*)(ws + WS_WINT); bf16* WOUTT = (bf16*)(ws + WS_WOUTT); bf16* LORAT = (bf16*)(ws + WS_LORAT); bf16* WPOOLT = (bf16*)(ws + WS_WPOOLT);
    float* PROJ = (float*)(ws + WS_PROJ); bf16* LIN = (bf16*)(ws + WS_LIN); bf16* POOLED = (bf16*)(ws + WS_POOLED);
    float* WDEC = (float*)(ws + WS_WDEC); float* LOUT = (float*)(ws + WS_LOUT); float* Rr = (float*)(ws + WS_R); float* K2 = (float*)(ws + WS_K2);
    float* Vv = (float*)(ws + WS_V); float* KK = (float*)(ws + WS_KK); float* BB = (float*)(ws + WS_BB); float* Yy = (float*)(ws + WS_Y);
    bf16* MIXIN = (bf16*)(ws + WS_MIXIN); float* MIX = (float*)(ws + WS_MIX); float* H = (float*)(ws + WS_H); unsigned char* HQ = (unsigned char*)(ws + WS_HB);
    unsigned char* XS = ws + WS_XS; unsigned char* W1T = ws + WS_W1T; unsigned char* W2T = ws + WS_W2T; unsigned char* ACT = ws + WS_ACT; bf16* YS = (bf16*)(ws + WS_YS);

    for (int u = tid; u < (LDS_BYTES - LDSCTL_OFF) / 4; u += NTHR) ((LAS unsigned*)(lds + LDSCTL_OFF))[u] = 0u;
    __syncthreads();
    XcdBarrier bar; bar.bar = (unsigned*)(ctl + CW_BAR); bar.x = 0; bar.st = nullptr;
    if (MK_N_LAUNCHES == 1) bar = xcd_barrier_post((unsigned*)(ctl + CW_BAR), MISC + 8);
    const int lo = args.ph_lo, hi = args.ph_hi;
#ifndef PHASE_MASK
#define PHASE_MASK 0xFFFF
#endif
#define IN(k) (((PHASE_MASK >> (k)) & 1) && lo <= (k) && (k) < hi)
#define SEAM(k) do { if (IN(k) && IN((k) + 1)) xcd_barrier(bar); } while (0)

    if (IN(0)) {
        LAS float* scr = (LAS float*)(lds + wave * 16640);
        for (size_t i = (size_t)gw * 64 + lane; i < (size_t)M * D / 8; i += (size_t)NGW * 64) {
            const f32x4 a = *(const GAS f32x4*)(x + i * 8), b = *(const GAS f32x4*)(x + i * 8 + 4);
            v4u o; o.x = pk2(a.x, a.y); o.y = pk2(a.z, a.w); o.z = pk2(b.x, b.y); o.w = pk2(b.z, b.w);
            *(GAS v4u*)(XB + i * 8) = o;
        }
        constexpr int I_IN = (D / 64) * (IN_COLS / 64)  , I_OUT = (D / 64) * (D / 64);
        for (int it = gw; it < I_IN + I_OUT; it += NGW) {
            if (it < I_IN) transpose_item(w_in, D, IN_COLS, WINT, 0, scr, it, lane);
            else transpose_item(w_out, D, D, WOUTT, 0, scr, it - I_IN, lane);
        }
        for (int i = gw * 64 + lane; i < 32 * D; i += NGW * 64) { const int nn = 4352 + (i >> 11), k = i & 2047; WINT[(size_t)nn * D + k] = (bf16)f2bf(w_in[(size_t)k * IN_COLS + nn]); }
        for (size_t i = (size_t)gw * 64 + lane; i < (size_t)(IN_PAD - IN_COLS) * D / 8; i += (size_t)NGW * 64) *(GAS v4u*)(WINT + (size_t)IN_COLS * D + i * 8) = (v4u){0u, 0u, 0u, 0u};
        for (int i = gw * 64 + lane; i < 3072 * LK; i += NGW * 64) {
            const int n = i / LK, k = i % LK; float v = 0.f;
            if (n < 1024) { if (k < 64) v = w2d[k * 1024 + n]; }
            else if (n < 2048) { if (k >= 64 && k < 128) v = a2[(k - 64) * 1024 + (n - 1024)]; }
            else { if (k >= 128 && k < 288) v = g2[(k - 128) * 1024 + (n - 2048)]; }
            LORAT[i] = (bf16)f2bf(v);
        }
        for (int i = gw * 64 + lane; i < 1024 * 256; i += NGW * 64) {
            const int n = i >> 8, c = i & 255, g = n >> 8, d = n & 255;
            WPOOLT[i] = (bf16)f2bf(w_pool[((size_t)g * 256 + c) * 256 + d]);
        }
    }
    SEAM(0);

    if (IN(1)) {
        pg8::Gemm g{XB, WINT, D, D}; pg8::GridOrder S; S.init(M / 256, IN_PAD / 256, G, bx, (size_t)256 * D * 2, 0, (size_t)256 * D * 2);
        pg8::EpiF32 E{PROJ, IN_PAD};
        pg8::gemm_phase<pg8::EpiF32, pg8::GridOrder, true, true>(lds, g, S, E);
    }
    SEAM(1);

    if (IN(2)) {
        for (int m = gw; m < M; m += NGW) {
            const int t = m % SEQ;
            const float* pr = PROJ + (size_t)m * IN_PAD; const float* pp = pr - IN_PAD;
#pragma unroll
            for (int q = 0; q < 6; ++q) {
                const int i = lane + 64 * q; float v = 0.f;
                if (i < 288) { const int c = 3072 + i; const float cur = pr[c], prev = t > 0 ? pp[c] : 0.f; const float s = cur + (prev - cur) * mu[c];
                    v = i < 64 ? tanhf(s) : (i < 128 ? s : 1.0f / (1.0f + __expf(-s))); }
                LIN[(size_t)m * LK + i] = (bf16)f2bf(v);
            }
#pragma unroll
            for (int q = 0; q < 4; ++q) {
                const int c = 4 * lane + 256 * q, win = 2 << q; const int n = (t + 1) < win ? (t + 1) : win;
                const f32x4 cur = *(const GAS f32x4*)(pr + SHIFT_W + c); f32x4 sum = cur;
                for (int s = 1; s < n; ++s) sum += *(const GAS f32x4*)(pr - (size_t)s * IN_PAD + SHIFT_W + c);
                const float inv = 1.0f / (float)n; const f32x4 pv = sum * inv - cur;
                v2u o; o.x = pk2(pv.x, pv.y); o.y = pk2(pv.z, pv.w);
                *(GAS v2u*)(POOLED + (size_t)m * 1024 + c) = o;
            }
        }
    }
    SEAM(2);

    if (IN(3)) {
#ifndef NO_LORA
        { pg8::Gemm g{LIN, LORAT, LK, LK}; pg8::GridOrder S; S.init(M / 256, 12, G, bx, (size_t)256 * LK * 2, 0, (size_t)256 * LK * 2);
          pg8::EpiF32 E{LOUT, 3072};
          pg8::gemm_phase<pg8::EpiF32, pg8::GridOrder, true, true>(lds, g, S, E); }
#endif
#ifndef NO_POOL
        { pg8::Gemm g{POOLED, WPOOLT, 1024, 256}; pg8::GridOrder S; S.init(M / 256, 4, G, bx, (size_t)256 * 1024 * 2, (size_t)256 * 2, (size_t)256 * 256 * 2);
          pg8::EpiPool E{MIXIN, pool_scale};
          pg8::gemm_phase<pg8::EpiPool, pg8::GridOrder, true, true>(lds, g, S, E); }
#endif
    }
    SEAM(3);

    if (IN(4)) {
        for (int m = gw; m < M; m += NGW) {
            const int t = m % SEQ;
            const float* pr = PROJ + (size_t)m * IN_PAD; const float* pp = pr - IN_PAD;
#pragma unroll
            for (int q = 0; q < 4; ++q) {
                const int c = 4 * lane + 256 * q; const size_t o = (size_t)m * 1024 + c;
                f32x4 r = *(const GAS f32x4*)(pr + c), k = *(const GAS f32x4*)(pr + 1024 + c), v = *(const GAS f32x4*)(pr + 2048 + c);
                f32x4 rp = (f32x4){0.f, 0.f, 0.f, 0.f}, kp = rp, vp = rp;
                if (t > 0) { rp = *(const GAS f32x4*)(pp + c); kp = *(const GAS f32x4*)(pp + 1024 + c); vp = *(const GAS f32x4*)(pp + 2048 + c); }
                r = r + (rp - r) * *(const GAS f32x4*)(mu + c); k = k + (kp - k) * *(const GAS f32x4*)(mu + 1024 + c); v = v + (vp - v) * *(const GAS f32x4*)(mu + 2048 + c);
                const f32x4 wl = *(const GAS f32x4*)(LOUT + (size_t)m * 3072 + c) + *(const GAS f32x4*)(w0 + c);
                const f32x4 al = *(const GAS f32x4*)(LOUT + (size_t)m * 3072 + 1024 + c) + *(const GAS f32x4*)(a0 + c);
                f32x4 a, dec;
#pragma unroll
                for (int j = 0; j < 4; ++j) { const float z = -wl[j]; const float sp = fmaxf(z, 0.f) + __logf(1.0f + __expf(-fabsf(z))); dec[j] = __expf(-__expf(-sp - 0.5f)); a[j] = 1.0f / (1.0f + __expf(-al[j])); }
                *(GAS f32x4*)(WDEC + o) = dec;
                f32x4 kk = k * *(const GAS f32x4*)(k_k + c);
                const float ss = row16_sum(kk.x * kk.x + kk.y * kk.y + kk.z * kk.z + kk.w * kk.w);
                kk = kk * __builtin_amdgcn_rsqf(fmaxf(ss, 1e-24f));
                const f32x4 k2 = k * (1.0f + (a - 1.0f) * *(const GAS f32x4*)(k_a + c));
                const f32x4 rk = *(const GAS f32x4*)(r_k + c);
                const float bon = row16_sum(r.x * k2.x * rk.x + r.y * k2.y * rk.y + r.z * k2.z * rk.z + r.w * k2.w * rk.w);
                *(GAS f32x4*)(Rr + o) = r; *(GAS f32x4*)(K2 + o) = k2; *(GAS f32x4*)(Vv + o) = v; *(GAS f32x4*)(KK + o) = kk; *(GAS f32x4*)(BB + o) = kk * a;
                if ((lane & 15) == 0) BONUS[m * 16 + (c >> 6)] = bon;
            }
        }
    }
    SEAM(4);

    if (IN(5)) {
        const int xcd_i = bx % 8, slot_i = bx / 8;
        if (slot_i < 16) for (int srep_ = 0; srep_ < P5_SCAN_REPS; ++srep_) {
            const int sid = xcd_i * 16 + slot_i, hd = sid >> 1, half = sid & 1, b = hd >> 4, h = hd & 15;
            LAS float* OPS = (LAS float*)lds;
            LAS float* VVs = (LAS float*)(lds + 81920);
            LAS float* YBs = (LAS float*)(lds + 81920 + 8192);
            const int r4 = lane >> 4, jq = lane & 15;
            const int tl = tid >> 4, j4 = (tid & 15) * 4;
            const int vt = tid >> 3, vi4 = (tid & 7) * 4;
            const size_t gbase = ((size_t)b * SEQ) * 1024 + h * 64;
            const float* arr[5] = {KK, WDEC, BB, K2, Rr};
            f32x4 st[5]; f32x4 sv = (f32x4){0.f, 0.f, 0.f, 0.f};
#pragma unroll
            for (int a = 0; a < 5; ++a) st[a] = *(const GAS f32x4*)(arr[a] + gbase + (size_t)tl * 1024 + j4);
            if (tid < 256) sv = *(const GAS f32x4*)(Vv + gbase + (size_t)vt * 1024 + half * 32 + vi4);
#pragma unroll
            for (int a = 0; a < 5; ++a) *(LAS f32x4*)(OPS + (a * 32 + tl) * 64 + j4) = st[a];
            if (tid < 256) *(LAS f32x4*)(VVs + vt * 32 + vi4) = sv;
            __syncthreads();
            float S0 = 0.f, S1 = 0.f, S2 = 0.f, S3 = 0.f;
            for (int c = 0; c < SEQ / 32; ++c) {
                const int buf = c & 1;
                if (c + 1 < SEQ / 32) {
                    const size_t gb = gbase + (size_t)(c + 1) * 32 * 1024;
#pragma unroll
                    for (int a = 0; a < 5; ++a) st[a] = *(const GAS f32x4*)(arr[a] + gb + (size_t)tl * 1024 + j4);
                    if (tid < 256) sv = *(const GAS f32x4*)(Vv + gb + (size_t)vt * 1024 + half * 32 + vi4);
                }
                const LAS float* ob = OPS + buf * (5 * 32 * 64) + 4 * jq;
                const LAS float* vb = VVs + buf * 1024 + 4 * wave + r4;
                LAS float* yb = YBs + buf * 1024 + 4 * wave + r4;
                f32x4 a4 = *(const LAS f32x4*)(ob + (0 * 32) * 64), w4 = *(const LAS f32x4*)(ob + (1 * 32) * 64), b4 = *(const LAS f32x4*)(ob + (2 * 32) * 64),
                      k4 = *(const LAS f32x4*)(ob + (3 * 32) * 64), q4 = *(const LAS f32x4*)(ob + (4 * 32) * 64);
                float v = vb[0];
#pragma unroll 8
                for (int t = 0; t < 32; ++t) {
                    const int tn = (t + 1) & 31;
                    const f32x4 a4n = *(const LAS f32x4*)(ob + (0 * 32 + tn) * 64), w4n = *(const LAS f32x4*)(ob + (1 * 32 + tn) * 64), b4n = *(const LAS f32x4*)(ob + (2 * 32 + tn) * 64),
                                k4n = *(const LAS f32x4*)(ob + (3 * 32 + tn) * 64), q4n = *(const LAS f32x4*)(ob + (4 * 32 + tn) * 64);
                    const float vn = vb[tn * 32];
                    float p = S0 * a4.x; p += S1 * a4.y; p += S2 * a4.z; p += S3 * a4.w;
                    const float sa = -row16_sum(p);
                    S0 = S0 * w4.x + (sa * b4.x + v * k4.x); S1 = S1 * w4.y + (sa * b4.y + v * k4.y); S2 = S2 * w4.z + (sa * b4.z + v * k4.z); S3 = S3 * w4.w + (sa * b4.w + v * k4.w);
                    float y = S0 * q4.x; y += S1 * q4.y; y += S2 * q4.z; y += S3 * q4.w;
                    y = row16_sum(y);
                    yb[t * 32] = y;
                    a4 = a4n; w4 = w4n; b4 = b4n; k4 = k4n; q4 = q4n; v = vn;
                }
                if (c + 1 < SEQ / 32) {
                    const int nb = buf ^ 1;
#pragma unroll
                    for (int a = 0; a < 5; ++a) *(LAS f32x4*)(OPS + nb * (5 * 32 * 64) + (a * 32 + tl) * 64 + j4) = st[a];
                    if (tid < 256) *(LAS f32x4*)(VVs + nb * 1024 + vt * 32 + vi4) = sv;
                }
                __syncthreads();
                if (tid < 256) *(GAS f32x4*)(Yy + gbase + (size_t)(c * 32 + vt) * 1024 + half * 32 + vi4) = *(const LAS f32x4*)(YBs + buf * 1024 + vt * 32 + vi4);
            }
        } else for (int crep_ = 0; crep_ < P5_CONV_REPS; ++crep_) {
            LAS float* scr = (LAS float*)(lds + wave * 16640);
            const int cw = (xcd_i * 16 + slot_i - 16) * NWAVES + wave;
            constexpr int I1 = (D / 64) * (4096 / 64), I2 = (DFF / 64) * (D / 64), IPE = I1 + I2;
            auto src_of = [&](int it, const float*& Wp, int& N, int& li) { const int e = it / IPE, r = it % IPE; if (r < I1) { Wp = w1 + (size_t)e * D * 4096; N = 4096; li = r; } else { Wp = w2 + (size_t)e * DFF * D; N = D; li = r - I1; } };
            f32x4 va[16], vb2[16];
            int it = cw; const float* Wp; int N, li;
            constexpr int TOT = NE * IPE, STRIDE = 128 * NWAVES;
#define CONV_STEP(cur, nxtbuf) { const int itn = it + STRIDE; const float* Wn; int Nn, lin; \
                src_of(itn < TOT ? itn : it, Wn, Nn, lin); tr_load(Wn, Nn, lin, lane, nxtbuf);     \
                { const int e = it / IPE, r = it % IPE; \
                  if (r < I1) tr_store_fp8(cur, D, 4096, W1T, (size_t)e * 4096, scr, li, lane, pg8::W_SCALE); else tr_store_fp8(cur, DFF, D, W2T, (size_t)e * 2048, scr, li, lane, pg8::W_SCALE); } \
                it = itn; li = lin; }
            if (it < TOT) { src_of(it, Wp, N, li); tr_load(Wp, N, li, lane, va);
                for (;;) { CONV_STEP(va, vb2); if (it >= TOT) break; CONV_STEP(vb2, va); if (it >= TOT) break; } }
#undef CONV_STEP
        }
    }
    SEAM(5);

    if (IN(6)) {
        for (int m = gw; m < M; m += NGW) {
#pragma unroll
            for (int q = 0; q < 4; ++q) {
                const int c = 4 * lane + 256 * q; const size_t o = (size_t)m * 1024 + c;
                const f32x4 y = *(const GAS f32x4*)(Yy + o);
                const float mean = row16_sum(y.x + y.y + y.z + y.w) * (1.0f / 64.0f);
                const f32x4 d = y - mean;
                const float var = row16_sum(d.x * d.x + d.y * d.y + d.z * d.z + d.w * d.w) * (1.0f / 64.0f);
                const float rstd = __builtin_amdgcn_rsqf(var + GN_EPS);
                f32x4 yn = d * rstd * *(const GAS f32x4*)(lnx_w + c) + *(const GAS f32x4*)(lnx_b + c);
                yn = yn + BONUS[m * 16 + (c >> 6)] * *(const GAS f32x4*)(Vv + o);
                yn = yn * *(const GAS f32x4*)(LOUT + (size_t)m * 3072 + 2048 + c);
                v2u ov; ov.x = pk2(yn.x, yn.y); ov.y = pk2(yn.z, yn.w);
                *(GAS v2u*)(MIXIN + (size_t)m * 2048 + c) = ov;
            }
        }
    }
    SEAM(6);

    if (IN(7)) {
        pg8::Gemm g{MIXIN, WOUTT, D, D}; pg8::GridOrder S; S.init(M / 256, D / 256, G, bx, (size_t)256 * D * 2, 0, (size_t)256 * D * 2);
        pg8::EpiF32 E{MIX, D};
        pg8::gemm_phase<pg8::EpiF32, pg8::GridOrder, true, true>(lds, g, S, E);
    }
    SEAM(7);

    if (IN(8)) {
        LAS float* s_h = (LAS float*)lds;
        LAS float* s_part = (LAS float*)(lds + 65536);
        const int e = tid & 31, part = tid >> 5;
        float wreg[128];
#pragma unroll
        for (int i = 0; i < 128; ++i) wreg[i] = router_w[(size_t)(part * 128 + i) * 32 + e];
        LAS int* lcnt = (LAS int*)(lds + LDSCTL_OFF + 512);
        if (tid < NE) lcnt[tid] = 0;
        __syncthreads();
        for (int m0 = vcu * 8; m0 < M; m0 += G * 8) {
            const int m = m0 + wave;
            {
                f32x4 v[8]; float s = 0.f;
#pragma unroll
                for (int q = 0; q < 8; ++q) { const int c = 4 * lane + 256 * q; v[q] = ALPHA * *(const GAS f32x4*)(x + (size_t)m * D + c) + *(const GAS f32x4*)(MIX + (size_t)m * D + c); s += (v[q].x + v[q].y) + (v[q].z + v[q].w); }
                const float mean = wave_sum(s) * (1.0f / D); float s2 = 0.f;
#pragma unroll
                for (int q = 0; q < 8; ++q) { v[q] = v[q] - mean; s2 += (v[q].x * v[q].x + v[q].y * v[q].y) + (v[q].z * v[q].z + v[q].w * v[q].w); }
                const float rstd = 1.0f / sqrtf(wave_sum(s2) * (1.0f / D) + LN_EPS);
#pragma unroll
                for (int q = 0; q < 8; ++q) { const int c = 4 * lane + 256 * q;
                    const f32x4 hv = v[q] * rstd * *(const GAS f32x4*)(ln1_w + c) + *(const GAS f32x4*)(ln1_b + c);
                    *(GAS f32x4*)(H + (size_t)m * D + c) = hv; *(LAS f32x4*)(s_h + wave * 2048 + c) = hv;
                    *(GAS unsigned*)(HQ + (size_t)m * D + c) = pg8::pk4_fp8(hv.x * pg8::XS_SCALE, hv.y * pg8::XS_SCALE, hv.z * pg8::XS_SCALE, hv.w * pg8::XS_SCALE); }
            }
            __syncthreads();
#pragma unroll 1
            for (int tk = 0; tk < 8; ++tk) {
                const LAS float* hp = s_h + tk * 2048 + part * 128; float acc = 0.f;
#pragma unroll
                for (int i = 0; i < 32; ++i) { const f32x4 hv = *(const LAS f32x4*)(hp + 4 * i); acc += hv.x * wreg[4 * i]; acc += hv.y * wreg[4 * i + 1]; acc += hv.z * wreg[4 * i + 2]; acc += hv.w * wreg[4 * i + 3]; }
                s_part[(tk * 16 + part) * 32 + e] = acc;
            }
            __syncthreads();
            {
                float lg = -3.0e38f;
                if (lane < 32) { lg = router_b[lane];
#pragma unroll
                    for (int p = 0; p < 16; ++p) lg += s_part[(wave * 16 + p) * 32 + lane]; }
                int idx[4]; float val[4];
#pragma unroll
                for (int k = 0; k < 4; ++k) {
                    float best = lg; int bi = lane;
#pragma unroll
                    for (int o = 1; o < 64; o <<= 1) { const float ob = __shfl_xor(best, o); const int oi = __shfl_xor(bi, o); const bool take = (ob > best) || (ob == best && oi < bi); best = take ? ob : best; bi = take ? oi : bi; }
                    idx[k] = bi; val[k] = best; if (lane == bi) lg = -3.0e38f;
                }
                if (lane == 0) {
                    float ex[4], se = 0.f;
#pragma unroll
                    for (int k = 0; k < 4; ++k) { ex[k] = __expf(val[k] - val[0]); se += ex[k]; }
                    const float inv = 1.0f / se;
#pragma unroll
                    for (int k = 0; k < 4; ++k) { TOPI[m * 4 + k] = idx[k]; GATE[m * 4 + k] = ex[k] * inv; POS[m * 4 + k] = __hip_atomic_fetch_add(lcnt + idx[k], 1, __ATOMIC_RELAXED, __HIP_MEMORY_SCOPE_WORKGROUP); }
                }
            }
            __syncthreads();
        }
        if (tid < NE) CNTWG[vcu * NE + tid] = lcnt[tid];
    }
    SEAM(8);

    if (IN(9) || IN(10) || IN(11)) {
        LAS int* s_t = (LAS int*)lds; LAS int* s_p = s_t + 512;
        LAS int* PSB = (LAS int*)(lds + LDSCTL_OFF + 640);
        { const int e = tid & 31, part = tid >> 5; int tsum = 0, psum = 0;
          for (int w = part * 16; w < part * 16 + 16; ++w) { const int cv = CNTWG[w * NE + e]; tsum += cv; psum += (w < vcu) ? cv : 0; }
          s_t[part * 32 + e] = tsum; s_p[part * 32 + e] = psum; }
        __syncthreads();
        if (tid < NE) { int tsum = 0, psum = 0; for (int p = 0; p < 16; ++p) { tsum += s_t[p * 32 + tid]; psum += s_p[p * 32 + tid]; } s_t[tid] = tsum; PSB[tid] = psum; }
        __syncthreads();
        if (tid == 0) { int acc = 0; for (int e = 0; e < NE; ++e) { PS[e] = acc; acc += (s_t[e] + 255) / 256 * 256; } PS[NE] = acc; }
        __syncthreads();
        if (tid < NE) PSB[tid] += PS[tid];
        __syncthreads();
    }
    if (IN(9)) {
        const LAS int* PSB = (const LAS int*)(lds + LDSCTL_OFF + 640);
        for (int m0 = vcu * 8; m0 < M; m0 += G * 8) {
            const int m = m0 + wave;
            const GAS v4u* src = (const GAS v4u*)(HQ + (size_t)m * D);
            v4u rv[2];
#pragma unroll
            for (int q = 0; q < 2; ++q) rv[q] = src[lane + 64 * q];
#pragma unroll
            for (int k = 0; k < 4; ++k) {
                const int a = m * 4 + k, slot = PSB[TOPI[a]] + POS[a];
                if (lane == 0) { slot_tok[slot] = m; SLOT_OF[a] = slot; }
                GAS v4u* dst = (GAS v4u*)(XS + (size_t)slot * D);
#pragma unroll
                for (int q = 0; q < 2; ++q) dst[lane + 64 * q] = rv[q];
            }
        }
    }
    SEAM(9);

    if (IN(10)) {
        pg8::Gemm g{(const bf16*)XS, (const bf16*)W1T, D / 2, D / 2}; pg8::MoeOrder S; S.ps = PS; S.ntile = 16; S.npan = PS[NE] / 256; S.cprime = vcu; S.a_tstep = (size_t)256 * D; S.b_tstep = (size_t)256 * D;
        pg8::EpiSwiglu E{ACT, b1};
        pg8::gemm_phase<pg8::EpiSwiglu, pg8::MoeOrder, true, true, true>(lds, g, S, E);
    }
    SEAM(10);

    if (IN(11)) {
        pg8::Gemm g{(const bf16*)ACT, (const bf16*)W2T, DFF / 2, DFF / 2}; pg8::MoeOrder S; S.ps = PS; S.ntile = 8; S.npan = PS[NE] / 256; S.cprime = vcu; S.a_tstep = (size_t)256 * DFF; S.b_tstep = (size_t)256 * DFF;
        pg8::EpiBias16 E{YS, b2};
        pg8::gemm_phase<pg8::EpiBias16, pg8::MoeOrder, true, true, true>(lds, g, S, E);
    }
    SEAM(11);

    if (IN(12)) {
        for (int m = gw; m < M; m += NGW) {
            int sl[4]; float gt[4];
#pragma unroll
            for (int k = 0; k < 4; ++k) { sl[k] = SLOT_OF[m * 4 + k]; gt[k] = GATE[m * 4 + k]; }
            f32x4 v[8]; float s = 0.f;
#pragma unroll
            for (int q = 0; q < 8; ++q) { const int c = 4 * lane + 256 * q; f32x4 f = (f32x4){0.f, 0.f, 0.f, 0.f};
#pragma unroll
                for (int k = 0; k < 4; ++k) { const v2u yv = *(const GAS v2u*)(YS + (size_t)sl[k] * D + c); f += gt[k] * (f32x4){bflo(yv.x), bfhi(yv.x), bflo(yv.y), bfhi(yv.y)}; }
                v[q] = ALPHA * *(const GAS f32x4*)(H + (size_t)m * D + c) + f; s += (v[q].x + v[q].y) + (v[q].z + v[q].w); }
            const float mean = wave_sum(s) * (1.0f / D); float s2 = 0.f;
#pragma unroll
            for (int q = 0; q < 8; ++q) { v[q] = v[q] - mean; s2 += (v[q].x * v[q].x + v[q].y * v[q].y) + (v[q].z * v[q].z + v[q].w * v[q].w); }
            const float rstd = 1.0f / sqrtf(wave_sum(s2) * (1.0f / D) + LN_EPS);
#pragma unroll
            for (int q = 0; q < 8; ++q) { const int c = 4 * lane + 256 * q; *(GAS f32x4*)(out + (size_t)m * D + c) = v[q] * rstd * *(const GAS f32x4*)(ln2_w + c) + *(const GAS f32x4*)(ln2_b + c); }
        }
    }
#undef IN
#undef SEAM
}

extern "C" void kernel_launch(void* const* d_in, const int* in_sizes, int n_in, void* d_out, int out_size, void* d_ws, size_t ws_size, hipStream_t stream) {
    static int grid = 0;
    if (grid == 0) {
        if (n_in != 26 || out_size != M * D || ws_size < WS_END) { fprintf(stderr, "kernel_launch: unexpected problem (n_in %d, out %d, ws %zu < %zu)\n", n_in, out_size, ws_size, (size_t)WS_END); grid = -1; return; }
        int dev = 0, cus = 0, per_cu = 0;
        if (hipGetDevice(&dev) != hipSuccess || hipDeviceGetAttribute(&cus, hipDeviceAttributeMultiprocessorCount, dev) != hipSuccess) { grid = -1; return; }
        if (hipFuncSetAttribute((const void*)mk_fwd, hipFuncAttributeMaxDynamicSharedMemorySize, LDS_BYTES) != hipSuccess) { fprintf(stderr, "kernel_launch: hipFuncSetAttribute failed\n"); grid = -1; return; }
        if (hipOccupancyMaxActiveBlocksPerMultiprocessor(&per_cu, (const void*)mk_fwd, NTHR, LDS_BYTES) != hipSuccess || per_cu < 1) fprintf(stderr, "kernel_launch: occupancy query reports %d\n", per_cu);
        (void)hipGetLastError();
        if (cus != NWG) { fprintf(stderr, "kernel_launch: built for %d CUs, device has %d\n", NWG, cus); grid = -1; return; }
        grid = NWG;
    }
    if (grid < 0) return;
    (void)hipMemsetAsync((char*)d_ws + WS_CTL, 0, CTL_BYTES, stream);
    (void)hipMemsetAsync((char*)d_ws + WS_SLOTTOK, 0xFF, (size_t)NSLOT_MAX * 4, stream);
    Args a{};
    for (int i = 0; i < 26; ++i) a.in[i] = (const float*)d_in[i];
    a.out = (float*)d_out; a.ws = (unsigned char*)d_ws; a.dup = DUP_MASK;
    if (MK_N_LAUNCHES == 1) { a.ph_lo = 0; a.ph_hi = NPHASE; hipLaunchKernelGGL(mk_fwd, dim3(grid), dim3(NTHR), LDS_BYTES, stream, a); }
    else { for (int p = 0; p < NPHASE; ++p) for (int rep = 0; rep <= ((DUP_MASK >> p) & 1); ++rep) { a.ph_lo = p; a.ph_hi = p + 1; hipLaunchKernelGGL(mk_fwd, dim3(grid), dim3(NTHR), LDS_BYTES, stream, a); } }
}
```

```cpp
#include <hip/hip_runtime.h>
#include <stdint.h>
#include <stdio.h>

#ifndef P5_SCAN_REPS
#define P5_SCAN_REPS 1
#endif
#ifndef P5_CONV_REPS
#define P5_CONV_REPS 1
#endif
#ifndef DUP_MASK
#define DUP_MASK 0
#endif
#ifndef MK_N_LAUNCHES
#define MK_N_LAUNCHES 1
#endif

constexpr int D = 2048, BATCH = 4, SEQ = 4096, M = BATCH * SEQ;
constexpr int RW = 1024, PW = 1024, NH = 16;
constexpr int SHIFT_W = 3360, IN_COLS = 4384, IN_PAD = 4608;
constexpr int LK = 384;
constexpr int NE = 32, DFF = 2048;
constexpr int NASG = M * 4;
constexpr int NSLOT_MAX = NASG + NE * 256;
constexpr float LN_EPS = 1e-5f, GN_EPS = 64e-5f;
constexpr float ALPHA = 1.189207115002721f;
constexpr int NWG = 256, NWAVES = 8, NTHR = 512;
constexpr int NPHASE = 13;

#define GAS __attribute__((address_space(1)))
#define LAS __attribute__((address_space(3)))
typedef unsigned short bf16;
typedef unsigned v4u __attribute__((ext_vector_type(4)));
typedef unsigned v2u __attribute__((ext_vector_type(2)));
typedef float f32x4 __attribute__((ext_vector_type(4)));
typedef short bf16x8 __attribute__((ext_vector_type(8)));
typedef GAS unsigned gu32;
#define RLX_AGENT __ATOMIC_RELAXED, __HIP_MEMORY_SCOPE_AGENT
#define LDS_WAIT() asm volatile("s_waitcnt lgkmcnt(0)" ::: "memory")
#define VM_WAIT() asm volatile("s_waitcnt vmcnt(0)" ::: "memory")

__device__ __forceinline__ unsigned f2bf(float f) { unsigned u = __builtin_bit_cast(unsigned, f); return (u + 0x7fffu + ((u >> 16) & 1u)) >> 16; }
__device__ __forceinline__ unsigned pk2(float lo, float hi) { return f2bf(lo) | (f2bf(hi) << 16); }
__device__ __forceinline__ float bflo(unsigned w) { return __builtin_bit_cast(float, w << 16); }
__device__ __forceinline__ float bfhi(unsigned w) { return __builtin_bit_cast(float, w & 0xffff0000u); }
__device__ __forceinline__ float wave_sum(float v) {
#pragma unroll
    for (int o = 1; o < 64; o <<= 1) v += __shfl_xor(v, o);
    return v;
}
__device__ __forceinline__ float fast_sigmoid(float x) { return __builtin_amdgcn_rcpf(1.0f + __builtin_amdgcn_exp2f(-1.4426950408889634f * x)); }
__device__ __forceinline__ float fast_decay(float wl) { const float z = -wl; const float sp = fmaxf(z, 0.f) + 0.6931471805599453f * __builtin_amdgcn_logf(1.0f + __builtin_amdgcn_exp2f(-1.4426950408889634f * fabsf(z)));
    return __builtin_amdgcn_exp2f(-1.4426950408889634f * __builtin_amdgcn_exp2f(-1.4426950408889634f * (sp + 0.5f))); }
template <int CTRL> __device__ __forceinline__ float dpp_mov(float x) { return __builtin_bit_cast(float, __builtin_amdgcn_update_dpp(0, __builtin_bit_cast(int, x), CTRL, 0xF, 0xF, true)); }
__device__ __forceinline__ float row16_sum(float x) {
    x += dpp_mov<0xB1>(x);
    x += dpp_mov<0x4E>(x);
    x += dpp_mov<0x141>(x);
    x += dpp_mov<0x140>(x);
    return x;
}

namespace pg8 {
typedef unsigned short bf16_t;
typedef unsigned u32x4 __attribute__((ext_vector_type(4)));
typedef int v4i_t __attribute__((ext_vector_type(4)));
typedef int v8i_t __attribute__((ext_vector_type(8)));
constexpr int BM = 256, BK = 64, HALF = 128, HTB = HALF * BK * 2, STAGE_BYTES = 8 * HTB, NXCD = 8, WGM = 8;
__host__ __device__ __forceinline__ int lds_byte(int r, int c) { const int st = (r >> 4) * 2 + (c >> 5), rr = r & 15, cc = c & 31, ob = rr * 64 + cc * 2; return st * 1024 + (ob ^ (((ob >> 9) & 1) << 5)); }
__host__ __device__ __forceinline__ void stage_rc(int b, int& R, int& C) { const int st = b / 1024, sb = b % 1024, swz = sb ^ (((sb >> 9) & 1) << 5); R = (st >> 1) * 16 + swz / 64; C = (st & 1) * 32 + (swz % 64) / 2; }
__host__ __device__ __forceinline__ int perm32(int rho) { const int n = rho >> 4, i = rho & 15; return 8 * (i >> 2) + 4 * n + (i & 3); }
struct Unit { int pm, pn; };
struct Gemm { const bf16_t* A; const bf16_t* Bt; int lda, K; };
__device__ __forceinline__ unsigned cvt_pk_bf16(float lo, float hi) { unsigned r; asm volatile("v_cvt_pk_bf16_f32 %0, %1, %2" : "=v"(r) : "v"(lo), "v"(hi)); return r; }

struct GridOrder {
    int nM, nN, nwg, G, c; size_t a_tstep, a_pnstep, b_tstep;
    __device__ void init(int nM_, int nN_, int G_, int c_, size_t a_tstep_, size_t a_pnstep_, size_t b_tstep_) { nM = nM_; nN = nN_; nwg = nM * nN; G = G_; c = c_; a_tstep = a_tstep_; a_pnstep = a_pnstep_; b_tstep = b_tstep_; }
    __device__ bool next(int i, Unit& u) const {
        const long L = (long)i * G + c; if (L >= nwg) return false;
        int wgid = (int)L; { const int q = nwg / NXCD, r = nwg % NXCD, xcd = wgid % NXCD, off = wgid / NXCD; wgid = (xcd < r ? xcd * (q + 1) : r * (q + 1) + (xcd - r) * q) + off; }
        const int nig = WGM * nN, gid = wgid / nig, fm = gid * WGM, gsz = (nM - fm) < WGM ? (nM - fm) : WGM;
        u.pm = fm + ((wgid % nig) % gsz); u.pn = (wgid % nig) / gsz; return true;
    }
    __device__ __forceinline__ size_t aoff(const Unit& u) const { return (size_t)u.pm * a_tstep + (size_t)u.pn * a_pnstep; }
    __device__ __forceinline__ size_t boff(const Unit& u) const { return (size_t)u.pn * b_tstep; }
};
struct MoeOrder {
    const LAS int* ps; int ntile, npan, cprime; size_t a_tstep, b_tstep;
    __device__ bool next(int i, Unit& u) const {
        const int U = i * NWG + cprime; const int p = U / ntile; if (p >= npan) return false;
        const int row = p * 256; int e = 0;
#pragma unroll 1
        for (int q = 1; q < NE; ++q) e = (row >= ps[q]) ? q : e;
        u.pm = p; u.pn = e * ntile + (U % ntile); return true;
    }
    __device__ __forceinline__ size_t aoff(const Unit& u) const { return (size_t)u.pm * a_tstep; }
    __device__ __forceinline__ size_t boff(const Unit& u) const { return (size_t)u.pn * b_tstep; }
};

template <class Epi, class Sched, bool ALIGN_EPI, bool SP2, bool FP8 = false>
__device__ __forceinline__ void gemm_phase(LAS unsigned char* lds, const Gemm g, const Sched& S, const Epi& E) {
    int tid_ = threadIdx.x; asm volatile("" : "+v"(tid_));
    const int tid = tid_, wid = __builtin_amdgcn_readfirstlane(tid >> 6), lane = tid & 63, wr = wid >> 2, wc = wid & 3, fr = lane & 15, fq = lane >> 4;
    const int K = g.K, nt = K / BK;
    unsigned voffA[2], voffB[2];
#pragma unroll
    for (int i = 0; i < 2; ++i) { int R, C; stage_rc(tid * 16 + i * 8192, R, C); const int Rb = Epi::PERM ? ((R & ~31) + perm32(R & 31)) : R;
        voffA[i] = (unsigned)(R * g.lda + C) * 2u; voffB[i] = (unsigned)(Rb * K + C) * 2u; }
    const size_t kstep = (size_t)(BK * 2);
    const size_t hstepA = (size_t)HALF * g.lda * 2, hstepB = (size_t)HALF * K * 2;
    const unsigned ldsw = (unsigned)wid * 1024u;
    const int aoff = lds_byte(wr * 64 + fr, fq * 8), boff = lds_byte(wc * 32 + fr, fq * 8);
#define PG8_SA(b, h) (((b) * 2 + (h)) * HTB)
#define PG8_SB(b, h) ((4 + (b) * 2 + (h)) * HTB)
#define PG8_STAGE(bufoff, gbase, voff) do { _Pragma("unroll") for (int _i = 0; _i < 2; ++_i) \
        __builtin_amdgcn_global_load_lds((const unsigned*)((const char*)(gbase) + (voff)[_i]), (LAS unsigned*)(lds + (bufoff) + ldsw + _i * 8192), 16, 0, 0); } while (0)
#define PG8_LDA(dst, b, h) do { _Pragma("unroll") for (int m = 0; m < 4; ++m) { if constexpr (FP8) { const v4i_t l_ = *(const LAS v4i_t*)(lds + PG8_SA(b, h) + aoff + m * 2048), h_ = *(const LAS v4i_t*)(lds + PG8_SA(b, h) + aoff + m * 2048 + 1024); dst##8[m] = __builtin_shufflevector(l_, h_, 0, 1, 2, 3, 4, 5, 6, 7); } \
        else { _Pragma("unroll") for (int k = 0; k < 2; ++k) dst[m][k] = *(const LAS bf16x8*)(lds + PG8_SA(b, h) + aoff + m * 2048 + k * 1024); } } } while (0)
#define PG8_LDB(dst, b, h) do { _Pragma("unroll") for (int n = 0; n < 2; ++n) { if constexpr (FP8) { const v4i_t l_ = *(const LAS v4i_t*)(lds + PG8_SB(b, h) + boff + n * 2048), h_ = *(const LAS v4i_t*)(lds + PG8_SB(b, h) + boff + n * 2048 + 1024); dst##8[n] = __builtin_shufflevector(l_, h_, 0, 1, 2, 3, 4, 5, 6, 7); } \
        else { _Pragma("unroll") for (int k = 0; k < 2; ++k) dst[n][k] = *(const LAS bf16x8*)(lds + PG8_SB(b, h) + boff + n * 2048 + k * 1024); } } } while (0)
#define PG8_MMA(ai, bj, At, Bt) do { __builtin_amdgcn_s_setprio(1); _Pragma("unroll") for (int m = 0; m < 4; ++m) _Pragma("unroll") for (int n = 0; n < 2; ++n) { \
        if constexpr (FP8) asm volatile("v_mfma_scale_f32_16x16x128_f8f6f4 %0, %1, %2, %0, %3, %3 op_sel_hi:[0,0,0]" : "+v"(acc[ai][bj][m][n]) : "v"(Bt##8[n]), "v"(At##8[m]), "v"(scale1_)); \
        else { _Pragma("unroll") for (int k = 0; k < 2; ++k) acc[ai][bj][m][n] = __builtin_amdgcn_mfma_f32_16x16x32_bf16(Bt[n][k], At[m][k], acc[ai][bj][m][n], 0, 0, 0); } } \
        __builtin_amdgcn_s_setprio(0); } while (0)
#define PG8_WAIT_V(n) asm volatile("s_waitcnt vmcnt(" #n ")" ::: "memory")
#define PG8_WAIT_L(n) asm volatile("s_waitcnt lgkmcnt(" #n ")" ::: "memory")
#define PG8_BAR __builtin_amdgcn_s_barrier()
#define PG8_SCHED __builtin_amdgcn_sched_barrier(0)
    Unit cur, nxt; int ui = 0;
    if (!S.next(0, cur)) return;
    f32x4 acc[2][2][4][2];
#pragma unroll
    for (int a = 0; a < 2; ++a)
#pragma unroll
        for (int b = 0; b < 2; ++b)
#pragma unroll
            for (int m = 0; m < 4; ++m)
#pragma unroll
                for (int n = 0; n < 2; ++n) acc[a][b][m][n] = (f32x4){0.f, 0.f, 0.f, 0.f};
    int scale1_ = 0x7F7F7F7F; asm volatile("" : "+v"(scale1_));
    bf16x8 At[4][2], B0[2][2], B1[2][2];
    v8i_t At8[4], B08[2], B18[2];
    const char* cA = (const char*)g.A + S.aoff(cur); const char* cB = (const char*)g.Bt + S.boff(cur);
    if constexpr (SP2) {
        PG8_STAGE(PG8_SB(0, 0), cB, voffB); PG8_STAGE(PG8_SB(0, 1), cB + hstepB, voffB); PG8_STAGE(PG8_SA(0, 0), cA, voffA); PG8_STAGE(PG8_SA(0, 1), cA + hstepA, voffA);
        if (wr == 1) PG8_BAR;
        PG8_WAIT_V(2); PG8_BAR;
        PG8_STAGE(PG8_SB(1, 0), cB + kstep, voffB); PG8_STAGE(PG8_SA(1, 0), cA + kstep, voffA); PG8_STAGE(PG8_SB(1, 1), cB + hstepB + kstep, voffB);
        PG8_WAIT_V(6); PG8_BAR;
    } else {
        PG8_STAGE(PG8_SB(0, 0), cB, voffB); PG8_STAGE(PG8_SA(0, 0), cA, voffA); PG8_STAGE(PG8_SB(0, 1), cB + hstepB, voffB); PG8_STAGE(PG8_SA(0, 1), cA + hstepA, voffA);
        if (wr == 1) PG8_BAR;
        PG8_WAIT_V(4); PG8_BAR;
        PG8_STAGE(PG8_SB(1, 0), cB + kstep, voffB); PG8_STAGE(PG8_SA(1, 0), cA + kstep, voffA); PG8_STAGE(PG8_SB(1, 1), cB + hstepB + kstep, voffB);
        PG8_WAIT_V(6); PG8_BAR;
    }
    for (;;) {
        const bool has_next = S.next(ui + 1, nxt);
        const char* nA = has_next ? (const char*)g.A + S.aoff(nxt) : cA; const char* nB = has_next ? (const char*)g.Bt + S.boff(nxt) : cB;
#pragma unroll 1
        for (int t = 0; t < nt; t += 2) {
            const bool last = (t == nt - 2);
            const char* a1 = cA + (size_t)(t + 1) * kstep;
            const char* a2 = last ? nA : cA + (size_t)(t + 2) * kstep; const char* b2 = last ? nB : cB + (size_t)(t + 2) * kstep;
            const char* a3 = a2 + kstep; const char* b3 = b2 + kstep;
            if constexpr (SP2) {
            PG8_LDB(B0, 0, 0); PG8_LDB(B1, 0, 1); PG8_SCHED; PG8_LDA(At, 0, 0); PG8_STAGE(PG8_SA(1, 1), a1 + hstepA, voffA);
            PG8_WAIT_V(8); PG8_WAIT_L(0); PG8_BAR; PG8_MMA(0, 0, At, B0); PG8_MMA(0, 1, At, B1); PG8_BAR; PG8_SCHED;
            PG8_LDA(At, 0, 1); PG8_STAGE(PG8_SB(0, 0), b2, voffB); PG8_STAGE(PG8_SB(0, 1), b2 + hstepB, voffB); PG8_STAGE(PG8_SA(0, 0), a2, voffA);
            PG8_WAIT_V(8); PG8_WAIT_L(0); PG8_BAR; PG8_MMA(1, 0, At, B0); PG8_MMA(1, 1, At, B1); PG8_BAR; PG8_SCHED;
            PG8_LDB(B0, 1, 0); PG8_LDB(B1, 1, 1); PG8_SCHED; PG8_LDA(At, 1, 0); PG8_STAGE(PG8_SA(0, 1), a2 + hstepA, voffA);
            PG8_WAIT_V(8); PG8_WAIT_L(0); PG8_BAR; PG8_MMA(0, 0, At, B0); PG8_MMA(0, 1, At, B1); PG8_BAR; PG8_SCHED;
            PG8_LDA(At, 1, 1); PG8_STAGE(PG8_SB(1, 0), b3, voffB); PG8_STAGE(PG8_SB(1, 1), b3 + hstepB, voffB); PG8_STAGE(PG8_SA(1, 0), a3, voffA);
            PG8_WAIT_V(8); PG8_WAIT_L(0); PG8_BAR; PG8_MMA(1, 0, At, B0); PG8_MMA(1, 1, At, B1); PG8_BAR; PG8_SCHED;
            } else {
            PG8_LDB(B0, 0, 0); PG8_SCHED; PG8_LDA(At, 0, 0); PG8_STAGE(PG8_SA(1, 1), a1 + hstepA, voffA);
            PG8_WAIT_L(8); PG8_BAR; PG8_WAIT_L(0); PG8_MMA(0, 0, At, B0); PG8_BAR; PG8_SCHED;
            PG8_LDB(B1, 0, 1); PG8_STAGE(PG8_SB(0, 0), b2, voffB);
            PG8_BAR; PG8_WAIT_L(0); PG8_MMA(0, 1, At, B1); PG8_BAR;
            PG8_LDA(At, 0, 1); PG8_STAGE(PG8_SA(0, 0), a2, voffA);
            PG8_BAR; PG8_WAIT_L(0); PG8_MMA(1, 0, At, B0); PG8_BAR; PG8_SCHED;
            PG8_STAGE(PG8_SB(0, 1), b2 + hstepB, voffB);
            PG8_WAIT_V(6); PG8_BAR; PG8_MMA(1, 1, At, B1); PG8_BAR;
            PG8_LDB(B0, 1, 0); PG8_SCHED; PG8_LDA(At, 1, 0); PG8_STAGE(PG8_SA(0, 1), a2 + hstepA, voffA);
            PG8_WAIT_L(8); PG8_BAR; PG8_WAIT_L(0); PG8_MMA(0, 0, At, B0); PG8_BAR; PG8_SCHED;
            PG8_LDB(B1, 1, 1); PG8_STAGE(PG8_SB(1, 0), b3, voffB);
            PG8_BAR; PG8_WAIT_L(0); PG8_MMA(0, 1, At, B1); PG8_BAR;
            PG8_LDA(At, 1, 1); PG8_STAGE(PG8_SA(1, 0), a3, voffA);
            PG8_BAR; PG8_WAIT_L(0); PG8_MMA(1, 0, At, B0); PG8_BAR; PG8_SCHED;
            PG8_STAGE(PG8_SB(1, 1), b3 + hstepB, voffB);
            PG8_WAIT_V(6); PG8_BAR; PG8_MMA(1, 1, At, B1); PG8_BAR;
            }
        }
        if constexpr (ALIGN_EPI) { if (wr == 0) PG8_BAR; }
        if constexpr (FP8) asm volatile("s_nop 15\n\ts_nop 15" ::: "memory");
        E(acc, cur, wr, wc, fr, fq);
        if (!has_next) break;
#pragma unroll
        for (int a = 0; a < 2; ++a)
#pragma unroll
            for (int b = 0; b < 2; ++b)
#pragma unroll
                for (int m = 0; m < 4; ++m)
#pragma unroll
                    for (int n = 0; n < 2; ++n) acc[a][b][m][n] = (f32x4){0.f, 0.f, 0.f, 0.f};
        cur = nxt; cA = nA; cB = nB; ++ui;
        if constexpr (ALIGN_EPI) { if (wr == 1) PG8_BAR; }
    }
    PG8_WAIT_V(0);
    if constexpr (!ALIGN_EPI) { if (wr == 0) PG8_BAR; }
    PG8_BAR;
#undef PG8_SA
#undef PG8_SB
#undef PG8_STAGE
#undef PG8_LDA
#undef PG8_LDB
#undef PG8_MMA
#undef PG8_WAIT_V
#undef PG8_WAIT_L
#undef PG8_BAR
#undef PG8_SCHED
}

struct EpiF32 {
    static constexpr bool PERM = false;
    float* C; int ldc;
    __device__ __forceinline__ void operator()(const f32x4 (&acc)[2][2][4][2], const Unit& u, int wr, int wc, int fr, int fq) const {
        const int row0 = u.pm * BM + wr * 64 + fr, col0 = u.pn * BM + wc * 32 + 4 * fq;
#pragma unroll
        for (int ai = 0; ai < 2; ++ai)
#pragma unroll
            for (int m = 0; m < 4; ++m) { float* rowp = C + (size_t)(row0 + ai * HALF + m * 16) * ldc + col0;
#pragma unroll
                for (int bj = 0; bj < 2; ++bj)
#pragma unroll
                    for (int n = 0; n < 2; ++n) *(f32x4*)(rowp + bj * HALF + n * 16) = acc[ai][bj][m][n]; }
    }
};
struct EpiPool {
    static constexpr bool PERM = true;
    bf16_t* O; const float* scale;
    __device__ __forceinline__ void operator()(const f32x4 (&acc)[2][2][4][2], const Unit& u, int wr, int wc, int fr, int fq) const {
        const int row0 = u.pm * BM + wr * 64 + fr; int col0 = u.pn * BM + wc * 32 + 8 * fq;
        asm volatile("" : "+v"(col0));
        f32x4 sv[2][2];
#pragma unroll
        for (int bj = 0; bj < 2; ++bj)
#pragma unroll
            for (int n = 0; n < 2; ++n) sv[bj][n] = *(const f32x4*)(scale + col0 + bj * HALF + 4 * n);
#pragma unroll
        for (int ai = 0; ai < 2; ++ai)
#pragma unroll
            for (int m = 0; m < 4; ++m) { bf16_t* rowp = O + (size_t)(row0 + ai * HALF + m * 16) * 2048 + 1024 + col0;
#pragma unroll
                for (int bj = 0; bj < 2; ++bj) { const f32x4 v0 = acc[ai][bj][m][0] * sv[bj][0], v1 = acc[ai][bj][m][1] * sv[bj][1];
                    u32x4 w; w.x = cvt_pk_bf16(v0[0], v0[1]); w.y = cvt_pk_bf16(v0[2], v0[3]); w.z = cvt_pk_bf16(v1[0], v1[1]); w.w = cvt_pk_bf16(v1[2], v1[3]);
                    *(u32x4*)(rowp + bj * HALF) = w; } }
    }
};
constexpr float XS_SCALE = 8.0f, W_SCALE = 256.0f, ACT_SCALE = 8.0f, DESCALE = 1.0f / 2048.0f;
__device__ __forceinline__ unsigned pk4_fp8(float a, float b, float c, float d) {
    a = fminf(fmaxf(a, -448.f), 448.f); b = fminf(fmaxf(b, -448.f), 448.f); c = fminf(fmaxf(c, -448.f), 448.f); d = fminf(fmaxf(d, -448.f), 448.f);
    int w = 0; w = __builtin_amdgcn_cvt_pk_fp8_f32(a, b, w, false); w = __builtin_amdgcn_cvt_pk_fp8_f32(c, d, w, true); return (unsigned)w;
}
struct EpiSwiglu {
    static constexpr bool PERM = true;
    unsigned char* O; const float* b1;
    __device__ __forceinline__ void operator()(const f32x4 (&acc)[2][2][4][2], const Unit& u, int wr, int wc, int fr, int fq) const {
        const int e = u.pn >> 4, nt = u.pn & 15;
        const int row0 = u.pm * BM + wr * 64 + fr; int col0 = nt * BM + wc * 32 + 8 * fq;
        asm volatile("" : "+v"(col0));
        const float* bp = b1 + (size_t)e * 4096 + col0;
        f32x4 bv[2][2];
#pragma unroll
        for (int bj = 0; bj < 2; ++bj)
#pragma unroll
            for (int n = 0; n < 2; ++n) bv[bj][n] = *(const f32x4*)(bp + bj * HALF + 4 * n);
#pragma unroll
        for (int ai = 0; ai < 2; ++ai)
#pragma unroll
            for (int m = 0; m < 4; ++m) { unsigned char* rowp = O + (size_t)(row0 + ai * HALF + m * 16) * 2048 + (col0 >> 1);
#pragma unroll
                for (int bj = 0; bj < 2; ++bj) { const f32x4 v0 = acc[ai][bj][m][0] * DESCALE + bv[bj][0], v1 = acc[ai][bj][m][1] * DESCALE + bv[bj][1];
                    float a[4];
#pragma unroll
                    for (int p = 0; p < 4; ++p) { const float hg = p < 2 ? v0[2 * p] : v1[2 * p - 4], hl = p < 2 ? v0[2 * p + 1] : v1[2 * p - 3];
                        const float xg = fminf(hg, 7.0f), xl = fminf(fmaxf(hl, -7.0f), 7.0f);
                        a[p] = xg * __builtin_amdgcn_rcpf(1.0f + __expf(-1.702f * xg)) * (xl + 1.0f) * ACT_SCALE; }
                    *(unsigned*)(rowp + bj * (HALF / 2)) = pk4_fp8(a[0], a[1], a[2], a[3]); } }
    }
};
struct EpiBias16 {
    static constexpr bool PERM = true;
    bf16_t* O; const float* b2;
    __device__ __forceinline__ void operator()(const f32x4 (&acc)[2][2][4][2], const Unit& u, int wr, int wc, int fr, int fq) const {
        const int e = u.pn >> 3, nt = u.pn & 7;
        const int row0 = u.pm * BM + wr * 64 + fr; int col0 = nt * BM + wc * 32 + 8 * fq;
        asm volatile("" : "+v"(col0));
        const float* bp = b2 + (size_t)e * 2048 + col0;
        f32x4 bv[2][2];
#pragma unroll
        for (int bj = 0; bj < 2; ++bj)
#pragma unroll
            for (int n = 0; n < 2; ++n) bv[bj][n] = *(const f32x4*)(bp + bj * HALF + 4 * n);
#pragma unroll
        for (int ai = 0; ai < 2; ++ai)
#pragma unroll
            for (int m = 0; m < 4; ++m) { bf16_t* rowp = O + (size_t)(row0 + ai * HALF + m * 16) * 2048 + col0;
#pragma unroll
                for (int bj = 0; bj < 2; ++bj) { const f32x4 v0 = acc[ai][bj][m][0] * DESCALE + bv[bj][0], v1 = acc[ai][bj][m][1] * DESCALE + bv[bj][1];
                    u32x4 w; w.x = cvt_pk_bf16(v0[0], v0[1]); w.y = cvt_pk_bf16(v0[2], v0[3]); w.z = cvt_pk_bf16(v1[0], v1[1]); w.w = cvt_pk_bf16(v1[2], v1[3]);
                    *(u32x4*)(rowp + bj * HALF) = w; } }
    }
};
}

#define XB_TMO      128
#define XB_XCNT(j)  (256  + 64 * (j))
#define XB_XSUB(j)  (1280 + 64 * (j))
#define XB_XGEN(j)  (2304 + 64 * (j))
#define XB_TOP      3328
#define XB_TOPGEN   3392
#define XCD_BAR_WORDS 3456
#define XB_SPIN_CAP (1u << 22)
__device__ __forceinline__ unsigned xb_ld(unsigned* p)              { return __hip_atomic_load(p, __ATOMIC_RELAXED, __HIP_MEMORY_SCOPE_AGENT); }
__device__ __forceinline__ unsigned xb_add(unsigned* p, unsigned v) { return __hip_atomic_fetch_add(p, v, __ATOMIC_RELAXED, __HIP_MEMORY_SCOPE_AGENT); }
__device__ __forceinline__ unsigned xb_xcc_id() { return (unsigned)__builtin_amdgcn_s_getreg((3 << 11) | 20) & 0xFu; }
#define XB_SPIN(cond, bar) do { unsigned _sp = 0; while (cond) { __builtin_amdgcn_s_sleep(1); \
    if ((++_sp & 255u) == 0u) { if (xb_ld(&(bar)[XB_TMO])) break; if (_sp > XB_SPIN_CAP) { atomicAdd(&(bar)[XB_TMO], 1u); break; } } } } while (0)
struct XcdBarrier { unsigned* bar; unsigned x; volatile LAS unsigned* st; };
__device__ __forceinline__ XcdBarrier xcd_barrier_post(unsigned* bar, volatile LAS unsigned* st) {
    XcdBarrier b; b.bar = bar; b.x = xb_xcc_id(); b.st = st;
    if (threadIdx.x == 0) (void)xb_add(&bar[XB_XCNT(b.x)], 1u);
    return b;
}
__device__ __forceinline__ void xcd_barrier_complete(unsigned* bar, unsigned x, unsigned& nloc, unsigned& nx) {
    const unsigned G = gridDim.x * gridDim.y * gridDim.z;
    unsigned sum, cnt, mine, sp = 0u;
    for (;;) {
        sum = 0u; cnt = 0u; mine = 0u;
#pragma unroll
        for (unsigned j = 0; j < 16; ++j) { const unsigned c = xb_ld(&bar[XB_XCNT(j)]); sum += c; cnt += (c > 0u) ? 1u : 0u; mine = (j == x) ? c : mine; }
        if (sum == G) break;
        __builtin_amdgcn_s_sleep(1);
        if ((++sp & 255u) == 0u) { if (xb_ld(&bar[XB_TMO])) break; if (sp > XB_SPIN_CAP) { atomicAdd(&bar[XB_TMO], 1u); break; } }
    }
    nloc = mine > 0u ? mine : 1u; nx = cnt > 0u ? cnt : 1u;
}
__device__ __forceinline__ void xcd_barrier(const XcdBarrier& b) {
    asm volatile("s_waitcnt vmcnt(0)" ::: "memory");
    __syncthreads();
    if (threadIdx.x == 0) {
        unsigned* bar = b.bar;
        __builtin_amdgcn_s_waitcnt(0);
        unsigned nloc = b.st[0], nx = b.st[1];
        if (nloc == 0u) { xcd_barrier_complete(bar, b.x, nloc, nx); b.st[0] = nloc; b.st[1] = nx; }
        const unsigned old = xb_add(&bar[XB_XSUB(b.x)], 1u);
        const unsigned gen = old / nloc;
        if (old + 1u == (gen + 1u) * nloc) {
            __builtin_amdgcn_fence(__ATOMIC_RELEASE, "agent");
            asm volatile("s_waitcnt vmcnt(0)" ::: "memory");
            const unsigned og = xb_add(&bar[XB_TOP], 1u);
            const unsigned tg = og / nx;
            if (og + 1u == (tg + 1u) * nx) xb_add(&bar[XB_TOPGEN], 1u);
            else XB_SPIN(xb_ld(&bar[XB_TOPGEN]) == tg, bar);
            __builtin_amdgcn_fence(__ATOMIC_ACQUIRE, "agent");
            xb_add(&bar[XB_XGEN(b.x)], 1u);
            asm volatile("s_waitcnt vmcnt(0)" ::: "memory");
        } else {
            XB_SPIN(xb_ld(&bar[XB_XGEN(b.x)]) == gen, bar);
            __builtin_amdgcn_fence(__ATOMIC_ACQUIRE, "agent");
            asm volatile("s_waitcnt vmcnt(0)" ::: "memory");
        }
    }
    __syncthreads();
}

constexpr size_t al256(size_t x) { return (x + 255) & ~(size_t)255; }
constexpr size_t WS_CTL = 0, CTL_BYTES = 1u << 20;
constexpr int CW_BAR = 4096;
constexpr int CW_CNT = 16384;
constexpr size_t WS_SLOTTOK = WS_CTL + CTL_BYTES;
constexpr size_t WS_TOPI = WS_SLOTTOK + al256((size_t)NSLOT_MAX * 4);
constexpr size_t WS_GATE = WS_TOPI + (size_t)NASG * 4;
constexpr size_t WS_POS = WS_GATE + (size_t)NASG * 4;
constexpr size_t WS_SLOTOF = WS_POS + (size_t)NASG * 4;
constexpr size_t WS_BONUS = WS_SLOTOF + (size_t)NASG * 4;
constexpr size_t WS_XB = WS_BONUS + (size_t)M * 16 * 4;
constexpr size_t WS_WINT = WS_XB + (size_t)M * D * 2;
constexpr size_t WS_WOUTT = WS_WINT + (size_t)IN_PAD * D * 2;
constexpr size_t WS_LORAT = WS_WOUTT + (size_t)D * D * 2;
constexpr size_t WS_WPOOLT = WS_LORAT + (size_t)3072 * LK * 2;
constexpr size_t WS_PROJ = WS_WPOOLT + (size_t)1024 * 256 * 2;
constexpr size_t WS_LIN = WS_PROJ + (size_t)M * IN_PAD * 4;
constexpr size_t WS_POOLED = WS_LIN + (size_t)M * LK * 2;
constexpr size_t WS_WDEC = WS_POOLED + (size_t)M * 1024 * 2;
constexpr size_t SZ_F1K = (size_t)M * 1024 * 4;
constexpr size_t WS_LOUT = WS_WDEC + SZ_F1K  , WS_R = WS_LOUT + 3 * SZ_F1K, WS_K2 = WS_R + SZ_F1K, WS_V = WS_K2 + SZ_F1K, WS_KK = WS_V + SZ_F1K, WS_BB = WS_KK + SZ_F1K, WS_Y = WS_BB + SZ_F1K;
constexpr size_t WS_MIXIN = WS_Y + SZ_F1K;
constexpr size_t WS_MIX = WS_MIXIN + (size_t)M * D * 2;
constexpr size_t WS_H = WS_MIX + (size_t)M * D * 4;
constexpr size_t WS_HB = WS_H + (size_t)M * D * 4;
constexpr size_t WS_XS = WS_HB + (size_t)M * D;
constexpr size_t WS_W1T = WS_XS + (size_t)NSLOT_MAX * D;
constexpr size_t WS_W2T = WS_W1T + (size_t)NE * 4096 * D;
constexpr size_t WS_ACT = WS_W2T + (size_t)NE * 2048 * DFF;
constexpr size_t WS_YS = WS_ACT + (size_t)NSLOT_MAX * DFF;
constexpr size_t WS_END = WS_YS + (size_t)NSLOT_MAX * D * 2;

constexpr int RING_BYTES = 131072;
constexpr int LDSCTL_OFF = 159744;
constexpr int LDS_BYTES = 163840;

struct Args { const float* in[26]; float* out; unsigned char* ws; int ph_lo, ph_hi, dup, pad; };

__device__ __forceinline__ void tr_load(const float* W, int N, int item, int lane, f32x4 (&v)[16]) {
    const int nblk = N / 64, kb = item / nblk, nb = item % nblk, k0 = 64 * kb, n0 = 64 * nb;
    const int r = lane >> 4, c4 = (lane & 15) * 4;
#pragma unroll
    for (int i = 0; i < 16; ++i) v[i] = *(const GAS f32x4*)(W + (size_t)(k0 + 4 * i + r) * N + n0 + c4);
}
__device__ __forceinline__ void tr_store(const f32x4 (&v)[16], int K, int N, bf16* WT, size_t row_off, LAS float* scr, int item, int lane) {
    const int nblk = N / 64, kb = item / nblk, nb = item % nblk, k0 = 64 * kb, n0 = 64 * nb;
    const int r = lane >> 4, c4 = (lane & 15) * 4;
#pragma unroll
    for (int i = 0; i < 16; ++i) { LAS float* d = scr + (4 * i + r) * 65 + c4; d[0] = v[i].x; d[1] = v[i].y; d[2] = v[i].z; d[3] = v[i].w; }
    LDS_WAIT(); asm volatile("" ::: "memory");
    const int c = lane & 7;
#pragma unroll
    for (int p = 0; p < 8; ++p) { const int n = (lane >> 3) + 8 * p; const LAS float* q = scr + (8 * c) * 65 + n;
        v4u o; o.x = pk2(q[0 * 65], q[1 * 65]); o.y = pk2(q[2 * 65], q[3 * 65]); o.z = pk2(q[4 * 65], q[5 * 65]); o.w = pk2(q[6 * 65], q[7 * 65]);
        *(GAS v4u*)(WT + (row_off + n0 + n) * (size_t)K + k0 + 8 * c) = o; }
    LDS_WAIT(); asm volatile("" ::: "memory");
}
__device__ __forceinline__ void tr_store_fp8(const f32x4 (&v)[16], int K, int N, unsigned char* WT, size_t row_off, LAS float* scr, int item, int lane, float scale) {
    const int nblk = N / 64, kb = item / nblk, nb = item % nblk, k0 = 64 * kb, n0 = 64 * nb;
    const int r = lane >> 4, c4 = (lane & 15) * 4;
#pragma unroll
    for (int i = 0; i < 16; ++i) { LAS float* d = scr + (4 * i + r) * 65 + c4; d[0] = v[i].x * scale; d[1] = v[i].y * scale; d[2] = v[i].z * scale; d[3] = v[i].w * scale; }
    LDS_WAIT(); asm volatile("" ::: "memory");
    const int c = lane & 3;
#pragma unroll
    for (int p = 0; p < 4; ++p) { const int n = (lane >> 2) + 16 * p; const LAS float* q = scr + (16 * c) * 65 + n;
        v4u o; o.x = pg8::pk4_fp8(q[0 * 65], q[1 * 65], q[2 * 65], q[3 * 65]); o.y = pg8::pk4_fp8(q[4 * 65], q[5 * 65], q[6 * 65], q[7 * 65]);
        o.z = pg8::pk4_fp8(q[8 * 65], q[9 * 65], q[10 * 65], q[11 * 65]); o.w = pg8::pk4_fp8(q[12 * 65], q[13 * 65], q[14 * 65], q[15 * 65]);
        *(GAS v4u*)(WT + (row_off + n0 + n) * (size_t)K + k0 + 16 * c) = o; }
    LDS_WAIT(); asm volatile("" ::: "memory");
}
__device__ __forceinline__ void transpose_item(const float* W, int K, int N, bf16* WT, size_t row_off, LAS float* scr, int item, int lane) {
    f32x4 v[16]; tr_load(W, N, item, lane, v); tr_store(v, K, N, WT, row_off, scr, item, lane);
}

__global__ void __launch_bounds__(NTHR, 2) mk_fwd(Args args) {
    extern __shared__ __attribute__((aligned(16))) unsigned char lds_raw[];
    LAS unsigned char* lds = (LAS unsigned char*)lds_raw;
    volatile LAS unsigned* MISC = (volatile LAS unsigned*)(lds + LDSCTL_OFF);
    LAS int* PS = (LAS int*)(lds + LDSCTL_OFF + 256);
    const int tid = threadIdx.x, lane = tid & 63, wave = __builtin_amdgcn_readfirstlane(tid >> 6);
    const int G = gridDim.x, bx = blockIdx.x;
    const int vcu = (bx % 8) * (G / 8) + bx / 8;
    const int gw = vcu * NWAVES + wave, NGW = G * NWAVES;
    unsigned char* ws = args.ws;
    gu32* ctl = (gu32*)(ws + WS_CTL);
    const float* x = args.in[0]; const float* w_in = args.in[1]; const float* mu = args.in[2]; const float* w0 = args.in[3]; const float* w2d = args.in[4];
    const float* a0 = args.in[5]; const float* a2 = args.in[6]; const float* g2 = args.in[7]; const float* k_k = args.in[8]; const float* k_a = args.in[9];
    const float* r_k = args.in[10]; const float* lnx_w = args.in[11]; const float* lnx_b = args.in[12]; const float* w_pool = args.in[13]; const float* pool_scale = args.in[14];
    const float* w_out = args.in[15]; const float* ln1_w = args.in[16]; const float* ln1_b = args.in[17]; const float* router_w = args.in[18]; const float* router_b = args.in[19];
    const float* w1 = args.in[20]; const float* b1 = args.in[21]; const float* w2 = args.in[22]; const float* b2 = args.in[23]; const float* ln2_w = args.in[24]; const float* ln2_b = args.in[25];
    float* out = args.out;
    int* CNTWG = (int*)(ws + WS_CTL) + CW_CNT;
    int* slot_tok = (int*)(ws + WS_SLOTTOK); int* TOPI = (int*)(ws + WS_TOPI); float* GATE = (float*)(ws + WS_GATE); int* POS = (int*)(ws + WS_POS); int* SLOT_OF = (int*)(ws + WS_SLOTOF);
    float* BONUS = (float*)(ws + WS_BONUS);
    bf16* XB = (bf16*)(ws + WS_XB); bf16* WINT = (bf16*)(ws + WS_WINT); bf16* WOUTT = (bf16*)(ws + WS_WOUTT); bf16* LORAT = (bf16*)(ws + WS_LORAT); bf16* WPOOLT = (bf16*)(ws + WS_WPOOLT);
    float* PROJ = (float*)(ws + WS_PROJ); bf16* LIN = (bf16*)(ws + WS_LIN); bf16* POOLED = (bf16*)(ws + WS_POOLED);
    float* WDEC = (float*)(ws + WS_WDEC); float* LOUT = (float*)(ws + WS_LOUT); float* Rr = (float*)(ws + WS_R); float* K2 = (float*)(ws + WS_K2);
    float* Vv = (float*)(ws + WS_V); float* KK = (float*)(ws + WS_KK); float* BB = (float*)(ws + WS_BB); float* Yy = (float*)(ws + WS_Y);
    bf16* MIXIN = (bf16*)(ws + WS_MIXIN); float* MIX = (float*)(ws + WS_MIX); float* H = (float*)(ws + WS_H); unsigned char* HQ = (unsigned char*)(ws + WS_HB);
    unsigned char* XS = ws + WS_XS; unsigned char* W1T = ws + WS_W1T; unsigned char* W2T = ws + WS_W2T; unsigned char* ACT = ws + WS_ACT; bf16* YS = (bf16*)(ws + WS_YS);

    for (int u = tid; u < (LDS_BYTES - LDSCTL_OFF) / 4; u += NTHR) ((LAS unsigned*)(lds + LDSCTL_OFF))[u] = 0u;
    __syncthreads();
    XcdBarrier bar; bar.bar = (unsigned*)(ctl + CW_BAR); bar.x = 0; bar.st = nullptr;
    if (MK_N_LAUNCHES == 1) bar = xcd_barrier_post((unsigned*)(ctl + CW_BAR), MISC + 8);
    const int lo = args.ph_lo, hi = args.ph_hi;
#ifndef PHASE_MASK
#define PHASE_MASK 0xFFFF
#endif
#define IN(k) (((PHASE_MASK >> (k)) & 1) && lo <= (k) && (k) < hi)
#define SEAM(k) do { if (IN(k) && IN((k) + 1)) xcd_barrier(bar); } while (0)

    if (IN(0)) {
        LAS float* scr = (LAS float*)(lds + wave * 16640);
        for (size_t i = (size_t)gw * 64 + lane; i < (size_t)M * D / 8; i += (size_t)NGW * 64) {
            const f32x4 a = *(const GAS f32x4*)(x + i * 8), b = *(const GAS f32x4*)(x + i * 8 + 4);
            v4u o; o.x = pk2(a.x, a.y); o.y = pk2(a.z, a.w); o.z = pk2(b.x, b.y); o.w = pk2(b.z, b.w);
            *(GAS v4u*)(XB + i * 8) = o;
        }
        constexpr int I_IN = (D / 64) * (IN_COLS / 64)  , I_OUT = (D / 64) * (D / 64);
        for (int it = gw; it < I_IN + I_OUT; it += NGW) {
            if (it < I_IN) transpose_item(w_in, D, IN_COLS, WINT, 0, scr, it, lane);
            else transpose_item(w_out, D, D, WOUTT, 0, scr, it - I_IN, lane);
        }
        for (int i = gw * 64 + lane; i < 32 * D; i += NGW * 64) { const int nn = 4352 + (i >> 11), k = i & 2047; WINT[(size_t)nn * D + k] = (bf16)f2bf(w_in[(size_t)k * IN_COLS + nn]); }
        for (size_t i = (size_t)gw * 64 + lane; i < (size_t)(IN_PAD - IN_COLS) * D / 8; i += (size_t)NGW * 64) *(GAS v4u*)(WINT + (size_t)IN_COLS * D + i * 8) = (v4u){0u, 0u, 0u, 0u};
        for (int i = gw * 64 + lane; i < 3072 * LK; i += NGW * 64) {
            const int n = i / LK, k = i % LK; float v = 0.f;
            if (n < 1024) { if (k < 64) v = w2d[k * 1024 + n]; }
            else if (n < 2048) { if (k >= 64 && k < 128) v = a2[(k - 64) * 1024 + (n - 1024)]; }
            else { if (k >= 128 && k < 288) v = g2[(k - 128) * 1024 + (n - 2048)]; }
            LORAT[i] = (bf16)f2bf(v);
        }
        for (int i = gw * 64 + lane; i < 1024 * 256; i += NGW * 64) {
            const int n = i >> 8, c = i & 255, g = n >> 8, d = n & 255;
            WPOOLT[i] = (bf16)f2bf(w_pool[((size_t)g * 256 + c) * 256 + d]);
        }
    }
    SEAM(0);

    if (IN(1)) {
        pg8::Gemm g{XB, WINT, D, D}; pg8::GridOrder S; S.init(M / 256, IN_PAD / 256, G, bx, (size_t)256 * D * 2, 0, (size_t)256 * D * 2);
        pg8::EpiF32 E{PROJ, IN_PAD};
        pg8::gemm_phase<pg8::EpiF32, pg8::GridOrder, true, true>(lds, g, S, E);
    }
    SEAM(1);

    if (IN(2)) {
        for (int m = gw; m < M; m += NGW) {
            const int t = m % SEQ;
            const float* pr = PROJ + (size_t)m * IN_PAD; const float* pp = pr - IN_PAD;
#pragma unroll
            for (int q = 0; q < 6; ++q) {
                const int i = lane + 64 * q; float v = 0.f;
                if (i < 288) { const int c = 3072 + i; const float cur = pr[c], prev = t > 0 ? pp[c] : 0.f; const float s = cur + (prev - cur) * mu[c];
                    v = i < 64 ? tanhf(s) : (i < 128 ? s : 1.0f / (1.0f + __expf(-s))); }
                LIN[(size_t)m * LK + i] = (bf16)f2bf(v);
            }
#pragma unroll
            for (int q = 0; q < 4; ++q) {
                const int c = 4 * lane + 256 * q, win = 2 << q; const int n = (t + 1) < win ? (t + 1) : win;
                const f32x4 cur = *(const GAS f32x4*)(pr + SHIFT_W + c); f32x4 sum = cur;
                for (int s = 1; s < n; ++s) sum += *(const GAS f32x4*)(pr - (size_t)s * IN_PAD + SHIFT_W + c);
                const float inv = 1.0f / (float)n; const f32x4 pv = sum * inv - cur;
                v2u o; o.x = pk2(pv.x, pv.y); o.y = pk2(pv.z, pv.w);
                *(GAS v2u*)(POOLED + (size_t)m * 1024 + c) = o;
            }
        }
    }
    SEAM(2);

    if (IN(3)) {
#ifndef NO_LORA
        { pg8::Gemm g{LIN, LORAT, LK, LK}; pg8::GridOrder S; S.init(M / 256, 12, G, bx, (size_t)256 * LK * 2, 0, (size_t)256 * LK * 2);
          pg8::EpiF32 E{LOUT, 3072};
          pg8::gemm_phase<pg8::EpiF32, pg8::GridOrder, true, true>(lds, g, S, E); }
#endif
#ifndef NO_POOL
        { pg8::Gemm g{POOLED, WPOOLT, 1024, 256}; pg8::GridOrder S; S.init(M / 256, 4, G, bx, (size_t)256 * 1024 * 2, (size_t)256 * 2, (size_t)256 * 256 * 2);
          pg8::EpiPool E{MIXIN, pool_scale};
          pg8::gemm_phase<pg8::EpiPool, pg8::GridOrder, true, true>(lds, g, S, E); }
#endif
    }
    SEAM(3);

    SEAM(4);

    if (IN(5)) {
        constexpr int P5_OPS = 0, P5_VV = 81920, P5_YW = 90112, P5_SC = 98304;
        const int xcd_i = bx % 8, slot_i = bx / 8;
        if (slot_i < 16) for (int srep_ = 0; srep_ < P5_SCAN_REPS; ++srep_) {
            const int sid = xcd_i * 16 + slot_i, hd = sid >> 1, half = sid & 1, b = hd >> 4, h = hd & 15;
            LAS float* OPS = (LAS float*)(lds + P5_OPS); LAS float* VVs = (LAS float*)(lds + P5_VV); LAS float* YBs = (LAS float*)(lds + P5_YW);
            const int r4 = lane >> 4, jq = lane & 15;
            const int st = tid;
            const int stt = st >> 4, sj = h * 64 + (st & 15) * 4;
            const int vtt = st >> 3, vi = h * 64 + half * 32 + (st & 7) * 4;
            const f32x4 mu_r = *(const GAS f32x4*)(mu + sj), mu_k = *(const GAS f32x4*)(mu + 1024 + sj), mu_v = *(const GAS f32x4*)(mu + 2048 + vi);
            const f32x4 c_w0 = *(const GAS f32x4*)(w0 + sj), c_a0 = *(const GAS f32x4*)(a0 + sj), c_kk = *(const GAS f32x4*)(k_k + sj), c_ka = *(const GAS f32x4*)(k_a + sj);
            const size_t mbase = (size_t)b * SEQ;
            f32x4 g_r, g_k, g_rp, g_kp, g_wl, g_al, g_v, g_vp;
#define P5_LOAD(c_) do { { const int t_ = (c_) * 32 + stt; const float* pr_ = PROJ + (mbase + t_) * IN_PAD; const float* lo_ = LOUT + (mbase + t_) * 3072; \
                g_r = *(const GAS f32x4*)(pr_ + sj); g_k = *(const GAS f32x4*)(pr_ + 1024 + sj); g_wl = *(const GAS f32x4*)(lo_ + sj); g_al = *(const GAS f32x4*)(lo_ + 1024 + sj); \
                if (t_ > 0) { g_rp = *(const GAS f32x4*)(pr_ - IN_PAD + sj); g_kp = *(const GAS f32x4*)(pr_ - IN_PAD + 1024 + sj); } else { g_rp = (f32x4){0.f, 0.f, 0.f, 0.f}; g_kp = g_rp; } } \
            if (st < 256) { const int t_ = (c_) * 32 + vtt; const float* pr_ = PROJ + (mbase + t_) * IN_PAD; g_v = *(const GAS f32x4*)(pr_ + 2048 + vi); g_vp = t_ > 0 ? *(const GAS f32x4*)(pr_ - IN_PAD + 2048 + vi) : (f32x4){0.f, 0.f, 0.f, 0.f}; } } while (0)
#define P5_STORE(nb_) do { { const int tt_ = stt; \
                const f32x4 r_ = g_r + (g_rp - g_r) * mu_r, k_ = g_k + (g_kp - g_k) * mu_k; const f32x4 wl_ = g_wl + c_w0, al_ = g_al + c_a0; f32x4 a_, dec_; \
                _Pragma("unroll") for (int j_ = 0; j_ < 4; ++j_) { dec_[j_] = fast_decay(wl_[j_]); a_[j_] = fast_sigmoid(al_[j_]); } \
                f32x4 kk_ = k_ * c_kk; const float ss_ = row16_sum(kk_.x * kk_.x + kk_.y * kk_.y + kk_.z * kk_.z + kk_.w * kk_.w); kk_ = kk_ * __builtin_amdgcn_rsqf(fmaxf(ss_, 1e-24f)); \
                const f32x4 k2_ = k_ * (1.0f + (a_ - 1.0f) * c_ka), bb_ = kk_ * a_; LAS float* o_ = OPS + (nb_) * (5 * 32 * 64) + tt_ * 64 + (st & 15) * 4; \
                *(LAS f32x4*)(o_ + 0 * 2048) = kk_; *(LAS f32x4*)(o_ + 1 * 2048) = dec_; *(LAS f32x4*)(o_ + 2 * 2048) = bb_; *(LAS f32x4*)(o_ + 3 * 2048) = k2_; *(LAS f32x4*)(o_ + 4 * 2048) = r_; } \
            if (st < 256) *(LAS f32x4*)(VVs + (nb_) * 1024 + vtt * 32 + (st & 7) * 4) = g_v + (g_vp - g_v) * mu_v; } while (0)
            P5_LOAD(0); P5_STORE(0);
            __syncthreads();
            float S0 = 0.f, S1 = 0.f, S2 = 0.f, S3 = 0.f;
            for (int c = 0; c < SEQ / 32; ++c) {
                const int buf = c & 1;
                if (c + 1 < SEQ / 32) P5_LOAD(c + 1);
                const LAS float* ob = OPS + buf * (5 * 32 * 64) + 4 * jq;
                const LAS float* vb = VVs + buf * 1024 + 4 * wave + r4;
                LAS float* yb = YBs + buf * 1024 + 4 * wave + r4;
                f32x4 a4 = *(const LAS f32x4*)(ob + (0 * 32) * 64), w4 = *(const LAS f32x4*)(ob + (1 * 32) * 64), b4 = *(const LAS f32x4*)(ob + (2 * 32) * 64),
                      k4 = *(const LAS f32x4*)(ob + (3 * 32) * 64), q4 = *(const LAS f32x4*)(ob + (4 * 32) * 64);
                float v = vb[0];
#pragma unroll
                for (int t = 0; t < 32; ++t) {
                    f32x4 a4n = a4, w4n = w4, b4n = b4, k4n = k4, q4n = q4; float vn = v;
                    if (t + 1 < 32) { a4n = *(const LAS f32x4*)(ob + (0 * 32 + t + 1) * 64); w4n = *(const LAS f32x4*)(ob + (1 * 32 + t + 1) * 64); b4n = *(const LAS f32x4*)(ob + (2 * 32 + t + 1) * 64);
                                      k4n = *(const LAS f32x4*)(ob + (3 * 32 + t + 1) * 64); q4n = *(const LAS f32x4*)(ob + (4 * 32 + t + 1) * 64); vn = vb[(t + 1) * 32]; }
                    float p = S0 * a4.x; p += S1 * a4.y; p += S2 * a4.z; p += S3 * a4.w;
                    const float sa = -row16_sum(p);
                    S0 = S0 * w4.x + (sa * b4.x + v * k4.x); S1 = S1 * w4.y + (sa * b4.y + v * k4.y); S2 = S2 * w4.z + (sa * b4.z + v * k4.z); S3 = S3 * w4.w + (sa * b4.w + v * k4.w);
                    float y = S0 * q4.x; y += S1 * q4.y; y += S2 * q4.z; y += S3 * q4.w;
                    yb[t * 32] = row16_sum(y);
                    a4 = a4n; w4 = w4n; b4 = b4n; k4 = k4n; q4 = q4n; v = vn;
                }
                if (c + 1 < SEQ / 32) P5_STORE(buf ^ 1);
                __syncthreads();
                if (tid < 256) *(GAS f32x4*)(Yy + (mbase + c * 32 + vtt) * 1024 + vi) = *(const LAS f32x4*)(YBs + buf * 1024 + vtt * 32 + (st & 7) * 4);
            }
#undef P5_LOAD
#undef P5_STORE
        } else for (int crep_ = 0; crep_ < P5_CONV_REPS; ++crep_) {
            LAS float* scr = (LAS float*)(lds + wave * 16640);
            const int cw = (xcd_i * 16 + slot_i - 16) * NWAVES + wave;
            constexpr int I1 = (D / 64) * (4096 / 64), I2 = (DFF / 64) * (D / 64), IPE = I1 + I2;
            auto src_of = [&](int it, const float*& Wp, int& N, int& li) { const int e = it / IPE, r = it % IPE; if (r < I1) { Wp = w1 + (size_t)e * D * 4096; N = 4096; li = r; } else { Wp = w2 + (size_t)e * DFF * D; N = D; li = r - I1; } };
            f32x4 va[16], vb2[16];
            int it = cw; const float* Wp; int N, li;
            constexpr int TOT = NE * IPE, STRIDE = 128 * NWAVES;
#define CONV_STEP(cur, nxtbuf) { const int itn = it + STRIDE; const float* Wn; int Nn, lin; \
                src_of(itn < TOT ? itn : it, Wn, Nn, lin); tr_load(Wn, Nn, lin, lane, nxtbuf);     \
                { const int e = it / IPE, r = it % IPE; \
                  if (r < I1) tr_store_fp8(cur, D, 4096, W1T, (size_t)e * 4096, scr, li, lane, pg8::W_SCALE); else tr_store_fp8(cur, DFF, D, W2T, (size_t)e * 2048, scr, li, lane, pg8::W_SCALE); } \
                it = itn; li = lin; }
            if (it < TOT) { src_of(it, Wp, N, li); tr_load(Wp, N, li, lane, va);
                for (;;) { CONV_STEP(va, vb2); if (it >= TOT) break; CONV_STEP(vb2, va); if (it >= TOT) break; } }
#undef CONV_STEP
        }
    }
    SEAM(5);

    if (IN(6)) {
        for (int m = gw; m < M; m += NGW) {
            const int t = m % SEQ;
            const float* pr = PROJ + (size_t)m * IN_PAD; const float* pp = pr - IN_PAD; const float* lo = LOUT + (size_t)m * 3072;
#pragma unroll
            for (int q = 0; q < 4; ++q) {
                const int c = 4 * lane + 256 * q; const size_t o = (size_t)m * 1024 + c;
                f32x4 r = *(const GAS f32x4*)(pr + c), k = *(const GAS f32x4*)(pr + 1024 + c), v = *(const GAS f32x4*)(pr + 2048 + c);
                f32x4 rp = (f32x4){0.f, 0.f, 0.f, 0.f}, kp = rp, vp = rp;
                if (t > 0) { rp = *(const GAS f32x4*)(pp + c); kp = *(const GAS f32x4*)(pp + 1024 + c); vp = *(const GAS f32x4*)(pp + 2048 + c); }
                r = r + (rp - r) * *(const GAS f32x4*)(mu + c); k = k + (kp - k) * *(const GAS f32x4*)(mu + 1024 + c); v = v + (vp - v) * *(const GAS f32x4*)(mu + 2048 + c);
                const f32x4 al = *(const GAS f32x4*)(lo + 1024 + c) + *(const GAS f32x4*)(a0 + c);
                f32x4 a;
#pragma unroll
                for (int j = 0; j < 4; ++j) a[j] = 1.0f / (1.0f + __expf(-al[j]));
                const f32x4 k2 = k * (1.0f + (a - 1.0f) * *(const GAS f32x4*)(k_a + c));
                const f32x4 rk = *(const GAS f32x4*)(r_k + c);
                const float bon = row16_sum(r.x * k2.x * rk.x + r.y * k2.y * rk.y + r.z * k2.z * rk.z + r.w * k2.w * rk.w);
                const f32x4 y = *(const GAS f32x4*)(Yy + o);
                const float mean = row16_sum(y.x + y.y + y.z + y.w) * (1.0f / 64.0f);
                const f32x4 d = y - mean;
                const float var = row16_sum(d.x * d.x + d.y * d.y + d.z * d.z + d.w * d.w) * (1.0f / 64.0f);
                const float rstd = __builtin_amdgcn_rsqf(var + GN_EPS);
                f32x4 yn = d * rstd * *(const GAS f32x4*)(lnx_w + c) + *(const GAS f32x4*)(lnx_b + c);
                yn = yn + bon * v;
                yn = yn * *(const GAS f32x4*)(lo + 2048 + c);
                v2u ov; ov.x = pk2(yn.x, yn.y); ov.y = pk2(yn.z, yn.w);
                *(GAS v2u*)(MIXIN + (size_t)m * 2048 + c) = ov;
            }
        }
    }
    SEAM(6);

    if (IN(7)) {
        pg8::Gemm g{MIXIN, WOUTT, D, D}; pg8::GridOrder S; S.init(M / 256, D / 256, G, bx, (size_t)256 * D * 2, 0, (size_t)256 * D * 2);
        pg8::EpiF32 E{MIX, D};
        pg8::gemm_phase<pg8::EpiF32, pg8::GridOrder, true, true>(lds, g, S, E);
    }
    SEAM(7);

    if (IN(8)) {
        LAS float* s_h = (LAS float*)lds;
        LAS float* s_part = (LAS float*)(lds + 65536);
        const int e = tid & 31, part = tid >> 5;
        float wreg[128];
#pragma unroll
        for (int i = 0; i < 128; ++i) wreg[i] = router_w[(size_t)(part * 128 + i) * 32 + e];
        LAS int* lcnt = (LAS int*)(lds + LDSCTL_OFF + 512);
        if (tid < NE) lcnt[tid] = 0;
        __syncthreads();
        for (int m0 = vcu * 8; m0 < M; m0 += G * 8) {
            const int m = m0 + wave;
            {
                f32x4 v[8]; float s = 0.f;
#pragma unroll
                for (int q = 0; q < 8; ++q) { const int c = 4 * lane + 256 * q; v[q] = ALPHA * *(const GAS f32x4*)(x + (size_t)m * D + c) + *(const GAS f32x4*)(MIX + (size_t)m * D + c); s += (v[q].x + v[q].y) + (v[q].z + v[q].w); }
                const float mean = wave_sum(s) * (1.0f / D); float s2 = 0.f;
#pragma unroll
                for (int q = 0; q < 8; ++q) { v[q] = v[q] - mean; s2 += (v[q].x * v[q].x + v[q].y * v[q].y) + (v[q].z * v[q].z + v[q].w * v[q].w); }
                const float rstd = 1.0f / sqrtf(wave_sum(s2) * (1.0f / D) + LN_EPS);
#pragma unroll
                for (int q = 0; q < 8; ++q) { const int c = 4 * lane + 256 * q;
                    const f32x4 hv = v[q] * rstd * *(const GAS f32x4*)(ln1_w + c) + *(const GAS f32x4*)(ln1_b + c);
                    *(GAS f32x4*)(H + (size_t)m * D + c) = hv; *(LAS f32x4*)(s_h + wave * 2048 + c) = hv;
                    *(GAS unsigned*)(HQ + (size_t)m * D + c) = pg8::pk4_fp8(hv.x * pg8::XS_SCALE, hv.y * pg8::XS_SCALE, hv.z * pg8::XS_SCALE, hv.w * pg8::XS_SCALE); }
            }
            __syncthreads();
#pragma unroll 1
            for (int tk = 0; tk < 8; ++tk) {
                const LAS float* hp = s_h + tk * 2048 + part * 128; float acc = 0.f;
#pragma unroll
                for (int i = 0; i < 32; ++i) { const f32x4 hv = *(const LAS f32x4*)(hp + 4 * i); acc += hv.x * wreg[4 * i]; acc += hv.y * wreg[4 * i + 1]; acc += hv.z * wreg[4 * i + 2]; acc += hv.w * wreg[4 * i + 3]; }
                s_part[(tk * 16 + part) * 32 + e] = acc;
            }
            __syncthreads();
            {
                float lg = -3.0e38f;
                if (lane < 32) { lg = router_b[lane];
#pragma unroll
                    for (int p = 0; p < 16; ++p) lg += s_part[(wave * 16 + p) * 32 + lane]; }
                int idx[4]; float val[4];
#pragma unroll
                for (int k = 0; k < 4; ++k) {
                    float best = lg; int bi = lane;
#pragma unroll
                    for (int o = 1; o < 64; o <<= 1) { const float ob = __shfl_xor(best, o); const int oi = __shfl_xor(bi, o); const bool take = (ob > best) || (ob == best && oi < bi); best = take ? ob : best; bi = take ? oi : bi; }
                    idx[k] = bi; val[k] = best; if (lane == bi) lg = -3.0e38f;
                }
                if (lane == 0) {
                    float ex[4], se = 0.f;
#pragma unroll
                    for (int k = 0; k < 4; ++k) { ex[k] = __expf(val[k] - val[0]); se += ex[k]; }
                    const float inv = 1.0f / se;
#pragma unroll
                    for (int k = 0; k < 4; ++k) { TOPI[m * 4 + k] = idx[k]; GATE[m * 4 + k] = ex[k] * inv; POS[m * 4 + k] = __hip_atomic_fetch_add(lcnt + idx[k], 1, __ATOMIC_RELAXED, __HIP_MEMORY_SCOPE_WORKGROUP); }
                }
            }
            __syncthreads();
        }
        if (tid < NE) CNTWG[vcu * NE + tid] = lcnt[tid];
    }
    SEAM(8);

    if (IN(9) || IN(10) || IN(11)) {
        LAS int* s_t = (LAS int*)lds; LAS int* s_p = s_t + 512;
        LAS int* PSB = (LAS int*)(lds + LDSCTL_OFF + 640);
        { const int e = tid & 31, part = tid >> 5; int tsum = 0, psum = 0;
          for (int w = part * 16; w < part * 16 + 16; ++w) { const int cv = CNTWG[w * NE + e]; tsum += cv; psum += (w < vcu) ? cv : 0; }
          s_t[part * 32 + e] = tsum; s_p[part * 32 + e] = psum; }
        __syncthreads();
        if (tid < NE) { int tsum = 0, psum = 0; for (int p = 0; p < 16; ++p) { tsum += s_t[p * 32 + tid]; psum += s_p[p * 32 + tid]; } s_t[tid] = tsum; PSB[tid] = psum; }
        __syncthreads();
        if (tid == 0) { int acc = 0; for (int e = 0; e < NE; ++e) { PS[e] = acc; acc += (s_t[e] + 255) / 256 * 256; } PS[NE] = acc; }
        __syncthreads();
        if (tid < NE) PSB[tid] += PS[tid];
        __syncthreads();
    }
    if (IN(9)) {
        const LAS int* PSB = (const LAS int*)(lds + LDSCTL_OFF + 640);
        for (int m0 = vcu * 8; m0 < M; m0 += G * 8) {
            const int m = m0 + wave;
            const GAS v4u* src = (const GAS v4u*)(HQ + (size_t)m * D);
            v4u rv[2];
#pragma unroll
            for (int q = 0; q < 2; ++q) rv[q] = src[lane + 64 * q];
#pragma unroll
            for (int k = 0; k < 4; ++k) {
                const int a = m * 4 + k, slot = PSB[TOPI[a]] + POS[a];
                if (lane == 0) { slot_tok[slot] = m; SLOT_OF[a] = slot; }
                GAS v4u* dst = (GAS v4u*)(XS + (size_t)slot * D);
#pragma unroll
                for (int q = 0; q < 2; ++q) dst[lane + 64 * q] = rv[q];
            }
        }
    }
    SEAM(9);

    if (IN(10)) {
        pg8::Gemm g{(const bf16*)XS, (const bf16*)W1T, D / 2, D / 2}; pg8::MoeOrder S; S.ps = PS; S.ntile = 16; S.npan = PS[NE] / 256; S.cprime = vcu; S.a_tstep = (size_t)256 * D; S.b_tstep = (size_t)256 * D;
        pg8::EpiSwiglu E{ACT, b1};
        pg8::gemm_phase<pg8::EpiSwiglu, pg8::MoeOrder, true, true, true>(lds, g, S, E);
    }
    SEAM(10);

    if (IN(11)) {
        pg8::Gemm g{(const bf16*)ACT, (const bf16*)W2T, DFF / 2, DFF / 2}; pg8::MoeOrder S; S.ps = PS; S.ntile = 8; S.npan = PS[NE] / 256; S.cprime = vcu; S.a_tstep = (size_t)256 * DFF; S.b_tstep = (size_t)256 * DFF;
        pg8::EpiBias16 E{YS, b2};
        pg8::gemm_phase<pg8::EpiBias16, pg8::MoeOrder, true, true, true>(lds, g, S, E);
    }
    SEAM(11);

    if (IN(12)) {
        for (int m = gw; m < M; m += NGW) {
            int sl[4]; float gt[4];
#pragma unroll
            for (int k = 0; k < 4; ++k) { sl[k] = SLOT_OF[m * 4 + k]; gt[k] = GATE[m * 4 + k]; }
            f32x4 v[8]; float s = 0.f;
#pragma unroll
            for (int q = 0; q < 8; ++q) { const int c = 4 * lane + 256 * q; f32x4 f = (f32x4){0.f, 0.f, 0.f, 0.f};
#pragma unroll
                for (int k = 0; k < 4; ++k) { const v2u yv = *(const GAS v2u*)(YS + (size_t)sl[k] * D + c); f += gt[k] * (f32x4){bflo(yv.x), bfhi(yv.x), bflo(yv.y), bfhi(yv.y)}; }
                v[q] = ALPHA * *(const GAS f32x4*)(H + (size_t)m * D + c) + f; s += (v[q].x + v[q].y) + (v[q].z + v[q].w); }
            const float mean = wave_sum(s) * (1.0f / D); float s2 = 0.f;
#pragma unroll
            for (int q = 0; q < 8; ++q) { v[q] = v[q] - mean; s2 += (v[q].x * v[q].x + v[q].y * v[q].y) + (v[q].z * v[q].z + v[q].w * v[q].w); }
            const float rstd = 1.0f / sqrtf(wave_sum(s2) * (1.0f / D) + LN_EPS);
#pragma unroll
            for (int q = 0; q < 8; ++q) { const int c = 4 * lane + 256 * q; *(GAS f32x4*)(out + (size_t)m * D + c) = v[q] * rstd * *(const GAS f32x4*)(ln2_w + c) + *(const GAS f32x4*)(ln2_b + c); }
        }
    }
#undef IN
#undef SEAM
}

extern "C" void kernel_launch(void* const* d_in, const int* in_sizes, int n_in, void* d_out, int out_size, void* d_ws, size_t ws_size, hipStream_t stream) {
    static int grid = 0;
    if (grid == 0) {
        if (n_in != 26 || out_size != M * D || ws_size < WS_END) { fprintf(stderr, "kernel_launch: unexpected problem (n_in %d, out %d, ws %zu < %zu)\n", n_in, out_size, ws_size, (size_t)WS_END); grid = -1; return; }
        int dev = 0, cus = 0, per_cu = 0;
        if (hipGetDevice(&dev) != hipSuccess || hipDeviceGetAttribute(&cus, hipDeviceAttributeMultiprocessorCount, dev) != hipSuccess) { grid = -1; return; }
        if (hipFuncSetAttribute((const void*)mk_fwd, hipFuncAttributeMaxDynamicSharedMemorySize, LDS_BYTES) != hipSuccess) { fprintf(stderr, "kernel_launch: hipFuncSetAttribute failed\n"); grid = -1; return; }
        if (hipOccupancyMaxActiveBlocksPerMultiprocessor(&per_cu, (const void*)mk_fwd, NTHR, LDS_BYTES) != hipSuccess || per_cu < 1) fprintf(stderr, "kernel_launch: occupancy query reports %d\n", per_cu);
        (void)hipGetLastError();
        if (cus != NWG) { fprintf(stderr, "kernel_launch: built for %d CUs, device has %d\n", NWG, cus); grid = -1; return; }
        grid = NWG;
    }
    if (grid < 0) return;
    (void)hipMemsetAsync((char*)d_ws + WS_CTL, 0, CTL_BYTES, stream);
    (void)hipMemsetAsync((char*)d_ws + WS_SLOTTOK, 0xFF, (size_t)NSLOT_MAX * 4, stream);
    Args a{};
    for (int i = 0; i < 26; ++i) a.in[i] = (const float*)d_in[i];
    a.out = (float*)d_out; a.ws = (unsigned char*)d_ws; a.dup = DUP_MASK;
    if (MK_N_LAUNCHES == 1) { a.ph_lo = 0; a.ph_hi = NPHASE; hipLaunchKernelGGL(mk_fwd, dim3(grid), dim3(NTHR), LDS_BYTES, stream, a); }
    else { for (int p = 0; p < NPHASE; ++p) for (int rep = 0; rep <= ((DUP_MASK >> p) & 1); ++rep) { a.ph_lo = p; a.ph_hi = p + 1; hipLaunchKernelGGL(mk_fwd, dim3(grid), dim3(NTHR), LDS_BYTES, stream, a); } }
}
```

```cpp
#include <hip/hip_runtime.h>
#include <stdint.h>
#include <stdio.h>

#ifndef P5_SCAN_REPS
#define P5_SCAN_REPS 1
#endif
#ifndef P5_CONV_REPS
#define P5_CONV_REPS 1
#endif
#ifndef P5A_REPS
#define P5A_REPS 1
#endif
#ifndef P5B_REPS
#define P5B_REPS 1
#endif
#ifndef SCAN_CHUNKED
#define SCAN_CHUNKED 1
#endif
#ifndef DUP_MASK
#define DUP_MASK 0
#endif
#ifndef MK_N_LAUNCHES
#define MK_N_LAUNCHES 1
#endif

constexpr int D = 2048, BATCH = 4, SEQ = 4096, M = BATCH * SEQ;
constexpr int RW = 1024, PW = 1024, NH = 16;
constexpr int SHIFT_W = 3360, IN_COLS = 4384, IN_PAD = 4608;
constexpr int LK = 384;
constexpr int NE = 32, DFF = 2048;
constexpr int NASG = M * 4;
constexpr int NSLOT_MAX = NASG + NE * 256;
constexpr float LN_EPS = 1e-5f, GN_EPS = 64e-5f;
constexpr float ALPHA = 1.189207115002721f;
constexpr int NWG = 256, NWAVES = 8, NTHR = 512;
constexpr int NPHASE = 13;

#define GAS __attribute__((address_space(1)))
#define LAS __attribute__((address_space(3)))
typedef unsigned short bf16;
typedef unsigned v4u __attribute__((ext_vector_type(4)));
typedef unsigned v2u __attribute__((ext_vector_type(2)));
typedef float f32x4 __attribute__((ext_vector_type(4)));
typedef short bf16x8 __attribute__((ext_vector_type(8)));
typedef GAS unsigned gu32;
#define RLX_AGENT __ATOMIC_RELAXED, __HIP_MEMORY_SCOPE_AGENT
#define LDS_WAIT() asm volatile("s_waitcnt lgkmcnt(0)" ::: "memory")
#define VM_WAIT() asm volatile("s_waitcnt vmcnt(0)" ::: "memory")

__device__ __forceinline__ unsigned f2bf(float f) { unsigned u = __builtin_bit_cast(unsigned, f); return (u + 0x7fffu + ((u >> 16) & 1u)) >> 16; }
__device__ __forceinline__ unsigned pk2(float lo, float hi) { return f2bf(lo) | (f2bf(hi) << 16); }
__device__ __forceinline__ float bflo(unsigned w) { return __builtin_bit_cast(float, w << 16); }
__device__ __forceinline__ float bfhi(unsigned w) { return __builtin_bit_cast(float, w & 0xffff0000u); }
__device__ __forceinline__ float wave_sum(float v) {
#pragma unroll
    for (int o = 1; o < 64; o <<= 1) v += __shfl_xor(v, o);
    return v;
}
typedef float f32x2n __attribute__((ext_vector_type(2)));
typedef __bf16 bf16x2n __attribute__((ext_vector_type(2)));
__device__ __forceinline__ unsigned cvt_pk_bf16_nat(float lo, float hi) { const f32x2n v = {lo, hi}; return __builtin_bit_cast(unsigned, __builtin_convertvector(v, bf16x2n)); }
__device__ __forceinline__ float fast_sigmoid(float x) { return __builtin_amdgcn_rcpf(1.0f + __builtin_amdgcn_exp2f(-1.4426950408889634f * x)); }
__device__ __forceinline__ float fast_decay(float wl) { const float z = -wl; const float sp = fmaxf(z, 0.f) + 0.6931471805599453f * __builtin_amdgcn_logf(1.0f + __builtin_amdgcn_exp2f(-1.4426950408889634f * fabsf(z)));
    return __builtin_amdgcn_exp2f(-1.4426950408889634f * __builtin_amdgcn_exp2f(-1.4426950408889634f * (sp + 0.5f))); }
template <int CTRL> __device__ __forceinline__ float dpp_mov(float x) { return __builtin_bit_cast(float, __builtin_amdgcn_update_dpp(0, __builtin_bit_cast(int, x), CTRL, 0xF, 0xF, true)); }
__device__ __forceinline__ float row16_sum(float x) {
    x += dpp_mov<0xB1>(x);
    x += dpp_mov<0x4E>(x);
    x += dpp_mov<0x141>(x);
    x += dpp_mov<0x140>(x);
    return x;
}

namespace pg8 {
typedef unsigned short bf16_t;
typedef unsigned u32x4 __attribute__((ext_vector_type(4)));
typedef int v4i_t __attribute__((ext_vector_type(4)));
typedef int v8i_t __attribute__((ext_vector_type(8)));
constexpr int BM = 256, BK = 64, HALF = 128, HTB = HALF * BK * 2, STAGE_BYTES = 8 * HTB, NXCD = 8, WGM = 8;
__host__ __device__ __forceinline__ int lds_byte(int r, int c) { const int st = (r >> 4) * 2 + (c >> 5), rr = r & 15, cc = c & 31, ob = rr * 64 + cc * 2; return st * 1024 + (ob ^ (((ob >> 9) & 1) << 5)); }
__host__ __device__ __forceinline__ void stage_rc(int b, int& R, int& C) { const int st = b / 1024, sb = b % 1024, swz = sb ^ (((sb >> 9) & 1) << 5); R = (st >> 1) * 16 + swz / 64; C = (st & 1) * 32 + (swz % 64) / 2; }
__host__ __device__ __forceinline__ int perm32(int rho) { const int n = rho >> 4, i = rho & 15; return 8 * (i >> 2) + 4 * n + (i & 3); }
struct Unit { int pm, pn; };
struct Gemm { const bf16_t* A; const bf16_t* Bt; int lda, K; };
__device__ __forceinline__ unsigned cvt_pk_bf16(float lo, float hi) { unsigned r; asm volatile("v_cvt_pk_bf16_f32 %0, %1, %2" : "=v"(r) : "v"(lo), "v"(hi)); return r; }

struct GridOrder {
    int nM, nN, nwg, G, c; size_t a_tstep, a_pnstep, b_tstep;
    __device__ void init(int nM_, int nN_, int G_, int c_, size_t a_tstep_, size_t a_pnstep_, size_t b_tstep_) { nM = nM_; nN = nN_; nwg = nM * nN; G = G_; c = c_; a_tstep = a_tstep_; a_pnstep = a_pnstep_; b_tstep = b_tstep_; }
    __device__ bool next(int i, Unit& u) const {
        const long L = (long)i * G + c; if (L >= nwg) return false;
        int wgid = (int)L; { const int q = nwg / NXCD, r = nwg % NXCD, xcd = wgid % NXCD, off = wgid / NXCD; wgid = (xcd < r ? xcd * (q + 1) : r * (q + 1) + (xcd - r) * q) + off; }
        const int nig = WGM * nN, gid = wgid / nig, fm = gid * WGM, gsz = (nM - fm) < WGM ? (nM - fm) : WGM;
        u.pm = fm + ((wgid % nig) % gsz); u.pn = (wgid % nig) / gsz; return true;
    }
    __device__ __forceinline__ size_t aoff(const Unit& u) const { return (size_t)u.pm * a_tstep + (size_t)u.pn * a_pnstep; }
    __device__ __forceinline__ size_t boff(const Unit& u) const { return (size_t)u.pn * b_tstep; }
};
struct MoeOrder {
    const LAS int* ps; int ntile, npan, cprime; size_t a_tstep, b_tstep;
    __device__ bool next(int i, Unit& u) const {
        const int U = i * NWG + cprime; const int p = U / ntile; if (p >= npan) return false;
        const int row = p * 256; int e = 0;
#pragma unroll 1
        for (int q = 1; q < NE; ++q) e = (row >= ps[q]) ? q : e;
        u.pm = p; u.pn = e * ntile + (U % ntile); return true;
    }
    __device__ __forceinline__ size_t aoff(const Unit& u) const { return (size_t)u.pm * a_tstep; }
    __device__ __forceinline__ size_t boff(const Unit& u) const { return (size_t)u.pn * b_tstep; }
};

template <class Epi, class Sched, bool ALIGN_EPI, bool SP2, bool FP8 = false>
__device__ __forceinline__ void gemm_phase(LAS unsigned char* lds, const Gemm g, const Sched& S, const Epi& E) {
    int tid_ = threadIdx.x; asm volatile("" : "+v"(tid_));
    const int tid = tid_, wid = __builtin_amdgcn_readfirstlane(tid >> 6), lane = tid & 63, wr = wid >> 2, wc = wid & 3, fr = lane & 15, fq = lane >> 4;
    const int K = g.K, nt = K / BK;
    unsigned voffA[2], voffB[2];
#pragma unroll
    for (int i = 0; i < 2; ++i) { int R, C; stage_rc(tid * 16 + i * 8192, R, C); const int Rb = Epi::PERM ? ((R & ~31) + perm32(R & 31)) : R;
        voffA[i] = (unsigned)(R * g.lda + C) * 2u; voffB[i] = (unsigned)(Rb * K + C) * 2u; }
    const size_t kstep = (size_t)(BK * 2);
    const size_t hstepA = (size_t)HALF * g.lda * 2, hstepB = (size_t)HALF * K * 2;
    const unsigned ldsw = (unsigned)wid * 1024u;
    const int aoff = lds_byte(wr * 64 + fr, fq * 8), boff = lds_byte(wc * 32 + fr, fq * 8);
#define PG8_SA(b, h) (((b) * 2 + (h)) * HTB)
#define PG8_SB(b, h) ((4 + (b) * 2 + (h)) * HTB)
#define PG8_STAGE(bufoff, gbase, voff) do { _Pragma("unroll") for (int _i = 0; _i < 2; ++_i) \
        __builtin_amdgcn_global_load_lds((const unsigned*)((const char*)(gbase) + (voff)[_i]), (LAS unsigned*)(lds + (bufoff) + ldsw + _i * 8192), 16, 0, 0); } while (0)
#define PG8_LDA(dst, b, h) do { _Pragma("unroll") for (int m = 0; m < 4; ++m) { if constexpr (FP8) { const v4i_t l_ = *(const LAS v4i_t*)(lds + PG8_SA(b, h) + aoff + m * 2048), h_ = *(const LAS v4i_t*)(lds + PG8_SA(b, h) + aoff + m * 2048 + 1024); dst##8[m] = __builtin_shufflevector(l_, h_, 0, 1, 2, 3, 4, 5, 6, 7); } \
        else { _Pragma("unroll") for (int k = 0; k < 2; ++k) dst[m][k] = *(const LAS bf16x8*)(lds + PG8_SA(b, h) + aoff + m * 2048 + k * 1024); } } } while (0)
#define PG8_LDB(dst, b, h) do { _Pragma("unroll") for (int n = 0; n < 2; ++n) { if constexpr (FP8) { const v4i_t l_ = *(const LAS v4i_t*)(lds + PG8_SB(b, h) + boff + n * 2048), h_ = *(const LAS v4i_t*)(lds + PG8_SB(b, h) + boff + n * 2048 + 1024); dst##8[n] = __builtin_shufflevector(l_, h_, 0, 1, 2, 3, 4, 5, 6, 7); } \
        else { _Pragma("unroll") for (int k = 0; k < 2; ++k) dst[n][k] = *(const LAS bf16x8*)(lds + PG8_SB(b, h) + boff + n * 2048 + k * 1024); } } } while (0)
#define PG8_MMA(ai, bj, At, Bt) do { __builtin_amdgcn_s_setprio(1); _Pragma("unroll") for (int m = 0; m < 4; ++m) _Pragma("unroll") for (int n = 0; n < 2; ++n) { \
        if constexpr (FP8) asm volatile("v_mfma_scale_f32_16x16x128_f8f6f4 %0, %1, %2, %0, %3, %3 op_sel_hi:[0,0,0]" : "+v"(acc[ai][bj][m][n]) : "v"(Bt##8[n]), "v"(At##8[m]), "v"(scale1_)); \
        else { _Pragma("unroll") for (int k = 0; k < 2; ++k) acc[ai][bj][m][n] = __builtin_amdgcn_mfma_f32_16x16x32_bf16(Bt[n][k], At[m][k], acc[ai][bj][m][n], 0, 0, 0); } } \
        __builtin_amdgcn_s_setprio(0); } while (0)
#define PG8_WAIT_V(n) asm volatile("s_waitcnt vmcnt(" #n ")" ::: "memory")
#define PG8_WAIT_L(n) asm volatile("s_waitcnt lgkmcnt(" #n ")" ::: "memory")
#define PG8_BAR __builtin_amdgcn_s_barrier()
#define PG8_SCHED __builtin_amdgcn_sched_barrier(0)
    Unit cur, nxt; int ui = 0;
    if (!S.next(0, cur)) return;
    f32x4 acc[2][2][4][2];
#pragma unroll
    for (int a = 0; a < 2; ++a)
#pragma unroll
        for (int b = 0; b < 2; ++b)
#pragma unroll
            for (int m = 0; m < 4; ++m)
#pragma unroll
                for (int n = 0; n < 2; ++n) acc[a][b][m][n] = (f32x4){0.f, 0.f, 0.f, 0.f};
    int scale1_ = 0x7F7F7F7F; asm volatile("" : "+v"(scale1_));
    bf16x8 At[4][2], B0[2][2], B1[2][2];
    v8i_t At8[4], B08[2], B18[2];
    const char* cA = (const char*)g.A + S.aoff(cur); const char* cB = (const char*)g.Bt + S.boff(cur);
    if constexpr (SP2) {
        PG8_STAGE(PG8_SB(0, 0), cB, voffB); PG8_STAGE(PG8_SB(0, 1), cB + hstepB, voffB); PG8_STAGE(PG8_SA(0, 0), cA, voffA); PG8_STAGE(PG8_SA(0, 1), cA + hstepA, voffA);
        if (wr == 1) PG8_BAR;
        PG8_WAIT_V(2); PG8_BAR;
        PG8_STAGE(PG8_SB(1, 0), cB + kstep, voffB); PG8_STAGE(PG8_SA(1, 0), cA + kstep, voffA); PG8_STAGE(PG8_SB(1, 1), cB + hstepB + kstep, voffB);
        PG8_WAIT_V(6); PG8_BAR;
    } else {
        PG8_STAGE(PG8_SB(0, 0), cB, voffB); PG8_STAGE(PG8_SA(0, 0), cA, voffA); PG8_STAGE(PG8_SB(0, 1), cB + hstepB, voffB); PG8_STAGE(PG8_SA(0, 1), cA + hstepA, voffA);
        if (wr == 1) PG8_BAR;
        PG8_WAIT_V(4); PG8_BAR;
        PG8_STAGE(PG8_SB(1, 0), cB + kstep, voffB); PG8_STAGE(PG8_SA(1, 0), cA + kstep, voffA); PG8_STAGE(PG8_SB(1, 1), cB + hstepB + kstep, voffB);
        PG8_WAIT_V(6); PG8_BAR;
    }
    for (;;) {
        const bool has_next = S.next(ui + 1, nxt);
        const char* nA = has_next ? (const char*)g.A + S.aoff(nxt) : cA; const char* nB = has_next ? (const char*)g.Bt + S.boff(nxt) : cB;
#pragma unroll 1
        for (int t = 0; t < nt; t += 2) {
            const bool last = (t == nt - 2);
            const char* a1 = cA + (size_t)(t + 1) * kstep;
            const char* a2 = last ? nA : cA + (size_t)(t + 2) * kstep; const char* b2 = last ? nB : cB + (size_t)(t + 2) * kstep;
            const char* a3 = a2 + kstep; const char* b3 = b2 + kstep;
            if constexpr (SP2) {
            PG8_LDB(B0, 0, 0); PG8_LDB(B1, 0, 1); PG8_SCHED; PG8_LDA(At, 0, 0); PG8_STAGE(PG8_SA(1, 1), a1 + hstepA, voffA);
            PG8_WAIT_V(8); PG8_WAIT_L(0); PG8_BAR; PG8_MMA(0, 0, At, B0); PG8_MMA(0, 1, At, B1); PG8_BAR; PG8_SCHED;
            PG8_LDA(At, 0, 1); PG8_STAGE(PG8_SB(0, 0), b2, voffB); PG8_STAGE(PG8_SB(0, 1), b2 + hstepB, voffB); PG8_STAGE(PG8_SA(0, 0), a2, voffA);
            PG8_WAIT_V(8); PG8_WAIT_L(0); PG8_BAR; PG8_MMA(1, 0, At, B0); PG8_MMA(1, 1, At, B1); PG8_BAR; PG8_SCHED;
            PG8_LDB(B0, 1, 0); PG8_LDB(B1, 1, 1); PG8_SCHED; PG8_LDA(At, 1, 0); PG8_STAGE(PG8_SA(0, 1), a2 + hstepA, voffA);
            PG8_WAIT_V(8); PG8_WAIT_L(0); PG8_BAR; PG8_MMA(0, 0, At, B0); PG8_MMA(0, 1, At, B1); PG8_BAR; PG8_SCHED;
            PG8_LDA(At, 1, 1); PG8_STAGE(PG8_SB(1, 0), b3, voffB); PG8_STAGE(PG8_SB(1, 1), b3 + hstepB, voffB); PG8_STAGE(PG8_SA(1, 0), a3, voffA);
            PG8_WAIT_V(8); PG8_WAIT_L(0); PG8_BAR; PG8_MMA(1, 0, At, B0); PG8_MMA(1, 1, At, B1); PG8_BAR; PG8_SCHED;
            } else {
            PG8_LDB(B0, 0, 0); PG8_SCHED; PG8_LDA(At, 0, 0); PG8_STAGE(PG8_SA(1, 1), a1 + hstepA, voffA);
            PG8_WAIT_L(8); PG8_BAR; PG8_WAIT_L(0); PG8_MMA(0, 0, At, B0); PG8_BAR; PG8_SCHED;
            PG8_LDB(B1, 0, 1); PG8_STAGE(PG8_SB(0, 0), b2, voffB);
            PG8_BAR; PG8_WAIT_L(0); PG8_MMA(0, 1, At, B1); PG8_BAR;
            PG8_LDA(At, 0, 1); PG8_STAGE(PG8_SA(0, 0), a2, voffA);
            PG8_BAR; PG8_WAIT_L(0); PG8_MMA(1, 0, At, B0); PG8_BAR; PG8_SCHED;
            PG8_STAGE(PG8_SB(0, 1), b2 + hstepB, voffB);
            PG8_WAIT_V(6); PG8_BAR; PG8_MMA(1, 1, At, B1); PG8_BAR;
            PG8_LDB(B0, 1, 0); PG8_SCHED; PG8_LDA(At, 1, 0); PG8_STAGE(PG8_SA(0, 1), a2 + hstepA, voffA);
            PG8_WAIT_L(8); PG8_BAR; PG8_WAIT_L(0); PG8_MMA(0, 0, At, B0); PG8_BAR; PG8_SCHED;
            PG8_LDB(B1, 1, 1); PG8_STAGE(PG8_SB(1, 0), b3, voffB);
            PG8_BAR; PG8_WAIT_L(0); PG8_MMA(0, 1, At, B1); PG8_BAR;
            PG8_LDA(At, 1, 1); PG8_STAGE(PG8_SA(1, 0), a3, voffA);
            PG8_BAR; PG8_WAIT_L(0); PG8_MMA(1, 0, At, B0); PG8_BAR; PG8_SCHED;
            PG8_STAGE(PG8_SB(1, 1), b3 + hstepB, voffB);
            PG8_WAIT_V(6); PG8_BAR; PG8_MMA(1, 1, At, B1); PG8_BAR;
            }
        }
        if constexpr (ALIGN_EPI) { if (wr == 0) PG8_BAR; }
        if constexpr (FP8) asm volatile("s_nop 15\n\ts_nop 15" ::: "memory");
        E(acc, cur, wr, wc, fr, fq);
        if (!has_next) break;
#pragma unroll
        for (int a = 0; a < 2; ++a)
#pragma unroll
            for (int b = 0; b < 2; ++b)
#pragma unroll
                for (int m = 0; m < 4; ++m)
#pragma unroll
                    for (int n = 0; n < 2; ++n) acc[a][b][m][n] = (f32x4){0.f, 0.f, 0.f, 0.f};
        cur = nxt; cA = nA; cB = nB; ++ui;
        if constexpr (ALIGN_EPI) { if (wr == 1) PG8_BAR; }
    }
    PG8_WAIT_V(0);
    if constexpr (!ALIGN_EPI) { if (wr == 0) PG8_BAR; }
    PG8_BAR;
#undef PG8_SA
#undef PG8_SB
#undef PG8_STAGE
#undef PG8_LDA
#undef PG8_LDB
#undef PG8_MMA
#undef PG8_WAIT_V
#undef PG8_WAIT_L
#undef PG8_BAR
#undef PG8_SCHED
}

struct EpiF32 {
    static constexpr bool PERM = false;
    float* C; int ldc;
    __device__ __forceinline__ void operator()(const f32x4 (&acc)[2][2][4][2], const Unit& u, int wr, int wc, int fr, int fq) const {
        const int row0 = u.pm * BM + wr * 64 + fr, col0 = u.pn * BM + wc * 32 + 4 * fq;
#pragma unroll
        for (int ai = 0; ai < 2; ++ai)
#pragma unroll
            for (int m = 0; m < 4; ++m) { float* rowp = C + (size_t)(row0 + ai * HALF + m * 16) * ldc + col0;
#pragma unroll
                for (int bj = 0; bj < 2; ++bj)
#pragma unroll
                    for (int n = 0; n < 2; ++n) *(f32x4*)(rowp + bj * HALF + n * 16) = acc[ai][bj][m][n]; }
    }
};
struct EpiPool {
    static constexpr bool PERM = true;
    bf16_t* O; const float* scale;
    __device__ __forceinline__ void operator()(const f32x4 (&acc)[2][2][4][2], const Unit& u, int wr, int wc, int fr, int fq) const {
        const int row0 = u.pm * BM + wr * 64 + fr; int col0 = u.pn * BM + wc * 32 + 8 * fq;
        asm volatile("" : "+v"(col0));
        f32x4 sv[2][2];
#pragma unroll
        for (int bj = 0; bj < 2; ++bj)
#pragma unroll
            for (int n = 0; n < 2; ++n) sv[bj][n] = *(const f32x4*)(scale + col0 + bj * HALF + 4 * n);
#pragma unroll
        for (int ai = 0; ai < 2; ++ai)
#pragma unroll
            for (int m = 0; m < 4; ++m) { bf16_t* rowp = O + (size_t)(row0 + ai * HALF + m * 16) * 2048 + 1024 + col0;
#pragma unroll
                for (int bj = 0; bj < 2; ++bj) { const f32x4 v0 = acc[ai][bj][m][0] * sv[bj][0], v1 = acc[ai][bj][m][1] * sv[bj][1];
                    u32x4 w; w.x = cvt_pk_bf16(v0[0], v0[1]); w.y = cvt_pk_bf16(v0[2], v0[3]); w.z = cvt_pk_bf16(v1[0], v1[1]); w.w = cvt_pk_bf16(v1[2], v1[3]);
                    *(u32x4*)(rowp + bj * HALF) = w; } }
    }
};
constexpr float XS_SCALE = 8.0f, W_SCALE = 256.0f, ACT_SCALE = 8.0f, DESCALE = 1.0f / 2048.0f;
__device__ __forceinline__ unsigned pk4_fp8(float a, float b, float c, float d) {
    a = fminf(fmaxf(a, -448.f), 448.f); b = fminf(fmaxf(b, -448.f), 448.f); c = fminf(fmaxf(c, -448.f), 448.f); d = fminf(fmaxf(d, -448.f), 448.f);
    int w = 0; w = __builtin_amdgcn_cvt_pk_fp8_f32(a, b, w, false); w = __builtin_amdgcn_cvt_pk_fp8_f32(c, d, w, true); return (unsigned)w;
}
struct EpiSwiglu {
    static constexpr bool PERM = true;
    unsigned char* O; const float* b1;
    __device__ __forceinline__ void operator()(const f32x4 (&acc)[2][2][4][2], const Unit& u, int wr, int wc, int fr, int fq) const {
        const int e = u.pn >> 4, nt = u.pn & 15;
        const int row0 = u.pm * BM + wr * 64 + fr; int col0 = nt * BM + wc * 32 + 8 * fq;
        asm volatile("" : "+v"(col0));
        const float* bp = b1 + (size_t)e * 4096 + col0;
        f32x4 bv[2][2];
#pragma unroll
        for (int bj = 0; bj < 2; ++bj)
#pragma unroll
            for (int n = 0; n < 2; ++n) bv[bj][n] = *(const f32x4*)(bp + bj * HALF + 4 * n);
#pragma unroll
        for (int ai = 0; ai < 2; ++ai)
#pragma unroll
            for (int m = 0; m < 4; ++m) { unsigned char* rowp = O + (size_t)(row0 + ai * HALF + m * 16) * 2048 + (col0 >> 1);
#pragma unroll
                for (int bj = 0; bj < 2; ++bj) { const f32x4 v0 = acc[ai][bj][m][0] * DESCALE + bv[bj][0], v1 = acc[ai][bj][m][1] * DESCALE + bv[bj][1];
                    float a[4];
#pragma unroll
                    for (int p = 0; p < 4; ++p) { const float hg = p < 2 ? v0[2 * p] : v1[2 * p - 4], hl = p < 2 ? v0[2 * p + 1] : v1[2 * p - 3];
                        const float xg = fminf(hg, 7.0f), xl = fminf(fmaxf(hl, -7.0f), 7.0f);
                        a[p] = xg * __builtin_amdgcn_rcpf(1.0f + __expf(-1.702f * xg)) * (xl + 1.0f) * ACT_SCALE; }
                    *(unsigned*)(rowp + bj * (HALF / 2)) = pk4_fp8(a[0], a[1], a[2], a[3]); } }
    }
};
struct EpiBias16 {
    static constexpr bool PERM = true;
    bf16_t* O; const float* b2;
    __device__ __forceinline__ void operator()(const f32x4 (&acc)[2][2][4][2], const Unit& u, int wr, int wc, int fr, int fq) const {
        const int e = u.pn >> 3, nt = u.pn & 7;
        const int row0 = u.pm * BM + wr * 64 + fr; int col0 = nt * BM + wc * 32 + 8 * fq;
        asm volatile("" : "+v"(col0));
        const float* bp = b2 + (size_t)e * 2048 + col0;
        f32x4 bv[2][2];
#pragma unroll
        for (int bj = 0; bj < 2; ++bj)
#pragma unroll
            for (int n = 0; n < 2; ++n) bv[bj][n] = *(const f32x4*)(bp + bj * HALF + 4 * n);
#pragma unroll
        for (int ai = 0; ai < 2; ++ai)
#pragma unroll
            for (int m = 0; m < 4; ++m) { bf16_t* rowp = O + (size_t)(row0 + ai * HALF + m * 16) * 2048 + col0;
#pragma unroll
                for (int bj = 0; bj < 2; ++bj) { const f32x4 v0 = acc[ai][bj][m][0] * DESCALE + bv[bj][0], v1 = acc[ai][bj][m][1] * DESCALE + bv[bj][1];
                    u32x4 w; w.x = cvt_pk_bf16(v0[0], v0[1]); w.y = cvt_pk_bf16(v0[2], v0[3]); w.z = cvt_pk_bf16(v1[0], v1[1]); w.w = cvt_pk_bf16(v1[2], v1[3]);
                    *(u32x4*)(rowp + bj * HALF) = w; } }
    }
};
}

#define XB_TMO      128
#define XB_XCNT(j)  (256  + 64 * (j))
#define XB_XSUB(j)  (1280 + 64 * (j))
#define XB_XGEN(j)  (2304 + 64 * (j))
#define XB_TOP      3328
#define XB_TOPGEN   3392
#define XCD_BAR_WORDS 3456
#define XB_SPIN_CAP (1u << 22)
__device__ __forceinline__ unsigned xb_ld(unsigned* p)              { return __hip_atomic_load(p, __ATOMIC_RELAXED, __HIP_MEMORY_SCOPE_AGENT); }
__device__ __forceinline__ unsigned xb_add(unsigned* p, unsigned v) { return __hip_atomic_fetch_add(p, v, __ATOMIC_RELAXED, __HIP_MEMORY_SCOPE_AGENT); }
__device__ __forceinline__ unsigned xb_xcc_id() { return (unsigned)__builtin_amdgcn_s_getreg((3 << 11) | 20) & 0xFu; }
#define XB_SPIN(cond, bar) do { unsigned _sp = 0; while (cond) { __builtin_amdgcn_s_sleep(1); \
    if ((++_sp & 255u) == 0u) { if (xb_ld(&(bar)[XB_TMO])) break; if (_sp > XB_SPIN_CAP) { atomicAdd(&(bar)[XB_TMO], 1u); break; } } } } while (0)
struct XcdBarrier { unsigned* bar; unsigned x; volatile LAS unsigned* st; };
__device__ __forceinline__ XcdBarrier xcd_barrier_post(unsigned* bar, volatile LAS unsigned* st) {
    XcdBarrier b; b.bar = bar; b.x = xb_xcc_id(); b.st = st;
    if (threadIdx.x == 0) (void)xb_add(&bar[XB_XCNT(b.x)], 1u);
    return b;
}
__device__ __forceinline__ void xcd_barrier_complete(unsigned* bar, unsigned x, unsigned& nloc, unsigned& nx) {
    const unsigned G = gridDim.x * gridDim.y * gridDim.z;
    unsigned sum, cnt, mine, sp = 0u;
    for (;;) {
        sum = 0u; cnt = 0u; mine = 0u;
#pragma unroll
        for (unsigned j = 0; j < 16; ++j) { const unsigned c = xb_ld(&bar[XB_XCNT(j)]); sum += c; cnt += (c > 0u) ? 1u : 0u; mine = (j == x) ? c : mine; }
        if (sum == G) break;
        __builtin_amdgcn_s_sleep(1);
        if ((++sp & 255u) == 0u) { if (xb_ld(&bar[XB_TMO])) break; if (sp > XB_SPIN_CAP) { atomicAdd(&bar[XB_TMO], 1u); break; } }
    }
    nloc = mine > 0u ? mine : 1u; nx = cnt > 0u ? cnt : 1u;
}
__device__ __forceinline__ void xcd_barrier(const XcdBarrier& b) {
    asm volatile("s_waitcnt vmcnt(0)" ::: "memory");
    __syncthreads();
    if (threadIdx.x == 0) {
        unsigned* bar = b.bar;
        __builtin_amdgcn_s_waitcnt(0);
        unsigned nloc = b.st[0], nx = b.st[1];
        if (nloc == 0u) { xcd_barrier_complete(bar, b.x, nloc, nx); b.st[0] = nloc; b.st[1] = nx; }
        const unsigned old = xb_add(&bar[XB_XSUB(b.x)], 1u);
        const unsigned gen = old / nloc;
        if (old + 1u == (gen + 1u) * nloc) {
            __builtin_amdgcn_fence(__ATOMIC_RELEASE, "agent");
            asm volatile("s_waitcnt vmcnt(0)" ::: "memory");
            const unsigned og = xb_add(&bar[XB_TOP], 1u);
            const unsigned tg = og / nx;
            if (og + 1u == (tg + 1u) * nx) xb_add(&bar[XB_TOPGEN], 1u);
            else XB_SPIN(xb_ld(&bar[XB_TOPGEN]) == tg, bar);
            __builtin_amdgcn_fence(__ATOMIC_ACQUIRE, "agent");
            xb_add(&bar[XB_XGEN(b.x)], 1u);
            asm volatile("s_waitcnt vmcnt(0)" ::: "memory");
        } else {
            XB_SPIN(xb_ld(&bar[XB_XGEN(b.x)]) == gen, bar);
            __builtin_amdgcn_fence(__ATOMIC_ACQUIRE, "agent");
            asm volatile("s_waitcnt vmcnt(0)" ::: "memory");
        }
    }
    __syncthreads();
}

constexpr size_t al256(size_t x) { return (x + 255) & ~(size_t)255; }
constexpr size_t WS_CTL = 0, CTL_BYTES = 1u << 20;
constexpr int CW_BAR = 4096;
constexpr int CW_CNT = 16384;
constexpr size_t WS_SLOTTOK = WS_CTL + CTL_BYTES;
constexpr size_t WS_TOPI = WS_SLOTTOK + al256((size_t)NSLOT_MAX * 4);
constexpr size_t WS_GATE = WS_TOPI + (size_t)NASG * 4;
constexpr size_t WS_POS = WS_GATE + (size_t)NASG * 4;
constexpr size_t WS_SLOTOF = WS_POS + (size_t)NASG * 4;
constexpr size_t WS_BONUS = WS_SLOTOF + (size_t)NASG * 4;
constexpr size_t WS_XB = WS_BONUS + (size_t)M * 16 * 4;
constexpr size_t WS_WINT = WS_XB + (size_t)M * D * 2;
constexpr size_t WS_WOUTT = WS_WINT + (size_t)IN_PAD * D * 2;
constexpr size_t WS_LORAT = WS_WOUTT + (size_t)D * D * 2;
constexpr size_t WS_WPOOLT = WS_LORAT + (size_t)3072 * LK * 2;
constexpr size_t WS_PROJ = WS_WPOOLT + (size_t)1024 * 256 * 2;
constexpr size_t WS_LIN = WS_PROJ + (size_t)M * IN_PAD * 4;
constexpr size_t WS_POOLED = WS_LIN + (size_t)M * LK * 2;
constexpr size_t WS_WDEC = WS_POOLED + (size_t)M * 1024 * 2;
constexpr size_t SZ_F1K = (size_t)M * 1024 * 4;
constexpr size_t WS_LOUT = WS_WDEC + SZ_F1K  , WS_R = WS_LOUT + 3 * SZ_F1K, WS_K2 = WS_R + SZ_F1K, WS_V = WS_K2 + SZ_F1K, WS_KK = WS_V + SZ_F1K, WS_BB = WS_KK + SZ_F1K, WS_Y = WS_BB + SZ_F1K;
constexpr size_t WS_MIXIN = WS_Y + SZ_F1K;
constexpr size_t WS_MIX = WS_MIXIN + (size_t)M * D * 2;
constexpr size_t WS_H = WS_MIX + (size_t)M * D * 4;
constexpr size_t WS_HB = WS_H + (size_t)M * D * 4;
constexpr size_t WS_XS = WS_HB + (size_t)M * D;
constexpr size_t WS_W1T = WS_XS + (size_t)NSLOT_MAX * D;
constexpr size_t WS_W2T = WS_W1T + (size_t)NE * 4096 * D;
constexpr size_t WS_ACT = WS_W2T + (size_t)NE * 2048 * DFF;
constexpr size_t WS_YS = WS_ACT + (size_t)NSLOT_MAX * DFF;
constexpr size_t WS_END = WS_YS + (size_t)NSLOT_MAX * D * 2;

constexpr int RING_BYTES = 131072;
constexpr int LDSCTL_OFF = 159744;
constexpr int LDS_BYTES = 163840;

struct Args { const float* in[26]; float* out; unsigned char* ws; int ph_lo, ph_hi, dup, pad; };

template <bool KFAST = false> __device__ __forceinline__ void tr_load(const float* W, int N, int item, int lane, f32x4 (&v)[16]) {
    const int nblk = N / 64, kb = KFAST ? (item & 31) : item / nblk, nb = KFAST ? (item >> 5) : item % nblk, k0 = 64 * kb, n0 = 64 * nb;
    const int r = lane >> 4, c4 = (lane & 15) * 4;
#pragma unroll
    for (int i = 0; i < 16; ++i) v[i] = *(const GAS f32x4*)(W + (size_t)(k0 + 4 * i + r) * N + n0 + c4);
}
__device__ __forceinline__ void tr_store(const f32x4 (&v)[16], int K, int N, bf16* WT, size_t row_off, LAS float* scr, int item, int lane) {
    const int nblk = N / 64, kb = item / nblk, nb = item % nblk, k0 = 64 * kb, n0 = 64 * nb;
    const int r = lane >> 4, c4 = (lane & 15) * 4;
#pragma unroll
    for (int i = 0; i < 16; ++i) { LAS float* d = scr + (4 * i + r) * 65 + c4; d[0] = v[i].x; d[1] = v[i].y; d[2] = v[i].z; d[3] = v[i].w; }
    LDS_WAIT(); asm volatile("" ::: "memory");
    const int c = lane & 7;
#pragma unroll
    for (int p = 0; p < 8; ++p) { const int n = (lane >> 3) + 8 * p; const LAS float* q = scr + (8 * c) * 65 + n;
        v4u o; o.x = pk2(q[0 * 65], q[1 * 65]); o.y = pk2(q[2 * 65], q[3 * 65]); o.z = pk2(q[4 * 65], q[5 * 65]); o.w = pk2(q[6 * 65], q[7 * 65]);
        *(GAS v4u*)(WT + (row_off + n0 + n) * (size_t)K + k0 + 8 * c) = o; }
    LDS_WAIT(); asm volatile("" ::: "memory");
}
__device__ __forceinline__ void tr_store_fp8(const f32x4 (&v)[16], int K, int N, unsigned char* WT, size_t row_off, LAS float* scr, int item, int lane, float scale) {
    const int kb = item & 31, nb = item >> 5, k0 = 64 * kb, n0 = 64 * nb;
    const int r = lane >> 4, c4 = (lane & 15) * 4;
#pragma unroll
    for (int i = 0; i < 16; ++i) { LAS float* d = scr + (4 * i + r) * 65 + c4; d[0] = v[i].x * scale; d[1] = v[i].y * scale; d[2] = v[i].z * scale; d[3] = v[i].w * scale; }
    LDS_WAIT(); asm volatile("" ::: "memory");
    const int c = lane & 3;
#pragma unroll
    for (int p = 0; p < 4; ++p) { const int n = (lane >> 2) + 16 * p; const LAS float* q = scr + (16 * c) * 65 + n;
        v4u o; o.x = pg8::pk4_fp8(q[0 * 65], q[1 * 65], q[2 * 65], q[3 * 65]); o.y = pg8::pk4_fp8(q[4 * 65], q[5 * 65], q[6 * 65], q[7 * 65]);
        o.z = pg8::pk4_fp8(q[8 * 65], q[9 * 65], q[10 * 65], q[11 * 65]); o.w = pg8::pk4_fp8(q[12 * 65], q[13 * 65], q[14 * 65], q[15 * 65]);
        *(GAS v4u*)(WT + (row_off + n0 + n) * (size_t)K + k0 + 16 * c) = o; }
    LDS_WAIT(); asm volatile("" ::: "memory");
}
__device__ __forceinline__ void transpose_item(const float* W, int K, int N, bf16* WT, size_t row_off, LAS float* scr, int item, int lane) {
    f32x4 v[16]; tr_load(W, N, item, lane, v); tr_store(v, K, N, WT, row_off, scr, item, lane);
}

__global__ void __launch_bounds__(NTHR, 2) mk_fwd(Args args) {
    extern __shared__ __attribute__((aligned(16))) unsigned char lds_raw[];
    LAS unsigned char* lds = (LAS unsigned char*)lds_raw;
    volatile LAS unsigned* MISC = (volatile LAS unsigned*)(lds + LDSCTL_OFF);
    LAS int* PS = (LAS int*)(lds + LDSCTL_OFF + 256);
    const int tid = threadIdx.x, lane = tid & 63, wave = __builtin_amdgcn_readfirstlane(tid >> 6);
    const int G = gridDim.x, bx = blockIdx.x;
    const int vcu = (bx % 8) * (G / 8) + bx / 8;
    const int gw = vcu * NWAVES + wave, NGW = G * NWAVES;
    unsigned char* ws = args.ws;
    gu32* ctl = (gu32*)(ws + WS_CTL);
    const float* x = args.in[0]; const float* w_in = args.in[1]; const float* mu = args.in[2]; const float* w0 = args.in[3]; const float* w2d = args.in[4];
    const float* a0 = args.in[5]; const float* a2 = args.in[6]; const float* g2 = args.in[7]; const float* k_k = args.in[8]; const float* k_a = args.in[9];
    const float* r_k = args.in[10]; const float* lnx_w = args.in[11]; const float* lnx_b = args.in[12]; const float* w_pool = args.in[13]; const float* pool_scale = args.in[14];
    const float* w_out = args.in[15]; const float* ln1_w = args.in[16]; const float* ln1_b = args.in[17]; const float* router_w = args.in[18]; const float* router_b = args.in[19];
    const float* w1 = args.in[20]; const float* b1 = args.in[21]; const float* w2 = args.in[22]; const float* b2 = args.in[23]; const float* ln2_w = args.in[24]; const float* ln2_b = args.in[25];
    float* out = args.out;
    int* CNTWG = (int*)(ws + WS_CTL) + CW_CNT;
    int* slot_tok = (int*)(ws + WS_SLOTTOK); int* TOPI = (int*)(ws + WS_TOPI); float* GATE = (float*)(ws + WS_GATE); int* POS = (int*)(ws + WS_POS); int* SLOT_OF = (int*)(ws + WS_SLOTOF);
    float* BONUS = (float*)(ws + WS_BONUS);
    bf16* XB = (bf16*)(ws + WS_XB); bf16* WINT = (bf16*)(ws + WS_WINT); bf16* WOUTT = (bf16*)(ws + WS_WOUTT); bf16* LORAT = (bf16*)(ws + WS_LORAT); bf16* WPOOLT = (bf16*)(ws + WS_WPOOLT);
    float* PROJ = (float*)(ws + WS_PROJ); bf16* LIN = (bf16*)(ws + WS_LIN); bf16* POOLED = (bf16*)(ws + WS_POOLED);
    float* WDEC = (float*)(ws + WS_WDEC); float* LOUT = (float*)(ws + WS_LOUT); float* Rr = (float*)(ws + WS_R); float* K2 = (float*)(ws + WS_K2);
    float* Vv = (float*)(ws + WS_V); float* KK = (float*)(ws + WS_KK); float* BB = (float*)(ws + WS_BB); float* Yy = (float*)(ws + WS_Y);
    bf16* MIXIN = (bf16*)(ws + WS_MIXIN); float* MIX = (float*)(ws + WS_MIX); float* H = (float*)(ws + WS_H); unsigned char* HQ = (unsigned char*)(ws + WS_HB);
    unsigned char* XS = ws + WS_XS; unsigned char* W1T = ws + WS_W1T; unsigned char* W2T = ws + WS_W2T; unsigned char* ACT = ws + WS_ACT; bf16* YS = (bf16*)(ws + WS_YS);

    for (int u = tid; u < (LDS_BYTES - LDSCTL_OFF) / 4; u += NTHR) ((LAS unsigned*)(lds + LDSCTL_OFF))[u] = 0u;
    __syncthreads();
    XcdBarrier bar; bar.bar = (unsigned*)(ctl + CW_BAR); bar.x = 0; bar.st = nullptr;
    if (MK_N_LAUNCHES == 1) bar = xcd_barrier_post((unsigned*)(ctl + CW_BAR), MISC + 8);
    const int lo = args.ph_lo, hi = args.ph_hi;
#ifndef PHASE_MASK
#define PHASE_MASK 0xFFFF
#endif
#define IN(k) (((PHASE_MASK >> (k)) & 1) && lo <= (k) && (k) < hi)
#define SEAM(k) do { if (IN(k) && IN((k) + 1)) xcd_barrier(bar); } while (0)

    if (IN(0)) {
        LAS float* scr = (LAS float*)(lds + wave * 16640);
        for (size_t i = (size_t)gw * 64 + lane; i < (size_t)M * D / 8; i += (size_t)NGW * 64) {
            const f32x4 a = *(const GAS f32x4*)(x + i * 8), b = *(const GAS f32x4*)(x + i * 8 + 4);
            v4u o; o.x = pk2(a.x, a.y); o.y = pk2(a.z, a.w); o.z = pk2(b.x, b.y); o.w = pk2(b.z, b.w);
            *(GAS v4u*)(XB + i * 8) = o;
        }
        constexpr int I_IN = (D / 64) * (IN_COLS / 64)  , I_OUT = (D / 64) * (D / 64);
        for (int it = gw; it < I_IN + I_OUT; it += NGW) {
            if (it < I_IN) transpose_item(w_in, D, IN_COLS, WINT, 0, scr, it, lane);
            else transpose_item(w_out, D, D, WOUTT, 0, scr, it - I_IN, lane);
        }
        for (int i = gw * 64 + lane; i < 32 * D; i += NGW * 64) { const int nn = 4352 + (i >> 11), k = i & 2047; WINT[(size_t)nn * D + k] = (bf16)f2bf(w_in[(size_t)k * IN_COLS + nn]); }
        for (size_t i = (size_t)gw * 64 + lane; i < (size_t)(IN_PAD - IN_COLS) * D / 8; i += (size_t)NGW * 64) *(GAS v4u*)(WINT + (size_t)IN_COLS * D + i * 8) = (v4u){0u, 0u, 0u, 0u};
        for (int i = gw * 64 + lane; i < 3072 * LK; i += NGW * 64) {
            const int n = i / LK, k = i % LK; float v = 0.f;
            if (n < 1024) { if (k < 64) v = w2d[k * 1024 + n]; }
            else if (n < 2048) { if (k >= 64 && k < 128) v = a2[(k - 64) * 1024 + (n - 1024)]; }
            else { if (k >= 128 && k < 288) v = g2[(k - 128) * 1024 + (n - 2048)]; }
            LORAT[i] = (bf16)f2bf(v);
        }
        for (int i = gw * 64 + lane; i < 1024 * 256; i += NGW * 64) {
            const int n = i >> 8, c = i & 255, g = n >> 8, d = n & 255;
            WPOOLT[i] = (bf16)f2bf(w_pool[((size_t)g * 256 + c) * 256 + d]);
        }
    }
    SEAM(0);

    if (IN(1)) {
        pg8::Gemm g{XB, WINT, D, D}; pg8::GridOrder S; S.init(M / 256, IN_PAD / 256, G, bx, (size_t)256 * D * 2, 0, (size_t)256 * D * 2);
        pg8::EpiF32 E{PROJ, IN_PAD};
        pg8::gemm_phase<pg8::EpiF32, pg8::GridOrder, true, true>(lds, g, S, E);
    }
    SEAM(1);

    if (IN(2)) {
        for (int m = gw; m < M; m += NGW) {
            const int t = m % SEQ;
            const float* pr = PROJ + (size_t)m * IN_PAD; const float* pp = pr - IN_PAD;
#pragma unroll
            for (int q = 0; q < 6; ++q) {
                const int i = lane + 64 * q; float v = 0.f;
                if (i < 288) { const int c = 3072 + i; const float cur = pr[c], prev = t > 0 ? pp[c] : 0.f; const float s = cur + (prev - cur) * mu[c];
                    v = i < 64 ? tanhf(s) : (i < 128 ? s : 1.0f / (1.0f + __expf(-s))); }
                LIN[(size_t)m * LK + i] = (bf16)f2bf(v);
            }
#pragma unroll
            for (int q = 0; q < 4; ++q) {
                const int c = 4 * lane + 256 * q, win = 2 << q; const int n = (t + 1) < win ? (t + 1) : win;
                const f32x4 cur = *(const GAS f32x4*)(pr + SHIFT_W + c); f32x4 sum = cur;
                for (int s = 1; s < n; ++s) sum += *(const GAS f32x4*)(pr - (size_t)s * IN_PAD + SHIFT_W + c);
                const float inv = 1.0f / (float)n; const f32x4 pv = sum * inv - cur;
                v2u o; o.x = pk2(pv.x, pv.y); o.y = pk2(pv.z, pv.w);
                *(GAS v2u*)(POOLED + (size_t)m * 1024 + c) = o;
            }
        }
    }
    SEAM(2);

    if (IN(3)) {
#ifndef NO_LORA
        { pg8::Gemm g{LIN, LORAT, LK, LK}; pg8::GridOrder S; S.init(M / 256, 12, G, bx, (size_t)256 * LK * 2, 0, (size_t)256 * LK * 2);
          pg8::EpiF32 E{LOUT, 3072};
          pg8::gemm_phase<pg8::EpiF32, pg8::GridOrder, true, true>(lds, g, S, E); }
#endif
#ifndef NO_POOL
        { pg8::Gemm g{POOLED, WPOOLT, 1024, 256}; pg8::GridOrder S; S.init(M / 256, 4, G, bx, (size_t)256 * 1024 * 2, (size_t)256 * 2, (size_t)256 * 256 * 2);
          pg8::EpiPool E{MIXIN, pool_scale};
          pg8::gemm_phase<pg8::EpiPool, pg8::GridOrder, true, true>(lds, g, S, E); }
#endif
    }
    SEAM(3);

#if SCAN_CHUNKED
    if (IN(4)) {
        constexpr int CH = 16, NCHUNK = SEQ / CH;
        constexpr int PK_PA = 0, PK_PR = 2048, PK_QQ = 4096, PK_TT = 5120, PK_GG = 6144, PK_BK = 7168, PK_VT = 11264, PK_WC = 13312, PK_BYTES = 16384;
        const int tr = lane & 15, q = lane >> 4;
        for (int arep_ = 0; arep_ < P5A_REPS; ++arep_) {
                const int j = lane;
                LAS bf16* IMG = (LAS bf16*)(lds + wave * 10240);
                LAS float* PTs = (LAS float*)(lds + wave * 10240 + 9216);
                const int pos = (j & 32) | ((j & 12) << 1) | ((j & 16) >> 2) | (j & 3);
#pragma unroll 1
                for (int u = gw; u < 64 * NCHUNK; u += NGW) {
                    const int hd = u >> 8, c = u & 255, b = hd >> 4, h = hd & 15, cj = h * 64 + j;
                    const float mu_r = mu[cj], mu_k = mu[1024 + cj], mu_v = mu[2048 + cj], c_w0 = w0[cj], c_a0 = a0[cj], c_kk = k_k[cj], c_ka = k_a[cj];
                    unsigned char* pk = ws + WS_R + ((size_t)hd * NCHUNK + c) * PK_BYTES;
                    const size_t m0 = (size_t)b * SEQ + (size_t)c * CH;
                    float At[16], Rt[16], Bt[16], Kt[16], Vt[16];
                    float Wc = 1.f, pr_r = 0.f, pr_k = 0.f, pr_v = 0.f;
                    if (c > 0) { const float* pp = PROJ + (m0 - 1) * IN_PAD + cj; pr_r = pp[0]; pr_k = pp[1024]; pr_v = pp[2048]; }
#pragma unroll
                    for (int t = 0; t < 16; ++t) {
                        const float* prow = PROJ + (m0 + t) * IN_PAD + cj; const float* lrow = LOUT + (m0 + t) * 3072 + cj;
                        const float cr = prow[0], ck = prow[1024], cv = prow[2048], wl = lrow[0] + c_w0, al = lrow[1024] + c_a0;
                        const float r = cr + (pr_r - cr) * mu_r, k = ck + (pr_k - ck) * mu_k, v = cv + (pr_v - cv) * mu_v;
                        pr_r = cr; pr_k = ck; pr_v = cv;
                        const float dec = fast_decay(wl), a = fast_sigmoid(al);
                        float kk = k * c_kk; const float ss = wave_sum(kk * kk); kk = kk * __builtin_amdgcn_rsqf(fmaxf(ss, 1e-24f));
                        const float k2 = k * (1.0f + (a - 1.0f) * c_ka), bb = kk * a;
                        const float Wprev = Wc; Wc = Wc * dec; const float iw = __builtin_amdgcn_rcpf(Wc);
                        At[t] = -kk * Wprev; Rt[t] = r * Wc; Bt[t] = bb * iw; Kt[t] = k2 * iw; Vt[t] = v;
                    }
#pragma unroll
                    for (int t = 0; t < 16; ++t) {
                        const bf16 ab = (bf16)f2bf(At[t]), rb = (bf16)f2bf(Rt[t]);
                        IMG[0 * 1152 + t * 72 + j] = ab; IMG[1 * 1152 + t * 72 + j] = rb; IMG[2 * 1152 + t * 72 + j] = (bf16)f2bf(Bt[t]); IMG[3 * 1152 + t * 72 + j] = (bf16)f2bf(Kt[t]);
                        ((GAS bf16*)(pk + PK_PA))[t * 64 + pos] = ab; ((GAS bf16*)(pk + PK_PR))[t * 64 + pos] = rb;
                    }
#pragma unroll
                    for (int qq = 0; qq < 4; ++qq) { v4u o; o.x = pk2(Bt[4 * qq] * Wc, Bt[4 * qq + 1] * Wc); o.y = pk2(Bt[4 * qq + 2] * Wc, Bt[4 * qq + 3] * Wc); o.z = pk2(Kt[4 * qq] * Wc, Kt[4 * qq + 1] * Wc); o.w = pk2(Kt[4 * qq + 2] * Wc, Kt[4 * qq + 3] * Wc);
                        *(GAS v4u*)(pk + PK_BK + j * 64 + qq * 16) = o; }
#pragma unroll
                    for (int g = 0; g < 2; ++g) { v4u o; o.x = pk2(Vt[8 * g], Vt[8 * g + 1]); o.y = pk2(Vt[8 * g + 2], Vt[8 * g + 3]); o.z = pk2(Vt[8 * g + 4], Vt[8 * g + 5]); o.w = pk2(Vt[8 * g + 6], Vt[8 * g + 7]);
                        *(GAS v4u*)(pk + PK_VT + j * 32 + g * 16) = o; }
                    ((GAS float*)(pk + PK_WC))[j] = Wc;
                    asm volatile("s_waitcnt lgkmcnt(0)" ::: "memory");
                    const bf16x8 fa0 = *(const LAS bf16x8*)(IMG + 0 * 1152 + tr * 72 + 8 * q), fa1 = *(const LAS bf16x8*)(IMG + 0 * 1152 + tr * 72 + 32 + 8 * q);
                    const bf16x8 fr0 = *(const LAS bf16x8*)(IMG + 1 * 1152 + tr * 72 + 8 * q), fr1 = *(const LAS bf16x8*)(IMG + 1 * 1152 + tr * 72 + 32 + 8 * q);
                    const bf16x8 fb0 = *(const LAS bf16x8*)(IMG + 2 * 1152 + tr * 72 + 8 * q), fb1 = *(const LAS bf16x8*)(IMG + 2 * 1152 + tr * 72 + 32 + 8 * q);
                    const bf16x8 fk0 = *(const LAS bf16x8*)(IMG + 3 * 1152 + tr * 72 + 8 * q), fk1 = *(const LAS bf16x8*)(IMG + 3 * 1152 + tr * 72 + 32 + 8 * q);
                    const f32x4 z4 = (f32x4){0.f, 0.f, 0.f, 0.f};
                    f32x4 PT = __builtin_amdgcn_mfma_f32_16x16x32_bf16(fa0, fb0, z4, 0, 0, 0); PT = __builtin_amdgcn_mfma_f32_16x16x32_bf16(fa1, fb1, PT, 0, 0, 0);
                    f32x4 QT = __builtin_amdgcn_mfma_f32_16x16x32_bf16(fa0, fk0, z4, 0, 0, 0); QT = __builtin_amdgcn_mfma_f32_16x16x32_bf16(fa1, fk1, QT, 0, 0, 0);
                    f32x4 GB = __builtin_amdgcn_mfma_f32_16x16x32_bf16(fr0, fb0, z4, 0, 0, 0); GB = __builtin_amdgcn_mfma_f32_16x16x32_bf16(fr1, fb1, GB, 0, 0, 0);
                    f32x4 GK = __builtin_amdgcn_mfma_f32_16x16x32_bf16(fr0, fk0, z4, 0, 0, 0); GK = __builtin_amdgcn_mfma_f32_16x16x32_bf16(fr1, fk1, GK, 0, 0, 0);
                    const int s_ = tr, rec = (s_ >> 2) * 8 + (s_ & 3);
#pragma unroll
                    for (int e = 0; e < 4; ++e) { const int t = 4 * q + e;
                        const float pv = s_ < t ? PT[e] : 0.f, qv = s_ < t ? QT[e] : 0.f, gb = s_ <= t ? GB[e] : 0.f, gk = s_ <= t ? GK[e] : 0.f;
                        PTs[t * 16 + s_] = pv;
                        ((GAS bf16*)(pk + PK_QQ))[t * 32 + rec] = (bf16)f2bf(qv); ((GAS bf16*)(pk + PK_QQ))[t * 32 + rec + 4] = (bf16)0;
                        ((GAS bf16*)(pk + PK_GG))[t * 32 + rec] = (bf16)f2bf(gb); ((GAS bf16*)(pk + PK_GG))[t * 32 + rec + 4] = (bf16)f2bf(gk); }
                    asm volatile("s_waitcnt lgkmcnt(0)" ::: "memory");
                    float Tr[16];
#pragma unroll
                    for (int t = 0; t < 16; ++t) { float acc = (t == s_) ? 1.f : 0.f;
#pragma unroll
                        for (int r4_ = 0; r4_ < (t + 3) / 4; ++r4_) { const f32x4 pr4 = *(const LAS f32x4*)(PTs + t * 16 + 4 * r4_);
#pragma unroll
                            for (int e = 0; e < 4; ++e) if (4 * r4_ + e < t) acc += pr4[e] * Tr[4 * r4_ + e]; }
                        Tr[t] = acc; }
                    if (q == 0) {
#pragma unroll
                        for (int t = 0; t < 16; ++t) { ((GAS bf16*)(pk + PK_TT))[t * 32 + rec] = (bf16)f2bf(Tr[t]); ((GAS bf16*)(pk + PK_TT))[t * 32 + rec + 4] = (bf16)0; } }
                    asm volatile("s_waitcnt lgkmcnt(0)" ::: "memory");
                }
            }
    }
#endif
    SEAM(4);

    if (IN(5)) {
        constexpr int P5_OPS = 0, P5_VV = 81920, P5_YW = 90112, P5_SC = 98304;
        const int xcd_i = bx % 8, slot_i = bx / 8;
        constexpr int NSCAN_X = SCAN_CHUNKED ? 8 : 16;
#if !SCAN_CHUNKED
        if (slot_i < 16) for (int srep_ = 0; srep_ < P5_SCAN_REPS; ++srep_) {
            const int sid = xcd_i * 16 + slot_i, hd = sid >> 1, half = sid & 1, b = hd >> 4, h = hd & 15;
            LAS float* OPS = (LAS float*)(lds + P5_OPS); LAS float* VVs = (LAS float*)(lds + P5_VV); LAS float* YBs = (LAS float*)(lds + P5_YW);
            const int r4 = lane >> 4, jq = lane & 15;
            const int st = tid;
            const int stt = st >> 4, sj = h * 64 + (st & 15) * 4;
            const int vtt = st >> 3, vi = h * 64 + half * 32 + (st & 7) * 4;
            const f32x4 mu_r = *(const GAS f32x4*)(mu + sj), mu_k = *(const GAS f32x4*)(mu + 1024 + sj), mu_v = *(const GAS f32x4*)(mu + 2048 + vi);
            const f32x4 c_w0 = *(const GAS f32x4*)(w0 + sj), c_a0 = *(const GAS f32x4*)(a0 + sj), c_kk = *(const GAS f32x4*)(k_k + sj), c_ka = *(const GAS f32x4*)(k_a + sj);
            const size_t mbase = (size_t)b * SEQ;
            f32x4 g_r, g_k, g_rp, g_kp, g_wl, g_al, g_v, g_vp;
#define P5_LOAD(c_) do { { const int t_ = (c_) * 32 + stt; const float* pr_ = PROJ + (mbase + t_) * IN_PAD; const float* lo_ = LOUT + (mbase + t_) * 3072; \
                g_r = *(const GAS f32x4*)(pr_ + sj); g_k = *(const GAS f32x4*)(pr_ + 1024 + sj); g_wl = *(const GAS f32x4*)(lo_ + sj); g_al = *(const GAS f32x4*)(lo_ + 1024 + sj); \
                if (t_ > 0) { g_rp = *(const GAS f32x4*)(pr_ - IN_PAD + sj); g_kp = *(const GAS f32x4*)(pr_ - IN_PAD + 1024 + sj); } else { g_rp = (f32x4){0.f, 0.f, 0.f, 0.f}; g_kp = g_rp; } } \
            if (st < 256) { const int t_ = (c_) * 32 + vtt; const float* pr_ = PROJ + (mbase + t_) * IN_PAD; g_v = *(const GAS f32x4*)(pr_ + 2048 + vi); g_vp = t_ > 0 ? *(const GAS f32x4*)(pr_ - IN_PAD + 2048 + vi) : (f32x4){0.f, 0.f, 0.f, 0.f}; } } while (0)
#define P5_STORE(nb_) do { { const int tt_ = stt; \
                const f32x4 r_ = g_r + (g_rp - g_r) * mu_r, k_ = g_k + (g_kp - g_k) * mu_k; const f32x4 wl_ = g_wl + c_w0, al_ = g_al + c_a0; f32x4 a_, dec_; \
                _Pragma("unroll") for (int j_ = 0; j_ < 4; ++j_) { dec_[j_] = fast_decay(wl_[j_]); a_[j_] = fast_sigmoid(al_[j_]); } \
                f32x4 kk_ = k_ * c_kk; const float ss_ = row16_sum(kk_.x * kk_.x + kk_.y * kk_.y + kk_.z * kk_.z + kk_.w * kk_.w); kk_ = kk_ * __builtin_amdgcn_rsqf(fmaxf(ss_, 1e-24f)); \
                const f32x4 k2_ = k_ * (1.0f + (a_ - 1.0f) * c_ka), bb_ = kk_ * a_; LAS float* o_ = OPS + (nb_) * (5 * 32 * 64) + tt_ * 64 + (st & 15) * 4; \
                *(LAS f32x4*)(o_ + 0 * 2048) = kk_; *(LAS f32x4*)(o_ + 1 * 2048) = dec_; *(LAS f32x4*)(o_ + 2 * 2048) = bb_; *(LAS f32x4*)(o_ + 3 * 2048) = k2_; *(LAS f32x4*)(o_ + 4 * 2048) = r_; } \
            if (st < 256) *(LAS f32x4*)(VVs + (nb_) * 1024 + vtt * 32 + (st & 7) * 4) = g_v + (g_vp - g_v) * mu_v; } while (0)
            P5_LOAD(0); P5_STORE(0);
            __syncthreads();
            float S0 = 0.f, S1 = 0.f, S2 = 0.f, S3 = 0.f;
            for (int c = 0; c < SEQ / 32; ++c) {
                const int buf = c & 1;
                if (c + 1 < SEQ / 32) P5_LOAD(c + 1);
                const LAS float* ob = OPS + buf * (5 * 32 * 64) + 4 * jq;
                const LAS float* vb = VVs + buf * 1024 + 4 * wave + r4;
                LAS float* yb = YBs + buf * 1024 + 4 * wave + r4;
                f32x4 a4 = *(const LAS f32x4*)(ob + (0 * 32) * 64), w4 = *(const LAS f32x4*)(ob + (1 * 32) * 64), b4 = *(const LAS f32x4*)(ob + (2 * 32) * 64),
                      k4 = *(const LAS f32x4*)(ob + (3 * 32) * 64), q4 = *(const LAS f32x4*)(ob + (4 * 32) * 64);
                float v = vb[0];
#pragma unroll
                for (int t = 0; t < 32; ++t) {
                    f32x4 a4n = a4, w4n = w4, b4n = b4, k4n = k4, q4n = q4; float vn = v;
                    if (t + 1 < 32) { a4n = *(const LAS f32x4*)(ob + (0 * 32 + t + 1) * 64); w4n = *(const LAS f32x4*)(ob + (1 * 32 + t + 1) * 64); b4n = *(const LAS f32x4*)(ob + (2 * 32 + t + 1) * 64);
                                      k4n = *(const LAS f32x4*)(ob + (3 * 32 + t + 1) * 64); q4n = *(const LAS f32x4*)(ob + (4 * 32 + t + 1) * 64); vn = vb[(t + 1) * 32]; }
                    float p = S0 * a4.x; p += S1 * a4.y; p += S2 * a4.z; p += S3 * a4.w;
                    const float sa = -row16_sum(p);
                    S0 = S0 * w4.x + (sa * b4.x + v * k4.x); S1 = S1 * w4.y + (sa * b4.y + v * k4.y); S2 = S2 * w4.z + (sa * b4.z + v * k4.z); S3 = S3 * w4.w + (sa * b4.w + v * k4.w);
                    float y = S0 * q4.x; y += S1 * q4.y; y += S2 * q4.z; y += S3 * q4.w;
                    yb[t * 32] = row16_sum(y);
                    a4 = a4n; w4 = w4n; b4 = b4n; k4 = k4n; q4 = q4n; v = vn;
                }
                if (c + 1 < SEQ / 32) P5_STORE(buf ^ 1);
                __syncthreads();
                if (tid < 256) *(GAS f32x4*)(Yy + (mbase + c * 32 + vtt) * 1024 + vi) = *(const LAS f32x4*)(YBs + buf * 1024 + vtt * 32 + (st & 7) * 4);
            }
#undef P5_LOAD
#undef P5_STORE
        }
#else
        if (slot_i < NSCAN_X) {
            constexpr int CH = 16, NCHUNK = SEQ / CH, NSLOT = 8, LAG = 3;
            LAS unsigned* ring_ready = (LAS unsigned*)(lds + LDSCTL_OFF + 896); LAS unsigned* ring_done = ring_ready + 4;
            constexpr int PK_PA = 0, PK_PR = 2048, PK_QQ = 4096, PK_TT = 5120, PK_GG = 6144, PK_BK = 7168, PK_VT = 11264, PK_WC = 13312, PK_BYTES = 16384;
            const int hd = xcd_i * NSCAN_X + slot_i, b = hd >> 4, h = hd & 15;
            const size_t mbase = (size_t)b * SEQ;
            static_assert((size_t)64 * NCHUNK * PK_BYTES <= 4 * SZ_F1K, "packs fit the four unused f32 [M][1024] buffers at WS_R");
            unsigned char* PACK = ws + WS_R + (size_t)hd * NCHUNK * PK_BYTES;
            const int tr = lane & 15, q = lane >> 4;
            if (wave < 4) {
                const int icol = 16 * wave + tr;
                f32x4 H0 = (f32x4){0.f, 0.f, 0.f, 0.f}, H1 = H0, H2 = H0, H3 = H0;
                bf16x8 A_fa0, A_fa1, A_fr0, A_fr1, A_fq, A_ft, A_fg, A_b0, A_b1, A_b2, A_b3; v2u A_v; f32x4 A_w0, A_w1, A_w2, A_w3;
                bf16x8 B_fa0, B_fa1, B_fr0, B_fr1, B_fq, B_ft, B_fg, B_b0, B_b1, B_b2, B_b3; v2u B_v; f32x4 B_w0, B_w1, B_w2, B_w3;
#define CK_LOAD(P, c_) do { { unsigned sp_ = 0; for (;;) { const v4u rr_ = *(volatile LAS v4u*)ring_ready; const unsigned mn_ = min(min(rr_.x, rr_.y), min(rr_.z, rr_.w)); if (mn_ >= (unsigned)((c_) + 1)) break; __builtin_amdgcn_s_sleep(0); if (++sp_ > (1u << 26)) break; } } asm volatile("" ::: "memory"); \
                    const LAS unsigned char* pk_ = lds + ((c_) & (NSLOT - 1)) * PK_BYTES; \
                    P##_fa0 = *(const LAS bf16x8*)(pk_ + PK_PA + (tr * 64 + 8 * q) * 2); P##_fa1 = *(const LAS bf16x8*)(pk_ + PK_PA + (tr * 64 + 32 + 8 * q) * 2); \
                    P##_fr0 = *(const LAS bf16x8*)(pk_ + PK_PR + (tr * 64 + 8 * q) * 2); P##_fr1 = *(const LAS bf16x8*)(pk_ + PK_PR + (tr * 64 + 32 + 8 * q) * 2); \
                    P##_fq = *(const LAS bf16x8*)(pk_ + PK_QQ + (tr * 4 + q) * 16); P##_ft = *(const LAS bf16x8*)(pk_ + PK_TT + (tr * 4 + q) * 16); P##_fg = *(const LAS bf16x8*)(pk_ + PK_GG + (tr * 4 + q) * 16); \
                    P##_b0 = *(const LAS bf16x8*)(pk_ + PK_BK + ((0 + tr) * 4 + q) * 16); P##_b1 = *(const LAS bf16x8*)(pk_ + PK_BK + ((16 + tr) * 4 + q) * 16); \
                    P##_b2 = *(const LAS bf16x8*)(pk_ + PK_BK + ((32 + tr) * 4 + q) * 16); P##_b3 = *(const LAS bf16x8*)(pk_ + PK_BK + ((48 + tr) * 4 + q) * 16); \
                    P##_v = *(const LAS v2u*)(pk_ + PK_VT + icol * 32 + q * 8); \
                    P##_w0 = *(const LAS f32x4*)(pk_ + PK_WC + (0 + 4 * q) * 4); P##_w1 = *(const LAS f32x4*)(pk_ + PK_WC + (16 + 4 * q) * 4); P##_w2 = *(const LAS f32x4*)(pk_ + PK_WC + (32 + 4 * q) * 4); P##_w3 = *(const LAS f32x4*)(pk_ + PK_WC + (48 + 4 * q) * 4); } while (0)
#define CK_MM(a_, b_, c_) __builtin_amdgcn_mfma_f32_16x16x32_bf16(a_, b_, c_, 0, 0, 0)
#define CK_STEP(P, c_) do { const f32x4 z4 = (f32x4){0.f, 0.f, 0.f, 0.f}; \
                    v4u hb0, hb1; hb0.x = cvt_pk_bf16_nat(H0[0], H0[1]); hb0.y = cvt_pk_bf16_nat(H0[2], H0[3]); hb0.z = cvt_pk_bf16_nat(H1[0], H1[1]); hb0.w = cvt_pk_bf16_nat(H1[2], H1[3]); \
                    hb1.x = cvt_pk_bf16_nat(H2[0], H2[1]); hb1.y = cvt_pk_bf16_nat(H2[2], H2[3]); hb1.z = cvt_pk_bf16_nat(H3[0], H3[1]); hb1.w = cvt_pk_bf16_nat(H3[2], H3[3]); \
                    const bf16x8 Hb0 = __builtin_bit_cast(bf16x8, hb0), Hb1 = __builtin_bit_cast(bf16x8, hb1); \
                    v4u vb_; vb_.x = P##_v.x; vb_.y = P##_v.y; vb_.z = P##_v.x; vb_.w = P##_v.y; const bf16x8 Vb = __builtin_bit_cast(bf16x8, vb_); \
                    f32x4 XQ = CK_MM(P##_fa0, Hb0, z4); XQ = CK_MM(P##_fa1, Hb1, XQ); XQ = CK_MM(P##_fq, Vb, XQ); \
                    v4u xb_; xb_.x = cvt_pk_bf16_nat(XQ[0], XQ[1]); xb_.y = cvt_pk_bf16_nat(XQ[2], XQ[3]); xb_.z = 0u; xb_.w = 0u; \
                    const f32x4 U = CK_MM(P##_ft, __builtin_bit_cast(bf16x8, xb_), z4); \
                    v4u ub_; ub_.x = cvt_pk_bf16_nat(U[0], U[1]); ub_.y = cvt_pk_bf16_nat(U[2], U[3]); ub_.z = P##_v.x; ub_.w = P##_v.y; const bf16x8 UVb = __builtin_bit_cast(bf16x8, ub_); \
                    f32x4 Y = CK_MM(P##_fr0, Hb0, z4); Y = CK_MM(P##_fr1, Hb1, Y); Y = CK_MM(P##_fg, UVb, Y); \
                    H0 = CK_MM(P##_b0, UVb, H0 * P##_w0); H1 = CK_MM(P##_b1, UVb, H1 * P##_w1); H2 = CK_MM(P##_b2, UVb, H2 * P##_w2); H3 = CK_MM(P##_b3, UVb, H3 * P##_w3); \
                    float* yo_ = Yy + (mbase + (size_t)(c_) * CH + 4 * q) * 1024 + h * 64 + icol; \
                    yo_[0] = Y[0]; yo_[1024] = Y[1]; yo_[2048] = Y[2]; yo_[3072] = Y[3]; \
                    asm volatile("s_waitcnt lgkmcnt(0)" ::: "memory"); if (lane == 0) __hip_atomic_fetch_add(ring_done + wave, 1u, __ATOMIC_RELAXED, __HIP_MEMORY_SCOPE_WORKGROUP);     } while (0)
                CK_LOAD(A, 0);
#pragma unroll 1
                for (int c = 0; c < NCHUNK; c += 2) {
                    CK_LOAD(B, c + 1); CK_STEP(A, c);
                    CK_LOAD(A, (c + 2 < NCHUNK ? c + 2 : c)); CK_STEP(B, c + 1);
                }
#undef CK_LOAD
#undef CK_MM
#undef CK_STEP
            } else {
                const int lw = wave - 4;
#pragma unroll 1
                for (int c = 0; c < NCHUNK + LAG; ++c) {
                    if (c < NCHUNK) {
                        if (c >= NSLOT) { const unsigned want = (unsigned)(c - NSLOT + 1); unsigned sp_ = 0;
                            for (;;) { const v4u dd_ = *(volatile LAS v4u*)ring_done; if (min(min(dd_.x, dd_.y), min(dd_.z, dd_.w)) >= want) break; __builtin_amdgcn_s_sleep(0); if (++sp_ > (1u << 26)) break; } }
                        asm volatile("" ::: "memory");
                        const unsigned char* src = PACK + (size_t)c * PK_BYTES + lw * 1024 + lane * 16;
                        LAS unsigned char* dst = lds + (c & (NSLOT - 1)) * PK_BYTES + lw * 1024;
#pragma unroll
                        for (int p = 0; p < 4; ++p) __builtin_amdgcn_global_load_lds((const unsigned*)(src + p * 4096), (LAS unsigned*)(dst + p * 4096), 16, 0, 0);
                    }
                    if (c >= LAG) {
                        if (c < NCHUNK) asm volatile("s_waitcnt vmcnt(12)" ::: "memory"); else asm volatile("s_waitcnt vmcnt(0)" ::: "memory");
                        if (lane == 0) __hip_atomic_fetch_add(ring_ready + lw, 1u, __ATOMIC_RELAXED, __HIP_MEMORY_SCOPE_WORKGROUP);
                    }
                }
            }
        }
#endif
        else for (int crep_ = 0; crep_ < P5_CONV_REPS; ++crep_) {
            LAS float* scr = (LAS float*)(lds + wave * 16640);
            const int cw = (xcd_i * (32 - NSCAN_X) + slot_i - NSCAN_X) * NWAVES + wave;
            constexpr int I1 = (D / 64) * (4096 / 64), I2 = (DFF / 64) * (D / 64), IPE = I1 + I2;
            auto src_of = [&](int it, const float*& Wp, int& N, int& li) { const int e = it / IPE, r = it % IPE; if (r < I1) { Wp = w1 + (size_t)e * D * 4096; N = 4096; li = r; } else { Wp = w2 + (size_t)e * DFF * D; N = D; li = r - I1; } };
            f32x4 va[16], vb2[16];
            constexpr int TOT = NE * IPE, NCW = (NWG - 8 * NSCAN_X) * NWAVES, PER = (TOT + NCW - 1) / NCW;
            int it = cw * PER; const int it_end = (it + PER < TOT) ? it + PER : TOT; const float* Wp; int N, li;
#define CONV_STEP(cur, nxtbuf) { const int itn = it + 1; const float* Wn; int Nn, lin; \
                src_of(itn < it_end ? itn : it, Wn, Nn, lin); tr_load<true>(Wn, Nn, lin, lane, nxtbuf);     \
                { const int e = it / IPE, r = it % IPE; \
                  if (r < I1) tr_store_fp8(cur, D, 4096, W1T, (size_t)e * 4096, scr, li, lane, pg8::W_SCALE); else tr_store_fp8(cur, DFF, D, W2T, (size_t)e * 2048, scr, li, lane, pg8::W_SCALE); } \
                it = itn; li = lin; }
            if (it < it_end) { src_of(it, Wp, N, li); tr_load<true>(Wp, N, li, lane, va);
                for (;;) { CONV_STEP(va, vb2); if (it >= it_end) break; CONV_STEP(vb2, va); if (it >= it_end) break; } }
#undef CONV_STEP
        }
    }
    SEAM(5);

    if (IN(6)) {
        for (int m = gw; m < M; m += NGW) {
            const int t = m % SEQ;
            const float* pr = PROJ + (size_t)m * IN_PAD; const float* pp = pr - IN_PAD; const float* lo = LOUT + (size_t)m * 3072;
#pragma unroll
            for (int q = 0; q < 4; ++q) {
                const int c = 4 * lane + 256 * q; const size_t o = (size_t)m * 1024 + c;
                f32x4 r = *(const GAS f32x4*)(pr + c), k = *(const GAS f32x4*)(pr + 1024 + c), v = *(const GAS f32x4*)(pr + 2048 + c);
                f32x4 rp = (f32x4){0.f, 0.f, 0.f, 0.f}, kp = rp, vp = rp;
                if (t > 0) { rp = *(const GAS f32x4*)(pp + c); kp = *(const GAS f32x4*)(pp + 1024 + c); vp = *(const GAS f32x4*)(pp + 2048 + c); }
                r = r + (rp - r) * *(const GAS f32x4*)(mu + c); k = k + (kp - k) * *(const GAS f32x4*)(mu + 1024 + c); v = v + (vp - v) * *(const GAS f32x4*)(mu + 2048 + c);
                const f32x4 al = *(const GAS f32x4*)(lo + 1024 + c) + *(const GAS f32x4*)(a0 + c);
                f32x4 a;
#pragma unroll
                for (int j = 0; j < 4; ++j) a[j] = 1.0f / (1.0f + __expf(-al[j]));
                const f32x4 k2 = k * (1.0f + (a - 1.0f) * *(const GAS f32x4*)(k_a + c));
                const f32x4 rk = *(const GAS f32x4*)(r_k + c);
                const float bon = row16_sum(r.x * k2.x * rk.x + r.y * k2.y * rk.y + r.z * k2.z * rk.z + r.w * k2.w * rk.w);
                const f32x4 y = *(const GAS f32x4*)(Yy + o);
                const float mean = row16_sum(y.x + y.y + y.z + y.w) * (1.0f / 64.0f);
                const f32x4 d = y - mean;
                const float var = row16_sum(d.x * d.x + d.y * d.y + d.z * d.z + d.w * d.w) * (1.0f / 64.0f);
                const float rstd = __builtin_amdgcn_rsqf(var + GN_EPS);
                f32x4 yn = d * rstd * *(const GAS f32x4*)(lnx_w + c) + *(const GAS f32x4*)(lnx_b + c);
                yn = yn + bon * v;
                yn = yn * *(const GAS f32x4*)(lo + 2048 + c);
                v2u ov; ov.x = pk2(yn.x, yn.y); ov.y = pk2(yn.z, yn.w);
                *(GAS v2u*)(MIXIN + (size_t)m * 2048 + c) = ov;
            }
        }
    }
    SEAM(6);

    if (IN(7)) {
        pg8::Gemm g{MIXIN, WOUTT, D, D}; pg8::GridOrder S; S.init(M / 256, D / 256, G, bx, (size_t)256 * D * 2, 0, (size_t)256 * D * 2);
        pg8::EpiF32 E{MIX, D};
        pg8::gemm_phase<pg8::EpiF32, pg8::GridOrder, true, true>(lds, g, S, E);
    }
    SEAM(7);

    if (IN(8)) {
        LAS float* s_h = (LAS float*)lds;
        LAS float* s_part = (LAS float*)(lds + 65536);
        const int e = tid & 31, part = tid >> 5;
        float wreg[128];
#pragma unroll
        for (int i = 0; i < 128; ++i) wreg[i] = router_w[(size_t)(part * 128 + i) * 32 + e];
        LAS int* lcnt = (LAS int*)(lds + LDSCTL_OFF + 512);
        if (tid < NE) lcnt[tid] = 0;
        __syncthreads();
        for (int m0 = vcu * 8; m0 < M; m0 += G * 8) {
            const int m = m0 + wave;
            {
                f32x4 v[8]; float s = 0.f;
#pragma unroll
                for (int q = 0; q < 8; ++q) { const int c = 4 * lane + 256 * q; v[q] = ALPHA * *(const GAS f32x4*)(x + (size_t)m * D + c) + *(const GAS f32x4*)(MIX + (size_t)m * D + c); s += (v[q].x + v[q].y) + (v[q].z + v[q].w); }
                const float mean = wave_sum(s) * (1.0f / D); float s2 = 0.f;
#pragma unroll
                for (int q = 0; q < 8; ++q) { v[q] = v[q] - mean; s2 += (v[q].x * v[q].x + v[q].y * v[q].y) + (v[q].z * v[q].z + v[q].w * v[q].w); }
                const float rstd = 1.0f / sqrtf(wave_sum(s2) * (1.0f / D) + LN_EPS);
#pragma unroll
                for (int q = 0; q < 8; ++q) { const int c = 4 * lane + 256 * q;
                    const f32x4 hv = v[q] * rstd * *(const GAS f32x4*)(ln1_w + c) + *(const GAS f32x4*)(ln1_b + c);
                    *(GAS f32x4*)(H + (size_t)m * D + c) = hv; *(LAS f32x4*)(s_h + wave * 2048 + c) = hv;
                    *(GAS unsigned*)(HQ + (size_t)m * D + c) = pg8::pk4_fp8(hv.x * pg8::XS_SCALE, hv.y * pg8::XS_SCALE, hv.z * pg8::XS_SCALE, hv.w * pg8::XS_SCALE); }
            }
            __syncthreads();
#pragma unroll 1
            for (int tk = 0; tk < 8; ++tk) {
                const LAS float* hp = s_h + tk * 2048 + part * 128; float acc = 0.f;
#pragma unroll
                for (int i = 0; i < 32; ++i) { const f32x4 hv = *(const LAS f32x4*)(hp + 4 * i); acc += hv.x * wreg[4 * i]; acc += hv.y * wreg[4 * i + 1]; acc += hv.z * wreg[4 * i + 2]; acc += hv.w * wreg[4 * i + 3]; }
                s_part[(tk * 16 + part) * 32 + e] = acc;
            }
            __syncthreads();
            {
                float lg = -3.0e38f;
                if (lane < 32) { lg = router_b[lane];
#pragma unroll
                    for (int p = 0; p < 16; ++p) lg += s_part[(wave * 16 + p) * 32 + lane];
                    lg = (lg == lg) ? fminf(fmaxf(lg, -1.0e30f), 1.0e30f) : -1.0e30f; }
                int idx[4]; float val[4];
#pragma unroll
                for (int k = 0; k < 4; ++k) {
                    float best = lg; int bi = lane;
#pragma unroll
                    for (int o = 1; o < 64; o <<= 1) { const float ob = __shfl_xor(best, o); const int oi = __shfl_xor(bi, o); const bool take = (ob > best) || (ob == best && oi < bi); best = take ? ob : best; bi = take ? oi : bi; }
                    idx[k] = bi; val[k] = best; if (lane == bi) lg = -3.0e38f;
                }
                if (lane == 0) {
                    float ex[4], se = 0.f;
#pragma unroll
                    for (int k = 0; k < 4; ++k) { ex[k] = __expf(val[k] - val[0]); se += ex[k]; }
                    const float inv = 1.0f / se;
#pragma unroll
                    for (int k = 0; k < 4; ++k) { TOPI[m * 4 + k] = idx[k]; GATE[m * 4 + k] = ex[k] * inv; POS[m * 4 + k] = __hip_atomic_fetch_add(lcnt + idx[k], 1, __ATOMIC_RELAXED, __HIP_MEMORY_SCOPE_WORKGROUP); }
                }
            }
            __syncthreads();
        }
        if (tid < NE) CNTWG[vcu * NE + tid] = lcnt[tid];
    }
    SEAM(8);

    if (IN(9) || IN(10) || IN(11)) {
        LAS int* s_t = (LAS int*)lds; LAS int* s_p = s_t + 512;
        LAS int* PSB = (LAS int*)(lds + LDSCTL_OFF + 640);
        { const int e = tid & 31, part = tid >> 5; int tsum = 0, psum = 0;
          for (int w = part * 16; w < part * 16 + 16; ++w) { const int cv = CNTWG[w * NE + e]; tsum += cv; psum += (w < vcu) ? cv : 0; }
          s_t[part * 32 + e] = tsum; s_p[part * 32 + e] = psum; }
        __syncthreads();
        if (tid < NE) { int tsum = 0, psum = 0; for (int p = 0; p < 16; ++p) { tsum += s_t[p * 32 + tid]; psum += s_p[p * 32 + tid]; } s_t[tid] = tsum; PSB[tid] = psum; }
        __syncthreads();
        if (tid == 0) { int acc = 0; for (int e = 0; e < NE; ++e) { PS[e] = acc; acc += (s_t[e] + 255) / 256 * 256; } PS[NE] = acc; }
        __syncthreads();
        if (tid < NE) PSB[tid] += PS[tid];
        __syncthreads();
    }
    if (IN(9)) {
        const LAS int* PSB = (const LAS int*)(lds + LDSCTL_OFF + 640);
        for (int m0 = vcu * 8; m0 < M; m0 += G * 8) {
            const int m = m0 + wave;
            const GAS v4u* src = (const GAS v4u*)(HQ + (size_t)m * D);
            v4u rv[2];
#pragma unroll
            for (int q = 0; q < 2; ++q) rv[q] = src[lane + 64 * q];
#pragma unroll
            for (int k = 0; k < 4; ++k) {
                const int a = m * 4 + k, slot = PSB[TOPI[a]] + POS[a];
                if (lane == 0) { slot_tok[slot] = m; SLOT_OF[a] = slot; }
                GAS v4u* dst = (GAS v4u*)(XS + (size_t)slot * D);
#pragma unroll
                for (int q = 0; q < 2; ++q) dst[lane + 64 * q] = rv[q];
            }
        }
    }
    SEAM(9);

    if (IN(10)) {
        pg8::Gemm g{(const bf16*)XS, (const bf16*)W1T, D / 2, D / 2}; pg8::MoeOrder S; S.ps = PS; S.ntile = 16; S.npan = PS[NE] / 256; S.cprime = vcu; S.a_tstep = (size_t)256 * D; S.b_tstep = (size_t)256 * D;
        pg8::EpiSwiglu E{ACT, b1};
        pg8::gemm_phase<pg8::EpiSwiglu, pg8::MoeOrder, true, true, true>(lds, g, S, E);
    }
    SEAM(10);

    if (IN(11)) {
        pg8::Gemm g{(const bf16*)ACT, (const bf16*)W2T, DFF / 2, DFF / 2}; pg8::MoeOrder S; S.ps = PS; S.ntile = 8; S.npan = PS[NE] / 256; S.cprime = vcu; S.a_tstep = (size_t)256 * DFF; S.b_tstep = (size_t)256 * DFF;
        pg8::EpiBias16 E{YS, b2};
        pg8::gemm_phase<pg8::EpiBias16, pg8::MoeOrder, true, true, true>(lds, g, S, E);
    }
    SEAM(11);

    if (IN(12)) {
        for (int m = gw; m < M; m += NGW) {
            int sl[4]; float gt[4];
#pragma unroll
            for (int k = 0; k < 4; ++k) { sl[k] = SLOT_OF[m * 4 + k]; gt[k] = GATE[m * 4 + k]; }
            f32x4 v[8]; float s = 0.f;
#pragma unroll
            for (int q = 0; q < 8; ++q) { const int c = 4 * lane + 256 * q; f32x4 f = (f32x4){0.f, 0.f, 0.f, 0.f};
#pragma unroll
                for (int k = 0; k < 4; ++k) { const v2u yv = *(const GAS v2u*)(YS + (size_t)sl[k] * D + c); f += gt[k] * (f32x4){bflo(yv.x), bfhi(yv.x), bflo(yv.y), bfhi(yv.y)}; }
                v[q] = ALPHA * *(const GAS f32x4*)(H + (size_t)m * D + c) + f; s += (v[q].x + v[q].y) + (v[q].z + v[q].w); }
            const float mean = wave_sum(s) * (1.0f / D); float s2 = 0.f;
#pragma unroll
            for (int q = 0; q < 8; ++q) { v[q] = v[q] - mean; s2 += (v[q].x * v[q].x + v[q].y * v[q].y) + (v[q].z * v[q].z + v[q].w * v[q].w); }
            const float rstd = 1.0f / sqrtf(wave_sum(s2) * (1.0f / D) + LN_EPS);
#pragma unroll
            for (int q = 0; q < 8; ++q) { const int c = 4 * lane + 256 * q; *(GAS f32x4*)(out + (size_t)m * D + c) = v[q] * rstd * *(const GAS f32x4*)(ln2_w + c) + *(const GAS f32x4*)(ln2_b + c); }
        }
    }
#undef IN
#undef SEAM
}

extern "C" void kernel_launch(void* const* d_in, const int* in_sizes, int n_in, void* d_out, int out_size, void* d_ws, size_t ws_size, hipStream_t stream) {
    static int grid = 0;
    if (grid == 0) {
        if (n_in != 26 || out_size != M * D || ws_size < WS_END) { fprintf(stderr, "kernel_launch: unexpected problem (n_in %d, out %d, ws %zu < %zu)\n", n_in, out_size, ws_size, (size_t)WS_END); grid = -1; return; }
        int dev = 0, cus = 0, per_cu = 0;
        if (hipGetDevice(&dev) != hipSuccess || hipDeviceGetAttribute(&cus, hipDeviceAttributeMultiprocessorCount, dev) != hipSuccess) { grid = -1; return; }
        if (hipFuncSetAttribute((const void*)mk_fwd, hipFuncAttributeMaxDynamicSharedMemorySize, LDS_BYTES) != hipSuccess) { fprintf(stderr, "kernel_launch: hipFuncSetAttribute failed\n"); grid = -1; return; }
        if (hipOccupancyMaxActiveBlocksPerMultiprocessor(&per_cu, (const void*)mk_fwd, NTHR, LDS_BYTES) != hipSuccess || per_cu < 1) fprintf(stderr, "kernel_launch: occupancy query reports %d\n", per_cu);
        (void)hipGetLastError();
        if (cus != NWG) { fprintf(stderr, "kernel_launch: built for %d CUs, device has %d\n", NWG, cus); grid = -1; return; }
        grid = NWG;
    }
    if (grid < 0) return;
    (void)hipMemsetAsync((char*)d_ws + WS_CTL, 0, CTL_BYTES, stream);
    (void)hipMemsetAsync((char*)d_ws + WS_SLOTTOK, 0xFF, (size_t)NSLOT_MAX * 4, stream);
    Args a{};
    for (int i = 0; i < 26; ++i) a.in[i] = (const float*)d_in[i];
    a.out = (float*)d_out; a.ws = (unsigned char*)d_ws; a.dup = DUP_MASK;
    if (MK_N_LAUNCHES == 1) { a.ph_lo = 0; a.ph_hi = NPHASE; hipLaunchKernelGGL(mk_fwd, dim3(grid), dim3(NTHR), LDS_BYTES, stream, a); }
    else { for (int p = 0; p < NPHASE; ++p) for (int rep = 0; rep <= ((DUP_MASK >> p) & 1); ++rep) { a.ph_lo = p; a.ph_hi = p + 1; hipLaunchKernelGGL(mk_fwd, dim3(grid), dim3(NTHR), LDS_BYTES, stream, a); } }
}
```

```cpp
#include <hip/hip_runtime.h>
#include <stdint.h>
#include <stdio.h>

#ifndef P5_SCAN_REPS
#define P5_SCAN_REPS 1
#endif
#ifndef P5_CONV_REPS
#define P5_CONV_REPS 1
#endif
#ifndef P5A_REPS
#define P5A_REPS 1
#endif
#ifndef P5B_REPS
#define P5B_REPS 1
#endif
#ifndef SCAN_CHUNKED
#define SCAN_CHUNKED 1
#endif
#ifndef DUP_MASK
#define DUP_MASK 0
#endif
#ifndef MK_N_LAUNCHES
#define MK_N_LAUNCHES 1
#endif

constexpr int D = 2048, BATCH = 4, SEQ = 4096, M = BATCH * SEQ;
constexpr int RW = 1024, PW = 1024, NH = 16;
constexpr int SHIFT_W = 3360, IN_COLS = 4384, IN_PAD = 4608;
constexpr int LK = 384;
constexpr int NE = 32, DFF = 2048;
constexpr int NASG = M * 4;
constexpr int NSLOT_MAX = NASG + NE * 256;
constexpr float LN_EPS = 1e-5f, GN_EPS = 64e-5f;
constexpr float ALPHA = 1.189207115002721f;
constexpr int NWG = 256, NWAVES = 8, NTHR = 512;
constexpr int NPHASE = 13;

#define GAS __attribute__((address_space(1)))
#define LAS __attribute__((address_space(3)))
typedef unsigned short bf16;
typedef unsigned v4u __attribute__((ext_vector_type(4)));
typedef unsigned v2u __attribute__((ext_vector_type(2)));
typedef float f32x4 __attribute__((ext_vector_type(4)));
typedef short bf16x8 __attribute__((ext_vector_type(8)));
typedef GAS unsigned gu32;
#define RLX_AGENT __ATOMIC_RELAXED, __HIP_MEMORY_SCOPE_AGENT
#define LDS_WAIT() asm volatile("s_waitcnt lgkmcnt(0)" ::: "memory")
#define VM_WAIT() asm volatile("s_waitcnt vmcnt(0)" ::: "memory")

__device__ __forceinline__ unsigned f2bf(float f) { unsigned u = __builtin_bit_cast(unsigned, f); return (u + 0x7fffu + ((u >> 16) & 1u)) >> 16; }
__device__ __forceinline__ unsigned pk2(float lo, float hi) { return f2bf(lo) | (f2bf(hi) << 16); }
__device__ __forceinline__ float bflo(unsigned w) { return __builtin_bit_cast(float, w << 16); }
__device__ __forceinline__ float bfhi(unsigned w) { return __builtin_bit_cast(float, w & 0xffff0000u); }
__device__ __forceinline__ float wave_sum(float v) {
#pragma unroll
    for (int o = 1; o < 64; o <<= 1) v += __shfl_xor(v, o);
    return v;
}
typedef float f32x2n __attribute__((ext_vector_type(2)));
typedef __bf16 bf16x2n __attribute__((ext_vector_type(2)));
__device__ __forceinline__ unsigned cvt_pk_bf16_nat(float lo, float hi) { const f32x2n v = {lo, hi}; return __builtin_bit_cast(unsigned, __builtin_convertvector(v, bf16x2n)); }
__device__ __forceinline__ float fast_sigmoid(float x) { return __builtin_amdgcn_rcpf(1.0f + __builtin_amdgcn_exp2f(-1.4426950408889634f * x)); }
__device__ __forceinline__ float fast_decay(float wl) { const float z = -wl; const float sp = fmaxf(z, 0.f) + 0.6931471805599453f * __builtin_amdgcn_logf(1.0f + __builtin_amdgcn_exp2f(-1.4426950408889634f * fabsf(z)));
    return __builtin_amdgcn_exp2f(-1.4426950408889634f * __builtin_amdgcn_exp2f(-1.4426950408889634f * (sp + 0.5f))); }
template <int CTRL> __device__ __forceinline__ float dpp_mov(float x) { return __builtin_bit_cast(float, __builtin_amdgcn_update_dpp(0, __builtin_bit_cast(int, x), CTRL, 0xF, 0xF, true)); }
__device__ __forceinline__ float row16_sum(float x) {
    x += dpp_mov<0xB1>(x);
    x += dpp_mov<0x4E>(x);
    x += dpp_mov<0x141>(x);
    x += dpp_mov<0x140>(x);
    return x;
}

__device__ __forceinline__ float wave_sum_dpp(float x) {
    x = row16_sum(x);
    x += __builtin_bit_cast(float, __builtin_amdgcn_update_dpp(0, __builtin_bit_cast(int, x), 0x142, 0xA, 0xF, false));
    x += __builtin_bit_cast(float, __builtin_amdgcn_update_dpp(0, __builtin_bit_cast(int, x), 0x143, 0xC, 0xF, false));
    return __builtin_bit_cast(float, __builtin_amdgcn_readlane(__builtin_bit_cast(int, x), 63));
}

namespace pg8 {
typedef unsigned short bf16_t;
typedef unsigned u32x4 __attribute__((ext_vector_type(4)));
typedef int v4i_t __attribute__((ext_vector_type(4)));
typedef int v8i_t __attribute__((ext_vector_type(8)));
constexpr int BM = 256, BK = 64, HALF = 128, HTB = HALF * BK * 2, STAGE_BYTES = 8 * HTB, NXCD = 8, WGM = 8;
__host__ __device__ __forceinline__ int lds_byte(int r, int c) { const int st = (r >> 4) * 2 + (c >> 5), rr = r & 15, cc = c & 31, ob = rr * 64 + cc * 2; return st * 1024 + (ob ^ (((ob >> 9) & 1) << 5)); }
__host__ __device__ __forceinline__ void stage_rc(int b, int& R, int& C) { const int st = b / 1024, sb = b % 1024, swz = sb ^ (((sb >> 9) & 1) << 5); R = (st >> 1) * 16 + swz / 64; C = (st & 1) * 32 + (swz % 64) / 2; }
__host__ __device__ __forceinline__ int perm32(int rho) { const int n = rho >> 4, i = rho & 15; return 8 * (i >> 2) + 4 * n + (i & 3); }
struct Unit { int pm, pn; };
struct Gemm { const bf16_t* A; const bf16_t* Bt; int lda, K; };
__device__ __forceinline__ unsigned cvt_pk_bf16(float lo, float hi) { unsigned r; asm volatile("v_cvt_pk_bf16_f32 %0, %1, %2" : "=v"(r) : "v"(lo), "v"(hi)); return r; }

struct GridOrder {
    int nM, nN, nwg, G, c; size_t a_tstep, a_pnstep, b_tstep;
    __device__ void init(int nM_, int nN_, int G_, int c_, size_t a_tstep_, size_t a_pnstep_, size_t b_tstep_) { nM = nM_; nN = nN_; nwg = nM * nN; G = G_; c = c_; a_tstep = a_tstep_; a_pnstep = a_pnstep_; b_tstep = b_tstep_; }
    __device__ bool next(int i, Unit& u) const {
        const long L = (long)i * G + c; if (L >= nwg) return false;
        int wgid = (int)L; { const int q = nwg / NXCD, r = nwg % NXCD, xcd = wgid % NXCD, off = wgid / NXCD; wgid = (xcd < r ? xcd * (q + 1) : r * (q + 1) + (xcd - r) * q) + off; }
        const int nig = WGM * nN, gid = wgid / nig, fm = gid * WGM, gsz = (nM - fm) < WGM ? (nM - fm) : WGM;
        u.pm = fm + ((wgid % nig) % gsz); u.pn = (wgid % nig) / gsz; return true;
    }
    __device__ __forceinline__ size_t aoff(const Unit& u) const { return (size_t)u.pm * a_tstep + (size_t)u.pn * a_pnstep; }
    __device__ __forceinline__ size_t boff(const Unit& u) const { return (size_t)u.pn * b_tstep; }
};
struct MoeOrder {
    const LAS int* ps; int ntile, npan, cprime; size_t a_tstep, b_tstep;
    __device__ bool next(int i, Unit& u) const {
        const int U = i * NWG + cprime; const int p = U / ntile; if (p >= npan) return false;
        const int row = p * 256; int e = 0;
#pragma unroll 1
        for (int q = 1; q < NE; ++q) e = (row >= ps[q]) ? q : e;
        u.pm = p; u.pn = e * ntile + (U % ntile); return true;
    }
    __device__ __forceinline__ size_t aoff(const Unit& u) const { return (size_t)u.pm * a_tstep; }
    __device__ __forceinline__ size_t boff(const Unit& u) const { return (size_t)u.pn * b_tstep; }
};

template <class Epi, class Sched, bool ALIGN_EPI, bool SP2, bool FP8 = false>
__device__ __forceinline__ void gemm_phase(LAS unsigned char* lds, const Gemm g, const Sched& S, const Epi& E) {
    int tid_ = threadIdx.x; asm volatile("" : "+v"(tid_));
    const int tid = tid_, wid = __builtin_amdgcn_readfirstlane(tid >> 6), lane = tid & 63, wr = wid >> 2, wc = wid & 3, fr = lane & 15, fq = lane >> 4;
    const int K = g.K, nt = K / BK;
    unsigned voffA[2], voffB[2];
#pragma unroll
    for (int i = 0; i < 2; ++i) { int R, C; stage_rc(tid * 16 + i * 8192, R, C); const int Rb = Epi::PERM ? ((R & ~31) + perm32(R & 31)) : R;
        voffA[i] = (unsigned)(R * g.lda + C) * 2u; voffB[i] = (unsigned)(Rb * K + C) * 2u; }
    const size_t kstep = (size_t)(BK * 2);
    const size_t hstepA = (size_t)HALF * g.lda * 2, hstepB = (size_t)HALF * K * 2;
    const unsigned ldsw = (unsigned)wid * 1024u;
    const int aoff = lds_byte(wr * 64 + fr, fq * 8), boff = lds_byte(wc * 32 + fr, fq * 8);
#define PG8_SA(b, h) (((b) * 2 + (h)) * HTB)
#define PG8_SB(b, h) ((4 + (b) * 2 + (h)) * HTB)
#define PG8_STAGE(bufoff, gbase, voff) do { _Pragma("unroll") for (int _i = 0; _i < 2; ++_i) \
        __builtin_amdgcn_global_load_lds((const unsigned*)((const char*)(gbase) + (voff)[_i]), (LAS unsigned*)(lds + (bufoff) + ldsw + _i * 8192), 16, 0, 0); } while (0)
#define PG8_LDA(dst, b, h) do { _Pragma("unroll") for (int m = 0; m < 4; ++m) { if constexpr (FP8) { const v4i_t l_ = *(const LAS v4i_t*)(lds + PG8_SA(b, h) + aoff + m * 2048), h_ = *(const LAS v4i_t*)(lds + PG8_SA(b, h) + aoff + m * 2048 + 1024); dst##8[m] = __builtin_shufflevector(l_, h_, 0, 1, 2, 3, 4, 5, 6, 7); } \
        else { _Pragma("unroll") for (int k = 0; k < 2; ++k) dst[m][k] = *(const LAS bf16x8*)(lds + PG8_SA(b, h) + aoff + m * 2048 + k * 1024); } } } while (0)
#define PG8_LDB(dst, b, h) do { _Pragma("unroll") for (int n = 0; n < 2; ++n) { if constexpr (FP8) { const v4i_t l_ = *(const LAS v4i_t*)(lds + PG8_SB(b, h) + boff + n * 2048), h_ = *(const LAS v4i_t*)(lds + PG8_SB(b, h) + boff + n * 2048 + 1024); dst##8[n] = __builtin_shufflevector(l_, h_, 0, 1, 2, 3, 4, 5, 6, 7); } \
        else { _Pragma("unroll") for (int k = 0; k < 2; ++k) dst[n][k] = *(const LAS bf16x8*)(lds + PG8_SB(b, h) + boff + n * 2048 + k * 1024); } } } while (0)
#define PG8_MMA(ai, bj, At, Bt) do { __builtin_amdgcn_s_setprio(1); _Pragma("unroll") for (int m = 0; m < 4; ++m) _Pragma("unroll") for (int n = 0; n < 2; ++n) { \
        if constexpr (FP8) asm volatile("v_mfma_scale_f32_16x16x128_f8f6f4 %0, %1, %2, %0, %3, %3 op_sel_hi:[0,0,0]" : "+v"(acc[ai][bj][m][n]) : "v"(Bt##8[n]), "v"(At##8[m]), "v"(scale1_)); \
        else { _Pragma("unroll") for (int k = 0; k < 2; ++k) acc[ai][bj][m][n] = __builtin_amdgcn_mfma_f32_16x16x32_bf16(Bt[n][k], At[m][k], acc[ai][bj][m][n], 0, 0, 0); } } \
        __builtin_amdgcn_s_setprio(0); } while (0)
#define PG8_WAIT_V(n) asm volatile("s_waitcnt vmcnt(" #n ")" ::: "memory")
#define PG8_WAIT_L(n) asm volatile("s_waitcnt lgkmcnt(" #n ")" ::: "memory")
#define PG8_BAR __builtin_amdgcn_s_barrier()
#define PG8_SCHED __builtin_amdgcn_sched_barrier(0)
    Unit cur, nxt; int ui = 0;
    if (!S.next(0, cur)) return;
    f32x4 acc[2][2][4][2];
#pragma unroll
    for (int a = 0; a < 2; ++a)
#pragma unroll
        for (int b = 0; b < 2; ++b)
#pragma unroll
            for (int m = 0; m < 4; ++m)
#pragma unroll
                for (int n = 0; n < 2; ++n) acc[a][b][m][n] = (f32x4){0.f, 0.f, 0.f, 0.f};
    int scale1_ = 0x7F7F7F7F; asm volatile("" : "+v"(scale1_));
    bf16x8 At[4][2], B0[2][2], B1[2][2];
    v8i_t At8[4], B08[2], B18[2];
    const char* cA = (const char*)g.A + S.aoff(cur); const char* cB = (const char*)g.Bt + S.boff(cur);
    if constexpr (SP2) {
        PG8_STAGE(PG8_SB(0, 0), cB, voffB); PG8_STAGE(PG8_SB(0, 1), cB + hstepB, voffB); PG8_STAGE(PG8_SA(0, 0), cA, voffA); PG8_STAGE(PG8_SA(0, 1), cA + hstepA, voffA);
        if (wr == 1) PG8_BAR;
        PG8_WAIT_V(2); PG8_BAR;
        PG8_STAGE(PG8_SB(1, 0), cB + kstep, voffB); PG8_STAGE(PG8_SA(1, 0), cA + kstep, voffA); PG8_STAGE(PG8_SB(1, 1), cB + hstepB + kstep, voffB);
        PG8_WAIT_V(6); PG8_BAR;
    } else {
        PG8_STAGE(PG8_SB(0, 0), cB, voffB); PG8_STAGE(PG8_SA(0, 0), cA, voffA); PG8_STAGE(PG8_SB(0, 1), cB + hstepB, voffB); PG8_STAGE(PG8_SA(0, 1), cA + hstepA, voffA);
        if (wr == 1) PG8_BAR;
        PG8_WAIT_V(4); PG8_BAR;
        PG8_STAGE(PG8_SB(1, 0), cB + kstep, voffB); PG8_STAGE(PG8_SA(1, 0), cA + kstep, voffA); PG8_STAGE(PG8_SB(1, 1), cB + hstepB + kstep, voffB);
        PG8_WAIT_V(6); PG8_BAR;
    }
    for (;;) {
        const bool has_next = S.next(ui + 1, nxt);
        const char* nA = has_next ? (const char*)g.A + S.aoff(nxt) : cA; const char* nB = has_next ? (const char*)g.Bt + S.boff(nxt) : cB;
#pragma unroll 1
        for (int t = 0; t < nt; t += 2) {
            const bool last = (t == nt - 2);
            const char* a1 = cA + (size_t)(t + 1) * kstep;
            const char* a2 = last ? nA : cA + (size_t)(t + 2) * kstep; const char* b2 = last ? nB : cB + (size_t)(t + 2) * kstep;
            const char* a3 = a2 + kstep; const char* b3 = b2 + kstep;
            if constexpr (SP2) {
            PG8_LDB(B0, 0, 0); PG8_LDB(B1, 0, 1); PG8_SCHED; PG8_LDA(At, 0, 0); PG8_STAGE(PG8_SA(1, 1), a1 + hstepA, voffA);
            PG8_WAIT_V(8); PG8_WAIT_L(0); PG8_BAR; PG8_MMA(0, 0, At, B0); PG8_MMA(0, 1, At, B1); PG8_BAR; PG8_SCHED;
            PG8_LDA(At, 0, 1); PG8_STAGE(PG8_SB(0, 0), b2, voffB); PG8_STAGE(PG8_SB(0, 1), b2 + hstepB, voffB); PG8_STAGE(PG8_SA(0, 0), a2, voffA);
            PG8_WAIT_V(8); PG8_WAIT_L(0); PG8_BAR; PG8_MMA(1, 0, At, B0); PG8_MMA(1, 1, At, B1); PG8_BAR; PG8_SCHED;
            PG8_LDB(B0, 1, 0); PG8_LDB(B1, 1, 1); PG8_SCHED; PG8_LDA(At, 1, 0); PG8_STAGE(PG8_SA(0, 1), a2 + hstepA, voffA);
            PG8_WAIT_V(8); PG8_WAIT_L(0); PG8_BAR; PG8_MMA(0, 0, At, B0); PG8_MMA(0, 1, At, B1); PG8_BAR; PG8_SCHED;
            PG8_LDA(At, 1, 1); PG8_STAGE(PG8_SB(1, 0), b3, voffB); PG8_STAGE(PG8_SB(1, 1), b3 + hstepB, voffB); PG8_STAGE(PG8_SA(1, 0), a3, voffA);
            PG8_WAIT_V(8); PG8_WAIT_L(0); PG8_BAR; PG8_MMA(1, 0, At, B0); PG8_MMA(1, 1, At, B1); PG8_BAR; PG8_SCHED;
            } else {
            PG8_LDB(B0, 0, 0); PG8_SCHED; PG8_LDA(At, 0, 0); PG8_STAGE(PG8_SA(1, 1), a1 + hstepA, voffA);
            PG8_WAIT_L(8); PG8_BAR; PG8_WAIT_L(0); PG8_MMA(0, 0, At, B0); PG8_BAR; PG8_SCHED;
            PG8_LDB(B1, 0, 1); PG8_STAGE(PG8_SB(0, 0), b2, voffB);
            PG8_BAR; PG8_WAIT_L(0); PG8_MMA(0, 1, At, B1); PG8_BAR;
            PG8_LDA(At, 0, 1); PG8_STAGE(PG8_SA(0, 0), a2, voffA);
            PG8_BAR; PG8_WAIT_L(0); PG8_MMA(1, 0, At, B0); PG8_BAR; PG8_SCHED;
            PG8_STAGE(PG8_SB(0, 1), b2 + hstepB, voffB);
            PG8_WAIT_V(6); PG8_BAR; PG8_MMA(1, 1, At, B1); PG8_BAR;
            PG8_LDB(B0, 1, 0); PG8_SCHED; PG8_LDA(At, 1, 0); PG8_STAGE(PG8_SA(0, 1), a2 + hstepA, voffA);
            PG8_WAIT_L(8); PG8_BAR; PG8_WAIT_L(0); PG8_MMA(0, 0, At, B0); PG8_BAR; PG8_SCHED;
            PG8_LDB(B1, 1, 1); PG8_STAGE(PG8_SB(1, 0), b3, voffB);
            PG8_BAR; PG8_WAIT_L(0); PG8_MMA(0, 1, At, B1); PG8_BAR;
            PG8_LDA(At, 1, 1); PG8_STAGE(PG8_SA(1, 0), a3, voffA);
            PG8_BAR; PG8_WAIT_L(0); PG8_MMA(1, 0, At, B0); PG8_BAR; PG8_SCHED;
            PG8_STAGE(PG8_SB(1, 1), b3 + hstepB, voffB);
            PG8_WAIT_V(6); PG8_BAR; PG8_MMA(1, 1, At, B1); PG8_BAR;
            }
        }
        if constexpr (ALIGN_EPI) { if (wr == 0) PG8_BAR; }
        if constexpr (FP8) asm volatile("s_nop 15\n\ts_nop 15" ::: "memory");
        E(acc, cur, wr, wc, fr, fq);
        if (!has_next) break;
#pragma unroll
        for (int a = 0; a < 2; ++a)
#pragma unroll
            for (int b = 0; b < 2; ++b)
#pragma unroll
                for (int m = 0; m < 4; ++m)
#pragma unroll
                    for (int n = 0; n < 2; ++n) acc[a][b][m][n] = (f32x4){0.f, 0.f, 0.f, 0.f};
        cur = nxt; cA = nA; cB = nB; ++ui;
        if constexpr (ALIGN_EPI) { if (wr == 1) PG8_BAR; }
    }
    PG8_WAIT_V(0);
    if constexpr (!ALIGN_EPI) { if (wr == 0) PG8_BAR; }
    PG8_BAR;
#undef PG8_SA
#undef PG8_SB
#undef PG8_STAGE
#undef PG8_LDA
#undef PG8_LDB
#undef PG8_MMA
#undef PG8_WAIT_V
#undef PG8_WAIT_L
#undef PG8_BAR
#undef PG8_SCHED
}

struct EpiF32 {
    static constexpr bool PERM = false;
    float* C; int ldc;
    __device__ __forceinline__ void operator()(const f32x4 (&acc)[2][2][4][2], const Unit& u, int wr, int wc, int fr, int fq) const {
        const int row0 = u.pm * BM + wr * 64 + fr, col0 = u.pn * BM + wc * 32 + 4 * fq;
#pragma unroll
        for (int ai = 0; ai < 2; ++ai)
#pragma unroll
            for (int m = 0; m < 4; ++m) { float* rowp = C + (size_t)(row0 + ai * HALF + m * 16) * ldc + col0;
#pragma unroll
                for (int bj = 0; bj < 2; ++bj)
#pragma unroll
                    for (int n = 0; n < 2; ++n) *(f32x4*)(rowp + bj * HALF + n * 16) = acc[ai][bj][m][n]; }
    }
};
struct EpiBf16Plain {
    static constexpr bool PERM = true;
    bf16_t* O; int ldc;
    __device__ __forceinline__ void operator()(const f32x4 (&acc)[2][2][4][2], const Unit& u, int wr, int wc, int fr, int fq) const {
        const int row0 = u.pm * BM + wr * 64 + fr, col0 = u.pn * BM + wc * 32 + 8 * fq;
#pragma unroll
        for (int ai = 0; ai < 2; ++ai)
#pragma unroll
            for (int m = 0; m < 4; ++m) { bf16_t* rowp = O + (size_t)(row0 + ai * HALF + m * 16) * ldc + col0;
#pragma unroll
                for (int bj = 0; bj < 2; ++bj) { const f32x4 v0 = acc[ai][bj][m][0], v1 = acc[ai][bj][m][1];
                    u32x4 w; w.x = cvt_pk_bf16(v0[0], v0[1]); w.y = cvt_pk_bf16(v0[2], v0[3]); w.z = cvt_pk_bf16(v1[0], v1[1]); w.w = cvt_pk_bf16(v1[2], v1[3]);
                    *(u32x4*)(rowp + bj * HALF) = w; } }
    }
};
struct EpiPool {
    static constexpr bool PERM = true;
    bf16_t* O; const float* scale;
    __device__ __forceinline__ void operator()(const f32x4 (&acc)[2][2][4][2], const Unit& u, int wr, int wc, int fr, int fq) const {
        const int row0 = u.pm * BM + wr * 64 + fr; int col0 = u.pn * BM + wc * 32 + 8 * fq;
        asm volatile("" : "+v"(col0));
        f32x4 sv[2][2];
#pragma unroll
        for (int bj = 0; bj < 2; ++bj)
#pragma unroll
            for (int n = 0; n < 2; ++n) sv[bj][n] = *(const f32x4*)(scale + col0 + bj * HALF + 4 * n);
#pragma unroll
        for (int ai = 0; ai < 2; ++ai)
#pragma unroll
            for (int m = 0; m < 4; ++m) { bf16_t* rowp = O + (size_t)(row0 + ai * HALF + m * 16) * 2048 + 1024 + col0;
#pragma unroll
                for (int bj = 0; bj < 2; ++bj) { const f32x4 v0 = acc[ai][bj][m][0] * sv[bj][0], v1 = acc[ai][bj][m][1] * sv[bj][1];
                    u32x4 w; w.x = cvt_pk_bf16(v0[0], v0[1]); w.y = cvt_pk_bf16(v0[2], v0[3]); w.z = cvt_pk_bf16(v1[0], v1[1]); w.w = cvt_pk_bf16(v1[2], v1[3]);
                    *(u32x4*)(rowp + bj * HALF) = w; } }
    }
};
constexpr float XS_SCALE = 8.0f, W_SCALE = 256.0f, ACT_SCALE = 8.0f, DESCALE = 1.0f / 2048.0f;
__device__ __forceinline__ unsigned pk4_fp8(float a, float b, float c, float d) {
    a = fminf(fmaxf(a, -448.f), 448.f); b = fminf(fmaxf(b, -448.f), 448.f); c = fminf(fmaxf(c, -448.f), 448.f); d = fminf(fmaxf(d, -448.f), 448.f);
    int w = 0; w = __builtin_amdgcn_cvt_pk_fp8_f32(a, b, w, false); w = __builtin_amdgcn_cvt_pk_fp8_f32(c, d, w, true); return (unsigned)w;
}
struct EpiSwiglu {
    static constexpr bool PERM = true;
    unsigned char* O; const float* b1;
    __device__ __forceinline__ void operator()(const f32x4 (&acc)[2][2][4][2], const Unit& u, int wr, int wc, int fr, int fq) const {
        const int e = u.pn >> 4, nt = u.pn & 15;
        const int row0 = u.pm * BM + wr * 64 + fr; int col0 = nt * BM + wc * 32 + 8 * fq;
        asm volatile("" : "+v"(col0));
        const float* bp = b1 + (size_t)e * 4096 + col0;
        f32x4 bv[2][2];
#pragma unroll
        for (int bj = 0; bj < 2; ++bj)
#pragma unroll
            for (int n = 0; n < 2; ++n) bv[bj][n] = *(const f32x4*)(bp + bj * HALF + 4 * n);
#pragma unroll
        for (int ai = 0; ai < 2; ++ai)
#pragma unroll
            for (int m = 0; m < 4; ++m) { unsigned char* rowp = O + (size_t)(row0 + ai * HALF + m * 16) * 2048 + (col0 >> 1);
#pragma unroll
                for (int bj = 0; bj < 2; ++bj) { const f32x4 v0 = acc[ai][bj][m][0] * DESCALE + bv[bj][0], v1 = acc[ai][bj][m][1] * DESCALE + bv[bj][1];
                    float a[4];
#pragma unroll
                    for (int p = 0; p < 4; ++p) { const float hg = p < 2 ? v0[2 * p] : v1[2 * p - 4], hl = p < 2 ? v0[2 * p + 1] : v1[2 * p - 3];
                        const float xg = fminf(hg, 7.0f), xl = fminf(fmaxf(hl, -7.0f), 7.0f);
                        a[p] = xg * __builtin_amdgcn_rcpf(1.0f + __expf(-1.702f * xg)) * (xl + 1.0f) * ACT_SCALE; }
                    *(unsigned*)(rowp + bj * (HALF / 2)) = pk4_fp8(a[0], a[1], a[2], a[3]); } }
    }
};
struct EpiBias16 {
    static constexpr bool PERM = true;
    bf16_t* O; const float* b2;
    __device__ __forceinline__ void operator()(const f32x4 (&acc)[2][2][4][2], const Unit& u, int wr, int wc, int fr, int fq) const {
        const int e = u.pn >> 3, nt = u.pn & 7;
        const int row0 = u.pm * BM + wr * 64 + fr; int col0 = nt * BM + wc * 32 + 8 * fq;
        asm volatile("" : "+v"(col0));
        const float* bp = b2 + (size_t)e * 2048 + col0;
        f32x4 bv[2][2];
#pragma unroll
        for (int bj = 0; bj < 2; ++bj)
#pragma unroll
            for (int n = 0; n < 2; ++n) bv[bj][n] = *(const f32x4*)(bp + bj * HALF + 4 * n);
#pragma unroll
        for (int ai = 0; ai < 2; ++ai)
#pragma unroll
            for (int m = 0; m < 4; ++m) { bf16_t* rowp = O + (size_t)(row0 + ai * HALF + m * 16) * 2048 + col0;
#pragma unroll
                for (int bj = 0; bj < 2; ++bj) { const f32x4 v0 = acc[ai][bj][m][0] * DESCALE + bv[bj][0], v1 = acc[ai][bj][m][1] * DESCALE + bv[bj][1];
                    u32x4 w; w.x = cvt_pk_bf16(v0[0], v0[1]); w.y = cvt_pk_bf16(v0[2], v0[3]); w.z = cvt_pk_bf16(v1[0], v1[1]); w.w = cvt_pk_bf16(v1[2], v1[3]);
                    *(u32x4*)(rowp + bj * HALF) = w; } }
    }
};
}

#define XB_TMO      128
#define XB_XCNT(j)  (256  + 64 * (j))
#define XB_XSUB(j)  (1280 + 64 * (j))
#define XB_XGEN(j)  (2304 + 64 * (j))
#define XB_TOP      3328
#define XB_TOPGEN   3392
#define XCD_BAR_WORDS 3456
#define XB_SPIN_CAP (1u << 22)
__device__ __forceinline__ unsigned xb_ld(unsigned* p)              { return __hip_atomic_load(p, __ATOMIC_RELAXED, __HIP_MEMORY_SCOPE_AGENT); }
__device__ __forceinline__ unsigned xb_add(unsigned* p, unsigned v) { return __hip_atomic_fetch_add(p, v, __ATOMIC_RELAXED, __HIP_MEMORY_SCOPE_AGENT); }
__device__ __forceinline__ unsigned xb_xcc_id() { return (unsigned)__builtin_amdgcn_s_getreg((3 << 11) | 20) & 0xFu; }
#define XB_SPIN(cond, bar) do { unsigned _sp = 0; while (cond) { __builtin_amdgcn_s_sleep(1); \
    if ((++_sp & 255u) == 0u) { if (xb_ld(&(bar)[XB_TMO])) break; if (_sp > XB_SPIN_CAP) { atomicAdd(&(bar)[XB_TMO], 1u); break; } } } } while (0)
struct XcdBarrier { unsigned* bar; unsigned x; volatile LAS unsigned* st; };
__device__ __forceinline__ XcdBarrier xcd_barrier_post(unsigned* bar, volatile LAS unsigned* st) {
    XcdBarrier b; b.bar = bar; b.x = xb_xcc_id(); b.st = st;
    if (threadIdx.x == 0) (void)xb_add(&bar[XB_XCNT(b.x)], 1u);
    return b;
}
__device__ __forceinline__ void xcd_barrier_complete(unsigned* bar, unsigned x, unsigned& nloc, unsigned& nx) {
    const unsigned G = gridDim.x * gridDim.y * gridDim.z;
    unsigned sum, cnt, mine, sp = 0u;
    for (;;) {
        sum = 0u; cnt = 0u; mine = 0u;
#pragma unroll
        for (unsigned j = 0; j < 16; ++j) { const unsigned c = xb_ld(&bar[XB_XCNT(j)]); sum += c; cnt += (c > 0u) ? 1u : 0u; mine = (j == x) ? c : mine; }
        if (sum == G) break;
        __builtin_amdgcn_s_sleep(1);
        if ((++sp & 255u) == 0u) { if (xb_ld(&bar[XB_TMO])) break; if (sp > XB_SPIN_CAP) { atomicAdd(&bar[XB_TMO], 1u); break; } }
    }
    nloc = mine > 0u ? mine : 1u; nx = cnt > 0u ? cnt : 1u;
}
__device__ __forceinline__ void xcd_barrier(const XcdBarrier& b) {
    asm volatile("s_waitcnt vmcnt(0)" ::: "memory");
    __syncthreads();
    if (threadIdx.x == 0) {
        unsigned* bar = b.bar;
        __builtin_amdgcn_s_waitcnt(0);
        unsigned nloc = b.st[0], nx = b.st[1];
        if (nloc == 0u) { xcd_barrier_complete(bar, b.x, nloc, nx); b.st[0] = nloc; b.st[1] = nx; }
        const unsigned old = xb_add(&bar[XB_XSUB(b.x)], 1u);
        const unsigned gen = old / nloc;
        if (old + 1u == (gen + 1u) * nloc) {
            __builtin_amdgcn_fence(__ATOMIC_RELEASE, "agent");
            asm volatile("s_waitcnt vmcnt(0)" ::: "memory");
            const unsigned og = xb_add(&bar[XB_TOP], 1u);
            const unsigned tg = og / nx;
            if (og + 1u == (tg + 1u) * nx) xb_add(&bar[XB_TOPGEN], 1u);
            else XB_SPIN(xb_ld(&bar[XB_TOPGEN]) == tg, bar);
            __builtin_amdgcn_fence(__ATOMIC_ACQUIRE, "agent");
            xb_add(&bar[XB_XGEN(b.x)], 1u);
            asm volatile("s_waitcnt vmcnt(0)" ::: "memory");
        } else {
            XB_SPIN(xb_ld(&bar[XB_XGEN(b.x)]) == gen, bar);
            __builtin_amdgcn_fence(__ATOMIC_ACQUIRE, "agent");
            asm volatile("s_waitcnt vmcnt(0)" ::: "memory");
        }
    }
    __syncthreads();
}

constexpr size_t al256(size_t x) { return (x + 255) & ~(size_t)255; }
constexpr size_t WS_CTL = 0, CTL_BYTES = 1u << 20;
constexpr int CW_BAR = 4096;
constexpr int CW_CNT = 16384;
constexpr size_t WS_SLOTTOK = WS_CTL + CTL_BYTES;
constexpr size_t WS_TOPI = WS_SLOTTOK + al256((size_t)NSLOT_MAX * 4);
constexpr size_t WS_GATE = WS_TOPI + (size_t)NASG * 4;
constexpr size_t WS_POS = WS_GATE + (size_t)NASG * 4;
constexpr size_t WS_SLOTOF = WS_POS + (size_t)NASG * 4;
constexpr size_t WS_BONUS = WS_SLOTOF + (size_t)NASG * 4;
constexpr size_t WS_XB = WS_BONUS + (size_t)M * 16 * 4;
constexpr size_t WS_WINT = WS_XB + (size_t)M * D * 2;
constexpr size_t WS_WOUTT = WS_WINT + (size_t)IN_PAD * D * 2;
constexpr size_t WS_LORAT = WS_WOUTT + (size_t)D * D * 2;
constexpr size_t WS_WPOOLT = WS_LORAT + (size_t)3072 * LK * 2;
constexpr size_t WS_PROJ = WS_WPOOLT + (size_t)1024 * 256 * 2;
constexpr size_t WS_LIN = WS_PROJ + (size_t)M * IN_PAD * 4;
constexpr size_t WS_POOLED = WS_LIN + (size_t)M * LK * 2;
constexpr size_t WS_WDEC = WS_POOLED + (size_t)M * 1024 * 2;
constexpr size_t SZ_F1K = (size_t)M * 1024 * 4;
constexpr size_t WS_LOUT = WS_WDEC + SZ_F1K  , WS_R = WS_LOUT + 3 * SZ_F1K, WS_K2 = WS_R + SZ_F1K, WS_V = WS_K2 + SZ_F1K, WS_KK = WS_V + SZ_F1K, WS_BB = WS_KK + SZ_F1K, WS_Y = WS_BB + SZ_F1K;
constexpr size_t WS_MIXIN = WS_Y + SZ_F1K;
constexpr size_t WS_MIX = WS_MIXIN + (size_t)M * D * 2;
constexpr size_t WS_H = WS_MIX + (size_t)M * D * 4;
constexpr size_t WS_HB = WS_H + (size_t)M * D * 4;
constexpr size_t WS_XS = WS_HB + (size_t)M * D;
constexpr size_t WS_W1T = WS_XS + (size_t)NSLOT_MAX * D;
constexpr size_t WS_W2T = WS_W1T + (size_t)NE * 4096 * D;
constexpr size_t WS_ACT = WS_W2T + (size_t)NE * 2048 * DFF;
constexpr size_t WS_YS = WS_ACT + (size_t)NSLOT_MAX * DFF;
constexpr size_t WS_END = WS_YS + (size_t)NSLOT_MAX * D * 2;

constexpr int RING_BYTES = 131072;
constexpr int LDSCTL_OFF = 159744;
constexpr int LDS_BYTES = 163840;

struct Args { const float* in[26]; float* out; unsigned char* ws; int ph_lo, ph_hi, dup, pad; };

template <bool KFAST = false> __device__ __forceinline__ void tr_load(const float* W, int N, int item, int lane, f32x4 (&v)[16]) {
    const int nblk = N / 64, kb = KFAST ? (item & 31) : item / nblk, nb = KFAST ? (item >> 5) : item % nblk, k0 = 64 * kb, n0 = 64 * nb;
    const int r = lane >> 4, c4 = (lane & 15) * 4;
#pragma unroll
    for (int i = 0; i < 16; ++i) v[i] = *(const GAS f32x4*)(W + (size_t)(k0 + 4 * i + r) * N + n0 + c4);
}
__device__ __forceinline__ void tr_store(const f32x4 (&v)[16], int K, int N, bf16* WT, size_t row_off, LAS float* scr, int item, int lane) {
    const int nblk = N / 64, kb = item / nblk, nb = item % nblk, k0 = 64 * kb, n0 = 64 * nb;
    const int r = lane >> 4, c4 = (lane & 15) * 4;
#pragma unroll
    for (int i = 0; i < 16; ++i) { LAS float* d = scr + (4 * i + r) * 65 + c4; d[0] = v[i].x; d[1] = v[i].y; d[2] = v[i].z; d[3] = v[i].w; }
    LDS_WAIT(); asm volatile("" ::: "memory");
    const int c = lane & 7;
#pragma unroll
    for (int p = 0; p < 8; ++p) { const int n = (lane >> 3) + 8 * p; const LAS float* q = scr + (8 * c) * 65 + n;
        v4u o; o.x = pk2(q[0 * 65], q[1 * 65]); o.y = pk2(q[2 * 65], q[3 * 65]); o.z = pk2(q[4 * 65], q[5 * 65]); o.w = pk2(q[6 * 65], q[7 * 65]);
        *(GAS v4u*)(WT + (row_off + n0 + n) * (size_t)K + k0 + 8 * c) = o; }
    LDS_WAIT(); asm volatile("" ::: "memory");
}
__device__ __forceinline__ unsigned pk4_fp8_nc(float a, float b, float c, float d) { int w = 0; w = __builtin_amdgcn_cvt_pk_fp8_f32(a, b, w, false); w = __builtin_amdgcn_cvt_pk_fp8_f32(c, d, w, true); return (unsigned)w; }
__device__ __forceinline__ void tr_store_fp8(const f32x4 (&v)[16], int K, int N, unsigned char* WT, size_t row_off, LAS float* scr, int item, int lane, float scale) {
    const int nblk = N / 64, kb = item / nblk, nb = item % nblk, k0 = 64 * kb, n0 = 64 * nb;
    const int r = lane >> 4, c4 = (lane & 15) * 4;
#pragma unroll
    for (int i = 0; i < 16; ++i) { const int k = 4 * i + r; *(LAS f32x4*)(scr + k * 64 + (c4 ^ (8 * (i >> 2)))) = v[i] * scale; }
    LDS_WAIT(); asm volatile("" ::: "memory");
    const int c = lane & 3;
#pragma unroll
    for (int p = 0; p < 4; ++p) { const int n = (lane >> 2) + 16 * p; const LAS float* q = scr + (16 * c) * 64 + (n ^ (8 * c));
        float f[16];
#pragma unroll
        for (int jj = 0; jj < 16; ++jj) f[jj] = q[jj * 64];
        v4u o; o.x = pk4_fp8_nc(f[0], f[1], f[2], f[3]); o.y = pk4_fp8_nc(f[4], f[5], f[6], f[7]); o.z = pk4_fp8_nc(f[8], f[9], f[10], f[11]); o.w = pk4_fp8_nc(f[12], f[13], f[14], f[15]);
        *(GAS v4u*)(WT + (row_off + n0 + n) * (size_t)K + k0 + 16 * c) = o; }
    LDS_WAIT(); asm volatile("" ::: "memory");
}
__device__ __forceinline__ void transpose_item(const float* W, int K, int N, bf16* WT, size_t row_off, LAS float* scr, int item, int lane) {
    f32x4 v[16]; tr_load(W, N, item, lane, v); tr_store(v, K, N, WT, row_off, scr, item, lane);
}

__global__ void __launch_bounds__(NTHR, 2) mk_fwd(Args args) {
    extern __shared__ __attribute__((aligned(16))) unsigned char lds_raw[];
    LAS unsigned char* lds = (LAS unsigned char*)lds_raw;
    volatile LAS unsigned* MISC = (volatile LAS unsigned*)(lds + LDSCTL_OFF);
    LAS int* PS = (LAS int*)(lds + LDSCTL_OFF + 256);
    const int tid = threadIdx.x, lane = tid & 63, wave = __builtin_amdgcn_readfirstlane(tid >> 6);
    const int G = gridDim.x, bx = blockIdx.x;
    const int vcu = (bx % 8) * (G / 8) + bx / 8;
    const int gw = vcu * NWAVES + wave, NGW = G * NWAVES;
    unsigned char* ws = args.ws;
    gu32* ctl = (gu32*)(ws + WS_CTL);
    const float* x = args.in[0]; const float* w_in = args.in[1]; const float* mu = args.in[2]; const float* w0 = args.in[3]; const float* w2d = args.in[4];
    const float* a0 = args.in[5]; const float* a2 = args.in[6]; const float* g2 = args.in[7]; const float* k_k = args.in[8]; const float* k_a = args.in[9];
    const float* r_k = args.in[10]; const float* lnx_w = args.in[11]; const float* lnx_b = args.in[12]; const float* w_pool = args.in[13]; const float* pool_scale = args.in[14];
    const float* w_out = args.in[15]; const float* ln1_w = args.in[16]; const float* ln1_b = args.in[17]; const float* router_w = args.in[18]; const float* router_b = args.in[19];
    const float* w1 = args.in[20]; const float* b1 = args.in[21]; const float* w2 = args.in[22]; const float* b2 = args.in[23]; const float* ln2_w = args.in[24]; const float* ln2_b = args.in[25];
    float* out = args.out;
    int* CNTWG = (int*)(ws + WS_CTL) + CW_CNT;
    int* slot_tok = (int*)(ws + WS_SLOTTOK); int* TOPI = (int*)(ws + WS_TOPI); float* GATE = (float*)(ws + WS_GATE); int* POS = (int*)(ws + WS_POS); int* SLOT_OF = (int*)(ws + WS_SLOTOF);
    float* BONUS = (float*)(ws + WS_BONUS);
    bf16* XB = (bf16*)(ws + WS_XB); bf16* WINT = (bf16*)(ws + WS_WINT); bf16* WOUTT = (bf16*)(ws + WS_WOUTT); bf16* LORAT = (bf16*)(ws + WS_LORAT); bf16* WPOOLT = (bf16*)(ws + WS_WPOOLT);
    float* PROJ = (float*)(ws + WS_PROJ); bf16* LIN = (bf16*)(ws + WS_LIN); bf16* POOLED = (bf16*)(ws + WS_POOLED);
    float* WDEC = (float*)(ws + WS_WDEC); float* LOUT = (float*)(ws + WS_LOUT); float* Rr = (float*)(ws + WS_R); float* K2 = (float*)(ws + WS_K2);
    float* Vv = (float*)(ws + WS_V); float* KK = (float*)(ws + WS_KK); float* BB = (float*)(ws + WS_BB); float* Yy = (float*)(ws + WS_Y);
    bf16* MIXIN = (bf16*)(ws + WS_MIXIN); bf16* MIX = (bf16*)(ws + WS_MIX); bf16* H = (bf16*)(ws + WS_H); unsigned char* HQ = (unsigned char*)(ws + WS_HB);
    unsigned char* XS = ws + WS_XS; unsigned char* W1T = ws + WS_W1T; unsigned char* W2T = ws + WS_W2T; unsigned char* ACT = ws + WS_ACT; bf16* YS = (bf16*)(ws + WS_YS);

    for (int u = tid; u < (LDS_BYTES - LDSCTL_OFF) / 4; u += NTHR) ((LAS unsigned*)(lds + LDSCTL_OFF))[u] = 0u;
    __syncthreads();
    XcdBarrier bar; bar.bar = (unsigned*)(ctl + CW_BAR); bar.x = 0; bar.st = nullptr;
    if (MK_N_LAUNCHES == 1) bar = xcd_barrier_post((unsigned*)(ctl + CW_BAR), MISC + 8);
    const int lo = args.ph_lo, hi = args.ph_hi;
#ifndef PHASE_MASK
#define PHASE_MASK 0xFFFF
#endif
#define IN(k) (((PHASE_MASK >> (k)) & 1) && lo <= (k) && (k) < hi)
#define SEAM(k) do { if (IN(k) && IN((k) + 1)) xcd_barrier(bar); } while (0)

    if (IN(0)) {
        LAS float* scr = (LAS float*)(lds + wave * 16640);
        for (size_t i = (size_t)gw * 64 + lane; i < (size_t)M * D / 8; i += (size_t)NGW * 64) {
            const f32x4 a = *(const GAS f32x4*)(x + i * 8), b = *(const GAS f32x4*)(x + i * 8 + 4);
            v4u o; o.x = pk2(a.x, a.y); o.y = pk2(a.z, a.w); o.z = pk2(b.x, b.y); o.w = pk2(b.z, b.w);
            *(GAS v4u*)(XB + i * 8) = o;
        }
        constexpr int I_IN = (D / 64) * (IN_COLS / 64)  , I_OUT = (D / 64) * (D / 64);
        for (int it = gw; it < I_IN + I_OUT; it += NGW) {
            if (it < I_IN) transpose_item(w_in, D, IN_COLS, WINT, 0, scr, it, lane);
            else transpose_item(w_out, D, D, WOUTT, 0, scr, it - I_IN, lane);
        }
        for (int i = gw * 64 + lane; i < 32 * D; i += NGW * 64) { const int nn = 4352 + (i >> 11), k = i & 2047; WINT[(size_t)nn * D + k] = (bf16)f2bf(w_in[(size_t)k * IN_COLS + nn]); }
        for (size_t i = (size_t)gw * 64 + lane; i < (size_t)(IN_PAD - IN_COLS) * D / 8; i += (size_t)NGW * 64) *(GAS v4u*)(WINT + (size_t)IN_COLS * D + i * 8) = (v4u){0u, 0u, 0u, 0u};
        for (int i = gw * 64 + lane; i < 3072 * LK; i += NGW * 64) {
            const int n = i / LK, k = i % LK; float v = 0.f;
            if (n < 1024) { if (k < 64) v = w2d[k * 1024 + n]; }
            else if (n < 2048) { if (k >= 64 && k < 128) v = a2[(k - 64) * 1024 + (n - 1024)]; }
            else { if (k >= 128 && k < 288) v = g2[(k - 128) * 1024 + (n - 2048)]; }
            LORAT[i] = (bf16)f2bf(v);
        }
        for (int i = gw * 64 + lane; i < 1024 * 256; i += NGW * 64) {
            const int n = i >> 8, c = i & 255, g = n >> 8, d = n & 255;
            WPOOLT[i] = (bf16)f2bf(w_pool[((size_t)g * 256 + c) * 256 + d]);
        }
    }
    SEAM(0);

    if (IN(1)) {
        pg8::Gemm g{XB, WINT, D, D}; pg8::GridOrder S; S.init(M / 256, IN_PAD / 256, G, bx, (size_t)256 * D * 2, 0, (size_t)256 * D * 2);
        pg8::EpiF32 E{PROJ, IN_PAD};
        pg8::gemm_phase<pg8::EpiF32, pg8::GridOrder, true, true>(lds, g, S, E);
    }
    SEAM(1);

    if (IN(2)) {
        for (int m = gw; m < M; m += NGW) {
            const int t = m % SEQ;
            const float* pr = PROJ + (size_t)m * IN_PAD; const float* pp = pr - IN_PAD;
#pragma unroll
            for (int q = 0; q < 6; ++q) {
                const int i = lane + 64 * q; float v = 0.f;
                if (i < 288) { const int c = 3072 + i; const float cur = pr[c], prev = t > 0 ? pp[c] : 0.f; const float s = cur + (prev - cur) * mu[c];
                    v = i < 64 ? tanhf(s) : (i < 128 ? s : 1.0f / (1.0f + __expf(-s))); }
                LIN[(size_t)m * LK + i] = (bf16)f2bf(v);
            }
#pragma unroll
            for (int q = 0; q < 4; ++q) {
                const int c = 4 * lane + 256 * q, win = 2 << q; const int n = (t + 1) < win ? (t + 1) : win;
                const f32x4 cur = *(const GAS f32x4*)(pr + SHIFT_W + c); f32x4 sum = cur;
                for (int s = 1; s < n; ++s) sum += *(const GAS f32x4*)(pr - (size_t)s * IN_PAD + SHIFT_W + c);
                const float inv = 1.0f / (float)n; const f32x4 pv = sum * inv - cur;
                v2u o; o.x = pk2(pv.x, pv.y); o.y = pk2(pv.z, pv.w);
                *(GAS v2u*)(POOLED + (size_t)m * 1024 + c) = o;
            }
        }
    }
    SEAM(2);

    if (IN(3)) {
#ifndef NO_LORA
        { pg8::Gemm g{LIN, LORAT, LK, LK}; pg8::GridOrder S; S.init(M / 256, 12, G, bx, (size_t)256 * LK * 2, 0, (size_t)256 * LK * 2);
          pg8::EpiF32 E{LOUT, 3072};
          pg8::gemm_phase<pg8::EpiF32, pg8::GridOrder, true, true>(lds, g, S, E); }
#endif
#ifndef NO_POOL
        { pg8::Gemm g{POOLED, WPOOLT, 1024, 256}; pg8::GridOrder S; S.init(M / 256, 4, G, bx, (size_t)256 * 1024 * 2, (size_t)256 * 2, (size_t)256 * 256 * 2);
          pg8::EpiPool E{MIXIN, pool_scale};
          pg8::gemm_phase<pg8::EpiPool, pg8::GridOrder, true, true>(lds, g, S, E); }
#endif
    }
    SEAM(3);

#if SCAN_CHUNKED
    if (IN(4)) {
        constexpr int CH = 16, NCHUNK = SEQ / CH;
        constexpr int PK_PA = 0, PK_PR = 2048, PK_QQ = 4096, PK_TT = 5120, PK_GG = 6144, PK_BK = 7168, PK_VT = 11264, PK_WC = 13312, PK_BYTES = 16384;
        const int tr = lane & 15, q = lane >> 4;
        for (int arep_ = 0; arep_ < P5A_REPS; ++arep_) {
                const int j = lane;
                LAS bf16* IMG = (LAS bf16*)(lds + wave * 10240);
                LAS float* PTs = (LAS float*)(lds + wave * 10240 + 9216);
                const int pos = (j & 32) | ((j & 12) << 1) | ((j & 16) >> 2) | (j & 3);
#pragma unroll 1
                for (int u = gw; u < 64 * NCHUNK; u += NGW) {
                    const int hd = u >> 8, c = u & 255, b = hd >> 4, h = hd & 15, cj = h * 64 + j;
                    const float mu_r = mu[cj], mu_k = mu[1024 + cj], mu_v = mu[2048 + cj], c_w0 = w0[cj], c_a0 = a0[cj], c_kk = k_k[cj], c_ka = k_a[cj];
                    unsigned char* pk = ws + WS_R + ((size_t)hd * NCHUNK + c) * PK_BYTES;
                    const size_t m0 = (size_t)b * SEQ + (size_t)c * CH;
                    float At[16], Rt[16], Bt[16], Kt[16], Vt[16];
                    float Wc = 1.f, pr_r = 0.f, pr_k = 0.f, pr_v = 0.f;
                    if (c > 0) { const float* pp = PROJ + (m0 - 1) * IN_PAD + cj; pr_r = pp[0]; pr_k = pp[1024]; pr_v = pp[2048]; }
#pragma unroll
                    for (int t = 0; t < 16; ++t) {
                        const float* prow = PROJ + (m0 + t) * IN_PAD + cj; const float* lrow = LOUT + (m0 + t) * 3072 + cj;
                        const float cr = prow[0], ck = prow[1024], cv = prow[2048], wl = lrow[0] + c_w0, al = lrow[1024] + c_a0;
                        const float r = cr + (pr_r - cr) * mu_r, k = ck + (pr_k - ck) * mu_k, v = cv + (pr_v - cv) * mu_v;
                        pr_r = cr; pr_k = ck; pr_v = cv;
                        const float dec = fast_decay(wl), a = fast_sigmoid(al);
                        float kk = k * c_kk; const float ss = wave_sum_dpp(kk * kk); kk = kk * __builtin_amdgcn_rsqf(fmaxf(ss, 1e-24f));
                        const float k2 = k * (1.0f + (a - 1.0f) * c_ka), bb = kk * a;
                        const float Wprev = Wc; Wc = Wc * dec; const float iw = __builtin_amdgcn_rcpf(Wc);
                        At[t] = -kk * Wprev; Rt[t] = r * Wc; Bt[t] = bb * iw; Kt[t] = k2 * iw; Vt[t] = v;
                    }
#pragma unroll
                    for (int t = 0; t < 16; ++t) {
                        const bf16 ab = (bf16)f2bf(At[t]), rb = (bf16)f2bf(Rt[t]);
                        IMG[0 * 1152 + t * 72 + j] = ab; IMG[1 * 1152 + t * 72 + j] = rb; IMG[2 * 1152 + t * 72 + j] = (bf16)f2bf(Bt[t]); IMG[3 * 1152 + t * 72 + j] = (bf16)f2bf(Kt[t]);
                        ((GAS bf16*)(pk + PK_PA))[t * 64 + pos] = ab; ((GAS bf16*)(pk + PK_PR))[t * 64 + pos] = rb;
                    }
#pragma unroll
                    for (int qq = 0; qq < 4; ++qq) { v4u o; o.x = pk2(Bt[4 * qq] * Wc, Bt[4 * qq + 1] * Wc); o.y = pk2(Bt[4 * qq + 2] * Wc, Bt[4 * qq + 3] * Wc); o.z = pk2(Kt[4 * qq] * Wc, Kt[4 * qq + 1] * Wc); o.w = pk2(Kt[4 * qq + 2] * Wc, Kt[4 * qq + 3] * Wc);
                        *(GAS v4u*)(pk + PK_BK + j * 64 + qq * 16) = o; }
#pragma unroll
                    for (int g = 0; g < 2; ++g) { v4u o; o.x = pk2(Vt[8 * g], Vt[8 * g + 1]); o.y = pk2(Vt[8 * g + 2], Vt[8 * g + 3]); o.z = pk2(Vt[8 * g + 4], Vt[8 * g + 5]); o.w = pk2(Vt[8 * g + 6], Vt[8 * g + 7]);
                        *(GAS v4u*)(pk + PK_VT + j * 32 + g * 16) = o; }
                    ((GAS float*)(pk + PK_WC))[j] = Wc;
                    asm volatile("s_waitcnt lgkmcnt(0)" ::: "memory");
                    const bf16x8 fa0 = *(const LAS bf16x8*)(IMG + 0 * 1152 + tr * 72 + 8 * q), fa1 = *(const LAS bf16x8*)(IMG + 0 * 1152 + tr * 72 + 32 + 8 * q);
                    const bf16x8 fr0 = *(const LAS bf16x8*)(IMG + 1 * 1152 + tr * 72 + 8 * q), fr1 = *(const LAS bf16x8*)(IMG + 1 * 1152 + tr * 72 + 32 + 8 * q);
                    const bf16x8 fb0 = *(const LAS bf16x8*)(IMG + 2 * 1152 + tr * 72 + 8 * q), fb1 = *(const LAS bf16x8*)(IMG + 2 * 1152 + tr * 72 + 32 + 8 * q);
                    const bf16x8 fk0 = *(const LAS bf16x8*)(IMG + 3 * 1152 + tr * 72 + 8 * q), fk1 = *(const LAS bf16x8*)(IMG + 3 * 1152 + tr * 72 + 32 + 8 * q);
                    const f32x4 z4 = (f32x4){0.f, 0.f, 0.f, 0.f};
                    f32x4 PT = __builtin_amdgcn_mfma_f32_16x16x32_bf16(fa0, fb0, z4, 0, 0, 0); PT = __builtin_amdgcn_mfma_f32_16x16x32_bf16(fa1, fb1, PT, 0, 0, 0);
                    f32x4 QT = __builtin_amdgcn_mfma_f32_16x16x32_bf16(fa0, fk0, z4, 0, 0, 0); QT = __builtin_amdgcn_mfma_f32_16x16x32_bf16(fa1, fk1, QT, 0, 0, 0);
                    f32x4 GB = __builtin_amdgcn_mfma_f32_16x16x32_bf16(fr0, fb0, z4, 0, 0, 0); GB = __builtin_amdgcn_mfma_f32_16x16x32_bf16(fr1, fb1, GB, 0, 0, 0);
                    f32x4 GK = __builtin_amdgcn_mfma_f32_16x16x32_bf16(fr0, fk0, z4, 0, 0, 0); GK = __builtin_amdgcn_mfma_f32_16x16x32_bf16(fr1, fk1, GK, 0, 0, 0);
                    const int s_ = tr, rec = (s_ >> 2) * 8 + (s_ & 3);
#pragma unroll
                    for (int e = 0; e < 4; ++e) { const int t = 4 * q + e;
                        const float pv = s_ < t ? PT[e] : 0.f, qv = s_ < t ? QT[e] : 0.f, gb = s_ <= t ? GB[e] : 0.f, gk = s_ <= t ? GK[e] : 0.f;
                        PTs[t * 16 + s_] = pv;
                        ((GAS bf16*)(pk + PK_QQ))[t * 32 + rec] = (bf16)f2bf(qv); ((GAS bf16*)(pk + PK_QQ))[t * 32 + rec + 4] = (bf16)0;
                        ((GAS bf16*)(pk + PK_GG))[t * 32 + rec] = (bf16)f2bf(gb); ((GAS bf16*)(pk + PK_GG))[t * 32 + rec + 4] = (bf16)f2bf(gk); }
                    asm volatile("s_waitcnt lgkmcnt(0)" ::: "memory");
                    float Tr[16];
#pragma unroll
                    for (int t = 0; t < 16; ++t) { float acc = (t == s_) ? 1.f : 0.f;
#pragma unroll
                        for (int r4_ = 0; r4_ < (t + 3) / 4; ++r4_) { const f32x4 pr4 = *(const LAS f32x4*)(PTs + t * 16 + 4 * r4_);
#pragma unroll
                            for (int e = 0; e < 4; ++e) if (4 * r4_ + e < t) acc += pr4[e] * Tr[4 * r4_ + e]; }
                        Tr[t] = acc; }
                    if (q == 0) {
#pragma unroll
                        for (int t = 0; t < 16; ++t) { ((GAS bf16*)(pk + PK_TT))[t * 32 + rec] = (bf16)f2bf(Tr[t]); ((GAS bf16*)(pk + PK_TT))[t * 32 + rec + 4] = (bf16)0; } }
                    asm volatile("s_waitcnt lgkmcnt(0)" ::: "memory");
                }
            }
    }
#endif
    SEAM(4);

    if (IN(5)) {
        constexpr int P5_OPS = 0, P5_VV = 81920, P5_YW = 90112, P5_SC = 98304;
        const int xcd_i = bx % 8, slot_i = bx / 8;
        constexpr int NSCAN_X = SCAN_CHUNKED ? 8 : 16;
#if !SCAN_CHUNKED
        if (slot_i < 16) for (int srep_ = 0; srep_ < P5_SCAN_REPS; ++srep_) {
            const int sid = xcd_i * 16 + slot_i, hd = sid >> 1, half = sid & 1, b = hd >> 4, h = hd & 15;
            LAS float* OPS = (LAS float*)(lds + P5_OPS); LAS float* VVs = (LAS float*)(lds + P5_VV); LAS float* YBs = (LAS float*)(lds + P5_YW);
            const int r4 = lane >> 4, jq = lane & 15;
            const int st = tid;
            const int stt = st >> 4, sj = h * 64 + (st & 15) * 4;
            const int vtt = st >> 3, vi = h * 64 + half * 32 + (st & 7) * 4;
            const f32x4 mu_r = *(const GAS f32x4*)(mu + sj), mu_k = *(const GAS f32x4*)(mu + 1024 + sj), mu_v = *(const GAS f32x4*)(mu + 2048 + vi);
            const f32x4 c_w0 = *(const GAS f32x4*)(w0 + sj), c_a0 = *(const GAS f32x4*)(a0 + sj), c_kk = *(const GAS f32x4*)(k_k + sj), c_ka = *(const GAS f32x4*)(k_a + sj);
            const size_t mbase = (size_t)b * SEQ;
            f32x4 g_r, g_k, g_rp, g_kp, g_wl, g_al, g_v, g_vp;
#define P5_LOAD(c_) do { { const int t_ = (c_) * 32 + stt; const float* pr_ = PROJ + (mbase + t_) * IN_PAD; const float* lo_ = LOUT + (mbase + t_) * 3072; \
                g_r = *(const GAS f32x4*)(pr_ + sj); g_k = *(const GAS f32x4*)(pr_ + 1024 + sj); g_wl = *(const GAS f32x4*)(lo_ + sj); g_al = *(const GAS f32x4*)(lo_ + 1024 + sj); \
                if (t_ > 0) { g_rp = *(const GAS f32x4*)(pr_ - IN_PAD + sj); g_kp = *(const GAS f32x4*)(pr_ - IN_PAD + 1024 + sj); } else { g_rp = (f32x4){0.f, 0.f, 0.f, 0.f}; g_kp = g_rp; } } \
            if (st < 256) { const int t_ = (c_) * 32 + vtt; const float* pr_ = PROJ + (mbase + t_) * IN_PAD; g_v = *(const GAS f32x4*)(pr_ + 2048 + vi); g_vp = t_ > 0 ? *(const GAS f32x4*)(pr_ - IN_PAD + 2048 + vi) : (f32x4){0.f, 0.f, 0.f, 0.f}; } } while (0)
#define P5_STORE(nb_) do { { const int tt_ = stt; \
                const f32x4 r_ = g_r + (g_rp - g_r) * mu_r, k_ = g_k + (g_kp - g_k) * mu_k; const f32x4 wl_ = g_wl + c_w0, al_ = g_al + c_a0; f32x4 a_, dec_; \
                _Pragma("unroll") for (int j_ = 0; j_ < 4; ++j_) { dec_[j_] = fast_decay(wl_[j_]); a_[j_] = fast_sigmoid(al_[j_]); } \
                f32x4 kk_ = k_ * c_kk; const float ss_ = row16_sum(kk_.x * kk_.x + kk_.y * kk_.y + kk_.z * kk_.z + kk_.w * kk_.w); kk_ = kk_ * __builtin_amdgcn_rsqf(fmaxf(ss_, 1e-24f)); \
                const f32x4 k2_ = k_ * (1.0f + (a_ - 1.0f) * c_ka), bb_ = kk_ * a_; LAS float* o_ = OPS + (nb_) * (5 * 32 * 64) + tt_ * 64 + (st & 15) * 4; \
                *(LAS f32x4*)(o_ + 0 * 2048) = kk_; *(LAS f32x4*)(o_ + 1 * 2048) = dec_; *(LAS f32x4*)(o_ + 2 * 2048) = bb_; *(LAS f32x4*)(o_ + 3 * 2048) = k2_; *(LAS f32x4*)(o_ + 4 * 2048) = r_; } \
            if (st < 256) *(LAS f32x4*)(VVs + (nb_) * 1024 + vtt * 32 + (st & 7) * 4) = g_v + (g_vp - g_v) * mu_v; } while (0)
            P5_LOAD(0); P5_STORE(0);
            __syncthreads();
            float S0 = 0.f, S1 = 0.f, S2 = 0.f, S3 = 0.f;
            for (int c = 0; c < SEQ / 32; ++c) {
                const int buf = c & 1;
                if (c + 1 < SEQ / 32) P5_LOAD(c + 1);
                const LAS float* ob = OPS + buf * (5 * 32 * 64) + 4 * jq;
                const LAS float* vb = VVs + buf * 1024 + 4 * wave + r4;
                LAS float* yb = YBs + buf * 1024 + 4 * wave + r4;
                f32x4 a4 = *(const LAS f32x4*)(ob + (0 * 32) * 64), w4 = *(const LAS f32x4*)(ob + (1 * 32) * 64), b4 = *(const LAS f32x4*)(ob + (2 * 32) * 64),
                      k4 = *(const LAS f32x4*)(ob + (3 * 32) * 64), q4 = *(const LAS f32x4*)(ob + (4 * 32) * 64);
                float v = vb[0];
#pragma unroll
                for (int t = 0; t < 32; ++t) {
                    f32x4 a4n = a4, w4n = w4, b4n = b4, k4n = k4, q4n = q4; float vn = v;
                    if (t + 1 < 32) { a4n = *(const LAS f32x4*)(ob + (0 * 32 + t + 1) * 64); w4n = *(const LAS f32x4*)(ob + (1 * 32 + t + 1) * 64); b4n = *(const LAS f32x4*)(ob + (2 * 32 + t + 1) * 64);
                                      k4n = *(const LAS f32x4*)(ob + (3 * 32 + t + 1) * 64); q4n = *(const LAS f32x4*)(ob + (4 * 32 + t + 1) * 64); vn = vb[(t + 1) * 32]; }
                    float p = S0 * a4.x; p += S1 * a4.y; p += S2 * a4.z; p += S3 * a4.w;
                    const float sa = -row16_sum(p);
                    S0 = S0 * w4.x + (sa * b4.x + v * k4.x); S1 = S1 * w4.y + (sa * b4.y + v * k4.y); S2 = S2 * w4.z + (sa * b4.z + v * k4.z); S3 = S3 * w4.w + (sa * b4.w + v * k4.w);
                    float y = S0 * q4.x; y += S1 * q4.y; y += S2 * q4.z; y += S3 * q4.w;
                    yb[t * 32] = row16_sum(y);
                    a4 = a4n; w4 = w4n; b4 = b4n; k4 = k4n; q4 = q4n; v = vn;
                }
                if (c + 1 < SEQ / 32) P5_STORE(buf ^ 1);
                __syncthreads();
                if (tid < 256) *(GAS f32x4*)(Yy + (mbase + c * 32 + vtt) * 1024 + vi) = *(const LAS f32x4*)(YBs + buf * 1024 + vtt * 32 + (st & 7) * 4);
            }
#undef P5_LOAD
#undef P5_STORE
        }
#else
        if (slot_i < NSCAN_X) {
            constexpr int CH = 16, NCHUNK = SEQ / CH, NSLOT = 8, LAG = 3;
            LAS unsigned* ring_ready = (LAS unsigned*)(lds + LDSCTL_OFF + 896); LAS unsigned* ring_done = ring_ready + 4;
            constexpr int PK_PA = 0, PK_PR = 2048, PK_QQ = 4096, PK_TT = 5120, PK_GG = 6144, PK_BK = 7168, PK_VT = 11264, PK_WC = 13312, PK_BYTES = 16384;
            const int hd = xcd_i * NSCAN_X + slot_i, b = hd >> 4, h = hd & 15;
            const size_t mbase = (size_t)b * SEQ;
            static_assert((size_t)64 * NCHUNK * PK_BYTES <= 4 * SZ_F1K, "packs fit the four unused f32 [M][1024] buffers at WS_R");
            unsigned char* PACK = ws + WS_R + (size_t)hd * NCHUNK * PK_BYTES;
            const int tr = lane & 15, q = lane >> 4;
            if (wave < 4) {
                const int icol = 16 * wave + tr;
                f32x4 H0 = (f32x4){0.f, 0.f, 0.f, 0.f}, H1 = H0, H2 = H0, H3 = H0;
                bf16x8 A_fa0, A_fa1, A_fr0, A_fr1, A_fq, A_ft, A_fg, A_b0, A_b1, A_b2, A_b3; v2u A_v; f32x4 A_w0, A_w1, A_w2, A_w3;
                bf16x8 B_fa0, B_fa1, B_fr0, B_fr1, B_fq, B_ft, B_fg, B_b0, B_b1, B_b2, B_b3; v2u B_v; f32x4 B_w0, B_w1, B_w2, B_w3;
#define CK_LOAD(P, c_) do { { unsigned sp_ = 0; for (;;) { const v4u rr_ = *(volatile LAS v4u*)ring_ready; const unsigned mn_ = min(min(rr_.x, rr_.y), min(rr_.z, rr_.w)); if (mn_ >= (unsigned)((c_) + 1)) break; __builtin_amdgcn_s_sleep(0); if (++sp_ > (1u << 26)) break; } } asm volatile("" ::: "memory"); \
                    const LAS unsigned char* pk_ = lds + ((c_) & (NSLOT - 1)) * PK_BYTES; \
                    P##_fa0 = *(const LAS bf16x8*)(pk_ + PK_PA + (tr * 64 + 8 * q) * 2); P##_fa1 = *(const LAS bf16x8*)(pk_ + PK_PA + (tr * 64 + 32 + 8 * q) * 2); \
                    P##_fr0 = *(const LAS bf16x8*)(pk_ + PK_PR + (tr * 64 + 8 * q) * 2); P##_fr1 = *(const LAS bf16x8*)(pk_ + PK_PR + (tr * 64 + 32 + 8 * q) * 2); \
                    P##_fq = *(const LAS bf16x8*)(pk_ + PK_QQ + (tr * 4 + q) * 16); P##_ft = *(const LAS bf16x8*)(pk_ + PK_TT + (tr * 4 + q) * 16); P##_fg = *(const LAS bf16x8*)(pk_ + PK_GG + (tr * 4 + q) * 16); \
                    P##_b0 = *(const LAS bf16x8*)(pk_ + PK_BK + ((0 + tr) * 4 + q) * 16); P##_b1 = *(const LAS bf16x8*)(pk_ + PK_BK + ((16 + tr) * 4 + q) * 16); \
                    P##_b2 = *(const LAS bf16x8*)(pk_ + PK_BK + ((32 + tr) * 4 + q) * 16); P##_b3 = *(const LAS bf16x8*)(pk_ + PK_BK + ((48 + tr) * 4 + q) * 16); \
                    P##_v = *(const LAS v2u*)(pk_ + PK_VT + icol * 32 + q * 8); \
                    P##_w0 = *(const LAS f32x4*)(pk_ + PK_WC + (0 + 4 * q) * 4); P##_w1 = *(const LAS f32x4*)(pk_ + PK_WC + (16 + 4 * q) * 4); P##_w2 = *(const LAS f32x4*)(pk_ + PK_WC + (32 + 4 * q) * 4); P##_w3 = *(const LAS f32x4*)(pk_ + PK_WC + (48 + 4 * q) * 4); } while (0)
#define CK_MM(a_, b_, c_) __builtin_amdgcn_mfma_f32_16x16x32_bf16(a_, b_, c_, 0, 0, 0)
#define CK_STEP(P, c_) do { const f32x4 z4 = (f32x4){0.f, 0.f, 0.f, 0.f}; \
                    v4u hb0, hb1; hb0.x = cvt_pk_bf16_nat(H0[0], H0[1]); hb0.y = cvt_pk_bf16_nat(H0[2], H0[3]); hb0.z = cvt_pk_bf16_nat(H1[0], H1[1]); hb0.w = cvt_pk_bf16_nat(H1[2], H1[3]); \
                    hb1.x = cvt_pk_bf16_nat(H2[0], H2[1]); hb1.y = cvt_pk_bf16_nat(H2[2], H2[3]); hb1.z = cvt_pk_bf16_nat(H3[0], H3[1]); hb1.w = cvt_pk_bf16_nat(H3[2], H3[3]); \
                    const bf16x8 Hb0 = __builtin_bit_cast(bf16x8, hb0), Hb1 = __builtin_bit_cast(bf16x8, hb1); \
                    v4u vb_; vb_.x = P##_v.x; vb_.y = P##_v.y; vb_.z = P##_v.x; vb_.w = P##_v.y; const bf16x8 Vb = __builtin_bit_cast(bf16x8, vb_); \
                    f32x4 XQ = CK_MM(P##_fa0, Hb0, z4); XQ = CK_MM(P##_fa1, Hb1, XQ); XQ = CK_MM(P##_fq, Vb, XQ); \
                    v4u xb_; xb_.x = cvt_pk_bf16_nat(XQ[0], XQ[1]); xb_.y = cvt_pk_bf16_nat(XQ[2], XQ[3]); xb_.z = 0u; xb_.w = 0u; \
                    const f32x4 U = CK_MM(P##_ft, __builtin_bit_cast(bf16x8, xb_), z4); \
                    v4u ub_; ub_.x = cvt_pk_bf16_nat(U[0], U[1]); ub_.y = cvt_pk_bf16_nat(U[2], U[3]); ub_.z = P##_v.x; ub_.w = P##_v.y; const bf16x8 UVb = __builtin_bit_cast(bf16x8, ub_); \
                    f32x4 Y = CK_MM(P##_fr0, Hb0, z4); Y = CK_MM(P##_fr1, Hb1, Y); Y = CK_MM(P##_fg, UVb, Y); \
                    H0 = CK_MM(P##_b0, UVb, H0 * P##_w0); H1 = CK_MM(P##_b1, UVb, H1 * P##_w1); H2 = CK_MM(P##_b2, UVb, H2 * P##_w2); H3 = CK_MM(P##_b3, UVb, H3 * P##_w3); \
                    float* yo_ = Yy + (mbase + (size_t)(c_) * CH + 4 * q) * 1024 + h * 64 + icol; \
                    yo_[0] = Y[0]; yo_[1024] = Y[1]; yo_[2048] = Y[2]; yo_[3072] = Y[3]; \
                    asm volatile("s_waitcnt lgkmcnt(0)" ::: "memory"); if (lane == 0) __hip_atomic_fetch_add(ring_done + wave, 1u, __ATOMIC_RELAXED, __HIP_MEMORY_SCOPE_WORKGROUP);     } while (0)
                CK_LOAD(A, 0);
#pragma unroll 1
                for (int c = 0; c < NCHUNK; c += 2) {
                    CK_LOAD(B, c + 1); CK_STEP(A, c);
                    CK_LOAD(A, (c + 2 < NCHUNK ? c + 2 : c)); CK_STEP(B, c + 1);
                }
#undef CK_LOAD
#undef CK_MM
#undef CK_STEP
            } else {
                const int lw = wave - 4;
#pragma unroll 1
                for (int c = 0; c < NCHUNK + LAG; ++c) {
                    if (c < NCHUNK) {
                        if (c >= NSLOT) { const unsigned want = (unsigned)(c - NSLOT + 1); unsigned sp_ = 0;
                            for (;;) { const v4u dd_ = *(volatile LAS v4u*)ring_done; if (min(min(dd_.x, dd_.y), min(dd_.z, dd_.w)) >= want) break; __builtin_amdgcn_s_sleep(0); if (++sp_ > (1u << 26)) break; } }
                        asm volatile("" ::: "memory");
                        const unsigned char* src = PACK + (size_t)c * PK_BYTES + lw * 1024 + lane * 16;
                        LAS unsigned char* dst = lds + (c & (NSLOT - 1)) * PK_BYTES + lw * 1024;
#pragma unroll
                        for (int p = 0; p < 4; ++p) __builtin_amdgcn_global_load_lds((const unsigned*)(src + p * 4096), (LAS unsigned*)(dst + p * 4096), 16, 0, 0);
                    }
                    if (c >= LAG) {
                        if (c < NCHUNK) asm volatile("s_waitcnt vmcnt(12)" ::: "memory"); else asm volatile("s_waitcnt vmcnt(0)" ::: "memory");
                        if (lane == 0) __hip_atomic_fetch_add(ring_ready + lw, 1u, __ATOMIC_RELAXED, __HIP_MEMORY_SCOPE_WORKGROUP);
                    }
                }
            }
        }
#endif
        else for (int crep_ = 0; crep_ < P5_CONV_REPS; ++crep_) {
            LAS float* scr = (LAS float*)(lds + wave * 16640);
            const int cw = (xcd_i * (32 - NSCAN_X) + slot_i - NSCAN_X) * NWAVES + wave;
            constexpr int I1 = (D / 64) * (4096 / 64), I2 = (DFF / 64) * (D / 64), IPE = I1 + I2;
            auto src_of = [&](int it, const float*& Wp, int& N, int& li) { const int e = it / IPE, r = it % IPE; if (r < I1) { Wp = w1 + (size_t)e * D * 4096; N = 4096; li = r; } else { Wp = w2 + (size_t)e * DFF * D; N = D; li = r - I1; } };
            f32x4 va[16], vb2[16], vc[16];
            constexpr int TOT = NE * IPE, STRIDE = (NWG - 8 * NSCAN_X) * NWAVES;
            int it = cw; const float* Wp; int N, li, li1;
#define CONV_STEP(cur, far) { const int itf = it + 2 * STRIDE; const float* Wn; int Nn, lif; \
                src_of(itf < TOT ? itf : it, Wn, Nn, lif); tr_load(Wn, Nn, lif, lane, far);     \
                { const int e = it / IPE, r = it % IPE; \
                  if (r < I1) tr_store_fp8(cur, D, 4096, W1T, (size_t)e * 4096, scr, li, lane, pg8::W_SCALE); else tr_store_fp8(cur, DFF, D, W2T, (size_t)e * 2048, scr, li, lane, pg8::W_SCALE); } \
                it += STRIDE; li = li1; li1 = lif; }
            if (it < TOT) { src_of(it, Wp, N, li); tr_load(Wp, N, li, lane, va);
                { const int it1 = it + STRIDE; src_of(it1 < TOT ? it1 : it, Wp, N, li1); tr_load(Wp, N, li1, lane, vb2); }
                for (;;) { CONV_STEP(va, vc); if (it >= TOT) break; CONV_STEP(vb2, va); if (it >= TOT) break; CONV_STEP(vc, vb2); if (it >= TOT) break; } }
#undef CONV_STEP
        }
    }
    SEAM(5);

    if (IN(6)) {
        for (int m = gw; m < M; m += NGW) {
            const int t = m % SEQ;
            const float* pr = PROJ + (size_t)m * IN_PAD; const float* pp = pr - IN_PAD; const float* lo = LOUT + (size_t)m * 3072;
#pragma unroll
            for (int q = 0; q < 4; ++q) {
                const int c = 4 * lane + 256 * q; const size_t o = (size_t)m * 1024 + c;
                f32x4 r = *(const GAS f32x4*)(pr + c), k = *(const GAS f32x4*)(pr + 1024 + c), v = *(const GAS f32x4*)(pr + 2048 + c);
                f32x4 rp = (f32x4){0.f, 0.f, 0.f, 0.f}, kp = rp, vp = rp;
                if (t > 0) { rp = *(const GAS f32x4*)(pp + c); kp = *(const GAS f32x4*)(pp + 1024 + c); vp = *(const GAS f32x4*)(pp + 2048 + c); }
                r = r + (rp - r) * *(const GAS f32x4*)(mu + c); k = k + (kp - k) * *(const GAS f32x4*)(mu + 1024 + c); v = v + (vp - v) * *(const GAS f32x4*)(mu + 2048 + c);
                const f32x4 al = *(const GAS f32x4*)(lo + 1024 + c) + *(const GAS f32x4*)(a0 + c);
                f32x4 a;
#pragma unroll
                for (int j = 0; j < 4; ++j) a[j] = 1.0f / (1.0f + __expf(-al[j]));
                const f32x4 k2 = k * (1.0f + (a - 1.0f) * *(const GAS f32x4*)(k_a + c));
                const f32x4 rk = *(const GAS f32x4*)(r_k + c);
                const float bon = row16_sum(r.x * k2.x * rk.x + r.y * k2.y * rk.y + r.z * k2.z * rk.z + r.w * k2.w * rk.w);
                const f32x4 y = *(const GAS f32x4*)(Yy + o);
                const float mean = row16_sum(y.x + y.y + y.z + y.w) * (1.0f / 64.0f);
                const f32x4 d = y - mean;
                const float var = row16_sum(d.x * d.x + d.y * d.y + d.z * d.z + d.w * d.w) * (1.0f / 64.0f);
                const float rstd = __builtin_amdgcn_rsqf(var + GN_EPS);
                f32x4 yn = d * rstd * *(const GAS f32x4*)(lnx_w + c) + *(const GAS f32x4*)(lnx_b + c);
                yn = yn + bon * v;
                yn = yn * *(const GAS f32x4*)(lo + 2048 + c);
                v2u ov; ov.x = pk2(yn.x, yn.y); ov.y = pk2(yn.z, yn.w);
                *(GAS v2u*)(MIXIN + (size_t)m * 2048 + c) = ov;
            }
        }
    }
    SEAM(6);

    if (IN(7)) {
        pg8::Gemm g{MIXIN, WOUTT, D, D}; pg8::GridOrder S; S.init(M / 256, D / 256, G, bx, (size_t)256 * D * 2, 0, (size_t)256 * D * 2);
        pg8::EpiBf16Plain E{MIX, D};
        pg8::gemm_phase<pg8::EpiBf16Plain, pg8::GridOrder, true, true>(lds, g, S, E);
    }
    SEAM(7);

    if (IN(8)) {
        LAS float* s_h = (LAS float*)lds;
        LAS float* s_part = (LAS float*)(lds + 65536);
        const int e = tid & 31, part = tid >> 5;
        float wreg[128];
#pragma unroll
        for (int i = 0; i < 128; ++i) wreg[i] = router_w[(size_t)(part * 128 + i) * 32 + e];
        LAS int* lcnt = (LAS int*)(lds + LDSCTL_OFF + 512);
        if (tid < NE) lcnt[tid] = 0;
        __syncthreads();
        for (int m0 = vcu * 8; m0 < M; m0 += G * 8) {
            const int m = m0 + wave;
            {
                f32x4 v[8]; float s = 0.f;
#pragma unroll
                for (int q = 0; q < 8; ++q) { const int c = 4 * lane + 256 * q; { const v2u mv = *(const GAS v2u*)(MIX + (size_t)m * D + c); v[q] = ALPHA * *(const GAS f32x4*)(x + (size_t)m * D + c) + (f32x4){bflo(mv.x), bfhi(mv.x), bflo(mv.y), bfhi(mv.y)}; } s += (v[q].x + v[q].y) + (v[q].z + v[q].w); }
                const float mean = wave_sum(s) * (1.0f / D); float s2 = 0.f;
#pragma unroll
                for (int q = 0; q < 8; ++q) { v[q] = v[q] - mean; s2 += (v[q].x * v[q].x + v[q].y * v[q].y) + (v[q].z * v[q].z + v[q].w * v[q].w); }
                const float rstd = 1.0f / sqrtf(wave_sum(s2) * (1.0f / D) + LN_EPS);
#pragma unroll
                for (int q = 0; q < 8; ++q) { const int c = 4 * lane + 256 * q;
                    const f32x4 hv = v[q] * rstd * *(const GAS f32x4*)(ln1_w + c) + *(const GAS f32x4*)(ln1_b + c);
                    { v2u hw; hw.x = pk2(hv.x, hv.y); hw.y = pk2(hv.z, hv.w); *(GAS v2u*)(H + (size_t)m * D + c) = hw; } *(LAS f32x4*)(s_h + wave * 2048 + c) = hv;
                    *(GAS unsigned*)(HQ + (size_t)m * D + c) = pg8::pk4_fp8(hv.x * pg8::XS_SCALE, hv.y * pg8::XS_SCALE, hv.z * pg8::XS_SCALE, hv.w * pg8::XS_SCALE); }
            }
            __syncthreads();
#pragma unroll 1
            for (int tk = 0; tk < 8; ++tk) {
                const LAS float* hp = s_h + tk * 2048 + part * 128; float acc = 0.f;
#pragma unroll
                for (int i = 0; i < 32; ++i) { const f32x4 hv = *(const LAS f32x4*)(hp + 4 * i); acc += hv.x * wreg[4 * i]; acc += hv.y * wreg[4 * i + 1]; acc += hv.z * wreg[4 * i + 2]; acc += hv.w * wreg[4 * i + 3]; }
                s_part[(tk * 16 + part) * 32 + e] = acc;
            }
            __syncthreads();
            {
                float lg = -3.0e38f;
                if (lane < 32) { lg = router_b[lane];
#pragma unroll
                    for (int p = 0; p < 16; ++p) lg += s_part[(wave * 16 + p) * 32 + lane];
                    lg = (lg == lg) ? fminf(fmaxf(lg, -1.0e30f), 1.0e30f) : -1.0e30f; }
                int idx[4]; float val[4];
#pragma unroll
                for (int k = 0; k < 4; ++k) {
                    float best = lg; int bi = lane;
#pragma unroll
                    for (int o = 1; o < 64; o <<= 1) { const float ob = __shfl_xor(best, o); const int oi = __shfl_xor(bi, o); const bool take = (ob > best) || (ob == best && oi < bi); best = take ? ob : best; bi = take ? oi : bi; }
                    idx[k] = bi; val[k] = best; if (lane == bi) lg = -3.0e38f;
                }
                if (lane == 0) {
                    float ex[4], se = 0.f;
#pragma unroll
                    for (int k = 0; k < 4; ++k) { ex[k] = __expf(val[k] - val[0]); se += ex[k]; }
                    const float inv = 1.0f / se;
#pragma unroll
                    for (int k = 0; k < 4; ++k) { TOPI[m * 4 + k] = idx[k]; GATE[m * 4 + k] = ex[k] * inv; POS[m * 4 + k] = __hip_atomic_fetch_add(lcnt + idx[k], 1, __ATOMIC_RELAXED, __HIP_MEMORY_SCOPE_WORKGROUP); }
                }
            }
            __syncthreads();
        }
        if (tid < NE) CNTWG[vcu * NE + tid] = lcnt[tid];
    }
    SEAM(8);

    if (IN(9) || IN(10) || IN(11)) {
        LAS int* s_t = (LAS int*)lds; LAS int* s_p = s_t + 512;
        LAS int* PSB = (LAS int*)(lds + LDSCTL_OFF + 640);
        { const int e = tid & 31, part = tid >> 5; int tsum = 0, psum = 0;
          for (int w = part * 16; w < part * 16 + 16; ++w) { const int cv = CNTWG[w * NE + e]; tsum += cv; psum += (w < vcu) ? cv : 0; }
          s_t[part * 32 + e] = tsum; s_p[part * 32 + e] = psum; }
        __syncthreads();
        if (tid < NE) { int tsum = 0, psum = 0; for (int p = 0; p < 16; ++p) { tsum += s_t[p * 32 + tid]; psum += s_p[p * 32 + tid]; } s_t[tid] = tsum; PSB[tid] = psum; }
        __syncthreads();
        if (tid == 0) { int acc = 0; for (int e = 0; e < NE; ++e) { PS[e] = acc; acc += (s_t[e] + 255) / 256 * 256; } PS[NE] = acc; }
        __syncthreads();
        if (tid < NE) PSB[tid] += PS[tid];
        __syncthreads();
    }
    if (IN(9)) {
        const LAS int* PSB = (const LAS int*)(lds + LDSCTL_OFF + 640);
        for (int m0 = vcu * 8; m0 < M; m0 += G * 8) {
            const int m = m0 + wave;
            const GAS v4u* src = (const GAS v4u*)(HQ + (size_t)m * D);
            v4u rv[2];
#pragma unroll
            for (int q = 0; q < 2; ++q) rv[q] = src[lane + 64 * q];
#pragma unroll
            for (int k = 0; k < 4; ++k) {
                const int a = m * 4 + k, slot = PSB[TOPI[a]] + POS[a];
                if (lane == 0) { slot_tok[slot] = m; SLOT_OF[a] = slot; }
                GAS v4u* dst = (GAS v4u*)(XS + (size_t)slot * D);
#pragma unroll
                for (int q = 0; q < 2; ++q) dst[lane + 64 * q] = rv[q];
            }
        }
    }
    SEAM(9);

    if (IN(10)) {
        pg8::Gemm g{(const bf16*)XS, (const bf16*)W1T, D / 2, D / 2}; pg8::MoeOrder S; S.ps = PS; S.ntile = 16; S.npan = PS[NE] / 256; S.cprime = vcu; S.a_tstep = (size_t)256 * D; S.b_tstep = (size_t)256 * D;
        pg8::EpiSwiglu E{ACT, b1};
        pg8::gemm_phase<pg8::EpiSwiglu, pg8::MoeOrder, true, true, true>(lds, g, S, E);
    }
    SEAM(10);

    if (IN(11)) {
        pg8::Gemm g{(const bf16*)ACT, (const bf16*)W2T, DFF / 2, DFF / 2}; pg8::MoeOrder S; S.ps = PS; S.ntile = 8; S.npan = PS[NE] / 256; S.cprime = vcu; S.a_tstep = (size_t)256 * DFF; S.b_tstep = (size_t)256 * DFF;
        pg8::EpiBias16 E{YS, b2};
        pg8::gemm_phase<pg8::EpiBias16, pg8::MoeOrder, true, true, true>(lds, g, S, E);
    }
    SEAM(11);

    if (IN(12)) {
        for (int m = gw; m < M; m += NGW) {
            int sl[4]; float gt[4];
#pragma unroll
            for (int k = 0; k < 4; ++k) { sl[k] = SLOT_OF[m * 4 + k]; gt[k] = GATE[m * 4 + k]; }
            f32x4 v[8]; float s = 0.f;
#pragma unroll
            for (int q = 0; q < 8; ++q) { const int c = 4 * lane + 256 * q; f32x4 f = (f32x4){0.f, 0.f, 0.f, 0.f};
#pragma unroll
                for (int k = 0; k < 4; ++k) { const v2u yv = *(const GAS v2u*)(YS + (size_t)sl[k] * D + c); f += gt[k] * (f32x4){bflo(yv.x), bfhi(yv.x), bflo(yv.y), bfhi(yv.y)}; }
                { const v2u hw = *(const GAS v2u*)(H + (size_t)m * D + c); v[q] = ALPHA * (f32x4){bflo(hw.x), bfhi(hw.x), bflo(hw.y), bfhi(hw.y)} + f; } s += (v[q].x + v[q].y) + (v[q].z + v[q].w); }
            const float mean = wave_sum(s) * (1.0f / D); float s2 = 0.f;
#pragma unroll
            for (int q = 0; q < 8; ++q) { v[q] = v[q] - mean; s2 += (v[q].x * v[q].x + v[q].y * v[q].y) + (v[q].z * v[q].z + v[q].w * v[q].w); }
            const float rstd = 1.0f / sqrtf(wave_sum(s2) * (1.0f / D) + LN_EPS);
#pragma unroll
            for (int q = 0; q < 8; ++q) { const int c = 4 * lane + 256 * q; *(GAS f32x4*)(out + (size_t)m * D + c) = v[q] * rstd * *(const GAS f32x4*)(ln2_w + c) + *(const GAS f32x4*)(ln2_b + c); }
        }
    }
#undef IN
#undef SEAM
}

extern "C" void kernel_launch(void* const* d_in, const int* in_sizes, int n_in, void* d_out, int out_size, void* d_ws, size_t ws_size, hipStream_t stream) {
    static int grid = 0;
    if (grid == 0) {
        if (n_in != 26 || out_size != M * D || ws_size < WS_END) { fprintf(stderr, "kernel_launch: unexpected problem (n_in %d, out %d, ws %zu < %zu)\n", n_in, out_size, ws_size, (size_t)WS_END); grid = -1; return; }
        int dev = 0, cus = 0, per_cu = 0;
        if (hipGetDevice(&dev) != hipSuccess || hipDeviceGetAttribute(&cus, hipDeviceAttributeMultiprocessorCount, dev) != hipSuccess) { grid = -1; return; }
        if (hipFuncSetAttribute((const void*)mk_fwd, hipFuncAttributeMaxDynamicSharedMemorySize, LDS_BYTES) != hipSuccess) { fprintf(stderr, "kernel_launch: hipFuncSetAttribute failed\n"); grid = -1; return; }
        if (hipOccupancyMaxActiveBlocksPerMultiprocessor(&per_cu, (const void*)mk_fwd, NTHR, LDS_BYTES) != hipSuccess || per_cu < 1) fprintf(stderr, "kernel_launch: occupancy query reports %d\n", per_cu);
        (void)hipGetLastError();
        if (cus != NWG) { fprintf(stderr, "kernel_launch: built for %d CUs, device has %d\n", NWG, cus); grid = -1; return; }
        grid = NWG;
    }
    if (grid < 0) return;
    (void)hipMemsetAsync((char*)d_ws + WS_CTL, 0, CTL_BYTES, stream);
    (void)hipMemsetAsync((char*)d_ws + WS_SLOTTOK, 0xFF, (size_t)NSLOT_MAX * 4, stream);
    Args a{};
    for (int i = 0; i < 26; ++i) a.in[i] = (const float*)d_in[i];
    a.out = (float*)d_out; a.ws = (unsigned char*)d_ws; a.dup = DUP_MASK;
    if (MK_N_LAUNCHES == 1) { a.ph_lo = 0; a.ph_hi = NPHASE; hipLaunchKernelGGL(mk_fwd, dim3(grid), dim3(NTHR), LDS_BYTES, stream, a); }
    else { for (int p = 0; p < NPHASE; ++p) for (int rep = 0; rep <= ((DUP_MASK >> p) & 1); ++rep) { a.ph_lo = p; a.ph_hi = p + 1; hipLaunchKernelGGL(mk_fwd, dim3(grid), dim3(NTHR), LDS_BYTES, stream, a); } }
}
```

```cpp
#include <hip/hip_runtime.h>
#include <stdint.h>
#include <stdio.h>

#ifndef P5_SCAN_REPS
#define P5_SCAN_REPS 1
#endif
#ifndef P5_CONV_REPS
#define P5_CONV_REPS 1
#endif
#ifndef P5A_REPS
#define P5A_REPS 1
#endif
#ifndef P5B_REPS
#define P5B_REPS 1
#endif
#ifndef SCAN_CHUNKED
#define SCAN_CHUNKED 1
#endif
#ifndef DUP_MASK
#define DUP_MASK 0
#endif
#ifndef MK_N_LAUNCHES
#define MK_N_LAUNCHES 1
#endif

constexpr int D = 2048, BATCH = 4, SEQ = 4096, M = BATCH * SEQ;
constexpr int RW = 1024, PW = 1024, NH = 16;
constexpr int SHIFT_W = 3360, IN_COLS = 4384, IN_PAD = 4608;
constexpr int LK = 384;
constexpr int NE = 32, DFF = 2048;
constexpr int NASG = M * 4;
constexpr int NSLOT_MAX = NASG + NE * 256;
constexpr float LN_EPS = 1e-5f, GN_EPS = 64e-5f;
constexpr float ALPHA = 1.189207115002721f;
constexpr int NWG = 256, NWAVES = 8, NTHR = 512;
constexpr int NPHASE = 13;

#define GAS __attribute__((address_space(1)))
#define LAS __attribute__((address_space(3)))
typedef unsigned short bf16;
typedef unsigned v4u __attribute__((ext_vector_type(4)));
typedef unsigned v2u __attribute__((ext_vector_type(2)));
typedef float f32x4 __attribute__((ext_vector_type(4)));
typedef short bf16x8 __attribute__((ext_vector_type(8)));
typedef GAS unsigned gu32;
#define RLX_AGENT __ATOMIC_RELAXED, __HIP_MEMORY_SCOPE_AGENT
#define LDS_WAIT() asm volatile("s_waitcnt lgkmcnt(0)" ::: "memory")
#define VM_WAIT() asm volatile("s_waitcnt vmcnt(0)" ::: "memory")

__device__ __forceinline__ unsigned f2bf(float f) { unsigned u = __builtin_bit_cast(unsigned, f); return (u + 0x7fffu + ((u >> 16) & 1u)) >> 16; }
__device__ __forceinline__ unsigned pk2(float lo, float hi) { return f2bf(lo) | (f2bf(hi) << 16); }
__device__ __forceinline__ float bflo(unsigned w) { return __builtin_bit_cast(float, w << 16); }
__device__ __forceinline__ float bfhi(unsigned w) { return __builtin_bit_cast(float, w & 0xffff0000u); }
__device__ __forceinline__ float ld1bf(const bf16* p) { return __builtin_bit_cast(float, (unsigned)(*(const GAS bf16*)p) << 16); }
__device__ __forceinline__ f32x4 ld4bf(const bf16* p) { const v2u w = *(const GAS v2u*)p; return (f32x4){bflo(w.x), bfhi(w.x), bflo(w.y), bfhi(w.y)}; }
__device__ __forceinline__ float wave_sum(float v) {
#pragma unroll
    for (int o = 1; o < 64; o <<= 1) v += __shfl_xor(v, o);
    return v;
}
typedef float f32x2n __attribute__((ext_vector_type(2)));
typedef __bf16 bf16x2n __attribute__((ext_vector_type(2)));
__device__ __forceinline__ unsigned cvt_pk_bf16_nat(float lo, float hi) { const f32x2n v = {lo, hi}; return __builtin_bit_cast(unsigned, __builtin_convertvector(v, bf16x2n)); }
__device__ __forceinline__ float fast_sigmoid(float x) { return __builtin_amdgcn_rcpf(1.0f + __builtin_amdgcn_exp2f(-1.4426950408889634f * x)); }
__device__ __forceinline__ float fast_decay(float wl) { const float z = -wl; const float sp = fmaxf(z, 0.f) + 0.6931471805599453f * __builtin_amdgcn_logf(1.0f + __builtin_amdgcn_exp2f(-1.4426950408889634f * fabsf(z)));
    return __builtin_amdgcn_exp2f(-1.4426950408889634f * __builtin_amdgcn_exp2f(-1.4426950408889634f * (sp + 0.5f))); }
template <int CTRL> __device__ __forceinline__ float dpp_mov(float x) { return __builtin_bit_cast(float, __builtin_amdgcn_update_dpp(0, __builtin_bit_cast(int, x), CTRL, 0xF, 0xF, true)); }
__device__ __forceinline__ float row16_sum(float x) {
    x += dpp_mov<0xB1>(x);
    x += dpp_mov<0x4E>(x);
    x += dpp_mov<0x141>(x);
    x += dpp_mov<0x140>(x);
    return x;
}

__device__ __forceinline__ float wave_sum_dpp(float x) {
    x = row16_sum(x);
    x += __builtin_bit_cast(float, __builtin_amdgcn_update_dpp(0, __builtin_bit_cast(int, x), 0x142, 0xA, 0xF, false));
    x += __builtin_bit_cast(float, __builtin_amdgcn_update_dpp(0, __builtin_bit_cast(int, x), 0x143, 0xC, 0xF, false));
    return __builtin_bit_cast(float, __builtin_amdgcn_readlane(__builtin_bit_cast(int, x), 63));
}

namespace pg8 {
typedef unsigned short bf16_t;
typedef unsigned u32x4 __attribute__((ext_vector_type(4)));
typedef int v4i_t __attribute__((ext_vector_type(4)));
typedef int v8i_t __attribute__((ext_vector_type(8)));
constexpr int BM = 256, BK = 64, HALF = 128, HTB = HALF * BK * 2, STAGE_BYTES = 8 * HTB, NXCD = 8, WGM = 8;
__host__ __device__ __forceinline__ int lds_byte(int r, int c) { const int st = (r >> 4) * 2 + (c >> 5), rr = r & 15, cc = c & 31, ob = rr * 64 + cc * 2; return st * 1024 + (ob ^ (((ob >> 9) & 1) << 5)); }
__host__ __device__ __forceinline__ void stage_rc(int b, int& R, int& C) { const int st = b / 1024, sb = b % 1024, swz = sb ^ (((sb >> 9) & 1) << 5); R = (st >> 1) * 16 + swz / 64; C = (st & 1) * 32 + (swz % 64) / 2; }
__host__ __device__ __forceinline__ int perm32(int rho) { const int n = rho >> 4, i = rho & 15; return 8 * (i >> 2) + 4 * n + (i & 3); }
struct Unit { int pm, pn; };
struct Gemm { const bf16_t* A; const bf16_t* Bt; int lda, K; };
__device__ __forceinline__ unsigned cvt_pk_bf16(float lo, float hi) { unsigned r; asm volatile("v_cvt_pk_bf16_f32 %0, %1, %2" : "=v"(r) : "v"(lo), "v"(hi)); return r; }

struct GridOrder {
    int nM, nN, nwg, G, c; size_t a_tstep, a_pnstep, b_tstep;
    __device__ void init(int nM_, int nN_, int G_, int c_, size_t a_tstep_, size_t a_pnstep_, size_t b_tstep_) { nM = nM_; nN = nN_; nwg = nM * nN; G = G_; c = c_; a_tstep = a_tstep_; a_pnstep = a_pnstep_; b_tstep = b_tstep_; }
    __device__ bool next(int i, Unit& u) const {
        const long L = (long)i * G + c; if (L >= nwg) return false;
        int wgid = (int)L; { const int q = nwg / NXCD, r = nwg % NXCD, xcd = wgid % NXCD, off = wgid / NXCD; wgid = (xcd < r ? xcd * (q + 1) : r * (q + 1) + (xcd - r) * q) + off; }
        const int nig = WGM * nN, gid = wgid / nig, fm = gid * WGM, gsz = (nM - fm) < WGM ? (nM - fm) : WGM;
        u.pm = fm + ((wgid % nig) % gsz); u.pn = (wgid % nig) / gsz; return true;
    }
    __device__ __forceinline__ size_t aoff(const Unit& u) const { return (size_t)u.pm * a_tstep + (size_t)u.pn * a_pnstep; }
    __device__ __forceinline__ size_t boff(const Unit& u) const { return (size_t)u.pn * b_tstep; }
};
struct MoeOrder {
    const LAS int* ps; int ntile, npan, cprime; size_t a_tstep, b_tstep;
    __device__ bool next(int i, Unit& u) const {
        const int U = i * NWG + cprime; const int p = U / ntile; if (p >= npan) return false;
        const int row = p * 256; int e = 0;
#pragma unroll 1
        for (int q = 1; q < NE; ++q) e = (row >= ps[q]) ? q : e;
        u.pm = p; u.pn = e * ntile + (U % ntile); return true;
    }
    __device__ __forceinline__ size_t aoff(const Unit& u) const { return (size_t)u.pm * a_tstep; }
    __device__ __forceinline__ size_t boff(const Unit& u) const { return (size_t)u.pn * b_tstep; }
};

template <class Epi, class Sched, bool ALIGN_EPI, bool SP2, bool FP8 = false>
__device__ __forceinline__ void gemm_phase(LAS unsigned char* lds, const Gemm g, const Sched& S, const Epi& E) {
    int tid_ = threadIdx.x; asm volatile("" : "+v"(tid_));
    const int tid = tid_, wid = __builtin_amdgcn_readfirstlane(tid >> 6), lane = tid & 63, wr = wid >> 2, wc = wid & 3, fr = lane & 15, fq = lane >> 4;
    const int K = g.K, nt = K / BK;
    unsigned voffA[2], voffB[2];
#pragma unroll
    for (int i = 0; i < 2; ++i) { int R, C; stage_rc(tid * 16 + i * 8192, R, C); const int Rb = Epi::PERM ? ((R & ~31) + perm32(R & 31)) : R;
        voffA[i] = (unsigned)(R * g.lda + C) * 2u; voffB[i] = (unsigned)(Rb * K + C) * 2u; }
    const size_t kstep = (size_t)(BK * 2);
    const size_t hstepA = (size_t)HALF * g.lda * 2, hstepB = (size_t)HALF * K * 2;
    const unsigned ldsw = (unsigned)wid * 1024u;
    const int aoff = lds_byte(wr * 64 + fr, fq * 8), boff = lds_byte(wc * 32 + fr, fq * 8);
#define PG8_SA(b, h) (((b) * 2 + (h)) * HTB)
#define PG8_SB(b, h) ((4 + (b) * 2 + (h)) * HTB)
#define PG8_STAGE(bufoff, gbase, voff) do { _Pragma("unroll") for (int _i = 0; _i < 2; ++_i) \
        __builtin_amdgcn_global_load_lds((const unsigned*)((const char*)(gbase) + (voff)[_i]), (LAS unsigned*)(lds + (bufoff) + ldsw + _i * 8192), 16, 0, 0); } while (0)
#define PG8_LDA(dst, b, h) do { _Pragma("unroll") for (int m = 0; m < 4; ++m) { if constexpr (FP8) { const v4i_t l_ = *(const LAS v4i_t*)(lds + PG8_SA(b, h) + aoff + m * 2048), h_ = *(const LAS v4i_t*)(lds + PG8_SA(b, h) + aoff + m * 2048 + 1024); dst##8[m] = __builtin_shufflevector(l_, h_, 0, 1, 2, 3, 4, 5, 6, 7); } \
        else { _Pragma("unroll") for (int k = 0; k < 2; ++k) dst[m][k] = *(const LAS bf16x8*)(lds + PG8_SA(b, h) + aoff + m * 2048 + k * 1024); } } } while (0)
#define PG8_LDB(dst, b, h) do { _Pragma("unroll") for (int n = 0; n < 2; ++n) { if constexpr (FP8) { const v4i_t l_ = *(const LAS v4i_t*)(lds + PG8_SB(b, h) + boff + n * 2048), h_ = *(const LAS v4i_t*)(lds + PG8_SB(b, h) + boff + n * 2048 + 1024); dst##8[n] = __builtin_shufflevector(l_, h_, 0, 1, 2, 3, 4, 5, 6, 7); } \
        else { _Pragma("unroll") for (int k = 0; k < 2; ++k) dst[n][k] = *(const LAS bf16x8*)(lds + PG8_SB(b, h) + boff + n * 2048 + k * 1024); } } } while (0)
#define PG8_MMA(ai, bj, At, Bt) do { __builtin_amdgcn_s_setprio(1); _Pragma("unroll") for (int m = 0; m < 4; ++m) _Pragma("unroll") for (int n = 0; n < 2; ++n) { \
        if constexpr (FP8) asm volatile("v_mfma_scale_f32_16x16x128_f8f6f4 %0, %1, %2, %0, %3, %3 op_sel_hi:[0,0,0]" : "+v"(acc[ai][bj][m][n]) : "v"(Bt##8[n]), "v"(At##8[m]), "v"(scale1_)); \
        else { _Pragma("unroll") for (int k = 0; k < 2; ++k) acc[ai][bj][m][n] = __builtin_amdgcn_mfma_f32_16x16x32_bf16(Bt[n][k], At[m][k], acc[ai][bj][m][n], 0, 0, 0); } } \
        __builtin_amdgcn_s_setprio(0); } while (0)
#define PG8_WAIT_V(n) asm volatile("s_waitcnt vmcnt(" #n ")" ::: "memory")
#define PG8_WAIT_L(n) asm volatile("s_waitcnt lgkmcnt(" #n ")" ::: "memory")
#define PG8_BAR __builtin_amdgcn_s_barrier()
#define PG8_SCHED __builtin_amdgcn_sched_barrier(0)
    Unit cur, nxt; int ui = 0;
    if (!S.next(0, cur)) return;
    f32x4 acc[2][2][4][2];
#pragma unroll
    for (int a = 0; a < 2; ++a)
#pragma unroll
        for (int b = 0; b < 2; ++b)
#pragma unroll
            for (int m = 0; m < 4; ++m)
#pragma unroll
                for (int n = 0; n < 2; ++n) acc[a][b][m][n] = (f32x4){0.f, 0.f, 0.f, 0.f};
    int scale1_ = 0x7F7F7F7F; asm volatile("" : "+v"(scale1_));
    bf16x8 At[4][2], B0[2][2], B1[2][2];
    v8i_t At8[4], B08[2], B18[2];
    const char* cA = (const char*)g.A + S.aoff(cur); const char* cB = (const char*)g.Bt + S.boff(cur);
    if constexpr (SP2) {
        PG8_STAGE(PG8_SB(0, 0), cB, voffB); PG8_STAGE(PG8_SB(0, 1), cB + hstepB, voffB); PG8_STAGE(PG8_SA(0, 0), cA, voffA); PG8_STAGE(PG8_SA(0, 1), cA + hstepA, voffA);
        if (wr == 1) PG8_BAR;
        PG8_WAIT_V(2); PG8_BAR;
        PG8_STAGE(PG8_SB(1, 0), cB + kstep, voffB); PG8_STAGE(PG8_SA(1, 0), cA + kstep, voffA); PG8_STAGE(PG8_SB(1, 1), cB + hstepB + kstep, voffB);
        PG8_WAIT_V(6); PG8_BAR;
    } else {
        PG8_STAGE(PG8_SB(0, 0), cB, voffB); PG8_STAGE(PG8_SA(0, 0), cA, voffA); PG8_STAGE(PG8_SB(0, 1), cB + hstepB, voffB); PG8_STAGE(PG8_SA(0, 1), cA + hstepA, voffA);
        if (wr == 1) PG8_BAR;
        PG8_WAIT_V(4); PG8_BAR;
        PG8_STAGE(PG8_SB(1, 0), cB + kstep, voffB); PG8_STAGE(PG8_SA(1, 0), cA + kstep, voffA); PG8_STAGE(PG8_SB(1, 1), cB + hstepB + kstep, voffB);
        PG8_WAIT_V(6); PG8_BAR;
    }
    for (;;) {
        const bool has_next = S.next(ui + 1, nxt);
        const char* nA = has_next ? (const char*)g.A + S.aoff(nxt) : cA; const char* nB = has_next ? (const char*)g.Bt + S.boff(nxt) : cB;
#pragma unroll 1
        for (int t = 0; t < nt; t += 2) {
            const bool last = (t == nt - 2);
            const char* a1 = cA + (size_t)(t + 1) * kstep;
            const char* a2 = last ? nA : cA + (size_t)(t + 2) * kstep; const char* b2 = last ? nB : cB + (size_t)(t + 2) * kstep;
            const char* a3 = a2 + kstep; const char* b3 = b2 + kstep;
            if constexpr (SP2) {
            PG8_LDB(B0, 0, 0); PG8_LDB(B1, 0, 1); PG8_SCHED; PG8_LDA(At, 0, 0); PG8_STAGE(PG8_SA(1, 1), a1 + hstepA, voffA);
            PG8_WAIT_V(8); PG8_WAIT_L(0); PG8_BAR; PG8_MMA(0, 0, At, B0); PG8_MMA(0, 1, At, B1); PG8_BAR; PG8_SCHED;
            PG8_LDA(At, 0, 1); PG8_STAGE(PG8_SB(0, 0), b2, voffB); PG8_STAGE(PG8_SB(0, 1), b2 + hstepB, voffB); PG8_STAGE(PG8_SA(0, 0), a2, voffA);
            PG8_WAIT_V(8); PG8_WAIT_L(0); PG8_BAR; PG8_MMA(1, 0, At, B0); PG8_MMA(1, 1, At, B1); PG8_BAR; PG8_SCHED;
            PG8_LDB(B0, 1, 0); PG8_LDB(B1, 1, 1); PG8_SCHED; PG8_LDA(At, 1, 0); PG8_STAGE(PG8_SA(0, 1), a2 + hstepA, voffA);
            PG8_WAIT_V(8); PG8_WAIT_L(0); PG8_BAR; PG8_MMA(0, 0, At, B0); PG8_MMA(0, 1, At, B1); PG8_BAR; PG8_SCHED;
            PG8_LDA(At, 1, 1); PG8_STAGE(PG8_SB(1, 0), b3, voffB); PG8_STAGE(PG8_SB(1, 1), b3 + hstepB, voffB); PG8_STAGE(PG8_SA(1, 0), a3, voffA);
            PG8_WAIT_V(8); PG8_WAIT_L(0); PG8_BAR; PG8_MMA(1, 0, At, B0); PG8_MMA(1, 1, At, B1); PG8_BAR; PG8_SCHED;
            } else {
            PG8_LDB(B0, 0, 0); PG8_SCHED; PG8_LDA(At, 0, 0); PG8_STAGE(PG8_SA(1, 1), a1 + hstepA, voffA);
            PG8_WAIT_L(8); PG8_BAR; PG8_WAIT_L(0); PG8_MMA(0, 0, At, B0); PG8_BAR; PG8_SCHED;
            PG8_LDB(B1, 0, 1); PG8_STAGE(PG8_SB(0, 0), b2, voffB);
            PG8_BAR; PG8_WAIT_L(0); PG8_MMA(0, 1, At, B1); PG8_BAR;
            PG8_LDA(At, 0, 1); PG8_STAGE(PG8_SA(0, 0), a2, voffA);
            PG8_BAR; PG8_WAIT_L(0); PG8_MMA(1, 0, At, B0); PG8_BAR; PG8_SCHED;
            PG8_STAGE(PG8_SB(0, 1), b2 + hstepB, voffB);
            PG8_WAIT_V(6); PG8_BAR; PG8_MMA(1, 1, At, B1); PG8_BAR;
            PG8_LDB(B0, 1, 0); PG8_SCHED; PG8_LDA(At, 1, 0); PG8_STAGE(PG8_SA(0, 1), a2 + hstepA, voffA);
            PG8_WAIT_L(8); PG8_BAR; PG8_WAIT_L(0); PG8_MMA(0, 0, At, B0); PG8_BAR; PG8_SCHED;
            PG8_LDB(B1, 1, 1); PG8_STAGE(PG8_SB(1, 0), b3, voffB);
            PG8_BAR; PG8_WAIT_L(0); PG8_MMA(0, 1, At, B1); PG8_BAR;
            PG8_LDA(At, 1, 1); PG8_STAGE(PG8_SA(1, 0), a3, voffA);
            PG8_BAR; PG8_WAIT_L(0); PG8_MMA(1, 0, At, B0); PG8_BAR; PG8_SCHED;
            PG8_STAGE(PG8_SB(1, 1), b3 + hstepB, voffB);
            PG8_WAIT_V(6); PG8_BAR; PG8_MMA(1, 1, At, B1); PG8_BAR;
            }
        }
        if constexpr (ALIGN_EPI) { if (wr == 0) PG8_BAR; }
        if constexpr (FP8) asm volatile("s_nop 15\n\ts_nop 15" ::: "memory");
        E(acc, cur, wr, wc, fr, fq);
        if (!has_next) break;
#pragma unroll
        for (int a = 0; a < 2; ++a)
#pragma unroll
            for (int b = 0; b < 2; ++b)
#pragma unroll
                for (int m = 0; m < 4; ++m)
#pragma unroll
                    for (int n = 0; n < 2; ++n) acc[a][b][m][n] = (f32x4){0.f, 0.f, 0.f, 0.f};
        cur = nxt; cA = nA; cB = nB; ++ui;
        if constexpr (ALIGN_EPI) { if (wr == 1) PG8_BAR; }
    }
    PG8_WAIT_V(0);
    if constexpr (!ALIGN_EPI) { if (wr == 0) PG8_BAR; }
    PG8_BAR;
#undef PG8_SA
#undef PG8_SB
#undef PG8_STAGE
#undef PG8_LDA
#undef PG8_LDB
#undef PG8_MMA
#undef PG8_WAIT_V
#undef PG8_WAIT_L
#undef PG8_BAR
#undef PG8_SCHED
}

struct EpiF32 {
    static constexpr bool PERM = false;
    float* C; int ldc;
    __device__ __forceinline__ void operator()(const f32x4 (&acc)[2][2][4][2], const Unit& u, int wr, int wc, int fr, int fq) const {
        const int row0 = u.pm * BM + wr * 64 + fr, col0 = u.pn * BM + wc * 32 + 4 * fq;
#pragma unroll
        for (int ai = 0; ai < 2; ++ai)
#pragma unroll
            for (int m = 0; m < 4; ++m) { float* rowp = C + (size_t)(row0 + ai * HALF + m * 16) * ldc + col0;
#pragma unroll
                for (int bj = 0; bj < 2; ++bj)
#pragma unroll
                    for (int n = 0; n < 2; ++n) *(f32x4*)(rowp + bj * HALF + n * 16) = acc[ai][bj][m][n]; }
    }
};
struct EpiBf16Plain {
    static constexpr bool PERM = true;
    bf16_t* O; int ldc;
    __device__ __forceinline__ void operator()(const f32x4 (&acc)[2][2][4][2], const Unit& u, int wr, int wc, int fr, int fq) const {
        const int row0 = u.pm * BM + wr * 64 + fr, col0 = u.pn * BM + wc * 32 + 8 * fq;
#pragma unroll
        for (int ai = 0; ai < 2; ++ai)
#pragma unroll
            for (int m = 0; m < 4; ++m) { bf16_t* rowp = O + (size_t)(row0 + ai * HALF + m * 16) * ldc + col0;
#pragma unroll
                for (int bj = 0; bj < 2; ++bj) { const f32x4 v0 = acc[ai][bj][m][0], v1 = acc[ai][bj][m][1];
                    u32x4 w; w.x = cvt_pk_bf16(v0[0], v0[1]); w.y = cvt_pk_bf16(v0[2], v0[3]); w.z = cvt_pk_bf16(v1[0], v1[1]); w.w = cvt_pk_bf16(v1[2], v1[3]);
                    *(u32x4*)(rowp + bj * HALF) = w; } }
    }
};
struct EpiPool {
    static constexpr bool PERM = true;
    bf16_t* O; const float* scale;
    __device__ __forceinline__ void operator()(const f32x4 (&acc)[2][2][4][2], const Unit& u, int wr, int wc, int fr, int fq) const {
        const int row0 = u.pm * BM + wr * 64 + fr; int col0 = u.pn * BM + wc * 32 + 8 * fq;
        asm volatile("" : "+v"(col0));
        f32x4 sv[2][2];
#pragma unroll
        for (int bj = 0; bj < 2; ++bj)
#pragma unroll
            for (int n = 0; n < 2; ++n) sv[bj][n] = *(const f32x4*)(scale + col0 + bj * HALF + 4 * n);
#pragma unroll
        for (int ai = 0; ai < 2; ++ai)
#pragma unroll
            for (int m = 0; m < 4; ++m) { bf16_t* rowp = O + (size_t)(row0 + ai * HALF + m * 16) * 2048 + 1024 + col0;
#pragma unroll
                for (int bj = 0; bj < 2; ++bj) { const f32x4 v0 = acc[ai][bj][m][0] * sv[bj][0], v1 = acc[ai][bj][m][1] * sv[bj][1];
                    u32x4 w; w.x = cvt_pk_bf16(v0[0], v0[1]); w.y = cvt_pk_bf16(v0[2], v0[3]); w.z = cvt_pk_bf16(v1[0], v1[1]); w.w = cvt_pk_bf16(v1[2], v1[3]);
                    *(u32x4*)(rowp + bj * HALF) = w; } }
    }
};
constexpr float XS_SCALE = 8.0f, W_SCALE = 256.0f, ACT_SCALE = 8.0f, DESCALE = 1.0f / 2048.0f;
__device__ __forceinline__ unsigned pk4_fp8(float a, float b, float c, float d) {
    a = fminf(fmaxf(a, -448.f), 448.f); b = fminf(fmaxf(b, -448.f), 448.f); c = fminf(fmaxf(c, -448.f), 448.f); d = fminf(fmaxf(d, -448.f), 448.f);
    int w = 0; w = __builtin_amdgcn_cvt_pk_fp8_f32(a, b, w, false); w = __builtin_amdgcn_cvt_pk_fp8_f32(c, d, w, true); return (unsigned)w;
}
struct EpiSwiglu {
    static constexpr bool PERM = true;
    unsigned char* O; const float* b1;
    __device__ __forceinline__ void operator()(const f32x4 (&acc)[2][2][4][2], const Unit& u, int wr, int wc, int fr, int fq) const {
        const int e = u.pn >> 4, nt = u.pn & 15;
        const int row0 = u.pm * BM + wr * 64 + fr; int col0 = nt * BM + wc * 32 + 8 * fq;
        asm volatile("" : "+v"(col0));
        const float* bp = b1 + (size_t)e * 4096 + col0;
        f32x4 bv[2][2];
#pragma unroll
        for (int bj = 0; bj < 2; ++bj)
#pragma unroll
            for (int n = 0; n < 2; ++n) bv[bj][n] = *(const f32x4*)(bp + bj * HALF + 4 * n);
#pragma unroll
        for (int ai = 0; ai < 2; ++ai)
#pragma unroll
            for (int m = 0; m < 4; ++m) { unsigned char* rowp = O + (size_t)(row0 + ai * HALF + m * 16) * 2048 + (col0 >> 1);
#pragma unroll
                for (int bj = 0; bj < 2; ++bj) { const f32x4 v0 = acc[ai][bj][m][0] * DESCALE + bv[bj][0], v1 = acc[ai][bj][m][1] * DESCALE + bv[bj][1];
                    float a[4];
#pragma unroll
                    for (int p = 0; p < 4; ++p) { const float hg = p < 2 ? v0[2 * p] : v1[2 * p - 4], hl = p < 2 ? v0[2 * p + 1] : v1[2 * p - 3];
                        const float xg = fminf(hg, 7.0f), xl = fminf(fmaxf(hl, -7.0f), 7.0f);
                        a[p] = xg * __builtin_amdgcn_rcpf(1.0f + __expf(-1.702f * xg)) * (xl + 1.0f) * ACT_SCALE; }
                    *(unsigned*)(rowp + bj * (HALF / 2)) = pk4_fp8(a[0], a[1], a[2], a[3]); } }
    }
};
struct EpiBias16 {
    static constexpr bool PERM = true;
    bf16_t* O; const float* b2;
    __device__ __forceinline__ void operator()(const f32x4 (&acc)[2][2][4][2], const Unit& u, int wr, int wc, int fr, int fq) const {
        const int e = u.pn >> 3, nt = u.pn & 7;
        const int row0 = u.pm * BM + wr * 64 + fr; int col0 = nt * BM + wc * 32 + 8 * fq;
        asm volatile("" : "+v"(col0));
        const float* bp = b2 + (size_t)e * 2048 + col0;
        f32x4 bv[2][2];
#pragma unroll
        for (int bj = 0; bj < 2; ++bj)
#pragma unroll
            for (int n = 0; n < 2; ++n) bv[bj][n] = *(const f32x4*)(bp + bj * HALF + 4 * n);
#pragma unroll
        for (int ai = 0; ai < 2; ++ai)
#pragma unroll
            for (int m = 0; m < 4; ++m) { bf16_t* rowp = O + (size_t)(row0 + ai * HALF + m * 16) * 2048 + col0;
#pragma unroll
                for (int bj = 0; bj < 2; ++bj) { const f32x4 v0 = acc[ai][bj][m][0] * DESCALE + bv[bj][0], v1 = acc[ai][bj][m][1] * DESCALE + bv[bj][1];
                    u32x4 w; w.x = cvt_pk_bf16(v0[0], v0[1]); w.y = cvt_pk_bf16(v0[2], v0[3]); w.z = cvt_pk_bf16(v1[0], v1[1]); w.w = cvt_pk_bf16(v1[2], v1[3]);
                    *(u32x4*)(rowp + bj * HALF) = w; } }
    }
};
}

#define XB_TMO      128
#define XB_XCNT(j)  (256  + 64 * (j))
#define XB_XSUB(j)  (1280 + 64 * (j))
#define XB_XGEN(j)  (2304 + 64 * (j))
#define XB_TOP      3328
#define XB_TOPGEN   3392
#define XCD_BAR_WORDS 3456
#define XB_SPIN_CAP (1u << 22)
__device__ __forceinline__ unsigned xb_ld(unsigned* p)              { return __hip_atomic_load(p, __ATOMIC_RELAXED, __HIP_MEMORY_SCOPE_AGENT); }
__device__ __forceinline__ unsigned xb_add(unsigned* p, unsigned v) { return __hip_atomic_fetch_add(p, v, __ATOMIC_RELAXED, __HIP_MEMORY_SCOPE_AGENT); }
__device__ __forceinline__ unsigned xb_xcc_id() { return (unsigned)__builtin_amdgcn_s_getreg((3 << 11) | 20) & 0xFu; }
#define XB_SPIN(cond, bar) do { unsigned _sp = 0; while (cond) { __builtin_amdgcn_s_sleep(1); \
    if ((++_sp & 255u) == 0u) { if (xb_ld(&(bar)[XB_TMO])) break; if (_sp > XB_SPIN_CAP) { atomicAdd(&(bar)[XB_TMO], 1u); break; } } } } while (0)
struct XcdBarrier { unsigned* bar; unsigned x; volatile LAS unsigned* st; };
__device__ __forceinline__ XcdBarrier xcd_barrier_post(unsigned* bar, volatile LAS unsigned* st) {
    XcdBarrier b; b.bar = bar; b.x = xb_xcc_id(); b.st = st;
    if (threadIdx.x == 0) (void)xb_add(&bar[XB_XCNT(b.x)], 1u);
    return b;
}
__device__ __forceinline__ void xcd_barrier_complete(unsigned* bar, unsigned x, unsigned& nloc, unsigned& nx) {
    const unsigned G = gridDim.x * gridDim.y * gridDim.z;
    unsigned sum, cnt, mine, sp = 0u;
    for (;;) {
        sum = 0u; cnt = 0u; mine = 0u;
#pragma unroll
        for (unsigned j = 0; j < 16; ++j) { const unsigned c = xb_ld(&bar[XB_XCNT(j)]); sum += c; cnt += (c > 0u) ? 1u : 0u; mine = (j == x) ? c : mine; }
        if (sum == G) break;
        __builtin_amdgcn_s_sleep(1);
        if ((++sp & 255u) == 0u) { if (xb_ld(&bar[XB_TMO])) break; if (sp > XB_SPIN_CAP) { atomicAdd(&bar[XB_TMO], 1u); break; } }
    }
    nloc = mine > 0u ? mine : 1u; nx = cnt > 0u ? cnt : 1u;
}
__device__ __forceinline__ void xcd_barrier(const XcdBarrier& b) {
    asm volatile("s_waitcnt vmcnt(0)" ::: "memory");
    __syncthreads();
    if (threadIdx.x == 0) {
        unsigned* bar = b.bar;
        __builtin_amdgcn_s_waitcnt(0);
        unsigned nloc = b.st[0], nx = b.st[1];
        if (nloc == 0u) { xcd_barrier_complete(bar, b.x, nloc, nx); b.st[0] = nloc; b.st[1] = nx; }
        const unsigned old = xb_add(&bar[XB_XSUB(b.x)], 1u);
        const unsigned gen = old / nloc;
        if (old + 1u == (gen + 1u) * nloc) {
            __builtin_amdgcn_fence(__ATOMIC_RELEASE, "agent");
            asm volatile("s_waitcnt vmcnt(0)" ::: "memory");
            const unsigned og = xb_add(&bar[XB_TOP], 1u);
            const unsigned tg = og / nx;
            if (og + 1u == (tg + 1u) * nx) xb_add(&bar[XB_TOPGEN], 1u);
            else XB_SPIN(xb_ld(&bar[XB_TOPGEN]) == tg, bar);
            __builtin_amdgcn_fence(__ATOMIC_ACQUIRE, "agent");
            xb_add(&bar[XB_XGEN(b.x)], 1u);
            asm volatile("s_waitcnt vmcnt(0)" ::: "memory");
        } else {
            XB_SPIN(xb_ld(&bar[XB_XGEN(b.x)]) == gen, bar);
            __builtin_amdgcn_fence(__ATOMIC_ACQUIRE, "agent");
            asm volatile("s_waitcnt vmcnt(0)" ::: "memory");
        }
    }
    __syncthreads();
}

constexpr size_t al256(size_t x) { return (x + 255) & ~(size_t)255; }
constexpr size_t WS_CTL = 0, CTL_BYTES = 1u << 20;
constexpr int CW_BAR = 4096;
constexpr int CW_CNT = 16384;
constexpr size_t WS_SLOTTOK = WS_CTL + CTL_BYTES;
constexpr size_t WS_TOPI = WS_SLOTTOK + al256((size_t)NSLOT_MAX * 4);
constexpr size_t WS_GATE = WS_TOPI + (size_t)NASG * 4;
constexpr size_t WS_POS = WS_GATE + (size_t)NASG * 4;
constexpr size_t WS_SLOTOF = WS_POS + (size_t)NASG * 4;
constexpr size_t WS_BONUS = WS_SLOTOF + (size_t)NASG * 4;
constexpr size_t WS_XB = WS_BONUS + (size_t)M * 16 * 4;
constexpr size_t WS_WINT = WS_XB + (size_t)M * D * 2;
constexpr size_t WS_WOUTT = WS_WINT + (size_t)IN_PAD * D * 2;
constexpr size_t WS_LORAT = WS_WOUTT + (size_t)D * D * 2;
constexpr size_t WS_WPOOLT = WS_LORAT + (size_t)3072 * LK * 2;
constexpr size_t WS_PROJ = WS_WPOOLT + (size_t)1024 * 256 * 2;
constexpr size_t WS_LIN = WS_PROJ + (size_t)M * IN_PAD * 2;
constexpr size_t WS_POOLED = WS_LIN + (size_t)M * LK * 2;
constexpr size_t WS_WDEC = WS_POOLED + (size_t)M * 1024 * 2;
constexpr size_t SZ_F1K = (size_t)M * 1024 * 4;
constexpr size_t WS_LOUT = WS_WDEC + SZ_F1K  , WS_R = WS_LOUT + 3 * SZ_F1K, WS_K2 = WS_R + SZ_F1K, WS_V = WS_K2 + SZ_F1K, WS_KK = WS_V + SZ_F1K, WS_BB = WS_KK + SZ_F1K, WS_Y = WS_BB + SZ_F1K;
constexpr size_t WS_MIXIN = WS_Y + SZ_F1K;
constexpr size_t WS_MIX = WS_MIXIN + (size_t)M * D * 2;
constexpr size_t WS_H = WS_MIX + (size_t)M * D * 4;
constexpr size_t WS_HB = WS_H + (size_t)M * D * 4;
constexpr size_t WS_XS = WS_HB + (size_t)M * D;
constexpr size_t WS_W1T = WS_XS + (size_t)NSLOT_MAX * D;
constexpr size_t WS_W2T = WS_W1T + (size_t)NE * 4096 * D;
constexpr size_t WS_ACT = WS_W2T + (size_t)NE * 2048 * DFF;
constexpr size_t WS_YS = WS_ACT + (size_t)NSLOT_MAX * DFF;
constexpr size_t WS_END = WS_YS + (size_t)NSLOT_MAX * D * 2;

constexpr int RING_BYTES = 131072;
constexpr int LDSCTL_OFF = 159744;
constexpr int LDS_BYTES = 163840;

struct Args { const float* in[26]; float* out; unsigned char* ws; int ph_lo, ph_hi, dup, pad; };

template <bool KFAST = false> __device__ __forceinline__ void tr_load(const float* W, int N, int item, int lane, f32x4 (&v)[16]) {
    const int nblk = N / 64, kb = KFAST ? (item & 31) : item / nblk, nb = KFAST ? (item >> 5) : item % nblk, k0 = 64 * kb, n0 = 64 * nb;
    const int r = lane >> 4, c4 = (lane & 15) * 4;
#pragma unroll
    for (int i = 0; i < 16; ++i) v[i] = *(const GAS f32x4*)(W + (size_t)(k0 + 4 * i + r) * N + n0 + c4);
}
__device__ __forceinline__ void tr_store(const f32x4 (&v)[16], int K, int N, bf16* WT, size_t row_off, LAS float* scr, int item, int lane) {
    const int nblk = N / 64, kb = item / nblk, nb = item % nblk, k0 = 64 * kb, n0 = 64 * nb;
    const int r = lane >> 4, c4 = (lane & 15) * 4;
#pragma unroll
    for (int i = 0; i < 16; ++i) { LAS float* d = scr + (4 * i + r) * 65 + c4; d[0] = v[i].x; d[1] = v[i].y; d[2] = v[i].z; d[3] = v[i].w; }
    LDS_WAIT(); asm volatile("" ::: "memory");
    const int c = lane & 7;
#pragma unroll
    for (int p = 0; p < 8; ++p) { const int n = (lane >> 3) + 8 * p; const LAS float* q = scr + (8 * c) * 65 + n;
        v4u o; o.x = pk2(q[0 * 65], q[1 * 65]); o.y = pk2(q[2 * 65], q[3 * 65]); o.z = pk2(q[4 * 65], q[5 * 65]); o.w = pk2(q[6 * 65], q[7 * 65]);
        *(GAS v4u*)(WT + (row_off + n0 + n) * (size_t)K + k0 + 8 * c) = o; }
    LDS_WAIT(); asm volatile("" ::: "memory");
}
__device__ __forceinline__ unsigned pk4_fp8_nc(float a, float b, float c, float d) { int w = 0; w = __builtin_amdgcn_cvt_pk_fp8_f32(a, b, w, false); w = __builtin_amdgcn_cvt_pk_fp8_f32(c, d, w, true); return (unsigned)w; }
__device__ __forceinline__ void tr_store_fp8(const f32x4 (&v)[16], int K, int N, unsigned char* WT, size_t row_off, LAS float* scr, int item, int lane, float scale) {
    const int nblk = N / 64, kb = item / nblk, nb = item % nblk, k0 = 64 * kb, n0 = 64 * nb;
    const int r = lane >> 4, c4 = (lane & 15) * 4;
#pragma unroll
    for (int i = 0; i < 16; ++i) { const int k = 4 * i + r; *(LAS f32x4*)(scr + k * 64 + (c4 ^ (8 * (i >> 2)))) = v[i] * scale; }
    LDS_WAIT(); asm volatile("" ::: "memory");
    const int c = lane & 3;
#pragma unroll
    for (int p = 0; p < 4; ++p) { const int n = (lane >> 2) + 16 * p; const LAS float* q = scr + (16 * c) * 64 + (n ^ (8 * c));
        float f[16];
#pragma unroll
        for (int jj = 0; jj < 16; ++jj) f[jj] = q[jj * 64];
        v4u o; o.x = pk4_fp8_nc(f[0], f[1], f[2], f[3]); o.y = pk4_fp8_nc(f[4], f[5], f[6], f[7]); o.z = pk4_fp8_nc(f[8], f[9], f[10], f[11]); o.w = pk4_fp8_nc(f[12], f[13], f[14], f[15]);
        *(GAS v4u*)(WT + (row_off + n0 + n) * (size_t)K + k0 + 16 * c) = o; }
    LDS_WAIT(); asm volatile("" ::: "memory");
}
__device__ __forceinline__ void transpose_item(const float* W, int K, int N, bf16* WT, size_t row_off, LAS float* scr, int item, int lane) {
    f32x4 v[16]; tr_load(W, N, item, lane, v); tr_store(v, K, N, WT, row_off, scr, item, lane);
}

__global__ void __launch_bounds__(NTHR, 2) mk_fwd(Args args) {
    extern __shared__ __attribute__((aligned(16))) unsigned char lds_raw[];
    LAS unsigned char* lds = (LAS unsigned char*)lds_raw;
    volatile LAS unsigned* MISC = (volatile LAS unsigned*)(lds + LDSCTL_OFF);
    LAS int* PS = (LAS int*)(lds + LDSCTL_OFF + 256);
    const int tid = threadIdx.x, lane = tid & 63, wave = __builtin_amdgcn_readfirstlane(tid >> 6);
    const int G = gridDim.x, bx = blockIdx.x;
    const int vcu = (bx % 8) * (G / 8) + bx / 8;
    const int gw = vcu * NWAVES + wave, NGW = G * NWAVES;
    unsigned char* ws = args.ws;
    gu32* ctl = (gu32*)(ws + WS_CTL);
    const float* x = args.in[0]; const float* w_in = args.in[1]; const float* mu = args.in[2]; const float* w0 = args.in[3]; const float* w2d = args.in[4];
    const float* a0 = args.in[5]; const float* a2 = args.in[6]; const float* g2 = args.in[7]; const float* k_k = args.in[8]; const float* k_a = args.in[9];
    const float* r_k = args.in[10]; const float* lnx_w = args.in[11]; const float* lnx_b = args.in[12]; const float* w_pool = args.in[13]; const float* pool_scale = args.in[14];
    const float* w_out = args.in[15]; const float* ln1_w = args.in[16]; const float* ln1_b = args.in[17]; const float* router_w = args.in[18]; const float* router_b = args.in[19];
    const float* w1 = args.in[20]; const float* b1 = args.in[21]; const float* w2 = args.in[22]; const float* b2 = args.in[23]; const float* ln2_w = args.in[24]; const float* ln2_b = args.in[25];
    float* out = args.out;
    int* CNTWG = (int*)(ws + WS_CTL) + CW_CNT;
    int* slot_tok = (int*)(ws + WS_SLOTTOK); int* TOPI = (int*)(ws + WS_TOPI); float* GATE = (float*)(ws + WS_GATE); int* POS = (int*)(ws + WS_POS); int* SLOT_OF = (int*)(ws + WS_SLOTOF);
    float* BONUS = (float*)(ws + WS_BONUS);
    bf16* XB = (bf16*)(ws + WS_XB); bf16* WINT = (bf16*)(ws + WS_WINT); bf16* WOUTT = (bf16*)(ws + WS_WOUTT); bf16* LORAT = (bf16*)(ws + WS_LORAT); bf16* WPOOLT = (bf16*)(ws + WS_WPOOLT);
    bf16* PROJ = (bf16*)(ws + WS_PROJ); bf16* LIN = (bf16*)(ws + WS_LIN); bf16* POOLED = (bf16*)(ws + WS_POOLED);
    float* WDEC = (float*)(ws + WS_WDEC); float* LOUT = (float*)(ws + WS_LOUT); float* Rr = (float*)(ws + WS_R); float* K2 = (float*)(ws + WS_K2);
    float* Vv = (float*)(ws + WS_V); float* KK = (float*)(ws + WS_KK); float* BB = (float*)(ws + WS_BB); float* Yy = (float*)(ws + WS_Y);
    bf16* MIXIN = (bf16*)(ws + WS_MIXIN); bf16* MIX = (bf16*)(ws + WS_MIX); bf16* H = (bf16*)(ws + WS_H); unsigned char* HQ = (unsigned char*)(ws + WS_HB);
    unsigned char* XS = ws + WS_XS; unsigned char* W1T = ws + WS_W1T; unsigned char* W2T = ws + WS_W2T; unsigned char* ACT = ws + WS_ACT; bf16* YS = (bf16*)(ws + WS_YS);

    for (int u = tid; u < (LDS_BYTES - LDSCTL_OFF) / 4; u += NTHR) ((LAS unsigned*)(lds + LDSCTL_OFF))[u] = 0u;
    __syncthreads();
    XcdBarrier bar; bar.bar = (unsigned*)(ctl + CW_BAR); bar.x = 0; bar.st = nullptr;
    if (MK_N_LAUNCHES == 1) bar = xcd_barrier_post((unsigned*)(ctl + CW_BAR), MISC + 8);
    const int lo = args.ph_lo, hi = args.ph_hi;
#ifndef PHASE_MASK
#define PHASE_MASK 0xFFFF
#endif
#define IN(k) (((PHASE_MASK >> (k)) & 1) && lo <= (k) && (k) < hi)
#define SEAM(k) do { if (IN(k) && IN((k) + 1)) xcd_barrier(bar); } while (0)

    if (IN(0)) {
        LAS float* scr = (LAS float*)(lds + wave * 16640);
        for (size_t i = (size_t)gw * 64 + lane; i < (size_t)M * D / 8; i += (size_t)NGW * 64) {
            const f32x4 a = *(const GAS f32x4*)(x + i * 8), b = *(const GAS f32x4*)(x + i * 8 + 4);
            v4u o; o.x = pk2(a.x, a.y); o.y = pk2(a.z, a.w); o.z = pk2(b.x, b.y); o.w = pk2(b.z, b.w);
            *(GAS v4u*)(XB + i * 8) = o;
        }
        constexpr int I_IN = (D / 64) * (IN_COLS / 64)  , I_OUT = (D / 64) * (D / 64);
        for (int it = gw; it < I_IN + I_OUT; it += NGW) {
            if (it < I_IN) transpose_item(w_in, D, IN_COLS, WINT, 0, scr, it, lane);
            else transpose_item(w_out, D, D, WOUTT, 0, scr, it - I_IN, lane);
        }
        for (int i = gw * 64 + lane; i < 32 * D; i += NGW * 64) { const int nn = 4352 + (i >> 11), k = i & 2047; WINT[(size_t)nn * D + k] = (bf16)f2bf(w_in[(size_t)k * IN_COLS + nn]); }
        for (size_t i = (size_t)gw * 64 + lane; i < (size_t)(IN_PAD - IN_COLS) * D / 8; i += (size_t)NGW * 64) *(GAS v4u*)(WINT + (size_t)IN_COLS * D + i * 8) = (v4u){0u, 0u, 0u, 0u};
        for (int i = gw * 64 + lane; i < 3072 * LK; i += NGW * 64) {
            const int n = i / LK, k = i % LK; float v = 0.f;
            if (n < 1024) { if (k < 64) v = w2d[k * 1024 + n]; }
            else if (n < 2048) { if (k >= 64 && k < 128) v = a2[(k - 64) * 1024 + (n - 1024)]; }
            else { if (k >= 128 && k < 288) v = g2[(k - 128) * 1024 + (n - 2048)]; }
            LORAT[i] = (bf16)f2bf(v);
        }
        for (int i = gw * 64 + lane; i < 1024 * 256; i += NGW * 64) {
            const int n = i >> 8, c = i & 255, g = n >> 8, d = n & 255;
            WPOOLT[i] = (bf16)f2bf(w_pool[((size_t)g * 256 + c) * 256 + d]);
        }
    }
    SEAM(0);

    if (IN(1)) {
        pg8::Gemm g{XB, WINT, D, D}; pg8::GridOrder S; S.init(M / 256, IN_PAD / 256, G, bx, (size_t)256 * D * 2, 0, (size_t)256 * D * 2);
        pg8::EpiBf16Plain E{PROJ, IN_PAD};
        pg8::gemm_phase<pg8::EpiBf16Plain, pg8::GridOrder, true, true>(lds, g, S, E);
    }
    SEAM(1);

    if (IN(2)) {
        for (int m = gw; m < M; m += NGW) {
            const int t = m % SEQ;
            const bf16* pr = PROJ + (size_t)m * IN_PAD; const bf16* pp = pr - IN_PAD;
#pragma unroll
            for (int q = 0; q < 6; ++q) {
                const int i = lane + 64 * q; float v = 0.f;
                if (i < 288) { const int c = 3072 + i; const float cur = ld1bf(pr + c), prev = t > 0 ? ld1bf(pp + c) : 0.f; const float s = cur + (prev - cur) * mu[c];
                    v = i < 64 ? tanhf(s) : (i < 128 ? s : 1.0f / (1.0f + __expf(-s))); }
                LIN[(size_t)m * LK + i] = (bf16)f2bf(v);
            }
#pragma unroll
            for (int q = 0; q < 4; ++q) {
                const int c = 4 * lane + 256 * q, win = 2 << q; const int n = (t + 1) < win ? (t + 1) : win;
                const f32x4 cur = ld4bf(pr + SHIFT_W + c); f32x4 sum = cur;
                for (int s = 1; s < n; ++s) sum += ld4bf(pr - (size_t)s * IN_PAD + SHIFT_W + c);
                const float inv = 1.0f / (float)n; const f32x4 pv = sum * inv - cur;
                v2u o; o.x = pk2(pv.x, pv.y); o.y = pk2(pv.z, pv.w);
                *(GAS v2u*)(POOLED + (size_t)m * 1024 + c) = o;
            }
        }
    }
    SEAM(2);

    if (IN(3)) {
#ifndef NO_LORA
        { pg8::Gemm g{LIN, LORAT, LK, LK}; pg8::GridOrder S; S.init(M / 256, 12, G, bx, (size_t)256 * LK * 2, 0, (size_t)256 * LK * 2);
          pg8::EpiF32 E{LOUT, 3072};
          pg8::gemm_phase<pg8::EpiF32, pg8::GridOrder, true, true>(lds, g, S, E); }
#endif
#ifndef NO_POOL
        { pg8::Gemm g{POOLED, WPOOLT, 1024, 256}; pg8::GridOrder S; S.init(M / 256, 4, G, bx, (size_t)256 * 1024 * 2, (size_t)256 * 2, (size_t)256 * 256 * 2);
          pg8::EpiPool E{MIXIN, pool_scale};
          pg8::gemm_phase<pg8::EpiPool, pg8::GridOrder, true, true>(lds, g, S, E); }
#endif
    }
    SEAM(3);

    if (IN(4)) {
        constexpr int CH = 16, NCHUNK = SEQ / CH;
        constexpr int PK_PA = 0, PK_PR = 2048, PK_QQ = 4096, PK_TT = 5120, PK_GG = 6144, PK_BK = 7168, PK_VT = 11264, PK_WC = 13312, PK_BYTES = 16384;
        const int tr = lane & 15, q = lane >> 4;
        for (int arep_ = 0; arep_ < P5A_REPS; ++arep_) {
                const int j = lane;
                LAS bf16* IMG = (LAS bf16*)(lds + wave * 10240);
                LAS float* PTs = (LAS float*)(lds + wave * 10240 + 9216);
                const int pos = (j & 32) | ((j & 12) << 1) | ((j & 16) >> 2) | (j & 3);
#pragma unroll 1
                for (int u = gw; u < 64 * NCHUNK; u += NGW) {
                    const int hd = u >> 8, c = u & 255, b = hd >> 4, h = hd & 15, cj = h * 64 + j;
                    const float mu_r = mu[cj], mu_k = mu[1024 + cj], mu_v = mu[2048 + cj], c_w0 = w0[cj], c_a0 = a0[cj], c_kk = k_k[cj], c_ka = k_a[cj];
                    unsigned char* pk = ws + WS_R + ((size_t)hd * NCHUNK + c) * PK_BYTES;
                    const size_t m0 = (size_t)b * SEQ + (size_t)c * CH;
                    float At[16], Rt[16], Bt[16], Kt[16], Vt[16];
                    float Wc = 1.f, pr_r = 0.f, pr_k = 0.f, pr_v = 0.f;
                    if (c > 0) { const bf16* pp = PROJ + (m0 - 1) * IN_PAD + cj; pr_r = ld1bf(pp); pr_k = ld1bf(pp + 1024); pr_v = ld1bf(pp + 2048); }
#pragma unroll
                    for (int t = 0; t < 16; ++t) {
                        const bf16* prow = PROJ + (m0 + t) * IN_PAD + cj; const float* lrow = LOUT + (m0 + t) * 3072 + cj;
                        const float cr = ld1bf(prow), ck = ld1bf(prow + 1024), cv = ld1bf(prow + 2048), wl = lrow[0] + c_w0, al = lrow[1024] + c_a0;
                        const float r = cr + (pr_r - cr) * mu_r, k = ck + (pr_k - ck) * mu_k, v = cv + (pr_v - cv) * mu_v;
                        pr_r = cr; pr_k = ck; pr_v = cv;
                        const float dec = fast_decay(wl), a = fast_sigmoid(al);
                        float kk = k * c_kk; const float ss = wave_sum_dpp(kk * kk); kk = kk * __builtin_amdgcn_rsqf(fmaxf(ss, 1e-24f));
                        const float k2 = k * (1.0f + (a - 1.0f) * c_ka), bb = kk * a;
                        const float Wprev = Wc; Wc = Wc * dec; const float iw = __builtin_amdgcn_rcpf(Wc);
                        At[t] = -kk * Wprev; Rt[t] = r * Wc; Bt[t] = bb * iw; Kt[t] = k2 * iw; Vt[t] = v;
                    }
#pragma unroll
                    for (int t = 0; t < 16; ++t) {
                        const bf16 ab = (bf16)f2bf(At[t]), rb = (bf16)f2bf(Rt[t]);
                        IMG[0 * 1152 + t * 72 + j] = ab; IMG[1 * 1152 + t * 72 + j] = rb; IMG[2 * 1152 + t * 72 + j] = (bf16)f2bf(Bt[t]); IMG[3 * 1152 + t * 72 + j] = (bf16)f2bf(Kt[t]);
                        ((GAS bf16*)(pk + PK_PA))[t * 64 + pos] = ab; ((GAS bf16*)(pk + PK_PR))[t * 64 + pos] = rb;
                    }
#pragma unroll
                    for (int qq = 0; qq < 4; ++qq) { v4u o; o.x = pk2(Bt[4 * qq] * Wc, Bt[4 * qq + 1] * Wc); o.y = pk2(Bt[4 * qq + 2] * Wc, Bt[4 * qq + 3] * Wc); o.z = pk2(Kt[4 * qq] * Wc, Kt[4 * qq + 1] * Wc); o.w = pk2(Kt[4 * qq + 2] * Wc, Kt[4 * qq + 3] * Wc);
                        *(GAS v4u*)(pk + PK_BK + j * 64 + qq * 16) = o; }
#pragma unroll
                    for (int g = 0; g < 2; ++g) { v4u o; o.x = pk2(Vt[8 * g], Vt[8 * g + 1]); o.y = pk2(Vt[8 * g + 2], Vt[8 * g + 3]); o.z = pk2(Vt[8 * g + 4], Vt[8 * g + 5]); o.w = pk2(Vt[8 * g + 6], Vt[8 * g + 7]);
                        *(GAS v4u*)(pk + PK_VT + j * 32 + g * 16) = o; }
                    ((GAS float*)(pk + PK_WC))[j] = Wc;
                    asm volatile("s_waitcnt lgkmcnt(0)" ::: "memory");
                    const bf16x8 fa0 = *(const LAS bf16x8*)(IMG + 0 * 1152 + tr * 72 + 8 * q), fa1 = *(const LAS bf16x8*)(IMG + 0 * 1152 + tr * 72 + 32 + 8 * q);
                    const bf16x8 fr0 = *(const LAS bf16x8*)(IMG + 1 * 1152 + tr * 72 + 8 * q), fr1 = *(const LAS bf16x8*)(IMG + 1 * 1152 + tr * 72 + 32 + 8 * q);
                    const bf16x8 fb0 = *(const LAS bf16x8*)(IMG + 2 * 1152 + tr * 72 + 8 * q), fb1 = *(const LAS bf16x8*)(IMG + 2 * 1152 + tr * 72 + 32 + 8 * q);
                    const bf16x8 fk0 = *(const LAS bf16x8*)(IMG + 3 * 1152 + tr * 72 + 8 * q), fk1 = *(const LAS bf16x8*)(IMG + 3 * 1152 + tr * 72 + 32 + 8 * q);
                    const f32x4 z4 = (f32x4){0.f, 0.f, 0.f, 0.f};
                    f32x4 PT = __builtin_amdgcn_mfma_f32_16x16x32_bf16(fa0, fb0, z4, 0, 0, 0); PT = __builtin_amdgcn_mfma_f32_16x16x32_bf16(fa1, fb1, PT, 0, 0, 0);
                    f32x4 QT = __builtin_amdgcn_mfma_f32_16x16x32_bf16(fa0, fk0, z4, 0, 0, 0); QT = __builtin_amdgcn_mfma_f32_16x16x32_bf16(fa1, fk1, QT, 0, 0, 0);
                    f32x4 GB = __builtin_amdgcn_mfma_f32_16x16x32_bf16(fr0, fb0, z4, 0, 0, 0); GB = __builtin_amdgcn_mfma_f32_16x16x32_bf16(fr1, fb1, GB, 0, 0, 0);
                    f32x4 GK = __builtin_amdgcn_mfma_f32_16x16x32_bf16(fr0, fk0, z4, 0, 0, 0); GK = __builtin_amdgcn_mfma_f32_16x16x32_bf16(fr1, fk1, GK, 0, 0, 0);
                    const int s_ = tr, rec = (s_ >> 2) * 8 + (s_ & 3);
#pragma unroll
                    for (int e = 0; e < 4; ++e) { const int t = 4 * q + e;
                        const float pv = s_ < t ? PT[e] : 0.f, qv = s_ < t ? QT[e] : 0.f, gb = s_ <= t ? GB[e] : 0.f, gk = s_ <= t ? GK[e] : 0.f;
                        PTs[t * 16 + s_] = pv;
                        ((GAS bf16*)(pk + PK_QQ))[t * 32 + rec] = (bf16)f2bf(qv); ((GAS bf16*)(pk + PK_QQ))[t * 32 + rec + 4] = (bf16)0;
                        ((GAS bf16*)(pk + PK_GG))[t * 32 + rec] = (bf16)f2bf(gb); ((GAS bf16*)(pk + PK_GG))[t * 32 + rec + 4] = (bf16)f2bf(gk); }
                    asm volatile("s_waitcnt lgkmcnt(0)" ::: "memory");
                    float Tr[16];
#pragma unroll
                    for (int t = 0; t < 16; ++t) { float acc = (t == s_) ? 1.f : 0.f;
#pragma unroll
                        for (int r4_ = 0; r4_ < (t + 3) / 4; ++r4_) { const f32x4 pr4 = *(const LAS f32x4*)(PTs + t * 16 + 4 * r4_);
#pragma unroll
                            for (int e = 0; e < 4; ++e) if (4 * r4_ + e < t) acc += pr4[e] * Tr[4 * r4_ + e]; }
                        Tr[t] = acc; }
                    if (q == 0) {
#pragma unroll
                        for (int t = 0; t < 16; ++t) { ((GAS bf16*)(pk + PK_TT))[t * 32 + rec] = (bf16)f2bf(Tr[t]); ((GAS bf16*)(pk + PK_TT))[t * 32 + rec + 4] = (bf16)0; } }
                    asm volatile("s_waitcnt lgkmcnt(0)" ::: "memory");
                }
            }
    }
    SEAM(4);

    if (IN(5)) {
        constexpr int P5_OPS = 0, P5_VV = 81920, P5_YW = 90112, P5_SC = 98304;
        const int xcd_i = bx % 8, slot_i = bx / 8;
        constexpr int NSCAN_X = 8;
        if (slot_i < NSCAN_X) {
            constexpr int CH = 16, NCHUNK = SEQ / CH, NSLOT = 8, LAG = 3;
            LAS unsigned* ring_ready = (LAS unsigned*)(lds + LDSCTL_OFF + 896); LAS unsigned* ring_done = ring_ready + 4;
            constexpr int PK_PA = 0, PK_PR = 2048, PK_QQ = 4096, PK_TT = 5120, PK_GG = 6144, PK_BK = 7168, PK_VT = 11264, PK_WC = 13312, PK_BYTES = 16384;
            const int hd = xcd_i * NSCAN_X + slot_i, b = hd >> 4, h = hd & 15;
            const size_t mbase = (size_t)b * SEQ;
            static_assert((size_t)64 * NCHUNK * PK_BYTES <= 4 * SZ_F1K, "packs fit the four unused f32 [M][1024] buffers at WS_R");
            unsigned char* PACK = ws + WS_R + (size_t)hd * NCHUNK * PK_BYTES;
            const int tr = lane & 15, q = lane >> 4;
            if (wave < 4) {
                const int icol = 16 * wave + tr;
                f32x4 H0 = (f32x4){0.f, 0.f, 0.f, 0.f}, H1 = H0, H2 = H0, H3 = H0;
                bf16x8 A_fa0, A_fa1, A_fr0, A_fr1, A_fq, A_ft, A_fg, A_b0, A_b1, A_b2, A_b3; v2u A_v; f32x4 A_w0, A_w1, A_w2, A_w3;
                bf16x8 B_fa0, B_fa1, B_fr0, B_fr1, B_fq, B_ft, B_fg, B_b0, B_b1, B_b2, B_b3; v2u B_v; f32x4 B_w0, B_w1, B_w2, B_w3;
#define CK_LOAD(P, c_) do { { unsigned sp_ = 0; for (;;) { const v4u rr_ = *(volatile LAS v4u*)ring_ready; const unsigned mn_ = min(min(rr_.x, rr_.y), min(rr_.z, rr_.w)); if (mn_ >= (unsigned)((c_) + 1)) break; __builtin_amdgcn_s_sleep(0); if (++sp_ > (1u << 26)) break; } } asm volatile("" ::: "memory"); \
                    const LAS unsigned char* pk_ = lds + ((c_) & (NSLOT - 1)) * PK_BYTES; \
                    P##_fa0 = *(const LAS bf16x8*)(pk_ + PK_PA + (tr * 64 + 8 * q) * 2); P##_fa1 = *(const LAS bf16x8*)(pk_ + PK_PA + (tr * 64 + 32 + 8 * q) * 2); \
                    P##_fr0 = *(const LAS bf16x8*)(pk_ + PK_PR + (tr * 64 + 8 * q) * 2); P##_fr1 = *(const LAS bf16x8*)(pk_ + PK_PR + (tr * 64 + 32 + 8 * q) * 2); \
                    P##_fq = *(const LAS bf16x8*)(pk_ + PK_QQ + (tr * 4 + q) * 16); P##_ft = *(const LAS bf16x8*)(pk_ + PK_TT + (tr * 4 + q) * 16); P##_fg = *(const LAS bf16x8*)(pk_ + PK_GG + (tr * 4 + q) * 16); \
                    P##_b0 = *(const LAS bf16x8*)(pk_ + PK_BK + ((0 + tr) * 4 + q) * 16); P##_b1 = *(const LAS bf16x8*)(pk_ + PK_BK + ((16 + tr) * 4 + q) * 16); \
                    P##_b2 = *(const LAS bf16x8*)(pk_ + PK_BK + ((32 + tr) * 4 + q) * 16); P##_b3 = *(const LAS bf16x8*)(pk_ + PK_BK + ((48 + tr) * 4 + q) * 16); \
                    P##_v = *(const LAS v2u*)(pk_ + PK_VT + icol * 32 + q * 8); \
                    P##_w0 = *(const LAS f32x4*)(pk_ + PK_WC + (0 + 4 * q) * 4); P##_w1 = *(const LAS f32x4*)(pk_ + PK_WC + (16 + 4 * q) * 4); P##_w2 = *(const LAS f32x4*)(pk_ + PK_WC + (32 + 4 * q) * 4); P##_w3 = *(const LAS f32x4*)(pk_ + PK_WC + (48 + 4 * q) * 4); } while (0)
#define CK_MM(a_, b_, c_) __builtin_amdgcn_mfma_f32_16x16x32_bf16(a_, b_, c_, 0, 0, 0)
#define CK_STEP(P, c_) do { const f32x4 z4 = (f32x4){0.f, 0.f, 0.f, 0.f}; \
                    v4u hb0, hb1; hb0.x = cvt_pk_bf16_nat(H0[0], H0[1]); hb0.y = cvt_pk_bf16_nat(H0[2], H0[3]); hb0.z = cvt_pk_bf16_nat(H1[0], H1[1]); hb0.w = cvt_pk_bf16_nat(H1[2], H1[3]); \
                    hb1.x = cvt_pk_bf16_nat(H2[0], H2[1]); hb1.y = cvt_pk_bf16_nat(H2[2], H2[3]); hb1.z = cvt_pk_bf16_nat(H3[0], H3[1]); hb1.w = cvt_pk_bf16_nat(H3[2], H3[3]); \
                    const bf16x8 Hb0 = __builtin_bit_cast(bf16x8, hb0), Hb1 = __builtin_bit_cast(bf16x8, hb1); \
                    v4u vb_; vb_.x = P##_v.x; vb_.y = P##_v.y; vb_.z = P##_v.x; vb_.w = P##_v.y; const bf16x8 Vb = __builtin_bit_cast(bf16x8, vb_); \
                    f32x4 XQ = CK_MM(P##_fa0, Hb0, z4); XQ = CK_MM(P##_fa1, Hb1, XQ); XQ = CK_MM(P##_fq, Vb, XQ); \
                    v4u xb_; xb_.x = cvt_pk_bf16_nat(XQ[0], XQ[1]); xb_.y = cvt_pk_bf16_nat(XQ[2], XQ[3]); xb_.z = 0u; xb_.w = 0u; \
                    const f32x4 U = CK_MM(P##_ft, __builtin_bit_cast(bf16x8, xb_), z4); \
                    v4u ub_; ub_.x = cvt_pk_bf16_nat(U[0], U[1]); ub_.y = cvt_pk_bf16_nat(U[2], U[3]); ub_.z = P##_v.x; ub_.w = P##_v.y; const bf16x8 UVb = __builtin_bit_cast(bf16x8, ub_); \
                    f32x4 Y = CK_MM(P##_fr0, Hb0, z4); Y = CK_MM(P##_fr1, Hb1, Y); Y = CK_MM(P##_fg, UVb, Y); \
                    H0 = CK_MM(P##_b0, UVb, H0 * P##_w0); H1 = CK_MM(P##_b1, UVb, H1 * P##_w1); H2 = CK_MM(P##_b2, UVb, H2 * P##_w2); H3 = CK_MM(P##_b3, UVb, H3 * P##_w3); \
                    float* yo_ = Yy + (mbase + (size_t)(c_) * CH + 4 * q) * 1024 + h * 64 + icol; \
                    yo_[0] = Y[0]; yo_[1024] = Y[1]; yo_[2048] = Y[2]; yo_[3072] = Y[3]; \
                    asm volatile("s_waitcnt lgkmcnt(0)" ::: "memory"); if (lane == 0) __hip_atomic_fetch_add(ring_done + wave, 1u, __ATOMIC_RELAXED, __HIP_MEMORY_SCOPE_WORKGROUP);     } while (0)
                CK_LOAD(A, 0);
#pragma unroll 1
                for (int c = 0; c < NCHUNK; c += 2) {
                    CK_LOAD(B, c + 1); CK_STEP(A, c);
                    CK_LOAD(A, (c + 2 < NCHUNK ? c + 2 : c)); CK_STEP(B, c + 1);
                }
#undef CK_LOAD
#undef CK_MM
#undef CK_STEP
            } else {
                const int lw = wave - 4;
#pragma unroll 1
                for (int c = 0; c < NCHUNK + LAG; ++c) {
                    if (c < NCHUNK) {
                        if (c >= NSLOT) { const unsigned want = (unsigned)(c - NSLOT + 1); unsigned sp_ = 0;
                            for (;;) { const v4u dd_ = *(volatile LAS v4u*)ring_done; if (min(min(dd_.x, dd_.y), min(dd_.z, dd_.w)) >= want) break; __builtin_amdgcn_s_sleep(0); if (++sp_ > (1u << 26)) break; } }
                        asm volatile("" ::: "memory");
                        const unsigned char* src = PACK + (size_t)c * PK_BYTES + lw * 1024 + lane * 16;
                        LAS unsigned char* dst = lds + (c & (NSLOT - 1)) * PK_BYTES + lw * 1024;
#pragma unroll
                        for (int p = 0; p < 4; ++p) __builtin_amdgcn_global_load_lds((const unsigned*)(src + p * 4096), (LAS unsigned*)(dst + p * 4096), 16, 0, 0);
                    }
                    if (c >= LAG) {
                        if (c < NCHUNK) asm volatile("s_waitcnt vmcnt(12)" ::: "memory"); else asm volatile("s_waitcnt vmcnt(0)" ::: "memory");
                        if (lane == 0) __hip_atomic_fetch_add(ring_ready + lw, 1u, __ATOMIC_RELAXED, __HIP_MEMORY_SCOPE_WORKGROUP);
                    }
                }
            }
        }
        else for (int crep_ = 0; crep_ < P5_CONV_REPS; ++crep_) {
            LAS float* scr = (LAS float*)(lds + wave * 16640);
            const int cw = (xcd_i * (32 - NSCAN_X) + slot_i - NSCAN_X) * NWAVES + wave;
            constexpr int I1 = (D / 64) * (4096 / 64), I2 = (DFF / 64) * (D / 64), IPE = I1 + I2;
            auto src_of = [&](int it, const float*& Wp, int& N, int& li) { const int e = it / IPE, r = it % IPE; if (r < I1) { Wp = w1 + (size_t)e * D * 4096; N = 4096; li = r; } else { Wp = w2 + (size_t)e * DFF * D; N = D; li = r - I1; } };
            f32x4 va[16], vb2[16], vc[16];
            constexpr int TOT = NE * IPE, STRIDE = (NWG - 8 * NSCAN_X) * NWAVES;
            int it = cw; const float* Wp; int N, li, li1;
#define CONV_STEP(cur, far) { const int itf = it + 2 * STRIDE; const float* Wn; int Nn, lif; \
                src_of(itf < TOT ? itf : it, Wn, Nn, lif); tr_load(Wn, Nn, lif, lane, far);     \
                { const int e = it / IPE, r = it % IPE; \
                  if (r < I1) tr_store_fp8(cur, D, 4096, W1T, (size_t)e * 4096, scr, li, lane, pg8::W_SCALE); else tr_store_fp8(cur, DFF, D, W2T, (size_t)e * 2048, scr, li, lane, pg8::W_SCALE); } \
                it += STRIDE; li = li1; li1 = lif; }
            if (it < TOT) { src_of(it, Wp, N, li); tr_load(Wp, N, li, lane, va);
                { const int it1 = it + STRIDE; src_of(it1 < TOT ? it1 : it, Wp, N, li1); tr_load(Wp, N, li1, lane, vb2); }
                for (;;) { CONV_STEP(va, vc); if (it >= TOT) break; CONV_STEP(vb2, va); if (it >= TOT) break; CONV_STEP(vc, vb2); if (it >= TOT) break; } }
#undef CONV_STEP
        }
    }
    SEAM(5);

    if (IN(6)) {
        for (int m = gw; m < M; m += NGW) {
            const int t = m % SEQ;
            const bf16* pr = PROJ + (size_t)m * IN_PAD; const bf16* pp = pr - IN_PAD; const float* lo = LOUT + (size_t)m * 3072;
#pragma unroll
            for (int q = 0; q < 4; ++q) {
                const int c = 4 * lane + 256 * q; const size_t o = (size_t)m * 1024 + c;
                f32x4 r = ld4bf(pr + c), k = ld4bf(pr + 1024 + c), v = ld4bf(pr + 2048 + c);
                f32x4 rp = (f32x4){0.f, 0.f, 0.f, 0.f}, kp = rp, vp = rp;
                if (t > 0) { rp = ld4bf(pp + c); kp = ld4bf(pp + 1024 + c); vp = ld4bf(pp + 2048 + c); }
                r = r + (rp - r) * *(const GAS f32x4*)(mu + c); k = k + (kp - k) * *(const GAS f32x4*)(mu + 1024 + c); v = v + (vp - v) * *(const GAS f32x4*)(mu + 2048 + c);
                const f32x4 al = *(const GAS f32x4*)(lo + 1024 + c) + *(const GAS f32x4*)(a0 + c);
                f32x4 a;
#pragma unroll
                for (int j = 0; j < 4; ++j) a[j] = 1.0f / (1.0f + __expf(-al[j]));
                const f32x4 k2 = k * (1.0f + (a - 1.0f) * *(const GAS f32x4*)(k_a + c));
                const f32x4 rk = *(const GAS f32x4*)(r_k + c);
                const float bon = row16_sum(r.x * k2.x * rk.x + r.y * k2.y * rk.y + r.z * k2.z * rk.z + r.w * k2.w * rk.w);
                const f32x4 y = *(const GAS f32x4*)(Yy + o);
                const float mean = row16_sum(y.x + y.y + y.z + y.w) * (1.0f / 64.0f);
                const f32x4 d = y - mean;
                const float var = row16_sum(d.x * d.x + d.y * d.y + d.z * d.z + d.w * d.w) * (1.0f / 64.0f);
                const float rstd = __builtin_amdgcn_rsqf(var + GN_EPS);
                f32x4 yn = d * rstd * *(const GAS f32x4*)(lnx_w + c) + *(const GAS f32x4*)(lnx_b + c);
                yn = yn + bon * v;
                yn = yn * *(const GAS f32x4*)(lo + 2048 + c);
                v2u ov; ov.x = pk2(yn.x, yn.y); ov.y = pk2(yn.z, yn.w);
                *(GAS v2u*)(MIXIN + (size_t)m * 2048 + c) = ov;
            }
        }
    }
    SEAM(6);

    if (IN(7)) {
        pg8::Gemm g{MIXIN, WOUTT, D, D}; pg8::GridOrder S; S.init(M / 256, D / 256, G, bx, (size_t)256 * D * 2, 0, (size_t)256 * D * 2);
        pg8::EpiBf16Plain E{MIX, D};
        pg8::gemm_phase<pg8::EpiBf16Plain, pg8::GridOrder, true, true>(lds, g, S, E);
    }
    SEAM(7);

    if (IN(8)) {
        LAS float* s_h = (LAS float*)lds;
        LAS float* s_part = (LAS float*)(lds + 65536);
        const int e = tid & 31, part = tid >> 5;
        float wreg[128];
#pragma unroll
        for (int i = 0; i < 128; ++i) wreg[i] = router_w[(size_t)(part * 128 + i) * 32 + e];
        LAS int* lcnt = (LAS int*)(lds + LDSCTL_OFF + 512);
        if (tid < NE) lcnt[tid] = 0;
        __syncthreads();
        for (int m0 = vcu * 8; m0 < M; m0 += G * 8) {
            const int m = m0 + wave;
            {
                f32x4 v[8]; float s = 0.f;
#pragma unroll
                for (int q = 0; q < 8; ++q) { const int c = 4 * lane + 256 * q; { const v2u mv = *(const GAS v2u*)(MIX + (size_t)m * D + c); v[q] = ALPHA * *(const GAS f32x4*)(x + (size_t)m * D + c) + (f32x4){bflo(mv.x), bfhi(mv.x), bflo(mv.y), bfhi(mv.y)}; } s += (v[q].x + v[q].y) + (v[q].z + v[q].w); }
                const float mean = wave_sum(s) * (1.0f / D); float s2 = 0.f;
#pragma unroll
                for (int q = 0; q < 8; ++q) { v[q] = v[q] - mean; s2 += (v[q].x * v[q].x + v[q].y * v[q].y) + (v[q].z * v[q].z + v[q].w * v[q].w); }
                const float rstd = 1.0f / sqrtf(wave_sum(s2) * (1.0f / D) + LN_EPS);
#pragma unroll
                for (int q = 0; q < 8; ++q) { const int c = 4 * lane + 256 * q;
                    const f32x4 hv = v[q] * rstd * *(const GAS f32x4*)(ln1_w + c) + *(const GAS f32x4*)(ln1_b + c);
                    { v2u hw; hw.x = pk2(hv.x, hv.y); hw.y = pk2(hv.z, hv.w); *(GAS v2u*)(H + (size_t)m * D + c) = hw; } *(LAS f32x4*)(s_h + wave * 2048 + c) = hv;
                    *(GAS unsigned*)(HQ + (size_t)m * D + c) = pg8::pk4_fp8(hv.x * pg8::XS_SCALE, hv.y * pg8::XS_SCALE, hv.z * pg8::XS_SCALE, hv.w * pg8::XS_SCALE); }
            }
            __syncthreads();
#pragma unroll 1
            for (int tk = 0; tk < 8; ++tk) {
                const LAS float* hp = s_h + tk * 2048 + part * 128; float acc = 0.f;
#pragma unroll
                for (int i = 0; i < 32; ++i) { const f32x4 hv = *(const LAS f32x4*)(hp + 4 * i); acc += hv.x * wreg[4 * i]; acc += hv.y * wreg[4 * i + 1]; acc += hv.z * wreg[4 * i + 2]; acc += hv.w * wreg[4 * i + 3]; }
                s_part[(tk * 16 + part) * 32 + e] = acc;
            }
            __syncthreads();
            {
                float lg = -3.0e38f;
                if (lane < 32) { lg = router_b[lane];
#pragma unroll
                    for (int p = 0; p < 16; ++p) lg += s_part[(wave * 16 + p) * 32 + lane];
                    lg = (lg == lg) ? fminf(fmaxf(lg, -1.0e30f), 1.0e30f) : -1.0e30f; }
                int idx[4]; float val[4];
#pragma unroll
                for (int k = 0; k < 4; ++k) {
                    float best = lg; int bi = lane;
#pragma unroll
                    for (int o = 1; o < 64; o <<= 1) { const float ob = __shfl_xor(best, o); const int oi = __shfl_xor(bi, o); const bool take = (ob > best) || (ob == best && oi < bi); best = take ? ob : best; bi = take ? oi : bi; }
                    idx[k] = bi; val[k] = best; if (lane == bi) lg = -3.0e38f;
                }
                if (lane == 0) {
                    float ex[4], se = 0.f;
#pragma unroll
                    for (int k = 0; k < 4; ++k) { ex[k] = __expf(val[k] - val[0]); se += ex[k]; }
                    const float inv = 1.0f / se;
#pragma unroll
                    for (int k = 0; k < 4; ++k) { TOPI[m * 4 + k] = idx[k]; GATE[m * 4 + k] = ex[k] * inv; POS[m * 4 + k] = __hip_atomic_fetch_add(lcnt + idx[k], 1, __ATOMIC_RELAXED, __HIP_MEMORY_SCOPE_WORKGROUP); }
                }
            }
            __syncthreads();
        }
        if (tid < NE) CNTWG[vcu * NE + tid] = lcnt[tid];
    }
    SEAM(8);

    if (IN(9) || IN(10) || IN(11)) {
        LAS int* s_t = (LAS int*)lds; LAS int* s_p = s_t + 512;
        LAS int* PSB = (LAS int*)(lds + LDSCTL_OFF + 640);
        { const int e = tid & 31, part = tid >> 5; int tsum = 0, psum = 0;
          for (int w = part * 16; w < part * 16 + 16; ++w) { const int cv = CNTWG[w * NE + e]; tsum += cv; psum += (w < vcu) ? cv : 0; }
          s_t[part * 32 + e] = tsum; s_p[part * 32 + e] = psum; }
        __syncthreads();
        if (tid < NE) { int tsum = 0, psum = 0; for (int p = 0; p < 16; ++p) { tsum += s_t[p * 32 + tid]; psum += s_p[p * 32 + tid]; } s_t[tid] = tsum; PSB[tid] = psum; }
        __syncthreads();
        if (tid == 0) { int acc = 0; for (int e = 0; e < NE; ++e) { PS[e] = acc; acc += (s_t[e] + 255) / 256 * 256; } PS[NE] = acc; }
        __syncthreads();
        if (tid < NE) PSB[tid] += PS[tid];
        __syncthreads();
    }
    if (IN(9)) {
        const LAS int* PSB = (const LAS int*)(lds + LDSCTL_OFF + 640);
        for (int m0 = vcu * 8; m0 < M; m0 += G * 8) {
            const int m = m0 + wave;
            const GAS v4u* src = (const GAS v4u*)(HQ + (size_t)m * D);
            v4u rv[2];
#pragma unroll
            for (int q = 0; q < 2; ++q) rv[q] = src[lane + 64 * q];
#pragma unroll
            for (int k = 0; k < 4; ++k) {
                const int a = m * 4 + k, slot = PSB[TOPI[a]] + POS[a];
                if (lane == 0) { slot_tok[slot] = m; SLOT_OF[a] = slot; }
                GAS v4u* dst = (GAS v4u*)(XS + (size_t)slot * D);
#pragma unroll
                for (int q = 0; q < 2; ++q) dst[lane + 64 * q] = rv[q];
            }
        }
    }
    SEAM(9);

    if (IN(10)) {
        pg8::Gemm g{(const bf16*)XS, (const bf16*)W1T, D / 2, D / 2}; pg8::MoeOrder S; S.ps = PS; S.ntile = 16; S.npan = PS[NE] / 256; S.cprime = vcu; S.a_tstep = (size_t)256 * D; S.b_tstep = (size_t)256 * D;
        pg8::EpiSwiglu E{ACT, b1};
        pg8::gemm_phase<pg8::EpiSwiglu, pg8::MoeOrder, true, true, true>(lds, g, S, E);
    }
    SEAM(10);

    if (IN(11)) {
        pg8::Gemm g{(const bf16*)ACT, (const bf16*)W2T, DFF / 2, DFF / 2}; pg8::MoeOrder S; S.ps = PS; S.ntile = 8; S.npan = PS[NE] / 256; S.cprime = vcu; S.a_tstep = (size_t)256 * DFF; S.b_tstep = (size_t)256 * DFF;
        pg8::EpiBias16 E{YS, b2};
        pg8::gemm_phase<pg8::EpiBias16, pg8::MoeOrder, true, true, true>(lds, g, S, E);
    }
    SEAM(11);

    if (IN(12)) {
        for (int m = gw; m < M; m += NGW) {
            int sl[4]; float gt[4];
#pragma unroll
            for (int k = 0; k < 4; ++k) { sl[k] = SLOT_OF[m * 4 + k]; gt[k] = GATE[m * 4 + k]; }
            f32x4 v[8]; float s = 0.f;
#pragma unroll
            for (int q = 0; q < 8; ++q) { const int c = 4 * lane + 256 * q; f32x4 f = (f32x4){0.f, 0.f, 0.f, 0.f};
#pragma unroll
                for (int k = 0; k < 4; ++k) { const v2u yv = *(const GAS v2u*)(YS + (size_t)sl[k] * D + c); f += gt[k] * (f32x4){bflo(yv.x), bfhi(yv.x), bflo(yv.y), bfhi(yv.y)}; }
                { const v2u hw = *(const GAS v2u*)(H + (size_t)m * D + c); v[q] = ALPHA * (f32x4){bflo(hw.x), bfhi(hw.x), bflo(hw.y), bfhi(hw.y)} + f; } s += (v[q].x + v[q].y) + (v[q].z + v[q].w); }
            const float mean = wave_sum(s) * (1.0f / D); float s2 = 0.f;
#pragma unroll
            for (int q = 0; q < 8; ++q) { v[q] = v[q] - mean; s2 += (v[q].x * v[q].x + v[q].y * v[q].y) + (v[q].z * v[q].z + v[q].w * v[q].w); }
            const float rstd = 1.0f / sqrtf(wave_sum(s2) * (1.0f / D) + LN_EPS);
#pragma unroll
            for (int q = 0; q < 8; ++q) { const int c = 4 * lane + 256 * q; *(GAS f32x4*)(out + (size_t)m * D + c) = v[q] * rstd * *(const GAS f32x4*)(ln2_w + c) + *(const GAS f32x4*)(ln2_b + c); }
        }
    }
#undef IN
#undef SEAM
}

extern "C" void kernel_launch(void* const* d_in, const int* in_sizes, int n_in, void* d_out, int out_size, void* d_ws, size_t ws_size, hipStream_t stream) {
    static int grid = 0;
    if (grid == 0) {
        if (n_in != 26 || out_size != M * D || ws_size < WS_END) { fprintf(stderr, "kernel_launch: unexpected problem (n_in %d, out %d, ws %zu < %zu)\n", n_in, out_size, ws_size, (size_t)WS_END); grid = -1; return; }
        int dev = 0, cus = 0, per_cu = 0;
        if (hipGetDevice(&dev) != hipSuccess || hipDeviceGetAttribute(&cus, hipDeviceAttributeMultiprocessorCount, dev) != hipSuccess) { grid = -1; return; }
        if (hipFuncSetAttribute((const void*)mk_fwd, hipFuncAttributeMaxDynamicSharedMemorySize, LDS_BYTES) != hipSuccess) { fprintf(stderr, "kernel_launch: hipFuncSetAttribute failed\n"); grid = -1; return; }
        if (hipOccupancyMaxActiveBlocksPerMultiprocessor(&per_cu, (const void*)mk_fwd, NTHR, LDS_BYTES) != hipSuccess || per_cu < 1) fprintf(stderr, "kernel_launch: occupancy query reports %d\n", per_cu);
        (void)hipGetLastError();
        if (cus != NWG) { fprintf(stderr, "kernel_launch: built for %d CUs, device has %d\n", NWG, cus); grid = -1; return; }
        grid = NWG;
    }
    if (grid < 0) return;
    (void)hipMemsetAsync((char*)d_ws + WS_CTL, 0, CTL_BYTES, stream);
    (void)hipMemsetAsync((char*)d_ws + WS_SLOTTOK, 0xFF, (size_t)NSLOT_MAX * 4, stream);
    Args a{};
    for (int i = 0; i < 26; ++i) a.in[i] = (const float*)d_in[i];
    a.out = (float*)d_out; a.ws = (unsigned char*)d_ws; a.dup = DUP_MASK;
    if (MK_N_LAUNCHES == 1) { a.ph_lo = 0; a.ph_hi = NPHASE; hipLaunchKernelGGL(mk_fwd, dim3(grid), dim3(NTHR), LDS_BYTES, stream, a); }
    else { for (int p = 0; p < NPHASE; ++p) for (int rep = 0; rep <= ((DUP_MASK >> p) & 1); ++rep) { a.ph_lo = p; a.ph_hi = p + 1; hipLaunchKernelGGL(mk_fwd, dim3(grid), dim3(NTHR), LDS_BYTES, stream, a); } }
}
```

```cpp
#include <hip/hip_runtime.h>
#include <stdint.h>
#include <stdio.h>

#ifndef P5_SCAN_REPS
#define P5_SCAN_REPS 1
#endif
#ifndef P5_CONV_REPS
#define P5_CONV_REPS 1
#endif
#ifndef P5A_REPS
#define P5A_REPS 1
#endif
#ifndef P5B_REPS
#define P5B_REPS 1
#endif
#ifndef SCAN_CHUNKED
#define SCAN_CHUNKED 1
#endif
#ifndef DUP_MASK
#define DUP_MASK 0
#endif
#ifndef MK_N_LAUNCHES
#define MK_N_LAUNCHES 1
#endif

constexpr int D = 2048, BATCH = 4, SEQ = 4096, M = BATCH * SEQ;
constexpr int RW = 1024, PW = 1024, NH = 16;
constexpr int SHIFT_W = 3360, IN_COLS = 4384, IN_PAD = 4608;
constexpr int LK = 384;
constexpr int NE = 32, DFF = 2048;
constexpr int NASG = M * 4;
constexpr int NSLOT_MAX = NASG + NE * 256;
constexpr float LN_EPS = 1e-5f, GN_EPS = 64e-5f;
constexpr float ALPHA = 1.189207115002721f;
constexpr int NWG = 256, NWAVES = 8, NTHR = 512;
constexpr int NPHASE = 13;

#define GAS __attribute__((address_space(1)))
#define LAS __attribute__((address_space(3)))
typedef unsigned short bf16;
typedef unsigned v4u __attribute__((ext_vector_type(4)));
typedef unsigned v2u __attribute__((ext_vector_type(2)));
typedef float f32x4 __attribute__((ext_vector_type(4)));
typedef short bf16x8 __attribute__((ext_vector_type(8)));
typedef GAS unsigned gu32;
#define RLX_AGENT __ATOMIC_RELAXED, __HIP_MEMORY_SCOPE_AGENT
#define LDS_WAIT() asm volatile("s_waitcnt lgkmcnt(0)" ::: "memory")
#define VM_WAIT() asm volatile("s_waitcnt vmcnt(0)" ::: "memory")

typedef float f32x2n __attribute__((ext_vector_type(2)));
typedef __bf16 bf16x2n __attribute__((ext_vector_type(2)));
__device__ __forceinline__ unsigned cvt_pk_bf16_nat(float lo, float hi) { const f32x2n v = {lo, hi}; return __builtin_bit_cast(unsigned, __builtin_convertvector(v, bf16x2n)); }
__device__ __forceinline__ unsigned f2bf(float f) { return cvt_pk_bf16_nat(f, 0.f) & 0xffffu; }
__device__ __forceinline__ unsigned pk2(float lo, float hi) { return cvt_pk_bf16_nat(lo, hi); }
__device__ __forceinline__ float bflo(unsigned w) { return __builtin_bit_cast(float, w << 16); }
__device__ __forceinline__ float bfhi(unsigned w) { return __builtin_bit_cast(float, w & 0xffff0000u); }
__device__ __forceinline__ float ld1bf(const bf16* p) { return __builtin_bit_cast(float, (unsigned)(*(const GAS bf16*)p) << 16); }
__device__ __forceinline__ f32x4 ld4bf(const bf16* p) { const v2u w = *(const GAS v2u*)p; return (f32x4){bflo(w.x), bfhi(w.x), bflo(w.y), bfhi(w.y)}; }
__device__ __forceinline__ float wave_sum(float v) {
#pragma unroll
    for (int o = 1; o < 64; o <<= 1) v += __shfl_xor(v, o);
    return v;
}
__device__ __forceinline__ float fast_sigmoid(float x) { return __builtin_amdgcn_rcpf(1.0f + __builtin_amdgcn_exp2f(-1.4426950408889634f * x)); }
__device__ __forceinline__ float fast_decay(float wl) { const float z = -wl; const float sp = fmaxf(z, 0.f) + 0.6931471805599453f * __builtin_amdgcn_logf(1.0f + __builtin_amdgcn_exp2f(-1.4426950408889634f * fabsf(z)));
    return __builtin_amdgcn_exp2f(-1.4426950408889634f * __builtin_amdgcn_exp2f(-1.4426950408889634f * (sp + 0.5f))); }
template <int CTRL> __device__ __forceinline__ float dpp_mov(float x) { return __builtin_bit_cast(float, __builtin_amdgcn_update_dpp(0, __builtin_bit_cast(int, x), CTRL, 0xF, 0xF, true)); }
__device__ __forceinline__ float row16_sum(float x) {
    x += dpp_mov<0xB1>(x);
    x += dpp_mov<0x4E>(x);
    x += dpp_mov<0x141>(x);
    x += dpp_mov<0x140>(x);
    return x;
}

__device__ __forceinline__ float wave_sum_dpp(float x) {
    x = row16_sum(x);
    x += __builtin_bit_cast(float, __builtin_amdgcn_update_dpp(0, __builtin_bit_cast(int, x), 0x142, 0xA, 0xF, false));
    x += __builtin_bit_cast(float, __builtin_amdgcn_update_dpp(0, __builtin_bit_cast(int, x), 0x143, 0xC, 0xF, false));
    return __builtin_bit_cast(float, __builtin_amdgcn_readlane(__builtin_bit_cast(int, x), 63));
}

namespace pg8 {
typedef unsigned short bf16_t;
typedef unsigned u32x4 __attribute__((ext_vector_type(4)));
typedef int v4i_t __attribute__((ext_vector_type(4)));
typedef int v8i_t __attribute__((ext_vector_type(8)));
constexpr int BM = 256, BK = 64, HALF = 128, HTB = HALF * BK * 2, STAGE_BYTES = 8 * HTB, NXCD = 8, WGM = 8;
__host__ __device__ __forceinline__ int lds_byte(int r, int c) { const int st = (r >> 4) * 2 + (c >> 5), rr = r & 15, cc = c & 31, ob = rr * 64 + cc * 2; return st * 1024 + (ob ^ (((ob >> 9) & 1) << 5)); }
__host__ __device__ __forceinline__ void stage_rc(int b, int& R, int& C) { const int st = b / 1024, sb = b % 1024, swz = sb ^ (((sb >> 9) & 1) << 5); R = (st >> 1) * 16 + swz / 64; C = (st & 1) * 32 + (swz % 64) / 2; }
__host__ __device__ __forceinline__ int perm32(int rho) { const int n = rho >> 4, i = rho & 15; return 8 * (i >> 2) + 4 * n + (i & 3); }
__host__ __device__ __forceinline__ int perm128(int R) { return 64 * (R >> 5) + 16 * ((R >> 2) & 3) + 4 * ((R >> 4) & 1) + (R & 3); }
struct Unit { int pm, pn; };
struct Gemm { const bf16_t* A; const bf16_t* Bt; int lda, K; };
__device__ __forceinline__ unsigned cvt_pk_bf16(float lo, float hi) { unsigned r; asm volatile("v_cvt_pk_bf16_f32 %0, %1, %2" : "=v"(r) : "v"(lo), "v"(hi)); return r; }

struct GridOrder {
    static constexpr bool GATHER = false;
    int nM, nN, nwg, G, c; size_t a_tstep, a_pnstep, b_tstep;
    __device__ void init(int nM_, int nN_, int G_, int c_, size_t a_tstep_, size_t a_pnstep_, size_t b_tstep_) { nM = nM_; nN = nN_; nwg = nM * nN; G = G_; c = c_; a_tstep = a_tstep_; a_pnstep = a_pnstep_; b_tstep = b_tstep_; }
    __device__ bool next(int i, Unit& u) const {
        const long L = (long)i * G + c; if (L >= nwg) return false;
        int wgid = (int)L; { const int q = nwg / NXCD, r = nwg % NXCD, xcd = wgid % NXCD, off = wgid / NXCD; wgid = (xcd < r ? xcd * (q + 1) : r * (q + 1) + (xcd - r) * q) + off; }
        const int nig = WGM * nN, gid = wgid / nig, fm = gid * WGM, gsz = (nM - fm) < WGM ? (nM - fm) : WGM;
        u.pm = fm + ((wgid % nig) % gsz); u.pn = (wgid % nig) / gsz; return true;
    }
    __device__ __forceinline__ size_t aoff(const Unit& u) const { return (size_t)u.pm * a_tstep + (size_t)u.pn * a_pnstep; }
    __device__ __forceinline__ size_t boff(const Unit& u) const { return (size_t)u.pn * b_tstep; }
};
template <bool GATHER_> struct MoeOrderT {
    static constexpr bool GATHER = GATHER_;
    const LAS int* ps; int ntile, npan, cprime; size_t a_tstep, b_tstep; const LAS unsigned* toks;
    __device__ bool next(int i, Unit& u) const {
        const int U = i * NWG + cprime; const int p = U / ntile; if (p >= npan) return false;
        const int row = p * 256; int e = 0;
#pragma unroll 1
        for (int q = 1; q < NE; ++q) e = (row >= ps[q]) ? q : e;
        u.pm = p; u.pn = e * ntile + (U % ntile); return true;
    }
    __device__ __forceinline__ size_t aoff(const Unit& u) const { return GATHER ? (size_t)0 : (size_t)u.pm * a_tstep; }
    __device__ __forceinline__ size_t boff(const Unit& u) const { return (size_t)u.pn * b_tstep; }
};
typedef MoeOrderT<false> MoeOrder;

template <class Epi, class Sched, bool ALIGN_EPI, bool SP2, bool FP8 = false>
__device__ __forceinline__ void gemm_phase(LAS unsigned char* lds, const Gemm g, const Sched& S, const Epi& E) {
    int tid_ = threadIdx.x; asm volatile("" : "+v"(tid_));
    const int tid = tid_, wid = __builtin_amdgcn_readfirstlane(tid >> 6), lane = tid & 63, wr = wid >> 2, wc = wid & 3, fr = lane & 15, fq = lane >> 4;
    const int K = g.K, nt = K / BK;
    constexpr bool GATHER = Sched::GATHER; static_assert(!GATHER || SP2, "gathered A rows: SP2 loop only");
    unsigned voffA[2], voffB[2]; int rowA[2]; unsigned colA[2];
#pragma unroll
    for (int i = 0; i < 2; ++i) { int R, C; stage_rc(tid * 16 + i * 8192, R, C); const int Rb = Epi::PERM == 2 ? perm128(R) : (Epi::PERM ? ((R & ~31) + perm32(R & 31)) : R);
        voffA[i] = (unsigned)(R * g.lda + C) * 2u; voffB[i] = (unsigned)(Rb * K + C) * 2u; rowA[i] = R; colA[i] = (unsigned)C * 2u; }
    unsigned cG0[2] = {0u, 0u}, cG1[2] = {0u, 0u}, nG0[2] = {0u, 0u}, nG1[2] = {0u, 0u};
#define PG8_GLOAD(dst0, dst1, lu) do { if constexpr (GATHER) { _Pragma("unroll") for (int _i = 0; _i < 2; ++_i) { dst0[_i] = S.toks[(lu) * 256 + rowA[_i]] + colA[_i]; dst1[_i] = S.toks[(lu) * 256 + 128 + rowA[_i]] + colA[_i]; } } } while (0)
#define PG8_STAGE_A(bufoff, gbase, half, usenext) do { if constexpr (GATHER) { if (usenext) { if (half) PG8_STAGE(bufoff, gbase, nG1); else PG8_STAGE(bufoff, gbase, nG0); } else { if (half) PG8_STAGE(bufoff, gbase, cG1); else PG8_STAGE(bufoff, gbase, cG0); } } \
        else PG8_STAGE(bufoff, (gbase) + ((half) ? hstepA : (size_t)0), voffA); } while (0)
    const size_t kstep = (size_t)(BK * 2);
    const size_t hstepA = (size_t)HALF * g.lda * 2, hstepB = (size_t)(Epi::PERM == 2 ? 8 : HALF) * K * 2;
    const unsigned ldsw = (unsigned)wid * 1024u;
    const int aoff = lds_byte(wr * 64 + fr, fq * 8), boff = lds_byte(wc * 32 + fr, fq * 8);
#define PG8_SA(b, h) (((b) * 2 + (h)) * HTB)
#define PG8_SB(b, h) ((4 + (b) * 2 + (h)) * HTB)
#define PG8_STAGE(bufoff, gbase, voff) do { _Pragma("unroll") for (int _i = 0; _i < 2; ++_i) \
        __builtin_amdgcn_global_load_lds((const unsigned*)((const char*)(gbase) + (voff)[_i]), (LAS unsigned*)(lds + (bufoff) + ldsw + _i * 8192), 16, 0, 0); } while (0)
#define PG8_LDA(dst, b, h) do { _Pragma("unroll") for (int m = 0; m < 4; ++m) { if constexpr (FP8) { const v4i_t l_ = *(const LAS v4i_t*)(lds + PG8_SA(b, h) + aoff + m * 2048), h_ = *(const LAS v4i_t*)(lds + PG8_SA(b, h) + aoff + m * 2048 + 1024); dst##8[m] = __builtin_shufflevector(l_, h_, 0, 1, 2, 3, 4, 5, 6, 7); } \
        else { _Pragma("unroll") for (int k = 0; k < 2; ++k) dst[m][k] = *(const LAS bf16x8*)(lds + PG8_SA(b, h) + aoff + m * 2048 + k * 1024); } } } while (0)
#define PG8_LDB(dst, b, h) do { _Pragma("unroll") for (int n = 0; n < 2; ++n) { if constexpr (FP8) { const v4i_t l_ = *(const LAS v4i_t*)(lds + PG8_SB(b, h) + boff + n * 2048), h_ = *(const LAS v4i_t*)(lds + PG8_SB(b, h) + boff + n * 2048 + 1024); dst##8[n] = __builtin_shufflevector(l_, h_, 0, 1, 2, 3, 4, 5, 6, 7); } \
        else { _Pragma("unroll") for (int k = 0; k < 2; ++k) dst[n][k] = *(const LAS bf16x8*)(lds + PG8_SB(b, h) + boff + n * 2048 + k * 1024); } } } while (0)
#define PG8_MMA(ai, bj, At, Bt) do { __builtin_amdgcn_s_setprio(1); _Pragma("unroll") for (int m = 0; m < 4; ++m) _Pragma("unroll") for (int n = 0; n < 2; ++n) { \
        if constexpr (FP8) asm volatile("v_mfma_scale_f32_16x16x128_f8f6f4 %0, %1, %2, %0, %3, %3 op_sel_hi:[0,0,0]" : "+v"(acc[ai][bj][m][n]) : "v"(Bt##8[n]), "v"(At##8[m]), "v"(scale1_)); \
        else { _Pragma("unroll") for (int k = 0; k < 2; ++k) acc[ai][bj][m][n] = __builtin_amdgcn_mfma_f32_16x16x32_bf16(Bt[n][k], At[m][k], acc[ai][bj][m][n], 0, 0, 0); } } \
        __builtin_amdgcn_s_setprio(0); } while (0)
#define PG8_WAIT_V(n) asm volatile("s_waitcnt vmcnt(" #n ")" ::: "memory")
#define PG8_WAIT_L(n) asm volatile("s_waitcnt lgkmcnt(" #n ")" ::: "memory")
#define PG8_BAR __builtin_amdgcn_s_barrier()
#define PG8_SCHED __builtin_amdgcn_sched_barrier(0)
    Unit cur, nxt; int ui = 0;
    if (!S.next(0, cur)) return;
    f32x4 acc[2][2][4][2];
#pragma unroll
    for (int a = 0; a < 2; ++a)
#pragma unroll
        for (int b = 0; b < 2; ++b)
#pragma unroll
            for (int m = 0; m < 4; ++m)
#pragma unroll
                for (int n = 0; n < 2; ++n) acc[a][b][m][n] = (f32x4){0.f, 0.f, 0.f, 0.f};
    int scale1_ = 0x7F7F7F7F; asm volatile("" : "+v"(scale1_));
    bf16x8 At[4][2], B0[2][2], B1[2][2];
    v8i_t At8[4], B08[2], B18[2];
    const char* cA = (const char*)g.A + S.aoff(cur); const char* cB = (const char*)g.Bt + S.boff(cur);
    if constexpr (SP2) {
        PG8_GLOAD(cG0, cG1, 0);
        PG8_STAGE(PG8_SB(0, 0), cB, voffB); PG8_STAGE(PG8_SB(0, 1), cB + hstepB, voffB); PG8_STAGE_A(PG8_SA(0, 0), cA, 0, false); PG8_STAGE_A(PG8_SA(0, 1), cA, 1, false);
        if (wr == 1) PG8_BAR;
        PG8_WAIT_V(2); PG8_BAR;
        PG8_STAGE(PG8_SB(1, 0), cB + kstep, voffB); PG8_STAGE_A(PG8_SA(1, 0), cA + kstep, 0, false); PG8_STAGE(PG8_SB(1, 1), cB + hstepB + kstep, voffB);
        PG8_WAIT_V(6); PG8_BAR;
    } else {
        PG8_STAGE(PG8_SB(0, 0), cB, voffB); PG8_STAGE(PG8_SA(0, 0), cA, voffA); PG8_STAGE(PG8_SB(0, 1), cB + hstepB, voffB); PG8_STAGE(PG8_SA(0, 1), cA + hstepA, voffA);
        if (wr == 1) PG8_BAR;
        PG8_WAIT_V(4); PG8_BAR;
        PG8_STAGE(PG8_SB(1, 0), cB + kstep, voffB); PG8_STAGE(PG8_SA(1, 0), cA + kstep, voffA); PG8_STAGE(PG8_SB(1, 1), cB + hstepB + kstep, voffB);
        PG8_WAIT_V(6); PG8_BAR;
    }
    for (;;) {
        const bool has_next = S.next(ui + 1, nxt);
        const char* nA = has_next ? (const char*)g.A + S.aoff(nxt) : cA; const char* nB = has_next ? (const char*)g.Bt + S.boff(nxt) : cB;
        if constexpr (GATHER) { if (has_next) PG8_GLOAD(nG0, nG1, ui + 1); else { nG0[0] = cG0[0]; nG0[1] = cG0[1]; nG1[0] = cG1[0]; nG1[1] = cG1[1]; } }
#pragma unroll 1
        for (int t = 0; t < nt; t += 2) {
            const bool last = (t == nt - 2);
            const char* a1 = cA + (size_t)(t + 1) * kstep;
            const char* a2 = last ? nA : cA + (size_t)(t + 2) * kstep; const char* b2 = last ? nB : cB + (size_t)(t + 2) * kstep;
            const char* a3 = a2 + kstep; const char* b3 = b2 + kstep;
            if constexpr (SP2) {
            PG8_LDB(B0, 0, 0); PG8_LDB(B1, 0, 1); PG8_SCHED; PG8_LDA(At, 0, 0); PG8_STAGE_A(PG8_SA(1, 1), a1, 1, false);
            PG8_WAIT_V(8); PG8_WAIT_L(0); PG8_BAR; PG8_MMA(0, 0, At, B0); PG8_MMA(0, 1, At, B1); PG8_BAR; PG8_SCHED;
            PG8_LDA(At, 0, 1); PG8_STAGE(PG8_SB(0, 0), b2, voffB); PG8_STAGE(PG8_SB(0, 1), b2 + hstepB, voffB); PG8_STAGE_A(PG8_SA(0, 0), a2, 0, last);
            PG8_WAIT_V(8); PG8_WAIT_L(0); PG8_BAR; PG8_MMA(1, 0, At, B0); PG8_MMA(1, 1, At, B1); PG8_BAR; PG8_SCHED;
            PG8_LDB(B0, 1, 0); PG8_LDB(B1, 1, 1); PG8_SCHED; PG8_LDA(At, 1, 0); PG8_STAGE_A(PG8_SA(0, 1), a2, 1, last);
            PG8_WAIT_V(8); PG8_WAIT_L(0); PG8_BAR; PG8_MMA(0, 0, At, B0); PG8_MMA(0, 1, At, B1); PG8_BAR; PG8_SCHED;
            PG8_LDA(At, 1, 1); PG8_STAGE(PG8_SB(1, 0), b3, voffB); PG8_STAGE(PG8_SB(1, 1), b3 + hstepB, voffB); PG8_STAGE_A(PG8_SA(1, 0), a3, 0, last);
            PG8_WAIT_V(8); PG8_WAIT_L(0); PG8_BAR; PG8_MMA(1, 0, At, B0); PG8_MMA(1, 1, At, B1); PG8_BAR; PG8_SCHED;
            } else {
            PG8_LDB(B0, 0, 0); PG8_SCHED; PG8_LDA(At, 0, 0); PG8_STAGE(PG8_SA(1, 1), a1 + hstepA, voffA);
            PG8_WAIT_L(8); PG8_BAR; PG8_WAIT_L(0); PG8_MMA(0, 0, At, B0); PG8_BAR; PG8_SCHED;
            PG8_LDB(B1, 0, 1); PG8_STAGE(PG8_SB(0, 0), b2, voffB);
            PG8_BAR; PG8_WAIT_L(0); PG8_MMA(0, 1, At, B1); PG8_BAR;
            PG8_LDA(At, 0, 1); PG8_STAGE(PG8_SA(0, 0), a2, voffA);
            PG8_BAR; PG8_WAIT_L(0); PG8_MMA(1, 0, At, B0); PG8_BAR; PG8_SCHED;
            PG8_STAGE(PG8_SB(0, 1), b2 + hstepB, voffB);
            PG8_WAIT_V(6); PG8_BAR; PG8_MMA(1, 1, At, B1); PG8_BAR;
            PG8_LDB(B0, 1, 0); PG8_SCHED; PG8_LDA(At, 1, 0); PG8_STAGE(PG8_SA(0, 1), a2 + hstepA, voffA);
            PG8_WAIT_L(8); PG8_BAR; PG8_WAIT_L(0); PG8_MMA(0, 0, At, B0); PG8_BAR; PG8_SCHED;
            PG8_LDB(B1, 1, 1); PG8_STAGE(PG8_SB(1, 0), b3, voffB);
            PG8_BAR; PG8_WAIT_L(0); PG8_MMA(0, 1, At, B1); PG8_BAR;
            PG8_LDA(At, 1, 1); PG8_STAGE(PG8_SA(1, 0), a3, voffA);
            PG8_BAR; PG8_WAIT_L(0); PG8_MMA(1, 0, At, B0); PG8_BAR; PG8_SCHED;
            PG8_STAGE(PG8_SB(1, 1), b3 + hstepB, voffB);
            PG8_WAIT_V(6); PG8_BAR; PG8_MMA(1, 1, At, B1); PG8_BAR;
            }
        }
        if constexpr (ALIGN_EPI) { if (wr == 0) PG8_BAR; }
        if constexpr (FP8) asm volatile("s_nop 15\n\ts_nop 15" ::: "memory");
        E(acc, cur, wr, wc, fr, fq);
        if (!has_next) break;
#pragma unroll
        for (int a = 0; a < 2; ++a)
#pragma unroll
            for (int b = 0; b < 2; ++b)
#pragma unroll
                for (int m = 0; m < 4; ++m)
#pragma unroll
                    for (int n = 0; n < 2; ++n) acc[a][b][m][n] = (f32x4){0.f, 0.f, 0.f, 0.f};
        cur = nxt; cA = nA; cB = nB; ++ui;
        if constexpr (GATHER) { cG0[0] = nG0[0]; cG0[1] = nG0[1]; cG1[0] = nG1[0]; cG1[1] = nG1[1]; }
        if constexpr (ALIGN_EPI) { if (wr == 1) PG8_BAR; }
    }
    PG8_WAIT_V(0);
    if constexpr (!ALIGN_EPI) { if (wr == 0) PG8_BAR; }
    PG8_BAR;
#undef PG8_SA
#undef PG8_SB
#undef PG8_STAGE
#undef PG8_STAGE_A
#undef PG8_GLOAD
#undef PG8_LDA
#undef PG8_LDB
#undef PG8_MMA
#undef PG8_WAIT_V
#undef PG8_WAIT_L
#undef PG8_BAR
#undef PG8_SCHED
}

struct EpiF32 {
    static constexpr int PERM = 0;
    float* C; int ldc;
    __device__ __forceinline__ void operator()(const f32x4 (&acc)[2][2][4][2], const Unit& u, int wr, int wc, int fr, int fq) const {
        const int row0 = u.pm * BM + wr * 64 + fr, col0 = u.pn * BM + wc * 32 + 4 * fq;
#pragma unroll
        for (int ai = 0; ai < 2; ++ai)
#pragma unroll
            for (int m = 0; m < 4; ++m) { float* rowp = C + (size_t)(row0 + ai * HALF + m * 16) * ldc + col0;
#pragma unroll
                for (int bj = 0; bj < 2; ++bj)
#pragma unroll
                    for (int n = 0; n < 2; ++n) *(f32x4*)(rowp + bj * HALF + n * 16) = acc[ai][bj][m][n]; }
    }
};
struct EpiBf16Plain {
    static constexpr int PERM = 1;
    bf16_t* O; int ldc;
    __device__ __forceinline__ void operator()(const f32x4 (&acc)[2][2][4][2], const Unit& u, int wr, int wc, int fr, int fq) const {
        const int row0 = u.pm * BM + wr * 64 + fr, col0 = u.pn * BM + wc * 32 + 8 * fq;
#pragma unroll
        for (int ai = 0; ai < 2; ++ai)
#pragma unroll
            for (int m = 0; m < 4; ++m) { bf16_t* rowp = O + (size_t)(row0 + ai * HALF + m * 16) * ldc + col0;
#pragma unroll
                for (int bj = 0; bj < 2; ++bj) { const f32x4 v0 = acc[ai][bj][m][0], v1 = acc[ai][bj][m][1];
                    u32x4 w; w.x = cvt_pk_bf16(v0[0], v0[1]); w.y = cvt_pk_bf16(v0[2], v0[3]); w.z = cvt_pk_bf16(v1[0], v1[1]); w.w = cvt_pk_bf16(v1[2], v1[3]);
                    *(u32x4*)(rowp + bj * HALF) = w; } }
    }
};
struct EpiPool {
    static constexpr int PERM = 1;
    bf16_t* O; const float* scale;
    __device__ __forceinline__ void operator()(const f32x4 (&acc)[2][2][4][2], const Unit& u, int wr, int wc, int fr, int fq) const {
        const int row0 = u.pm * BM + wr * 64 + fr; int col0 = u.pn * BM + wc * 32 + 8 * fq;
        asm volatile("" : "+v"(col0));
        f32x4 sv[2][2];
#pragma unroll
        for (int bj = 0; bj < 2; ++bj)
#pragma unroll
            for (int n = 0; n < 2; ++n) sv[bj][n] = *(const f32x4*)(scale + col0 + bj * HALF + 4 * n);
#pragma unroll
        for (int ai = 0; ai < 2; ++ai)
#pragma unroll
            for (int m = 0; m < 4; ++m) { bf16_t* rowp = O + (size_t)(row0 + ai * HALF + m * 16) * 2048 + 1024 + col0;
#pragma unroll
                for (int bj = 0; bj < 2; ++bj) { const f32x4 v0 = acc[ai][bj][m][0] * sv[bj][0], v1 = acc[ai][bj][m][1] * sv[bj][1];
                    u32x4 w; w.x = cvt_pk_bf16(v0[0], v0[1]); w.y = cvt_pk_bf16(v0[2], v0[3]); w.z = cvt_pk_bf16(v1[0], v1[1]); w.w = cvt_pk_bf16(v1[2], v1[3]);
                    *(u32x4*)(rowp + bj * HALF) = w; } }
    }
};
constexpr float XS_SCALE = 8.0f, W_SCALE = 256.0f, ACT_SCALE = 8.0f, DESCALE = 1.0f / 2048.0f;
__device__ __forceinline__ unsigned pk4_fp8(float a, float b, float c, float d) {
    a = __builtin_amdgcn_fmed3f(a, -448.f, 448.f); b = __builtin_amdgcn_fmed3f(b, -448.f, 448.f); c = __builtin_amdgcn_fmed3f(c, -448.f, 448.f); d = __builtin_amdgcn_fmed3f(d, -448.f, 448.f);
    int w = 0; w = __builtin_amdgcn_cvt_pk_fp8_f32(a, b, w, false); w = __builtin_amdgcn_cvt_pk_fp8_f32(c, d, w, true); return (unsigned)w;
}
struct EpiSwiglu {
    static constexpr int PERM = 2;
    unsigned char* O; const float* b1;
    __device__ __forceinline__ void operator()(const f32x4 (&acc)[2][2][4][2], const Unit& u, int wr, int wc, int fr, int fq) const {
        const int e = u.pn >> 4, nt = u.pn & 15;
        const int row0 = u.pm * BM + wr * 64 + fr; int col0 = nt * BM + wc * 64 + 16 * fq;
        asm volatile("" : "+v"(col0));
        const float* bp = b1 + (size_t)e * 4096 + col0;
        f32x4 bv[2][2];
#pragma unroll
        for (int bj = 0; bj < 2; ++bj)
#pragma unroll
            for (int n = 0; n < 2; ++n) bv[bj][n] = *(const f32x4*)(bp + 8 * bj + 4 * n);
#pragma unroll
        for (int ai = 0; ai < 2; ++ai)
#pragma unroll
            for (int m = 0; m < 4; ++m) { unsigned char* rowp = O + (size_t)(row0 + ai * HALF + m * 16) * 2048 + (col0 >> 1);
                v2u wv;
#pragma unroll
                for (int bj = 0; bj < 2; ++bj) { const f32x4 v0 = acc[ai][bj][m][0] * DESCALE + bv[bj][0], v1 = acc[ai][bj][m][1] * DESCALE + bv[bj][1];
                    const f32x2n g01 = {fminf(v0[0], 7.0f), fminf(v0[2], 7.0f)}, g23 = {fminf(v1[0], 7.0f), fminf(v1[2], 7.0f)};
                    const f32x2n l01 = {__builtin_amdgcn_fmed3f(v0[1], -7.0f, 7.0f), __builtin_amdgcn_fmed3f(v0[3], -7.0f, 7.0f)}, l23 = {__builtin_amdgcn_fmed3f(v1[1], -7.0f, 7.0f), __builtin_amdgcn_fmed3f(v1[3], -7.0f, 7.0f)};
                    const f32x2n t01 = g01 * (-1.702f * 1.4426950408889634f), t23 = g23 * (-1.702f * 1.4426950408889634f);
                    const f32x2n d01 = (f32x2n){__builtin_amdgcn_exp2f(t01.x), __builtin_amdgcn_exp2f(t01.y)} + 1.0f, d23 = (f32x2n){__builtin_amdgcn_exp2f(t23.x), __builtin_amdgcn_exp2f(t23.y)} + 1.0f;
                    const f32x2n a01 = (g01 * (f32x2n){__builtin_amdgcn_rcpf(d01.x), __builtin_amdgcn_rcpf(d01.y)}) * (l01 * ACT_SCALE + ACT_SCALE), a23 = (g23 * (f32x2n){__builtin_amdgcn_rcpf(d23.x), __builtin_amdgcn_rcpf(d23.y)}) * (l23 * ACT_SCALE + ACT_SCALE);
                    int w = 0; w = __builtin_amdgcn_cvt_pk_fp8_f32(a01.x, a01.y, w, false); w = __builtin_amdgcn_cvt_pk_fp8_f32(a23.x, a23.y, w, true);
                    if (bj == 0) wv.x = (unsigned)w; else wv.y = (unsigned)w; }
                *(v2u*)rowp = wv; }
    }
};
constexpr float YS_SCALE = 16.0f;
struct EpiBias8 {
    static constexpr int PERM = 2;
    unsigned char* O; const float* b2;
    __device__ __forceinline__ void operator()(const f32x4 (&acc)[2][2][4][2], const Unit& u, int wr, int wc, int fr, int fq) const {
        const int e = u.pn >> 3, nt = u.pn & 7;
        const int row0 = u.pm * BM + wr * 64 + fr; int col0 = nt * BM + wc * 64 + 16 * fq;
        asm volatile("" : "+v"(col0));
        const float* bp = b2 + (size_t)e * 2048 + col0;
        f32x4 bv[2][2];
#pragma unroll
        for (int bj = 0; bj < 2; ++bj)
#pragma unroll
            for (int n = 0; n < 2; ++n) bv[bj][n] = *(const f32x4*)(bp + 8 * bj + 4 * n) * YS_SCALE;
#pragma unroll
        for (int ai = 0; ai < 2; ++ai)
#pragma unroll
            for (int m = 0; m < 4; ++m) { unsigned char* rowp = O + (size_t)(row0 + ai * HALF + m * 16) * 2048 + col0;
                const f32x4 v00 = acc[ai][0][m][0] * (DESCALE * YS_SCALE) + bv[0][0], v01 = acc[ai][0][m][1] * (DESCALE * YS_SCALE) + bv[0][1];
                const f32x4 v10 = acc[ai][1][m][0] * (DESCALE * YS_SCALE) + bv[1][0], v11 = acc[ai][1][m][1] * (DESCALE * YS_SCALE) + bv[1][1];
                u32x4 w; w.x = pk4_fp8(v00[0], v00[1], v00[2], v00[3]); w.y = pk4_fp8(v01[0], v01[1], v01[2], v01[3]); w.z = pk4_fp8(v10[0], v10[1], v10[2], v10[3]); w.w = pk4_fp8(v11[0], v11[1], v11[2], v11[3]);
                *(u32x4*)rowp = w; }
    }
};
}

#define XB_TMO      128
#define XB_XCNT(j)  (256  + 64 * (j))
#define XB_XSUB(j)  (1280 + 64 * (j))
#define XB_XGEN(j)  (2304 + 64 * (j))
#define XB_TOP      3328
#define XB_TOPGEN   3392
#define XCD_BAR_WORDS 3456
#define XB_SPIN_CAP (1u << 22)
__device__ __forceinline__ unsigned xb_ld(unsigned* p)              { return __hip_atomic_load(p, __ATOMIC_RELAXED, __HIP_MEMORY_SCOPE_AGENT); }
__device__ __forceinline__ unsigned xb_add(unsigned* p, unsigned v) { return __hip_atomic_fetch_add(p, v, __ATOMIC_RELAXED, __HIP_MEMORY_SCOPE_AGENT); }
__device__ __forceinline__ unsigned xb_xcc_id() { return (unsigned)__builtin_amdgcn_s_getreg((3 << 11) | 20) & 0xFu; }
#define XB_SPIN(cond, bar) do { unsigned _sp = 0; while (cond) { __builtin_amdgcn_s_sleep(1); \
    if ((++_sp & 255u) == 0u) { if (xb_ld(&(bar)[XB_TMO])) break; if (_sp > XB_SPIN_CAP) { atomicAdd(&(bar)[XB_TMO], 1u); break; } } } } while (0)
struct XcdBarrier { unsigned* bar; unsigned x; volatile LAS unsigned* st; };
__device__ __forceinline__ XcdBarrier xcd_barrier_post(unsigned* bar, volatile LAS unsigned* st) {
    XcdBarrier b; b.bar = bar; b.x = xb_xcc_id(); b.st = st;
    if (threadIdx.x == 0) (void)xb_add(&bar[XB_XCNT(b.x)], 1u);
    return b;
}
__device__ __forceinline__ void xcd_barrier_complete(unsigned* bar, unsigned x, unsigned& nloc, unsigned& nx) {
    const unsigned G = gridDim.x * gridDim.y * gridDim.z;
    unsigned sum, cnt, mine, sp = 0u;
    for (;;) {
        sum = 0u; cnt = 0u; mine = 0u;
#pragma unroll
        for (unsigned j = 0; j < 16; ++j) { const unsigned c = xb_ld(&bar[XB_XCNT(j)]); sum += c; cnt += (c > 0u) ? 1u : 0u; mine = (j == x) ? c : mine; }
        if (sum == G) break;
        __builtin_amdgcn_s_sleep(1);
        if ((++sp & 255u) == 0u) { if (xb_ld(&bar[XB_TMO])) break; if (sp > XB_SPIN_CAP) { atomicAdd(&bar[XB_TMO], 1u); break; } }
    }
    nloc = mine > 0u ? mine : 1u; nx = cnt > 0u ? cnt : 1u;
}
__device__ __forceinline__ void xcd_barrier(const XcdBarrier& b) {
    asm volatile("s_waitcnt vmcnt(0)" ::: "memory");
    __syncthreads();
    if (threadIdx.x == 0) {
        unsigned* bar = b.bar;
        __builtin_amdgcn_s_waitcnt(0);
        unsigned nloc = b.st[0], nx = b.st[1];
        if (nloc == 0u) { xcd_barrier_complete(bar, b.x, nloc, nx); b.st[0] = nloc; b.st[1] = nx; }
        const unsigned old = xb_add(&bar[XB_XSUB(b.x)], 1u);
        const unsigned gen = old / nloc;
        if (old + 1u == (gen + 1u) * nloc) {
            __builtin_amdgcn_fence(__ATOMIC_RELEASE, "agent");
            asm volatile("s_waitcnt vmcnt(0)" ::: "memory");
            const unsigned og = xb_add(&bar[XB_TOP], 1u);
            const unsigned tg = og / nx;
            if (og + 1u == (tg + 1u) * nx) xb_add(&bar[XB_TOPGEN], 1u);
            else XB_SPIN(xb_ld(&bar[XB_TOPGEN]) == tg, bar);
            __builtin_amdgcn_fence(__ATOMIC_ACQUIRE, "agent");
            xb_add(&bar[XB_XGEN(b.x)], 1u);
            asm volatile("s_waitcnt vmcnt(0)" ::: "memory");
        } else {
            XB_SPIN(xb_ld(&bar[XB_XGEN(b.x)]) == gen, bar);
            __builtin_amdgcn_fence(__ATOMIC_ACQUIRE, "agent");
            asm volatile("s_waitcnt vmcnt(0)" ::: "memory");
        }
    }
    __syncthreads();
}

constexpr size_t al256(size_t x) { return (x + 255) & ~(size_t)255; }
constexpr size_t WS_CTL = 0, CTL_BYTES = 1u << 20;
constexpr int CW_BAR = 4096;
constexpr int CW_CNT = 16384;
constexpr size_t WS_SLOTTOK = WS_CTL + CTL_BYTES;
constexpr size_t WS_TOPI = WS_SLOTTOK + al256((size_t)NSLOT_MAX * 4);
constexpr size_t WS_GATE = WS_TOPI + (size_t)NASG * 4;
constexpr size_t WS_POS = WS_GATE + (size_t)NASG * 4;
constexpr size_t WS_SLOTOF = WS_POS + (size_t)NASG * 4;
constexpr size_t WS_BONUS = WS_SLOTOF + (size_t)NASG * 4;
constexpr size_t WS_XB = WS_BONUS + (size_t)M * 16 * 4;
constexpr size_t WS_WINT = WS_XB + (size_t)M * D * 2;
constexpr size_t WS_WOUTT = WS_WINT + (size_t)IN_PAD * D * 2;
constexpr size_t WS_LORAT = WS_WOUTT + (size_t)D * D * 2;
constexpr size_t WS_WPOOLT = WS_LORAT + (size_t)3072 * LK * 2;
constexpr size_t WS_PROJ = WS_WPOOLT + (size_t)1024 * 256 * 2;
constexpr size_t WS_LIN = WS_PROJ + (size_t)M * IN_PAD * 2;
constexpr size_t WS_POOLED = WS_LIN + (size_t)M * LK * 2;
constexpr size_t WS_WDEC = WS_POOLED + (size_t)M * 1024 * 2;
constexpr size_t SZ_F1K = (size_t)M * 1024 * 4;
constexpr size_t WS_LOUT = WS_WDEC + SZ_F1K  , WS_R = WS_LOUT + 3 * SZ_F1K, WS_K2 = WS_R + SZ_F1K, WS_V = WS_K2 + SZ_F1K, WS_KK = WS_V + SZ_F1K, WS_BB = WS_KK + SZ_F1K, WS_Y = WS_BB + SZ_F1K;
constexpr size_t WS_MIXIN = WS_Y + SZ_F1K;
constexpr size_t WS_MIX = WS_MIXIN + (size_t)M * D * 2;
constexpr size_t WS_H = WS_MIX + (size_t)M * D * 4;
constexpr size_t WS_HB = WS_H + (size_t)M * D * 4;
constexpr size_t WS_XS = WS_HB + (size_t)M * D;
constexpr size_t WS_W1T = WS_XS + (size_t)NSLOT_MAX * D;
constexpr size_t WS_W2T = WS_W1T + (size_t)NE * 4096 * D;
constexpr size_t WS_ACT = WS_W2T + (size_t)NE * 2048 * DFF;
constexpr size_t WS_YS = WS_ACT + (size_t)NSLOT_MAX * DFF;
constexpr size_t WS_END = WS_YS + (size_t)NSLOT_MAX * D * 2;

constexpr int RING_BYTES = 131072;
constexpr int LDSCTL_OFF = 159744;
constexpr int LDS_BYTES = 163840;

struct Args { const float* in[26]; float* out; unsigned char* ws; int ph_lo, ph_hi, dup, pad; };

template <bool KFAST = false> __device__ __forceinline__ void tr_load(const float* W, int N, int item, int lane, f32x4 (&v)[16]) {
    const int nblk = N / 64, kb = KFAST ? (item & 31) : item / nblk, nb = KFAST ? (item >> 5) : item % nblk, k0 = 64 * kb, n0 = 64 * nb;
    const int r = lane >> 4, c4 = (lane & 15) * 4;
#pragma unroll
    for (int i = 0; i < 16; ++i) v[i] = *(const GAS f32x4*)(W + (size_t)(k0 + 4 * i + r) * N + n0 + c4);
}
__device__ __forceinline__ void tr_store(const f32x4 (&v)[16], int K, int N, bf16* WT, size_t row_off, LAS float* scr, int item, int lane) {
    const int nblk = N / 64, kb = item / nblk, nb = item % nblk, k0 = 64 * kb, n0 = 64 * nb;
    const int r = lane >> 4, c4 = (lane & 15) * 4;
#pragma unroll
    for (int i = 0; i < 16; ++i) { LAS float* d = scr + (4 * i + r) * 65 + c4; d[0] = v[i].x; d[1] = v[i].y; d[2] = v[i].z; d[3] = v[i].w; }
    LDS_WAIT(); asm volatile("" ::: "memory");
    const int c = lane & 7;
#pragma unroll
    for (int p = 0; p < 8; ++p) { const int n = (lane >> 3) + 8 * p; const LAS float* q = scr + (8 * c) * 65 + n;
        v4u o; o.x = pk2(q[0 * 65], q[1 * 65]); o.y = pk2(q[2 * 65], q[3 * 65]); o.z = pk2(q[4 * 65], q[5 * 65]); o.w = pk2(q[6 * 65], q[7 * 65]);
        *(GAS v4u*)(WT + (row_off + n0 + n) * (size_t)K + k0 + 8 * c) = o; }
    LDS_WAIT(); asm volatile("" ::: "memory");
}
__device__ __forceinline__ unsigned pk4_fp8_nc(float a, float b, float c, float d) { int w = 0; w = __builtin_amdgcn_cvt_pk_fp8_f32(a, b, w, false); w = __builtin_amdgcn_cvt_pk_fp8_f32(c, d, w, true); return (unsigned)w; }
__device__ __forceinline__ void tr_store_fp8(const f32x4 (&v)[16], int K, int N, unsigned char* WT, size_t row_off, LAS float* scr, int item, int lane, float scale) {
    const int nblk = N / 64, kb = item / nblk, nb = item % nblk, k0 = 64 * kb, n0 = 64 * nb;
    const int r = lane >> 4, c4 = (lane & 15) * 4;
#pragma unroll
    for (int i = 0; i < 16; ++i) { const int k = 4 * i + r; *(LAS f32x4*)(scr + k * 64 + (c4 ^ (8 * (i >> 2)))) = v[i] * scale; }
    LDS_WAIT(); asm volatile("" ::: "memory");
    const int c = lane & 3;
#pragma unroll
    for (int p = 0; p < 4; ++p) { const int n = (lane >> 2) + 16 * p; const LAS float* q = scr + (16 * c) * 64 + (n ^ (8 * c));
        float f[16];
#pragma unroll
        for (int jj = 0; jj < 16; ++jj) f[jj] = q[jj * 64];
        v4u o; o.x = pk4_fp8_nc(f[0], f[1], f[2], f[3]); o.y = pk4_fp8_nc(f[4], f[5], f[6], f[7]); o.z = pk4_fp8_nc(f[8], f[9], f[10], f[11]); o.w = pk4_fp8_nc(f[12], f[13], f[14], f[15]);
        *(GAS v4u*)(WT + (row_off + n0 + n) * (size_t)K + k0 + 16 * c) = o; }
    LDS_WAIT(); asm volatile("" ::: "memory");
}
constexpr int NHB = 4;
__device__ __forceinline__ void tr_load2(const float* W, int N, int fl, int hh, int lane, f32x4 (&v)[16]) {
    const int nblk = N / 64, kb = fl / nblk, nb = fl % nblk, k0 = 64 * NHB * kb + 64 * hh, n0 = 64 * nb;
    const int g = lane >> 4, c4 = (lane & 15) * 4;
#pragma unroll
    for (int i = 0; i < 16; ++i) v[i] = *(const GAS f32x4*)(W + (size_t)(k0 + 16 * (i >> 2) + 4 * g + (i & 3)) * N + n0 + c4);
}
__device__ __forceinline__ void tr_half(const f32x4 (&v)[16], int hh, LAS unsigned* img, int lane, float scale) {
    const int g = lane >> 4, m = lane & 15;
#pragma unroll
    for (int j = 0; j < 4; ++j) { const f32x4 a = v[4 * j] * scale, b = v[4 * j + 1] * scale, c = v[4 * j + 2] * scale, d = v[4 * j + 3] * scale;
        const int dwi = (16 * hh + 4 * j + g) ^ ((m & 7) << 2);
        img[(4 * m + 0) * (16 * NHB) + dwi] = pk4_fp8_nc(a.x, b.x, c.x, d.x); img[(4 * m + 1) * (16 * NHB) + dwi] = pk4_fp8_nc(a.y, b.y, c.y, d.y);
        img[(4 * m + 2) * (16 * NHB) + dwi] = pk4_fp8_nc(a.z, b.z, c.z, d.z); img[(4 * m + 3) * (16 * NHB) + dwi] = pk4_fp8_nc(a.w, b.w, c.w, d.w); }
}
__device__ __forceinline__ void tr_flush(LAS unsigned* img, int K, int N, unsigned char* WT, size_t row_off, int fl, int lane) {
    const int nblk = N / 64, kb = fl / nblk, nb = fl % nblk, k0 = 64 * NHB * kb, n0 = 64 * nb;
    LDS_WAIT(); asm volatile("" ::: "memory");
    constexpr int CPR = 4 * NHB, RPP = 64 / CPR;
    const int c = lane % CPR;
#pragma unroll 4
    for (int p = 0; p < CPR; ++p) { const int n = lane / CPR + RPP * p;
        const v4u o = *(const LAS v4u*)(img + n * (16 * NHB) + 4 * (c ^ ((n >> 2) & 7)));
        *(GAS v4u*)(WT + (row_off + n0 + n) * (size_t)K + k0 + 16 * c) = o; }
    LDS_WAIT(); asm volatile("" ::: "memory");
}
__device__ __forceinline__ void transpose_item(const float* W, int K, int N, bf16* WT, size_t row_off, LAS float* scr, int item, int lane) {
    f32x4 v[16]; tr_load(W, N, item, lane, v); tr_store(v, K, N, WT, row_off, scr, item, lane);
}

__global__ void __launch_bounds__(NTHR, 2) mk_fwd(Args args) {
    extern __shared__ __attribute__((aligned(16))) unsigned char lds_raw[];
    LAS unsigned char* lds = (LAS unsigned char*)lds_raw;
    volatile LAS unsigned* MISC = (volatile LAS unsigned*)(lds + LDSCTL_OFF);
    LAS int* PS = (LAS int*)(lds + LDSCTL_OFF + 256);
    const int tid = threadIdx.x, lane = tid & 63, wave = __builtin_amdgcn_readfirstlane(tid >> 6);
    const int G = gridDim.x, bx = blockIdx.x;
    const int vcu = (bx % 8) * (G / 8) + bx / 8;
    const int gw = vcu * NWAVES + wave, NGW = G * NWAVES;
    unsigned char* ws = args.ws;
    gu32* ctl = (gu32*)(ws + WS_CTL);
    const float* x = args.in[0]; const float* w_in = args.in[1]; const float* mu = args.in[2]; const float* w0 = args.in[3]; const float* w2d = args.in[4];
    const float* a0 = args.in[5]; const float* a2 = args.in[6]; const float* g2 = args.in[7]; const float* k_k = args.in[8]; const float* k_a = args.in[9];
    const float* r_k = args.in[10]; const float* lnx_w = args.in[11]; const float* lnx_b = args.in[12]; const float* w_pool = args.in[13]; const float* pool_scale = args.in[14];
    const float* w_out = args.in[15]; const float* ln1_w = args.in[16]; const float* ln1_b = args.in[17]; const float* router_w = args.in[18]; const float* router_b = args.in[19];
    const float* w1 = args.in[20]; const float* b1 = args.in[21]; const float* w2 = args.in[22]; const float* b2 = args.in[23]; const float* ln2_w = args.in[24]; const float* ln2_b = args.in[25];
    float* out = args.out;
    int* CNTWG = (int*)(ws + WS_CTL) + CW_CNT;
    int* slot_tok = (int*)(ws + WS_SLOTTOK); int* TOPI = (int*)(ws + WS_TOPI); float* GATE = (float*)(ws + WS_GATE); int* POS = (int*)(ws + WS_POS); int* SLOT_OF = (int*)(ws + WS_SLOTOF);
    float* BONUS = (float*)(ws + WS_BONUS);
    bf16* XB = (bf16*)(ws + WS_XB); bf16* WINT = (bf16*)(ws + WS_WINT); bf16* WOUTT = (bf16*)(ws + WS_WOUTT); bf16* LORAT = (bf16*)(ws + WS_LORAT); bf16* WPOOLT = (bf16*)(ws + WS_WPOOLT);
    bf16* PROJ = (bf16*)(ws + WS_PROJ); bf16* LIN = (bf16*)(ws + WS_LIN); bf16* POOLED = (bf16*)(ws + WS_POOLED);
    float* WDEC = (float*)(ws + WS_WDEC); float* LOUT = (float*)(ws + WS_LOUT); float* Rr = (float*)(ws + WS_R); float* K2 = (float*)(ws + WS_K2);
    float* Vv = (float*)(ws + WS_V); float* KK = (float*)(ws + WS_KK); float* BB = (float*)(ws + WS_BB); float* Yy = (float*)(ws + WS_Y);
    bf16* MIXIN = (bf16*)(ws + WS_MIXIN); bf16* MIX = (bf16*)(ws + WS_MIX); bf16* H = (bf16*)(ws + WS_H); unsigned char* HQ = (unsigned char*)(ws + WS_HB);
    unsigned char* XS = ws + WS_XS; unsigned char* W1T = ws + WS_W1T; unsigned char* W2T = ws + WS_W2T; unsigned char* ACT = ws + WS_ACT; unsigned char* YS = ws + WS_YS;

    for (int u = tid; u < (LDS_BYTES - LDSCTL_OFF) / 4; u += NTHR) ((LAS unsigned*)(lds + LDSCTL_OFF))[u] = 0u;
    __syncthreads();
    XcdBarrier bar; bar.bar = (unsigned*)(ctl + CW_BAR); bar.x = 0; bar.st = nullptr;
    if (MK_N_LAUNCHES == 1) bar = xcd_barrier_post((unsigned*)(ctl + CW_BAR), MISC + 8);
    const int lo = args.ph_lo, hi = args.ph_hi;
#ifndef PHASE_MASK
#define PHASE_MASK 0xFFFF
#endif
#define IN(k) (((PHASE_MASK >> (k)) & 1) && lo <= (k) && (k) < hi)
#define SEAM(k) do { if (IN(k) && IN((k) + 1)) xcd_barrier(bar); } while (0)

    if (IN(0)) {
        LAS float* scr = (LAS float*)(lds + wave * 16640);
        for (size_t i = (size_t)gw * 64 + lane; i < (size_t)M * D / 8; i += (size_t)NGW * 64) {
            const f32x4 a = *(const GAS f32x4*)(x + i * 8), b = *(const GAS f32x4*)(x + i * 8 + 4);
            v4u o; o.x = pk2(a.x, a.y); o.y = pk2(a.z, a.w); o.z = pk2(b.x, b.y); o.w = pk2(b.z, b.w);
            *(GAS v4u*)(XB + i * 8) = o;
        }
        constexpr int I_IN = (D / 64) * (IN_COLS / 64)  , I_OUT = (D / 64) * (D / 64);
        for (int it = gw; it < I_IN + I_OUT; it += NGW) {
            if (it < I_IN) transpose_item(w_in, D, IN_COLS, WINT, 0, scr, it, lane);
            else transpose_item(w_out, D, D, WOUTT, 0, scr, it - I_IN, lane);
        }
        for (int i = gw * 64 + lane; i < 32 * D; i += NGW * 64) { const int nn = 4352 + (i >> 11), k = i & 2047; WINT[(size_t)nn * D + k] = (bf16)f2bf(w_in[(size_t)k * IN_COLS + nn]); }
        for (size_t i = (size_t)gw * 64 + lane; i < (size_t)(IN_PAD - IN_COLS) * D / 8; i += (size_t)NGW * 64) *(GAS v4u*)(WINT + (size_t)IN_COLS * D + i * 8) = (v4u){0u, 0u, 0u, 0u};
        for (int i = gw * 64 + lane; i < 3072 * LK; i += NGW * 64) {
            const int n = i / LK, k = i % LK; float v = 0.f;
            if (n < 1024) { if (k < 64) v = w2d[k * 1024 + n]; }
            else if (n < 2048) { if (k >= 64 && k < 128) v = a2[(k - 64) * 1024 + (n - 1024)]; }
            else { if (k >= 128 && k < 288) v = g2[(k - 128) * 1024 + (n - 2048)]; }
            LORAT[i] = (bf16)f2bf(v);
        }
        for (int i = gw * 64 + lane; i < 1024 * 256; i += NGW * 64) {
            const int n = i >> 8, c = i & 255, g = n >> 8, d = n & 255;
            WPOOLT[i] = (bf16)f2bf(w_pool[((size_t)g * 256 + c) * 256 + d]);
        }
    }
    SEAM(0);

    if (IN(1)) {
        pg8::Gemm g{XB, WINT, D, D}; pg8::GridOrder S; S.init(M / 256, IN_PAD / 256, G, bx, (size_t)256 * D * 2, 0, (size_t)256 * D * 2);
        pg8::EpiBf16Plain E{PROJ, IN_PAD};
        pg8::gemm_phase<pg8::EpiBf16Plain, pg8::GridOrder, true, true>(lds, g, S, E);
    }
    SEAM(1);

    if (IN(2)) {
        const int m0 = gw * 8, t0 = m0 % SEQ;
        const float mu_l[5] = {mu[3072 + lane], mu[3072 + 64 + lane], mu[3072 + 128 + lane], mu[3072 + 192 + lane], lane < 32 ? mu[3072 + 256 + lane] : 0.f};
        float prevl[5];
#pragma unroll
        for (int q = 0; q < 5; ++q) { const int i = lane + 64 * q; prevl[q] = (i < 288 && t0 > 0) ? ld1bf(PROJ + (size_t)(m0 - 1) * IN_PAD + 3072 + i) : 0.f; }
        f32x4 wsum[4];
#pragma unroll
        for (int q = 0; q < 4; ++q) {
            const int c = 4 * lane + 256 * q, win = 2 << q; f32x4 sacc = (f32x4){0.f, 0.f, 0.f, 0.f};
#pragma unroll
            for (int s = 1; s < (2 << q); ++s) if (s <= t0) sacc += ld4bf(PROJ + (size_t)(m0 - s) * IN_PAD + SHIFT_W + c);
            wsum[q] = sacc; (void)win;
        }
#pragma unroll
        for (int i8 = 0; i8 < 8; ++i8) {
            const int m = m0 + i8, t = t0 + i8;
            const bf16* pr = PROJ + (size_t)m * IN_PAD;
#pragma unroll
            for (int q = 0; q < 6; ++q) {
                const int i = lane + 64 * q; float v = 0.f;
                if (q < 5) { if (i < 288) { const float cur = ld1bf(pr + 3072 + i); const float s_ = cur + (prevl[q] - cur) * mu_l[q]; prevl[q] = cur;
                    v = i < 64 ? tanhf(s_) : (i < 128 ? s_ : 1.0f / (1.0f + __expf(-s_))); } }
                LIN[(size_t)m * LK + i] = (bf16)f2bf(v);
            }
#pragma unroll
            for (int q = 0; q < 4; ++q) {
                const int c = 4 * lane + 256 * q, win = 2 << q; const int n = (t + 1) < win ? (t + 1) : win;
                const f32x4 cur = ld4bf(pr + SHIFT_W + c);
                const f32x4 sum = wsum[q] + cur;
                f32x4 nxt = sum; if (t + 1 >= win) nxt = sum - ld4bf(pr - (size_t)(win - 1) * IN_PAD + SHIFT_W + c);
                wsum[q] = nxt;
                const float inv = 1.0f / (float)n; const f32x4 pv = sum * inv - cur;
                v2u o; o.x = pk2(pv.x, pv.y); o.y = pk2(pv.z, pv.w);
                *(GAS v2u*)(POOLED + (size_t)m * 1024 + c) = o;
            }
        }
    }
    SEAM(2);

    if (IN(3)) {
#ifndef NO_LORA
        { pg8::Gemm g{LIN, LORAT, LK, LK}; pg8::GridOrder S; S.init(M / 256, 12, G, bx, (size_t)256 * LK * 2, 0, (size_t)256 * LK * 2);
          pg8::EpiF32 E{LOUT, 3072};
          pg8::gemm_phase<pg8::EpiF32, pg8::GridOrder, true, true>(lds, g, S, E); }
#endif
#ifndef NO_POOL
        { pg8::Gemm g{POOLED, WPOOLT, 1024, 256}; pg8::GridOrder S; S.init(M / 256, 4, G, bx, (size_t)256 * 1024 * 2, (size_t)256 * 2, (size_t)256 * 256 * 2);
          pg8::EpiPool E{MIXIN, pool_scale};
          pg8::gemm_phase<pg8::EpiPool, pg8::GridOrder, true, true>(lds, g, S, E); }
#endif
    }
    SEAM(3);

    if (IN(4)) {
        constexpr int CH = 16, NCHUNK = SEQ / CH;
        constexpr int PK_PA = 0, PK_PR = 2048, PK_QQ = 4096, PK_TT = 5120, PK_GG = 6144, PK_BK = 7168, PK_VT = 11264, PK_WC = 13312, PK_BON = 13568, PK_BYTES = 16384;
        const int tr = lane & 15, q = lane >> 4;
        for (int arep_ = 0; arep_ < P5A_REPS; ++arep_) {
                const int j = lane;
                LAS bf16* IMG = (LAS bf16*)(lds + wave * 10240);
                LAS float* PTs = (LAS float*)(lds + wave * 10240 + 9216);
                const int pos = (j & 32) | ((j & 12) << 1) | ((j & 16) >> 2) | (j & 3);
#pragma unroll 1
                for (int u = gw; u < 64 * NCHUNK; u += NGW) {
                    const int hd = u >> 8, c = u & 255, b = hd >> 4, h = hd & 15, cj = h * 64 + j;
                    const float mu_r = mu[cj], mu_k = mu[1024 + cj], mu_v = mu[2048 + cj], c_w0 = w0[cj], c_a0 = a0[cj], c_kk = k_k[cj], c_ka = k_a[cj];
                    unsigned char* pk = ws + WS_R + ((size_t)hd * NCHUNK + c) * PK_BYTES;
                    const size_t m0 = (size_t)b * SEQ + (size_t)c * CH;
                    float At[16], Rt[16], Bt[16], Kt[16], Vt[16];
                    float Wc = 1.f, pr_r = 0.f, pr_k = 0.f, pr_v = 0.f;
                    if (c > 0) { const bf16* pp = PROJ + (m0 - 1) * IN_PAD + cj; pr_r = ld1bf(pp); pr_k = ld1bf(pp + 1024); pr_v = ld1bf(pp + 2048); }
#pragma unroll
                    for (int t = 0; t < 16; ++t) {
                        const bf16* prow = PROJ + (m0 + t) * IN_PAD + cj; const float* lrow = LOUT + (m0 + t) * 3072 + cj;
                        const float cr = ld1bf(prow), ck = ld1bf(prow + 1024), cv = ld1bf(prow + 2048), wl = lrow[0] + c_w0, al = lrow[1024] + c_a0;
                        const float r = cr + (pr_r - cr) * mu_r, k = ck + (pr_k - ck) * mu_k, v = cv + (pr_v - cv) * mu_v;
                        pr_r = cr; pr_k = ck; pr_v = cv;
                        const float dec = fast_decay(wl), a = fast_sigmoid(al);
                        float kk = k * c_kk; const float ss = wave_sum_dpp(kk * kk); kk = kk * __builtin_amdgcn_rsqf(fmaxf(ss, 1e-24f));
                        const float k2 = k * (1.0f + (a - 1.0f) * c_ka), bb = kk * a;
                        const float Wprev = Wc; Wc = Wc * dec; const float iw = __builtin_amdgcn_rcpf(Wc);
                        At[t] = -kk * Wprev; Rt[t] = r * Wc; Bt[t] = bb * iw; Kt[t] = k2 * iw; Vt[t] = v;
                    }
#pragma unroll
                    for (int t = 0; t < 16; ++t) {
                        const unsigned ar_ = cvt_pk_bf16_nat(At[t], Rt[t]), bk_ = cvt_pk_bf16_nat(Bt[t], Kt[t]); const bf16 ab = (bf16)ar_, rb = (bf16)(ar_ >> 16);
                        IMG[0 * 1152 + t * 72 + j] = ab; IMG[1 * 1152 + t * 72 + j] = rb; IMG[2 * 1152 + t * 72 + j] = (bf16)bk_; IMG[3 * 1152 + t * 72 + j] = (bf16)(bk_ >> 16);
                        ((GAS bf16*)(pk + PK_PA))[t * 64 + pos] = ab; ((GAS bf16*)(pk + PK_PR))[t * 64 + pos] = rb;
                    }
#pragma unroll
                    for (int qq = 0; qq < 4; ++qq) { v4u o; o.x = pk2(Bt[4 * qq] * Wc, Bt[4 * qq + 1] * Wc); o.y = pk2(Bt[4 * qq + 2] * Wc, Bt[4 * qq + 3] * Wc); o.z = pk2(Kt[4 * qq] * Wc, Kt[4 * qq + 1] * Wc); o.w = pk2(Kt[4 * qq + 2] * Wc, Kt[4 * qq + 3] * Wc);
                        *(GAS v4u*)(pk + PK_BK + j * 64 + qq * 16) = o; }
#pragma unroll
                    for (int g = 0; g < 2; ++g) { v4u o; o.x = pk2(Vt[8 * g], Vt[8 * g + 1]); o.y = pk2(Vt[8 * g + 2], Vt[8 * g + 3]); o.z = pk2(Vt[8 * g + 4], Vt[8 * g + 5]); o.w = pk2(Vt[8 * g + 6], Vt[8 * g + 7]);
                        *(GAS v4u*)(pk + PK_VT + j * 32 + g * 16) = o; }
                    ((GAS float*)(pk + PK_WC))[j] = Wc;
                    asm volatile("s_waitcnt lgkmcnt(0)" ::: "memory");
                    const bf16x8 fa0 = *(const LAS bf16x8*)(IMG + 0 * 1152 + tr * 72 + 8 * q), fa1 = *(const LAS bf16x8*)(IMG + 0 * 1152 + tr * 72 + 32 + 8 * q);
                    const bf16x8 fr0 = *(const LAS bf16x8*)(IMG + 1 * 1152 + tr * 72 + 8 * q), fr1 = *(const LAS bf16x8*)(IMG + 1 * 1152 + tr * 72 + 32 + 8 * q);
                    const bf16x8 fb0 = *(const LAS bf16x8*)(IMG + 2 * 1152 + tr * 72 + 8 * q), fb1 = *(const LAS bf16x8*)(IMG + 2 * 1152 + tr * 72 + 32 + 8 * q);
                    const bf16x8 fk0 = *(const LAS bf16x8*)(IMG + 3 * 1152 + tr * 72 + 8 * q), fk1 = *(const LAS bf16x8*)(IMG + 3 * 1152 + tr * 72 + 32 + 8 * q);
                    const f32x4 z4 = (f32x4){0.f, 0.f, 0.f, 0.f};
                    f32x4 PT = __builtin_amdgcn_mfma_f32_16x16x32_bf16(fa0, fb0, z4, 0, 0, 0); PT = __builtin_amdgcn_mfma_f32_16x16x32_bf16(fa1, fb1, PT, 0, 0, 0);
                    f32x4 QT = __builtin_amdgcn_mfma_f32_16x16x32_bf16(fa0, fk0, z4, 0, 0, 0); QT = __builtin_amdgcn_mfma_f32_16x16x32_bf16(fa1, fk1, QT, 0, 0, 0);
                    f32x4 GB = __builtin_amdgcn_mfma_f32_16x16x32_bf16(fr0, fb0, z4, 0, 0, 0); GB = __builtin_amdgcn_mfma_f32_16x16x32_bf16(fr1, fb1, GB, 0, 0, 0);
                    f32x4 GK = __builtin_amdgcn_mfma_f32_16x16x32_bf16(fr0, fk0, z4, 0, 0, 0); GK = __builtin_amdgcn_mfma_f32_16x16x32_bf16(fr1, fk1, GK, 0, 0, 0);
                    const int s_ = tr, rec = (s_ >> 2) * 8 + (s_ & 3);
#pragma unroll
                    for (int e = 0; e < 4; ++e) { const int t = 4 * q + e;
                        const float pv = s_ < t ? PT[e] : 0.f, qv = s_ < t ? QT[e] : 0.f, gb = s_ <= t ? GB[e] : 0.f, gk = s_ <= t ? GK[e] : 0.f;
                        PTs[t * 16 + s_] = pv;
                        ((GAS bf16*)(pk + PK_QQ))[t * 32 + rec] = (bf16)f2bf(qv); ((GAS bf16*)(pk + PK_QQ))[t * 32 + rec + 4] = (bf16)0;
                        ((GAS bf16*)(pk + PK_GG))[t * 32 + rec] = (bf16)f2bf(gb); ((GAS bf16*)(pk + PK_GG))[t * 32 + rec + 4] = (bf16)f2bf(gk); }
                    asm volatile("s_waitcnt lgkmcnt(0)" ::: "memory");
                    float Tr[16];
#pragma unroll
                    for (int t = 0; t < 16; ++t) { float acc = (t == s_) ? 1.f : 0.f;
#pragma unroll
                        for (int r4_ = 0; r4_ < (t + 3) / 4; ++r4_) { const f32x4 pr4 = *(const LAS f32x4*)(PTs + t * 16 + 4 * r4_);
#pragma unroll
                            for (int e = 0; e < 4; ++e) if (4 * r4_ + e < t) acc += pr4[e] * Tr[4 * r4_ + e]; }
                        Tr[t] = acc; }
                    if (q == 0) {
#pragma unroll
                        for (int t = 0; t < 16; ++t) { ((GAS bf16*)(pk + PK_TT))[t * 32 + rec] = (bf16)f2bf(Tr[t]); ((GAS bf16*)(pk + PK_TT))[t * 32 + rec + 4] = (bf16)0; } }
                    asm volatile("s_waitcnt lgkmcnt(0)" ::: "memory");
                }
            }
    }
    SEAM(4);

    if (IN(5)) {
        constexpr int P5_OPS = 0, P5_VV = 81920, P5_YW = 90112, P5_SC = 98304;
        const int xcd_i = bx % 8, slot_i = bx / 8;
        constexpr int NSCAN_X = 8;
        if (slot_i < NSCAN_X) {
            constexpr int CH = 16, NCHUNK = SEQ / CH, NSLOT = 8, LAG = 3;
            LAS unsigned* ring_ready = (LAS unsigned*)(lds + LDSCTL_OFF + 896); LAS unsigned* ring_done = ring_ready + 4;
            constexpr int PK_PA = 0, PK_PR = 2048, PK_QQ = 4096, PK_TT = 5120, PK_GG = 6144, PK_BK = 7168, PK_VT = 11264, PK_WC = 13312, PK_BON = 13568, PK_BYTES = 16384;
            const int hd = xcd_i * NSCAN_X + slot_i, b = hd >> 4, h = hd & 15;
            const size_t mbase = (size_t)b * SEQ;
            static_assert((size_t)64 * NCHUNK * PK_BYTES <= 4 * SZ_F1K, "packs fit the four unused f32 [M][1024] buffers at WS_R");
            unsigned char* PACK = ws + WS_R + (size_t)hd * NCHUNK * PK_BYTES;
            const int tr = lane & 15, q = lane >> 4;
            if (wave < 4) {
                const int icol = 16 * wave + tr;
                LAS float* YT = (LAS float*)(lds + RING_BYTES);
                LAS unsigned* ywr = ring_ready + 8; LAS unsigned* yrd = ring_ready + 12;
                const int ptok = 4 * wave + (lane >> 4), pcol = 4 * (lane & 15);
                const f32x4 lw4 = *(const GAS f32x4*)(lnx_w + h * 64 + pcol), lb4 = *(const GAS f32x4*)(lnx_b + h * 64 + pcol), rk4 = *(const GAS f32x4*)(r_k + h * 64 + pcol);
                const int ppos = (pcol & 32) | ((pcol & 12) << 1) | ((pcol & 16) >> 2);
                f32x4 H0 = (f32x4){0.f, 0.f, 0.f, 0.f}, H1 = H0, H2 = H0, H3 = H0;
                bf16x8 A_fa0, A_fa1, A_fr0, A_fr1, A_fq, A_ft, A_fg, A_b0, A_b1, A_b2, A_b3; v2u A_v; f32x4 A_w0, A_w1, A_w2, A_w3, A_g;
                bf16x8 B_fa0, B_fa1, B_fr0, B_fr1, B_fq, B_ft, B_fg, B_b0, B_b1, B_b2, B_b3; v2u B_v; f32x4 B_w0, B_w1, B_w2, B_w3, B_g;
#define CK_LOAD(P, c_) do { { unsigned sp_ = 0; for (;;) { const v4u rr_ = *(volatile LAS v4u*)ring_ready; const unsigned mn_ = min(min(rr_.x, rr_.y), min(rr_.z, rr_.w)); if (mn_ >= (unsigned)((c_) + 1)) break; __builtin_amdgcn_s_sleep(0); if (++sp_ > (1u << 26)) break; } } asm volatile("" ::: "memory"); \
                    const LAS unsigned char* pk_ = lds + ((c_) & (NSLOT - 1)) * PK_BYTES; \
                    P##_fa0 = *(const LAS bf16x8*)(pk_ + PK_PA + (tr * 64 + 8 * q) * 2); P##_fa1 = *(const LAS bf16x8*)(pk_ + PK_PA + (tr * 64 + 32 + 8 * q) * 2); \
                    P##_fr0 = *(const LAS bf16x8*)(pk_ + PK_PR + (tr * 64 + 8 * q) * 2); P##_fr1 = *(const LAS bf16x8*)(pk_ + PK_PR + (tr * 64 + 32 + 8 * q) * 2); \
                    P##_fq = *(const LAS bf16x8*)(pk_ + PK_QQ + (tr * 4 + q) * 16); P##_ft = *(const LAS bf16x8*)(pk_ + PK_TT + (tr * 4 + q) * 16); P##_fg = *(const LAS bf16x8*)(pk_ + PK_GG + (tr * 4 + q) * 16); \
                    P##_b0 = *(const LAS bf16x8*)(pk_ + PK_BK + ((0 + tr) * 4 + q) * 16); P##_b1 = *(const LAS bf16x8*)(pk_ + PK_BK + ((16 + tr) * 4 + q) * 16); \
                    P##_b2 = *(const LAS bf16x8*)(pk_ + PK_BK + ((32 + tr) * 4 + q) * 16); P##_b3 = *(const LAS bf16x8*)(pk_ + PK_BK + ((48 + tr) * 4 + q) * 16); \
                    P##_v = *(const LAS v2u*)(pk_ + PK_VT + icol * 32 + q * 8); \
                    P##_g = *(const GAS f32x4*)(LOUT + (mbase + (size_t)(c_) * CH + ptok) * 3072 + 2048 + h * 64 + pcol); \
                    P##_w0 = *(const LAS f32x4*)(pk_ + PK_WC + (0 + 4 * q) * 4); P##_w1 = *(const LAS f32x4*)(pk_ + PK_WC + (16 + 4 * q) * 4); P##_w2 = *(const LAS f32x4*)(pk_ + PK_WC + (32 + 4 * q) * 4); P##_w3 = *(const LAS f32x4*)(pk_ + PK_WC + (48 + 4 * q) * 4); } while (0)
#define CK_MM(a_, b_, c_) __builtin_amdgcn_mfma_f32_16x16x32_bf16(a_, b_, c_, 0, 0, 0)
#define CK_STEP(P, c_) do { const f32x4 z4 = (f32x4){0.f, 0.f, 0.f, 0.f}; \
                    v4u hb0, hb1; hb0.x = cvt_pk_bf16_nat(H0[0], H0[1]); hb0.y = cvt_pk_bf16_nat(H0[2], H0[3]); hb0.z = cvt_pk_bf16_nat(H1[0], H1[1]); hb0.w = cvt_pk_bf16_nat(H1[2], H1[3]); \
                    hb1.x = cvt_pk_bf16_nat(H2[0], H2[1]); hb1.y = cvt_pk_bf16_nat(H2[2], H2[3]); hb1.z = cvt_pk_bf16_nat(H3[0], H3[1]); hb1.w = cvt_pk_bf16_nat(H3[2], H3[3]); \
                    const bf16x8 Hb0 = __builtin_bit_cast(bf16x8, hb0), Hb1 = __builtin_bit_cast(bf16x8, hb1); \
                    v4u vb_; vb_.x = P##_v.x; vb_.y = P##_v.y; vb_.z = P##_v.x; vb_.w = P##_v.y; const bf16x8 Vb = __builtin_bit_cast(bf16x8, vb_); \
                    f32x4 XQ = CK_MM(P##_fa0, Hb0, z4); XQ = CK_MM(P##_fa1, Hb1, XQ); XQ = CK_MM(P##_fq, Vb, XQ); \
                    v4u xb_; xb_.x = cvt_pk_bf16_nat(XQ[0], XQ[1]); xb_.y = cvt_pk_bf16_nat(XQ[2], XQ[3]); xb_.z = 0u; xb_.w = 0u; \
                    const f32x4 U = CK_MM(P##_ft, __builtin_bit_cast(bf16x8, xb_), z4); \
                    v4u ub_; ub_.x = cvt_pk_bf16_nat(U[0], U[1]); ub_.y = cvt_pk_bf16_nat(U[2], U[3]); ub_.z = P##_v.x; ub_.w = P##_v.y; const bf16x8 UVb = __builtin_bit_cast(bf16x8, ub_); \
                    f32x4 Y = CK_MM(P##_fr0, Hb0, z4); Y = CK_MM(P##_fr1, Hb1, Y); Y = CK_MM(P##_fg, UVb, Y); \
                    H0 = CK_MM(P##_b0, UVb, H0 * P##_w0); H1 = CK_MM(P##_b1, UVb, H1 * P##_w1); H2 = CK_MM(P##_b2, UVb, H2 * P##_w2); H3 = CK_MM(P##_b3, UVb, H3 * P##_w3); \
                    { unsigned sp_ = 0; for (;;) { const v4u dd_ = *(volatile LAS v4u*)yrd; if (min(min(dd_.x, dd_.y), min(dd_.z, dd_.w)) + 4u > (unsigned)(c_)) break; __builtin_amdgcn_s_sleep(0); if (++sp_ > (1u << 26)) break; } }     \
                    asm volatile("" ::: "memory"); \
                    { LAS float* yt_ = YT + ((c_) & 3) * 1024 + (4 * q) * 64 + icol; yt_[0] = Y[0]; yt_[64] = Y[1]; yt_[128] = Y[2]; yt_[192] = Y[3]; } \
                    asm volatile("s_waitcnt lgkmcnt(0)" ::: "memory"); if (lane == 0) __hip_atomic_fetch_add(ywr + wave, 1u, __ATOMIC_RELAXED, __HIP_MEMORY_SCOPE_WORKGROUP); } while (0)
#define CK_POST(P, c_) do { { unsigned sp_ = 0; for (;;) { const v4u ww_ = *(volatile LAS v4u*)ywr; if (min(min(ww_.x, ww_.y), min(ww_.z, ww_.w)) >= (unsigned)((c_) + 1)) break; __builtin_amdgcn_s_sleep(0); if (++sp_ > (1u << 26)) break; } } \
                    asm volatile("" ::: "memory"); \
                    const LAS unsigned char* pk_ = lds + ((c_) & (NSLOT - 1)) * PK_BYTES; \
                    const f32x4 y_ = *(const LAS f32x4*)(YT + ((c_) & 3) * 1024 + ptok * 64 + pcol); \
                    const LAS bf16* vt_ = (const LAS bf16*)(pk_ + PK_VT) + pcol * 16 + ptok; \
                    const f32x4 v_ = (f32x4){__builtin_bit_cast(float, (unsigned)vt_[0] << 16), __builtin_bit_cast(float, (unsigned)vt_[16] << 16), __builtin_bit_cast(float, (unsigned)vt_[32] << 16), __builtin_bit_cast(float, (unsigned)vt_[48] << 16)}; \
                    const v2u rr2_ = *(const LAS v2u*)(pk_ + PK_PR + (ptok * 64 + ppos) * 2); const LAS bf16* kh_ = (const LAS bf16*)(pk_ + PK_BK + pcol * 64 + (ptok >> 2) * 16 + 8 + (ptok & 3) * 2); \
                    const f32x4 wc_ = *(const LAS f32x4*)(pk_ + PK_WC + pcol * 4); \
                    const float bon_ = row16_sum(bflo(rr2_.x) * __builtin_bit_cast(float, (unsigned)kh_[0] << 16) * rk4.x * __builtin_amdgcn_rcpf(wc_.x) + bfhi(rr2_.x) * __builtin_bit_cast(float, (unsigned)kh_[32] << 16) * rk4.y * __builtin_amdgcn_rcpf(wc_.y) \
                                                 + bflo(rr2_.y) * __builtin_bit_cast(float, (unsigned)kh_[64] << 16) * rk4.z * __builtin_amdgcn_rcpf(wc_.z) + bfhi(rr2_.y) * __builtin_bit_cast(float, (unsigned)kh_[96] << 16) * rk4.w * __builtin_amdgcn_rcpf(wc_.w));     \
                    const float mean_ = row16_sum(y_.x + y_.y + y_.z + y_.w) * (1.0f / 64.0f); const f32x4 d_ = y_ - mean_; \
                    const float var_ = row16_sum(d_.x * d_.x + d_.y * d_.y + d_.z * d_.z + d_.w * d_.w) * (1.0f / 64.0f); \
                    f32x4 yn_ = d_ * __builtin_amdgcn_rsqf(var_ + GN_EPS) * lw4 + lb4; yn_ = (yn_ + bon_ * v_) * P##_g; \
                    v2u ov_; ov_.x = pk2(yn_.x, yn_.y); ov_.y = pk2(yn_.z, yn_.w); \
                    *(GAS v2u*)(MIXIN + (mbase + (size_t)(c_) * CH + ptok) * 2048 + h * 64 + pcol) = ov_; \
                    asm volatile("s_waitcnt lgkmcnt(0)" ::: "memory"); \
                    if (lane == 0) { __hip_atomic_fetch_add(yrd + wave, 1u, __ATOMIC_RELAXED, __HIP_MEMORY_SCOPE_WORKGROUP); __hip_atomic_fetch_add(ring_done + wave, 1u, __ATOMIC_RELAXED, __HIP_MEMORY_SCOPE_WORKGROUP); } } while (0)
                CK_LOAD(A, 0);
#pragma unroll 1
                for (int c = 0; c < NCHUNK; c += 2) {
                    if (c > 0) CK_POST(B, c - 1);
                    CK_LOAD(B, c + 1); CK_STEP(A, c);
                    CK_POST(A, c);
                    CK_LOAD(A, (c + 2 < NCHUNK ? c + 2 : c)); CK_STEP(B, c + 1);
                }
                CK_POST(B, NCHUNK - 1);
#undef CK_LOAD
#undef CK_MM
#undef CK_STEP
#undef CK_POST
            } else {
                const int lw = wave - 4;
#pragma unroll 1
                for (int c = 0; c < NCHUNK + LAG; ++c) {
                    if (c < NCHUNK) {
                        if (c >= NSLOT) { const unsigned want = (unsigned)(c - NSLOT + 1); unsigned sp_ = 0;
                            for (;;) { const v4u dd_ = *(volatile LAS v4u*)ring_done; if (min(min(dd_.x, dd_.y), min(dd_.z, dd_.w)) >= want) break; __builtin_amdgcn_s_sleep(0); if (++sp_ > (1u << 26)) break; } }
                        asm volatile("" ::: "memory");
                        const unsigned char* src = PACK + (size_t)c * PK_BYTES + lw * 1024 + lane * 16;
                        LAS unsigned char* dst = lds + (c & (NSLOT - 1)) * PK_BYTES + lw * 1024;
#pragma unroll
                        for (int p = 0; p < 3; ++p) __builtin_amdgcn_global_load_lds((const unsigned*)(src + p * 4096), (LAS unsigned*)(dst + p * 4096), 16, 0, 0);
                        if (lw < 2) __builtin_amdgcn_global_load_lds((const unsigned*)(src + 3 * 4096), (LAS unsigned*)(dst + 3 * 4096), 16, 0, 0);
                    }
                    if (c >= LAG) {
                        if (c < NCHUNK) { if (lw < 2) asm volatile("s_waitcnt vmcnt(12)" ::: "memory"); else asm volatile("s_waitcnt vmcnt(9)" ::: "memory"); } else asm volatile("s_waitcnt vmcnt(0)" ::: "memory");
                        if (lane == 0) __hip_atomic_fetch_add(ring_ready + lw, 1u, __ATOMIC_RELAXED, __HIP_MEMORY_SCOPE_WORKGROUP);
                    }
                }
            }
        }
        else for (int crep_ = 0; crep_ < P5_CONV_REPS; ++crep_) {
            LAS unsigned* img = (LAS unsigned*)(lds + wave * (4096 * NHB));
            const int cw = (xcd_i * (32 - NSCAN_X) + slot_i - NSCAN_X) * NWAVES + wave;
            constexpr int F1 = (D / (64 * NHB)) * (4096 / 64), F2 = (DFF / (64 * NHB)) * (D / 64), FPE = F1 + F2, NFULL = NE * FPE, STRIDE = (NWG - 8 * NSCAN_X) * NWAVES;
            const int nhalf = cw < NFULL ? NHB * ((NFULL - cw + STRIDE - 1) / STRIDE) : 0;
            f32x4 va[16], vb2[16], vc[16];
            int s = 0;
#define CONV_LD(ss_, buf_) { const int sc_ = (ss_) < nhalf ? (ss_) : nhalf - 1; const int fi_ = cw + (sc_ / NHB) * STRIDE, e_ = fi_ / FPE, r_ = fi_ % FPE; \
                if (r_ < F1) tr_load2(w1 + (size_t)e_ * D * 4096, 4096, r_, sc_ % NHB, lane, buf_); else tr_load2(w2 + (size_t)e_ * DFF * D, D, r_ - F1, sc_ % NHB, lane, buf_); }
#define CONV_STEP(cur, far) { CONV_LD(s + 2, far);     \
                tr_half(cur, s % NHB, img, lane, pg8::W_SCALE); \
                if (s % NHB == NHB - 1) { const int fi_ = cw + (s / NHB) * STRIDE, e_ = fi_ / FPE, r_ = fi_ % FPE; \
                    if (r_ < F1) tr_flush(img, D, 4096, W1T, (size_t)e_ * 4096, r_, lane); else tr_flush(img, DFF, D, W2T, (size_t)e_ * 2048, r_ - F1, lane); } \
                ++s; }
            if (nhalf > 0) { CONV_LD(0, va); CONV_LD(1, vb2);
                for (;;) { CONV_STEP(va, vc); if (s >= nhalf) break; CONV_STEP(vb2, va); if (s >= nhalf) break; CONV_STEP(vc, vb2); if (s >= nhalf) break; } }
#undef CONV_LD
#undef CONV_STEP
        }
    }
    SEAM(5);


    if (IN(7)) {
        pg8::Gemm g{MIXIN, WOUTT, D, D}; pg8::GridOrder S; S.init(M / 256, D / 256, G, bx, (size_t)256 * D * 2, 0, (size_t)256 * D * 2);
        pg8::EpiBf16Plain E{MIX, D};
        pg8::gemm_phase<pg8::EpiBf16Plain, pg8::GridOrder, true, true>(lds, g, S, E);
    }
    SEAM(7);

    if (IN(8)) {
        constexpr int HROW = 2048 + 32;
        LAS bf16* s_hh = (LAS bf16*)lds; LAS bf16* s_hl = s_hh + 8 * HROW;
        LAS float* s_part = (LAS float*)(lds + 69632);
        LAS float* s_lnw = (LAS float*)(lds + 81920); LAS float* s_lnb = s_lnw + 2048;
        const int re = lane & 15, rq = lane >> 4;
        bf16x8 wh[8][2], wl[8][2];
#pragma unroll
        for (int st = 0; st < 8; ++st)
#pragma unroll
            for (int hf = 0; hf < 2; ++hf) { float w8[8];
#pragma unroll
                for (int j = 0; j < 8; ++j) w8[j] = router_w[(size_t)(256 * wave + 32 * st + 8 * rq + j) * 32 + re + 16 * hf];
                v4u hi, lo;
                hi.x = pk2(w8[0], w8[1]); hi.y = pk2(w8[2], w8[3]); hi.z = pk2(w8[4], w8[5]); hi.w = pk2(w8[6], w8[7]);
                lo.x = pk2(w8[0] - bflo(hi.x), w8[1] - bfhi(hi.x)); lo.y = pk2(w8[2] - bflo(hi.y), w8[3] - bfhi(hi.y)); lo.z = pk2(w8[4] - bflo(hi.z), w8[5] - bfhi(hi.z)); lo.w = pk2(w8[6] - bflo(hi.w), w8[7] - bfhi(hi.w));
                wh[st][hf] = __builtin_bit_cast(bf16x8, hi); wl[st][hf] = __builtin_bit_cast(bf16x8, lo); }
        LAS int* lcnt = (LAS int*)(lds + LDSCTL_OFF + 512);
        if (tid < NE) lcnt[tid] = 0;
        const float rb = router_b[lane & 31];
        *(LAS f32x4*)(s_lnw + 4 * tid) = *(const GAS f32x4*)(ln1_w + 4 * tid); *(LAS f32x4*)(s_lnb + 4 * tid) = *(const GAS f32x4*)(ln1_b + 4 * tid);
        __syncthreads();
        constexpr int NIT = M / (NWG * 8);
        v4u rm[4], rx[4];
#define P8_FETCH(m_) do { _Pragma("unroll") for (int q = 0; q < 4; ++q) { rm[q] = *(const GAS v4u*)(MIX + (size_t)(m_) * D + 8 * lane + 512 * q); rx[q] = *(const GAS v4u*)(XB + (size_t)(m_) * D + 8 * lane + 512 * q); } } while (0)
#define P8_LN(m_) do { f32x4 v[8]; float s = 0.f; \
            _Pragma("unroll") for (int q = 0; q < 4; ++q) { \
                v[2 * q] = ALPHA * (f32x4){bflo(rx[q].x), bfhi(rx[q].x), bflo(rx[q].y), bfhi(rx[q].y)} + (f32x4){bflo(rm[q].x), bfhi(rm[q].x), bflo(rm[q].y), bfhi(rm[q].y)}; \
                v[2 * q + 1] = ALPHA * (f32x4){bflo(rx[q].z), bfhi(rx[q].z), bflo(rx[q].w), bfhi(rx[q].w)} + (f32x4){bflo(rm[q].z), bfhi(rm[q].z), bflo(rm[q].w), bfhi(rm[q].w)}; \
                s += ((v[2 * q].x + v[2 * q].y) + (v[2 * q].z + v[2 * q].w)) + ((v[2 * q + 1].x + v[2 * q + 1].y) + (v[2 * q + 1].z + v[2 * q + 1].w)); } \
            const float mean = wave_sum_dpp(s) * (1.0f / D); float s2 = 0.f; \
            _Pragma("unroll") for (int q = 0; q < 8; ++q) { v[q] = v[q] - mean; s2 += (v[q].x * v[q].x + v[q].y * v[q].y) + (v[q].z * v[q].z + v[q].w * v[q].w); } \
            const float rstd = 1.0f / sqrtf(wave_sum_dpp(s2) * (1.0f / D) + LN_EPS); \
            _Pragma("unroll") for (int q = 0; q < 4; ++q) { const int c = 8 * lane + 512 * q; \
                const f32x4 h0 = v[2 * q] * rstd * *(const LAS f32x4*)(s_lnw + c) + *(const LAS f32x4*)(s_lnb + c), h1 = v[2 * q + 1] * rstd * *(const LAS f32x4*)(s_lnw + c + 4) + *(const LAS f32x4*)(s_lnb + c + 4); \
                v4u hw; hw.x = pk2(h0.x, h0.y); hw.y = pk2(h0.z, h0.w); hw.z = pk2(h1.x, h1.y); hw.w = pk2(h1.z, h1.w); *(GAS v4u*)(H + (size_t)(m_) * D + c) = hw; \
                v4u hl; hl.x = pk2(h0.x - bflo(hw.x), h0.y - bfhi(hw.x)); hl.y = pk2(h0.z - bflo(hw.y), h0.w - bfhi(hw.y)); hl.z = pk2(h1.x - bflo(hw.z), h1.y - bfhi(hw.z)); hl.w = pk2(h1.z - bflo(hw.w), h1.w - bfhi(hw.w)); \
                *(LAS v4u*)(s_hh + wave * HROW + c) = hw; *(LAS v4u*)(s_hl + wave * HROW + c) = hl; \
                { v2u hq; hq.x = pg8::pk4_fp8(h0.x * pg8::XS_SCALE, h0.y * pg8::XS_SCALE, h0.z * pg8::XS_SCALE, h0.w * pg8::XS_SCALE); hq.y = pg8::pk4_fp8(h1.x * pg8::XS_SCALE, h1.y * pg8::XS_SCALE, h1.z * pg8::XS_SCALE, h1.w * pg8::XS_SCALE); \
                  *(GAS v2u*)(HQ + (size_t)(m_) * D + c) = hq; } } } while (0)
#define P8_MM(a_, b_, c_) __builtin_amdgcn_mfma_f32_16x16x32_bf16(a_, b_, c_, 0, 0, 0)
#define P8_ROUTER() do { const LAS bf16* ah_ = s_hh + (lane & 7) * HROW + 256 * wave + 8 * rq; const LAS bf16* al_ = s_hl + (lane & 7) * HROW + 256 * wave + 8 * rq; \
            f32x4 a0_ = (f32x4){0.f, 0.f, 0.f, 0.f}, a1_ = a0_; \
            _Pragma("unroll") for (int st = 0; st < 8; ++st) { const bf16x8 fh_ = *(const LAS bf16x8*)(ah_ + 32 * st), fl_ = *(const LAS bf16x8*)(al_ + 32 * st); \
                a0_ = P8_MM(fh_, wh[st][0], a0_); a1_ = P8_MM(fh_, wh[st][1], a1_); a0_ = P8_MM(fh_, wl[st][0], a0_); a1_ = P8_MM(fh_, wl[st][1], a1_); a0_ = P8_MM(fl_, wh[st][0], a0_); a1_ = P8_MM(fl_, wh[st][1], a1_); } \
            if (lane < 32) { _Pragma("unroll") for (int r = 0; r < 4; ++r) { s_part[(wave * 8 + 4 * rq + r) * 32 + re] = a0_[r]; s_part[(wave * 8 + 4 * rq + r) * 32 + 16 + re] = a1_[r]; } } } while (0)
#define P8_T4STEP(CTRL) do { const float ob = dpp_mov<CTRL>(best); const int oi = __builtin_amdgcn_update_dpp(0, bi, CTRL, 0xF, 0xF, true); const bool take = (ob > best) || (ob == best && oi < bi); best = take ? ob : best; bi = take ? oi : bi; } while (0)
#define P8_TOP4(m_) do { float lg = -3.0e38f; \
            if (lane < 32) { float tp_[8]; _Pragma("unroll") for (int p = 0; p < 8; ++p) tp_[p] = s_part[(p * 8 + wave) * 32 + lane]; \
                lg = rb + (((tp_[0] + tp_[1]) + (tp_[2] + tp_[3])) + ((tp_[4] + tp_[5]) + (tp_[6] + tp_[7]))); \
                lg = (lg == lg) ? fminf(fmaxf(lg, -1.0e30f), 1.0e30f) : -1.0e30f; }        \
            int idx[4]; float val[4]; \
            _Pragma("unroll") for (int k = 0; k < 4; ++k) { float best = lg; int bi = lane; \
                P8_T4STEP(0xB1); P8_T4STEP(0x4E); P8_T4STEP(0x141); P8_T4STEP(0x140); \
                { const float ob = __shfl_xor(best, 16); const int oi = __shfl_xor(bi, 16); const bool take = (ob > best) || (ob == best && oi < bi); best = take ? ob : best; bi = take ? oi : bi; } \
                idx[k] = bi; val[k] = best; if (lane == bi) lg = -3.0e38f; } \
            if (lane == 0) { float ex[4], se = 0.f; \
                _Pragma("unroll") for (int k = 0; k < 4; ++k) { ex[k] = __expf(val[k] - val[0]); se += ex[k]; } \
                const float inv = 1.0f / se; \
                _Pragma("unroll") for (int k = 0; k < 4; ++k) { TOPI[(m_) * 4 + k] = idx[k]; GATE[(m_) * 4 + k] = ex[k] * inv; POS[(m_) * 4 + k] = __hip_atomic_fetch_add(lcnt + idx[k], 1, __ATOMIC_RELAXED, __HIP_MEMORY_SCOPE_WORKGROUP); } } } while (0)
#define P8_SYNC() do { asm volatile("s_waitcnt lgkmcnt(0)" ::: "memory"); __builtin_amdgcn_s_barrier(); asm volatile("" ::: "memory"); } while (0)
        const int mfirst = vcu * 8 + wave;
        P8_FETCH(mfirst);
        P8_LN(mfirst); P8_FETCH(mfirst + G * 8);
        P8_SYNC();
        P8_ROUTER();
        P8_SYNC();
#pragma unroll 1
        for (int it = 1; it < NIT; ++it) {
            const int m = mfirst + it * G * 8;
            P8_LN(m); P8_FETCH(it + 1 < NIT ? m + G * 8 : m);
            P8_TOP4(m - G * 8);
            P8_SYNC();
            P8_ROUTER();
            P8_SYNC();
        }
        P8_TOP4(mfirst + (NIT - 1) * G * 8);
        P8_SYNC();
#undef P8_SYNC
#undef P8_FETCH
#undef P8_LN
#undef P8_MM
#undef P8_ROUTER
#undef P8_T4STEP
#undef P8_TOP4
        if (tid < NE) CNTWG[vcu * NE + tid] = lcnt[tid];
    }
    SEAM(8);

    if (IN(9) || IN(10) || IN(11)) {
        LAS int* s_t = (LAS int*)lds; LAS int* s_p = s_t + 512;
        LAS int* PSB = (LAS int*)(lds + LDSCTL_OFF + 640);
        { const int e = tid & 31, part = tid >> 5; int tsum = 0, psum = 0;
          for (int w = part * 16; w < part * 16 + 16; ++w) { const int cv = CNTWG[w * NE + e]; tsum += cv; psum += (w < vcu) ? cv : 0; }
          s_t[part * 32 + e] = tsum; s_p[part * 32 + e] = psum; }
        __syncthreads();
        if (tid < NE) { int tsum = 0, psum = 0; for (int p = 0; p < 16; ++p) { tsum += s_t[p * 32 + tid]; psum += s_p[p * 32 + tid]; } s_t[tid] = tsum; PSB[tid] = psum; }
        __syncthreads();
        if (tid == 0) { int acc = 0; for (int e = 0; e < NE; ++e) { PS[e] = acc; acc += (s_t[e] + 255) / 256 * 256; } PS[NE] = acc; }
        __syncthreads();
        if (tid < NE) PSB[tid] += PS[tid];
        __syncthreads();
    }
    if (IN(9)) {
        const LAS int* PSB = (const LAS int*)(lds + LDSCTL_OFF + 640);
        for (int m0 = vcu * 8; m0 < M; m0 += G * 8) {
            const int m = m0 + wave;
#pragma unroll
            for (int k = 0; k < 4; ++k) {
                const int a = m * 4 + k, slot = PSB[TOPI[a]] + POS[a];
                if (lane == 0) { slot_tok[slot] = m; SLOT_OF[a] = slot; }
            }
        }
    }
    SEAM(9);

    if (IN(10)) {
        LAS unsigned* TOKS = (LAS unsigned*)(lds + RING_BYTES);
        pg8::Gemm g{(const bf16*)HQ, (const bf16*)W1T, D / 2, D / 2}; pg8::MoeOrderT<true> S; S.ps = PS; S.ntile = 16; S.npan = PS[NE] / 256; S.cprime = vcu; S.a_tstep = (size_t)256 * D; S.b_tstep = (size_t)256 * D; S.toks = TOKS;
        { pg8::Unit u_; for (int i = 0; i < 18 && S.next(i, u_); ++i) if (tid < 256) { const int tk = slot_tok[u_.pm * 256 + tid]; TOKS[i * 256 + tid] = (unsigned)((tk < 0 || tk >= M) ? 0 : tk) * (unsigned)D; }
          __syncthreads(); }
        pg8::EpiSwiglu E{ACT, b1};
        pg8::gemm_phase<pg8::EpiSwiglu, pg8::MoeOrderT<true>, true, true, true>(lds, g, S, E);
    }
    SEAM(10);

    if (IN(11)) {
        pg8::Gemm g{(const bf16*)ACT, (const bf16*)W2T, DFF / 2, DFF / 2}; pg8::MoeOrder S; S.ps = PS; S.ntile = 8; S.npan = PS[NE] / 256; S.cprime = vcu; S.a_tstep = (size_t)256 * DFF; S.b_tstep = (size_t)256 * DFF;
        pg8::EpiBias8 E{YS, b2};
        pg8::gemm_phase<pg8::EpiBias8, pg8::MoeOrder, true, true, true>(lds, g, S, E);
    }
    SEAM(11);

    if (IN(12)) {
        for (int m = gw; m < M; m += NGW) {
            int sl[4]; float gt[4];
#pragma unroll
            for (int k = 0; k < 4; ++k) { sl[k] = SLOT_OF[m * 4 + k]; gt[k] = GATE[m * 4 + k]; }
            f32x4 v[8]; float s = 0.f;
#pragma unroll
            for (int q = 0; q < 8; ++q) { const int c = 4 * lane + 256 * q; f32x4 f = (f32x4){0.f, 0.f, 0.f, 0.f};
#pragma unroll
                for (int k = 0; k < 4; ++k) { const unsigned yv = *(const GAS unsigned*)(YS + (size_t)sl[k] * D + c); const f32x2n lo2 = __builtin_amdgcn_cvt_pk_f32_fp8(yv, false), hi2 = __builtin_amdgcn_cvt_pk_f32_fp8(yv, true); f += (gt[k] * (1.0f / pg8::YS_SCALE)) * (f32x4){lo2.x, lo2.y, hi2.x, hi2.y}; }
                { const v2u hw = *(const GAS v2u*)(H + (size_t)m * D + c); v[q] = ALPHA * (f32x4){bflo(hw.x), bfhi(hw.x), bflo(hw.y), bfhi(hw.y)} + f; } s += (v[q].x + v[q].y) + (v[q].z + v[q].w); }
            const float mean = wave_sum(s) * (1.0f / D); float s2 = 0.f;
#pragma unroll
            for (int q = 0; q < 8; ++q) { v[q] = v[q] - mean; s2 += (v[q].x * v[q].x + v[q].y * v[q].y) + (v[q].z * v[q].z + v[q].w * v[q].w); }
            const float rstd = 1.0f / sqrtf(wave_sum(s2) * (1.0f / D) + LN_EPS);
#pragma unroll
            for (int q = 0; q < 8; ++q) { const int c = 4 * lane + 256 * q; *(GAS f32x4*)(out + (size_t)m * D + c) = v[q] * rstd * *(const GAS f32x4*)(ln2_w + c) + *(const GAS f32x4*)(ln2_b + c); }
        }
    }
#undef IN
#undef SEAM
}

extern "C" void kernel_launch(void* const* d_in, const int* in_sizes, int n_in, void* d_out, int out_size, void* d_ws, size_t ws_size, hipStream_t stream) {
    static int grid = 0;
    if (grid == 0) {
        if (n_in != 26 || out_size != M * D || ws_size < WS_END) { fprintf(stderr, "kernel_launch: unexpected problem (n_in %d, out %d, ws %zu < %zu)\n", n_in, out_size, ws_size, (size_t)WS_END); grid = -1; return; }
        int dev = 0, cus = 0, per_cu = 0;
        if (hipGetDevice(&dev) != hipSuccess || hipDeviceGetAttribute(&cus, hipDeviceAttributeMultiprocessorCount, dev) != hipSuccess) { grid = -1; return; }
        if (hipFuncSetAttribute((const void*)mk_fwd, hipFuncAttributeMaxDynamicSharedMemorySize, LDS_BYTES) != hipSuccess) { fprintf(stderr, "kernel_launch: hipFuncSetAttribute failed\n"); grid = -1; return; }
        if (hipOccupancyMaxActiveBlocksPerMultiprocessor(&per_cu, (const void*)mk_fwd, NTHR, LDS_BYTES) != hipSuccess || per_cu < 1) fprintf(stderr, "kernel_launch: occupancy query reports %d\n", per_cu);
        (void)hipGetLastError();
        if (cus != NWG) { fprintf(stderr, "kernel_launch: built for %d CUs, device has %d\n", NWG, cus); grid = -1; return; }
        grid = NWG;
    }
    if (grid < 0) return;
    (void)hipMemsetAsync((char*)d_ws + WS_CTL, 0, CTL_BYTES, stream);
    Args a{};
    for (int i = 0; i < 26; ++i) a.in[i] = (const float*)d_in[i];
    a.out = (float*)d_out; a.ws = (unsigned char*)d_ws; a.dup = DUP_MASK;
    if (MK_N_LAUNCHES == 1) { a.ph_lo = 0; a.ph_hi = NPHASE; hipLaunchKernelGGL(mk_fwd, dim3(grid), dim3(NTHR), LDS_BYTES, stream, a); }
    else { for (int p = 0; p < NPHASE; ++p) for (int rep = 0; rep <= ((DUP_MASK >> p) & 1); ++rep) { a.ph_lo = p; a.ph_hi = p + 1; hipLaunchKernelGGL(mk_fwd, dim3(grid), dim3(NTHR), LDS_BYTES, stream, a); } }
}
```

```cpp
#include <hip/hip_runtime.h>
#include <stdint.h>
#include <stdio.h>

#ifndef P5_SCAN_REPS
#define P5_SCAN_REPS 1
#endif
#ifndef P5_CONV_REPS
#define P5_CONV_REPS 1
#endif
#ifndef P5A_REPS
#define P5A_REPS 1
#endif
#ifndef P5B_REPS
#define P5B_REPS 1
#endif
#ifndef SCAN_CHUNKED
#define SCAN_CHUNKED 1
#endif
#ifndef DUP_MASK
#define DUP_MASK 0
#endif
#ifndef MK_N_LAUNCHES
#define MK_N_LAUNCHES 1
#endif

constexpr int D = 2048, BATCH = 4, SEQ = 4096, M = BATCH * SEQ;
constexpr int RW = 1024, PW = 1024, NH = 16;
constexpr int SHIFT_W = 3360, IN_COLS = 4384, IN_PAD = 4608;
constexpr int LK = 384;
constexpr int NE = 32, DFF = 2048;
constexpr int NASG = M * 4;
constexpr int NSLOT_MAX = NASG + NE * 256;
constexpr float LN_EPS = 1e-5f, GN_EPS = 64e-5f;
constexpr float ALPHA = 1.189207115002721f;
constexpr int NWG = 256, NWAVES = 8, NTHR = 512;
constexpr int NPHASE = 13;

#define GAS __attribute__((address_space(1)))
#define LAS __attribute__((address_space(3)))
typedef unsigned short bf16;
typedef unsigned v4u __attribute__((ext_vector_type(4)));
typedef unsigned v2u __attribute__((ext_vector_type(2)));
typedef float f32x4 __attribute__((ext_vector_type(4)));
typedef short bf16x8 __attribute__((ext_vector_type(8)));
typedef GAS unsigned gu32;
#define RLX_AGENT __ATOMIC_RELAXED, __HIP_MEMORY_SCOPE_AGENT
#define LDS_WAIT() asm volatile("s_waitcnt lgkmcnt(0)" ::: "memory")
#define VM_WAIT() asm volatile("s_waitcnt vmcnt(0)" ::: "memory")

typedef float f32x2n __attribute__((ext_vector_type(2)));
typedef __bf16 bf16x2n __attribute__((ext_vector_type(2)));
__device__ __forceinline__ unsigned cvt_pk_bf16_nat(float lo, float hi) { const f32x2n v = {lo, hi}; return __builtin_bit_cast(unsigned, __builtin_convertvector(v, bf16x2n)); }
__device__ __forceinline__ unsigned f2bf(float f) { return cvt_pk_bf16_nat(f, 0.f) & 0xffffu; }
__device__ __forceinline__ unsigned pk2(float lo, float hi) { return cvt_pk_bf16_nat(lo, hi); }
__device__ __forceinline__ float bflo(unsigned w) { return __builtin_bit_cast(float, w << 16); }
__device__ __forceinline__ float bfhi(unsigned w) { return __builtin_bit_cast(float, w & 0xffff0000u); }
__device__ __forceinline__ float ld1bf(const bf16* p) { return __builtin_bit_cast(float, (unsigned)(*(const GAS bf16*)p) << 16); }
__device__ __forceinline__ f32x4 ld4bf(const bf16* p) { const v2u w = *(const GAS v2u*)p; return (f32x4){bflo(w.x), bfhi(w.x), bflo(w.y), bfhi(w.y)}; }
__device__ __forceinline__ float wave_sum(float v) {
#pragma unroll
    for (int o = 1; o < 64; o <<= 1) v += __shfl_xor(v, o);
    return v;
}
__device__ __forceinline__ float fast_sigmoid(float x) { return __builtin_amdgcn_rcpf(1.0f + __builtin_amdgcn_exp2f(-1.4426950408889634f * x)); }
__device__ __forceinline__ float fast_decay(float wl) { const float z = -wl; const float sp = fmaxf(z, 0.f) + 0.6931471805599453f * __builtin_amdgcn_logf(1.0f + __builtin_amdgcn_exp2f(-1.4426950408889634f * fabsf(z)));
    return __builtin_amdgcn_exp2f(-1.4426950408889634f * __builtin_amdgcn_exp2f(-1.4426950408889634f * (sp + 0.5f))); }
template <int CTRL> __device__ __forceinline__ float dpp_mov(float x) { return __builtin_bit_cast(float, __builtin_amdgcn_update_dpp(0, __builtin_bit_cast(int, x), CTRL, 0xF, 0xF, true)); }
__device__ __forceinline__ float row16_sum(float x) {
    x += dpp_mov<0xB1>(x);
    x += dpp_mov<0x4E>(x);
    x += dpp_mov<0x141>(x);
    x += dpp_mov<0x140>(x);
    return x;
}

__device__ __forceinline__ float wave_sum_dpp(float x) {
    x = row16_sum(x);
    x += __builtin_bit_cast(float, __builtin_amdgcn_update_dpp(0, __builtin_bit_cast(int, x), 0x142, 0xA, 0xF, false));
    x += __builtin_bit_cast(float, __builtin_amdgcn_update_dpp(0, __builtin_bit_cast(int, x), 0x143, 0xC, 0xF, false));
    return __builtin_bit_cast(float, __builtin_amdgcn_readlane(__builtin_bit_cast(int, x), 63));
}

namespace pg8 {
typedef unsigned short bf16_t;
typedef unsigned u32x4 __attribute__((ext_vector_type(4)));
typedef int v4i_t __attribute__((ext_vector_type(4)));
typedef int v8i_t __attribute__((ext_vector_type(8)));
constexpr int BM = 256, BK = 64, HALF = 128, HTB = HALF * BK * 2, STAGE_BYTES = 8 * HTB, NXCD = 8, WGM = 8;
__host__ __device__ __forceinline__ int lds_byte(int r, int c) { const int st = (r >> 4) * 2 + (c >> 5), rr = r & 15, cc = c & 31, ob = rr * 64 + cc * 2; return st * 1024 + (ob ^ (((ob >> 9) & 1) << 5)); }
__host__ __device__ __forceinline__ void stage_rc(int b, int& R, int& C) { const int st = b / 1024, sb = b % 1024, swz = sb ^ (((sb >> 9) & 1) << 5); R = (st >> 1) * 16 + swz / 64; C = (st & 1) * 32 + (swz % 64) / 2; }
__host__ __device__ __forceinline__ int perm32(int rho) { const int n = rho >> 4, i = rho & 15; return 8 * (i >> 2) + 4 * n + (i & 3); }
__host__ __device__ __forceinline__ int perm128(int R) { return 64 * (R >> 5) + 16 * ((R >> 2) & 3) + 4 * ((R >> 4) & 1) + (R & 3); }
struct Unit { int pm, pn; };
struct Gemm { const bf16_t* A; const bf16_t* Bt; int lda, K; };
__device__ __forceinline__ unsigned cvt_pk_bf16(float lo, float hi) { unsigned r; asm volatile("v_cvt_pk_bf16_f32 %0, %1, %2" : "=v"(r) : "v"(lo), "v"(hi)); return r; }

struct GridOrder {
    static constexpr bool GATHER = false;
    int nM, nN, nwg, G, c; size_t a_tstep, a_pnstep, b_tstep;
    __device__ void init(int nM_, int nN_, int G_, int c_, size_t a_tstep_, size_t a_pnstep_, size_t b_tstep_) { nM = nM_; nN = nN_; nwg = nM * nN; G = G_; c = c_; a_tstep = a_tstep_; a_pnstep = a_pnstep_; b_tstep = b_tstep_; }
    __device__ bool next(int i, Unit& u) const {
        const long L = (long)i * G + c; if (L >= nwg) return false;
        int wgid = (int)L; { const int q = nwg / NXCD, r = nwg % NXCD, xcd = wgid % NXCD, off = wgid / NXCD; wgid = (xcd < r ? xcd * (q + 1) : r * (q + 1) + (xcd - r) * q) + off; }
        const int nig = WGM * nN, gid = wgid / nig, fm = gid * WGM, gsz = (nM - fm) < WGM ? (nM - fm) : WGM;
        u.pm = fm + ((wgid % nig) % gsz); u.pn = (wgid % nig) / gsz; return true;
    }
    __device__ __forceinline__ size_t aoff(const Unit& u) const { return (size_t)u.pm * a_tstep + (size_t)u.pn * a_pnstep; }
    __device__ __forceinline__ size_t boff(const Unit& u) const { return (size_t)u.pn * b_tstep; }
};
template <bool GATHER_> struct MoeOrderT {
    static constexpr bool GATHER = GATHER_;
    const LAS int* ps; int ntile, npan, cprime; size_t a_tstep, b_tstep; const LAS unsigned* toks;
    __device__ bool next(int i, Unit& u) const {
        const int U = i * NWG + cprime; const int p = U / ntile; if (p >= npan) return false;
        const int row = p * 256; int e = 0;
#pragma unroll 1
        for (int q = 1; q < NE; ++q) e = (row >= ps[q]) ? q : e;
        u.pm = p; u.pn = e * ntile + (U % ntile); return true;
    }
    __device__ __forceinline__ size_t aoff(const Unit& u) const { return GATHER ? (size_t)0 : (size_t)u.pm * a_tstep; }
    __device__ __forceinline__ size_t boff(const Unit& u) const { return (size_t)u.pn * b_tstep; }
};
typedef MoeOrderT<false> MoeOrder;

template <class Epi, class Sched, bool ALIGN_EPI, bool SP2, bool FP8 = false>
__device__ __forceinline__ void gemm_phase(LAS unsigned char* lds, const Gemm g, const Sched& S, const Epi& E) {
    int tid_ = threadIdx.x; asm volatile("" : "+v"(tid_));
    const int tid = tid_, wid = __builtin_amdgcn_readfirstlane(tid >> 6), lane = tid & 63, wr = wid >> 2, wc = wid & 3, fr = lane & 15, fq = lane >> 4;
    const int K = g.K, nt = K / BK;
    constexpr bool GATHER = Sched::GATHER; static_assert(!GATHER || SP2, "gathered A rows: SP2 loop only");
    unsigned voffA[2], voffB[2]; int rowA[2]; unsigned colA[2];
#pragma unroll
    for (int i = 0; i < 2; ++i) { int R, C; stage_rc(tid * 16 + i * 8192, R, C); const int Rb = Epi::PERM == 2 ? perm128(R) : (Epi::PERM ? ((R & ~31) + perm32(R & 31)) : R);
        voffA[i] = (unsigned)(R * g.lda + C) * 2u; voffB[i] = (unsigned)(Rb * K + C) * 2u; rowA[i] = R; colA[i] = (unsigned)C * 2u; }
    unsigned cG0[2] = {0u, 0u}, cG1[2] = {0u, 0u}, nG0[2] = {0u, 0u}, nG1[2] = {0u, 0u};
#define PG8_GLOAD(dst0, dst1, lu) do { if constexpr (GATHER) { _Pragma("unroll") for (int _i = 0; _i < 2; ++_i) { dst0[_i] = S.toks[(lu) * 256 + rowA[_i]] + colA[_i]; dst1[_i] = S.toks[(lu) * 256 + 128 + rowA[_i]] + colA[_i]; } } } while (0)
#define PG8_STAGE_A(bufoff, gbase, half, usenext) do { if constexpr (GATHER) { if (usenext) { if (half) PG8_STAGE(bufoff, gbase, nG1); else PG8_STAGE(bufoff, gbase, nG0); } else { if (half) PG8_STAGE(bufoff, gbase, cG1); else PG8_STAGE(bufoff, gbase, cG0); } } \
        else PG8_STAGE(bufoff, (gbase) + ((half) ? hstepA : (size_t)0), voffA); } while (0)
    const size_t kstep = (size_t)(BK * 2);
    const size_t hstepA = (size_t)HALF * g.lda * 2, hstepB = (size_t)(Epi::PERM == 2 ? 8 : HALF) * K * 2;
    const unsigned ldsw = (unsigned)wid * 1024u;
    const int aoff = lds_byte(wr * 64 + fr, fq * 8), boff = lds_byte(wc * 32 + fr, fq * 8);
#define PG8_SA(b, h) (((b) * 2 + (h)) * HTB)
#define PG8_SB(b, h) ((4 + (b) * 2 + (h)) * HTB)
#define PG8_STAGE(bufoff, gbase, voff) do { _Pragma("unroll") for (int _i = 0; _i < 2; ++_i) \
        __builtin_amdgcn_global_load_lds((const unsigned*)((const char*)(gbase) + (voff)[_i]), (LAS unsigned*)(lds + (bufoff) + ldsw + _i * 8192), 16, 0, 0); } while (0)
#define PG8_LDA(dst, b, h) do { _Pragma("unroll") for (int m = 0; m < 4; ++m) { if constexpr (FP8) { const v4i_t l_ = *(const LAS v4i_t*)(lds + PG8_SA(b, h) + aoff + m * 2048), h_ = *(const LAS v4i_t*)(lds + PG8_SA(b, h) + aoff + m * 2048 + 1024); dst##8[m] = __builtin_shufflevector(l_, h_, 0, 1, 2, 3, 4, 5, 6, 7); } \
        else { _Pragma("unroll") for (int k = 0; k < 2; ++k) dst[m][k] = *(const LAS bf16x8*)(lds + PG8_SA(b, h) + aoff + m * 2048 + k * 1024); } } } while (0)
#define PG8_LDB(dst, b, h) do { _Pragma("unroll") for (int n = 0; n < 2; ++n) { if constexpr (FP8) { const v4i_t l_ = *(const LAS v4i_t*)(lds + PG8_SB(b, h) + boff + n * 2048), h_ = *(const LAS v4i_t*)(lds + PG8_SB(b, h) + boff + n * 2048 + 1024); dst##8[n] = __builtin_shufflevector(l_, h_, 0, 1, 2, 3, 4, 5, 6, 7); } \
        else { _Pragma("unroll") for (int k = 0; k < 2; ++k) dst[n][k] = *(const LAS bf16x8*)(lds + PG8_SB(b, h) + boff + n * 2048 + k * 1024); } } } while (0)
#define PG8_MMA(ai, bj, At, Bt) do { __builtin_amdgcn_s_setprio(1); _Pragma("unroll") for (int m = 0; m < 4; ++m) _Pragma("unroll") for (int n = 0; n < 2; ++n) { \
        if constexpr (FP8) asm volatile("v_mfma_scale_f32_16x16x128_f8f6f4 %0, %1, %2, %0, %3, %3 op_sel_hi:[0,0,0]" : "+v"(acc[ai][bj][m][n]) : "v"(Bt##8[n]), "v"(At##8[m]), "v"(scale1_)); \
        else { _Pragma("unroll") for (int k = 0; k < 2; ++k) acc[ai][bj][m][n] = __builtin_amdgcn_mfma_f32_16x16x32_bf16(Bt[n][k], At[m][k], acc[ai][bj][m][n], 0, 0, 0); } } \
        __builtin_amdgcn_s_setprio(0); } while (0)
#define PG8_WAIT_V(n) asm volatile("s_waitcnt vmcnt(" #n ")" ::: "memory")
#define PG8_WAIT_L(n) asm volatile("s_waitcnt lgkmcnt(" #n ")" ::: "memory")
#define PG8_BAR __builtin_amdgcn_s_barrier()
#define PG8_SCHED __builtin_amdgcn_sched_barrier(0)
    Unit cur, nxt; int ui = 0;
    if (!S.next(0, cur)) return;
    f32x4 acc[2][2][4][2];
#pragma unroll
    for (int a = 0; a < 2; ++a)
#pragma unroll
        for (int b = 0; b < 2; ++b)
#pragma unroll
            for (int m = 0; m < 4; ++m)
#pragma unroll
                for (int n = 0; n < 2; ++n) acc[a][b][m][n] = (f32x4){0.f, 0.f, 0.f, 0.f};
    int scale1_ = 0x7F7F7F7F; asm volatile("" : "+v"(scale1_));
    bf16x8 At[4][2], B0[2][2], B1[2][2];
    v8i_t At8[4], B08[2], B18[2];
    const char* cA = (const char*)g.A + S.aoff(cur); const char* cB = (const char*)g.Bt + S.boff(cur);
    if constexpr (SP2) {
        PG8_GLOAD(cG0, cG1, 0);
        PG8_STAGE(PG8_SB(0, 0), cB, voffB); PG8_STAGE(PG8_SB(0, 1), cB + hstepB, voffB); PG8_STAGE_A(PG8_SA(0, 0), cA, 0, false); PG8_STAGE_A(PG8_SA(0, 1), cA, 1, false);
        if (wr == 1) PG8_BAR;
        PG8_WAIT_V(2); PG8_BAR;
        PG8_STAGE(PG8_SB(1, 0), cB + kstep, voffB); PG8_STAGE_A(PG8_SA(1, 0), cA + kstep, 0, false); PG8_STAGE(PG8_SB(1, 1), cB + hstepB + kstep, voffB);
        PG8_WAIT_V(6); PG8_BAR;
    } else {
        PG8_STAGE(PG8_SB(0, 0), cB, voffB); PG8_STAGE(PG8_SA(0, 0), cA, voffA); PG8_STAGE(PG8_SB(0, 1), cB + hstepB, voffB); PG8_STAGE(PG8_SA(0, 1), cA + hstepA, voffA);
        if (wr == 1) PG8_BAR;
        PG8_WAIT_V(4); PG8_BAR;
        PG8_STAGE(PG8_SB(1, 0), cB + kstep, voffB); PG8_STAGE(PG8_SA(1, 0), cA + kstep, voffA); PG8_STAGE(PG8_SB(1, 1), cB + hstepB + kstep, voffB);
        PG8_WAIT_V(6); PG8_BAR;
    }
    for (;;) {
        const bool has_next = S.next(ui + 1, nxt);
        const char* nA = has_next ? (const char*)g.A + S.aoff(nxt) : cA; const char* nB = has_next ? (const char*)g.Bt + S.boff(nxt) : cB;
        if constexpr (GATHER) { if (has_next) PG8_GLOAD(nG0, nG1, ui + 1); else { nG0[0] = cG0[0]; nG0[1] = cG0[1]; nG1[0] = cG1[0]; nG1[1] = cG1[1]; } }
#pragma unroll 1
        for (int t = 0; t < nt; t += 2) {
            const bool last = (t == nt - 2);
            const char* a1 = cA + (size_t)(t + 1) * kstep;
            const char* a2 = last ? nA : cA + (size_t)(t + 2) * kstep; const char* b2 = last ? nB : cB + (size_t)(t + 2) * kstep;
            const char* a3 = a2 + kstep; const char* b3 = b2 + kstep;
            if constexpr (SP2) {
            PG8_LDB(B0, 0, 0); PG8_LDB(B1, 0, 1); PG8_SCHED; PG8_LDA(At, 0, 0); PG8_STAGE_A(PG8_SA(1, 1), a1, 1, false);
            PG8_WAIT_V(8); PG8_WAIT_L(0); PG8_BAR; PG8_MMA(0, 0, At, B0); PG8_MMA(0, 1, At, B1); PG8_BAR; PG8_SCHED;
            PG8_LDA(At, 0, 1); PG8_STAGE(PG8_SB(0, 0), b2, voffB); PG8_STAGE(PG8_SB(0, 1), b2 + hstepB, voffB); PG8_STAGE_A(PG8_SA(0, 0), a2, 0, last);
            PG8_WAIT_V(8); PG8_WAIT_L(0); PG8_BAR; PG8_MMA(1, 0, At, B0); PG8_MMA(1, 1, At, B1); PG8_BAR; PG8_SCHED;
            PG8_LDB(B0, 1, 0); PG8_LDB(B1, 1, 1); PG8_SCHED; PG8_LDA(At, 1, 0); PG8_STAGE_A(PG8_SA(0, 1), a2, 1, last);
            PG8_WAIT_V(8); PG8_WAIT_L(0); PG8_BAR; PG8_MMA(0, 0, At, B0); PG8_MMA(0, 1, At, B1); PG8_BAR; PG8_SCHED;
            PG8_LDA(At, 1, 1); PG8_STAGE(PG8_SB(1, 0), b3, voffB); PG8_STAGE(PG8_SB(1, 1), b3 + hstepB, voffB); PG8_STAGE_A(PG8_SA(1, 0), a3, 0, last);
            PG8_WAIT_V(8); PG8_WAIT_L(0); PG8_BAR; PG8_MMA(1, 0, At, B0); PG8_MMA(1, 1, At, B1); PG8_BAR; PG8_SCHED;
            } else {
            PG8_LDB(B0, 0, 0); PG8_SCHED; PG8_LDA(At, 0, 0); PG8_STAGE(PG8_SA(1, 1), a1 + hstepA, voffA);
            PG8_WAIT_L(8); PG8_BAR; PG8_WAIT_L(0); PG8_MMA(0, 0, At, B0); PG8_BAR; PG8_SCHED;
            PG8_LDB(B1, 0, 1); PG8_STAGE(PG8_SB(0, 0), b2, voffB);
            PG8_BAR; PG8_WAIT_L(0); PG8_MMA(0, 1, At, B1); PG8_BAR;
            PG8_LDA(At, 0, 1); PG8_STAGE(PG8_SA(0, 0), a2, voffA);
            PG8_BAR; PG8_WAIT_L(0); PG8_MMA(1, 0, At, B0); PG8_BAR; PG8_SCHED;
            PG8_STAGE(PG8_SB(0, 1), b2 + hstepB, voffB);
            PG8_WAIT_V(6); PG8_BAR; PG8_MMA(1, 1, At, B1); PG8_BAR;
            PG8_LDB(B0, 1, 0); PG8_SCHED; PG8_LDA(At, 1, 0); PG8_STAGE(PG8_SA(0, 1), a2 + hstepA, voffA);
            PG8_WAIT_L(8); PG8_BAR; PG8_WAIT_L(0); PG8_MMA(0, 0, At, B0); PG8_BAR; PG8_SCHED;
            PG8_LDB(B1, 1, 1); PG8_STAGE(PG8_SB(1, 0), b3, voffB);
            PG8_BAR; PG8_WAIT_L(0); PG8_MMA(0, 1, At, B1); PG8_BAR;
            PG8_LDA(At, 1, 1); PG8_STAGE(PG8_SA(1, 0), a3, voffA);
            PG8_BAR; PG8_WAIT_L(0); PG8_MMA(1, 0, At, B0); PG8_BAR; PG8_SCHED;
            PG8_STAGE(PG8_SB(1, 1), b3 + hstepB, voffB);
            PG8_WAIT_V(6); PG8_BAR; PG8_MMA(1, 1, At, B1); PG8_BAR;
            }
        }
        if constexpr (ALIGN_EPI) { if (wr == 0) PG8_BAR; }
        if constexpr (FP8) asm volatile("s_nop 15\n\ts_nop 15" ::: "memory");
        E(acc, cur, wr, wc, fr, fq);
        if (!has_next) break;
#pragma unroll
        for (int a = 0; a < 2; ++a)
#pragma unroll
            for (int b = 0; b < 2; ++b)
#pragma unroll
                for (int m = 0; m < 4; ++m)
#pragma unroll
                    for (int n = 0; n < 2; ++n) acc[a][b][m][n] = (f32x4){0.f, 0.f, 0.f, 0.f};
        cur = nxt; cA = nA; cB = nB; ++ui;
        if constexpr (GATHER) { cG0[0] = nG0[0]; cG0[1] = nG0[1]; cG1[0] = nG1[0]; cG1[1] = nG1[1]; }
        if constexpr (ALIGN_EPI) { if (wr == 1) PG8_BAR; }
    }
    PG8_WAIT_V(0);
    if constexpr (!ALIGN_EPI) { if (wr == 0) PG8_BAR; }
    PG8_BAR;
#undef PG8_SA
#undef PG8_SB
#undef PG8_STAGE
#undef PG8_STAGE_A
#undef PG8_GLOAD
#undef PG8_LDA
#undef PG8_LDB
#undef PG8_MMA
#undef PG8_WAIT_V
#undef PG8_WAIT_L
#undef PG8_BAR
#undef PG8_SCHED
}

struct EpiF32 {
    static constexpr int PERM = 0;
    float* C; int ldc;
    __device__ __forceinline__ void operator()(const f32x4 (&acc)[2][2][4][2], const Unit& u, int wr, int wc, int fr, int fq) const {
        const int row0 = u.pm * BM + wr * 64 + fr, col0 = u.pn * BM + wc * 32 + 4 * fq;
#pragma unroll
        for (int ai = 0; ai < 2; ++ai)
#pragma unroll
            for (int m = 0; m < 4; ++m) { float* rowp = C + (size_t)(row0 + ai * HALF + m * 16) * ldc + col0;
#pragma unroll
                for (int bj = 0; bj < 2; ++bj)
#pragma unroll
                    for (int n = 0; n < 2; ++n) *(f32x4*)(rowp + bj * HALF + n * 16) = acc[ai][bj][m][n]; }
    }
};
struct EpiBf16Plain {
    static constexpr int PERM = 2;
    bf16_t* O; int ldc;
    __device__ __forceinline__ void operator()(const f32x4 (&acc)[2][2][4][2], const Unit& u, int wr, int wc, int fr, int fq) const {
        const int row0 = u.pm * BM + wr * 64 + fr, col0 = u.pn * BM + wc * 64 + 16 * fq;
#pragma unroll
        for (int ai = 0; ai < 2; ++ai)
#pragma unroll
            for (int m = 0; m < 4; ++m) { bf16_t* rowp = O + (size_t)(row0 + ai * HALF + m * 16) * ldc + col0;
#pragma unroll
                for (int bj = 0; bj < 2; ++bj) { const f32x4 v0 = acc[ai][bj][m][0], v1 = acc[ai][bj][m][1];
                    u32x4 w; w.x = cvt_pk_bf16(v0[0], v0[1]); w.y = cvt_pk_bf16(v0[2], v0[3]); w.z = cvt_pk_bf16(v1[0], v1[1]); w.w = cvt_pk_bf16(v1[2], v1[3]);
                    *(u32x4*)(rowp + bj * 8) = w; } }
    }
};
struct EpiPool {
    static constexpr int PERM = 2;
    bf16_t* O; const float* scale;
    __device__ __forceinline__ void operator()(const f32x4 (&acc)[2][2][4][2], const Unit& u, int wr, int wc, int fr, int fq) const {
        const int row0 = u.pm * BM + wr * 64 + fr; int col0 = u.pn * BM + wc * 64 + 16 * fq;
        asm volatile("" : "+v"(col0));
        f32x4 sv[2][2];
#pragma unroll
        for (int bj = 0; bj < 2; ++bj)
#pragma unroll
            for (int n = 0; n < 2; ++n) sv[bj][n] = *(const f32x4*)(scale + col0 + 8 * bj + 4 * n);
#pragma unroll
        for (int ai = 0; ai < 2; ++ai)
#pragma unroll
            for (int m = 0; m < 4; ++m) { bf16_t* rowp = O + (size_t)(row0 + ai * HALF + m * 16) * 2048 + 1024 + col0;
#pragma unroll
                for (int bj = 0; bj < 2; ++bj) { const f32x4 v0 = acc[ai][bj][m][0] * sv[bj][0], v1 = acc[ai][bj][m][1] * sv[bj][1];
                    u32x4 w; w.x = cvt_pk_bf16(v0[0], v0[1]); w.y = cvt_pk_bf16(v0[2], v0[3]); w.z = cvt_pk_bf16(v1[0], v1[1]); w.w = cvt_pk_bf16(v1[2], v1[3]);
                    *(u32x4*)(rowp + bj * 8) = w; } }
    }
};
constexpr float XS_SCALE = 8.0f, W_SCALE = 256.0f, ACT_SCALE = 8.0f, DESCALE = 1.0f / 2048.0f;
__device__ __forceinline__ unsigned pk4_fp8(float a, float b, float c, float d) {
    a = __builtin_amdgcn_fmed3f(a, -448.f, 448.f); b = __builtin_amdgcn_fmed3f(b, -448.f, 448.f); c = __builtin_amdgcn_fmed3f(c, -448.f, 448.f); d = __builtin_amdgcn_fmed3f(d, -448.f, 448.f);
    int w = 0; w = __builtin_amdgcn_cvt_pk_fp8_f32(a, b, w, false); w = __builtin_amdgcn_cvt_pk_fp8_f32(c, d, w, true); return (unsigned)w;
}
struct EpiSwiglu {
    static constexpr int PERM = 2;
    unsigned char* O; const float* b1;
    __device__ __forceinline__ void operator()(const f32x4 (&acc)[2][2][4][2], const Unit& u, int wr, int wc, int fr, int fq) const {
        const int e = u.pn >> 4, nt = u.pn & 15;
        const int row0 = u.pm * BM + wr * 64 + fr; int col0 = nt * BM + wc * 64 + 16 * fq;
        asm volatile("" : "+v"(col0));
        const float* bp = b1 + (size_t)e * 4096 + col0;
        f32x4 bv[2][2];
#pragma unroll
        for (int bj = 0; bj < 2; ++bj)
#pragma unroll
            for (int n = 0; n < 2; ++n) bv[bj][n] = *(const f32x4*)(bp + 8 * bj + 4 * n);
#pragma unroll
        for (int ai = 0; ai < 2; ++ai)
#pragma unroll
            for (int m = 0; m < 4; ++m) { unsigned char* rowp = O + (size_t)(row0 + ai * HALF + m * 16) * 2048 + (col0 >> 1);
                v2u wv;
#pragma unroll
                for (int bj = 0; bj < 2; ++bj) { const f32x4 v0 = acc[ai][bj][m][0] * DESCALE + bv[bj][0], v1 = acc[ai][bj][m][1] * DESCALE + bv[bj][1];
                    const f32x2n g01 = {fminf(v0[0], 7.0f), fminf(v0[2], 7.0f)}, g23 = {fminf(v1[0], 7.0f), fminf(v1[2], 7.0f)};
                    const f32x2n l01 = {__builtin_amdgcn_fmed3f(v0[1], -7.0f, 7.0f), __builtin_amdgcn_fmed3f(v0[3], -7.0f, 7.0f)}, l23 = {__builtin_amdgcn_fmed3f(v1[1], -7.0f, 7.0f), __builtin_amdgcn_fmed3f(v1[3], -7.0f, 7.0f)};
                    const f32x2n t01 = g01 * (-1.702f * 1.4426950408889634f), t23 = g23 * (-1.702f * 1.4426950408889634f);
                    const f32x2n d01 = (f32x2n){__builtin_amdgcn_exp2f(t01.x), __builtin_amdgcn_exp2f(t01.y)} + 1.0f, d23 = (f32x2n){__builtin_amdgcn_exp2f(t23.x), __builtin_amdgcn_exp2f(t23.y)} + 1.0f;
                    const f32x2n a01 = (g01 * (f32x2n){__builtin_amdgcn_rcpf(d01.x), __builtin_amdgcn_rcpf(d01.y)}) * (l01 * ACT_SCALE + ACT_SCALE), a23 = (g23 * (f32x2n){__builtin_amdgcn_rcpf(d23.x), __builtin_amdgcn_rcpf(d23.y)}) * (l23 * ACT_SCALE + ACT_SCALE);
                    int w = 0; w = __builtin_amdgcn_cvt_pk_fp8_f32(a01.x, a01.y, w, false); w = __builtin_amdgcn_cvt_pk_fp8_f32(a23.x, a23.y, w, true);
                    if (bj == 0) wv.x = (unsigned)w; else wv.y = (unsigned)w; }
                *(v2u*)rowp = wv; }
    }
};
constexpr float YS_SCALE = 16.0f;
struct EpiBias8 {
    static constexpr int PERM = 2;
    unsigned char* O; const float* b2;
    __device__ __forceinline__ void operator()(const f32x4 (&acc)[2][2][4][2], const Unit& u, int wr, int wc, int fr, int fq) const {
        const int e = u.pn >> 3, nt = u.pn & 7;
        const int row0 = u.pm * BM + wr * 64 + fr; int col0 = nt * BM + wc * 64 + 16 * fq;
        asm volatile("" : "+v"(col0));
        const float* bp = b2 + (size_t)e * 2048 + col0;
        f32x4 bv[2][2];
#pragma unroll
        for (int bj = 0; bj < 2; ++bj)
#pragma unroll
            for (int n = 0; n < 2; ++n) bv[bj][n] = *(const f32x4*)(bp + 8 * bj + 4 * n) * YS_SCALE;
#pragma unroll
        for (int ai = 0; ai < 2; ++ai)
#pragma unroll
            for (int m = 0; m < 4; ++m) { unsigned char* rowp = O + (size_t)(row0 + ai * HALF + m * 16) * 2048 + col0;
                const f32x4 v00 = acc[ai][0][m][0] * (DESCALE * YS_SCALE) + bv[0][0], v01 = acc[ai][0][m][1] * (DESCALE * YS_SCALE) + bv[0][1];
                const f32x4 v10 = acc[ai][1][m][0] * (DESCALE * YS_SCALE) + bv[1][0], v11 = acc[ai][1][m][1] * (DESCALE * YS_SCALE) + bv[1][1];
                u32x4 w; w.x = pk4_fp8(v00[0], v00[1], v00[2], v00[3]); w.y = pk4_fp8(v01[0], v01[1], v01[2], v01[3]); w.z = pk4_fp8(v10[0], v10[1], v10[2], v10[3]); w.w = pk4_fp8(v11[0], v11[1], v11[2], v11[3]);
                *(u32x4*)rowp = w; }
    }
};
}

#define XB_TMO      128
#define XB_XCNT(j)  (256  + 64 * (j))
#define XB_XSUB(j)  (1280 + 64 * (j))
#define XB_XGEN(j)  (2304 + 64 * (j))
#define XB_TOP      3328
#define XB_TOPGEN   3392
#define XCD_BAR_WORDS 3456
#define XB_SPIN_CAP (1u << 22)
__device__ __forceinline__ unsigned xb_ld(unsigned* p)              { return __hip_atomic_load(p, __ATOMIC_RELAXED, __HIP_MEMORY_SCOPE_AGENT); }
__device__ __forceinline__ unsigned xb_add(unsigned* p, unsigned v) { return __hip_atomic_fetch_add(p, v, __ATOMIC_RELAXED, __HIP_MEMORY_SCOPE_AGENT); }
__device__ __forceinline__ unsigned xb_xcc_id() { return (unsigned)__builtin_amdgcn_s_getreg((3 << 11) | 20) & 0xFu; }
#define XB_SPIN(cond, bar) do { unsigned _sp = 0; while (cond) { __builtin_amdgcn_s_sleep(1); \
    if ((++_sp & 255u) == 0u) { if (xb_ld(&(bar)[XB_TMO])) break; if (_sp > XB_SPIN_CAP) { atomicAdd(&(bar)[XB_TMO], 1u); break; } } } } while (0)
struct XcdBarrier { unsigned* bar; unsigned x; volatile LAS unsigned* st; };
__device__ __forceinline__ XcdBarrier xcd_barrier_post(unsigned* bar, volatile LAS unsigned* st) {
    XcdBarrier b; b.bar = bar; b.x = xb_xcc_id(); b.st = st;
    if (threadIdx.x == 0) (void)xb_add(&bar[XB_XCNT(b.x)], 1u);
    return b;
}
__device__ __forceinline__ void xcd_barrier_complete(unsigned* bar, unsigned x, unsigned& nloc, unsigned& nx) {
    const unsigned G = gridDim.x * gridDim.y * gridDim.z;
    unsigned sum, cnt, mine, sp = 0u;
    for (;;) {
        sum = 0u; cnt = 0u; mine = 0u;
#pragma unroll
        for (unsigned j = 0; j < 16; ++j) { const unsigned c = xb_ld(&bar[XB_XCNT(j)]); sum += c; cnt += (c > 0u) ? 1u : 0u; mine = (j == x) ? c : mine; }
        if (sum == G) break;
        __builtin_amdgcn_s_sleep(1);
        if ((++sp & 255u) == 0u) { if (xb_ld(&bar[XB_TMO])) break; if (sp > XB_SPIN_CAP) { atomicAdd(&bar[XB_TMO], 1u); break; } }
    }
    nloc = mine > 0u ? mine : 1u; nx = cnt > 0u ? cnt : 1u;
}
__device__ __forceinline__ void xcd_barrier(const XcdBarrier& b) {
    asm volatile("s_waitcnt vmcnt(0)" ::: "memory");
    __syncthreads();
    if (threadIdx.x == 0) {
        unsigned* bar = b.bar;
        __builtin_amdgcn_s_waitcnt(0);
        unsigned nloc = b.st[0], nx = b.st[1];
        if (nloc == 0u) { xcd_barrier_complete(bar, b.x, nloc, nx); b.st[0] = nloc; b.st[1] = nx; }
        const unsigned old = xb_add(&bar[XB_XSUB(b.x)], 1u);
        const unsigned gen = old / nloc;
        if (old + 1u == (gen + 1u) * nloc) {
            __builtin_amdgcn_fence(__ATOMIC_RELEASE, "agent");
            asm volatile("s_waitcnt vmcnt(0)" ::: "memory");
            const unsigned og = xb_add(&bar[XB_TOP], 1u);
            const unsigned tg = og / nx;
            if (og + 1u == (tg + 1u) * nx) xb_add(&bar[XB_TOPGEN], 1u);
            else XB_SPIN(xb_ld(&bar[XB_TOPGEN]) == tg, bar);
            __builtin_amdgcn_fence(__ATOMIC_ACQUIRE, "agent");
            xb_add(&bar[XB_XGEN(b.x)], 1u);
            asm volatile("s_waitcnt vmcnt(0)" ::: "memory");
        } else {
            XB_SPIN(xb_ld(&bar[XB_XGEN(b.x)]) == gen, bar);
            __builtin_amdgcn_fence(__ATOMIC_ACQUIRE, "agent");
            asm volatile("s_waitcnt vmcnt(0)" ::: "memory");
        }
    }
    __syncthreads();
}

constexpr size_t al256(size_t x) { return (x + 255) & ~(size_t)255; }
constexpr size_t WS_CTL = 0, CTL_BYTES = 1u << 20;
constexpr int CW_BAR = 4096;
constexpr int CW_CNT = 16384;
constexpr size_t WS_SLOTTOK = WS_CTL + CTL_BYTES;
constexpr size_t WS_TOPI = WS_SLOTTOK + al256((size_t)NSLOT_MAX * 4);
constexpr size_t WS_GATE = WS_TOPI + (size_t)NASG * 4;
constexpr size_t WS_POS = WS_GATE + (size_t)NASG * 4;
constexpr size_t WS_SLOTOF = WS_POS + (size_t)NASG * 4;
constexpr size_t WS_BONUS = WS_SLOTOF + (size_t)NASG * 4;
constexpr size_t WS_XB = WS_BONUS + (size_t)M * 16 * 4;
constexpr size_t WS_WINT = WS_XB + (size_t)M * D * 2;
constexpr size_t WS_WOUTT = WS_WINT + (size_t)IN_PAD * D * 2;
constexpr size_t WS_LORAT = WS_WOUTT + (size_t)D * D * 2;
constexpr size_t WS_WPOOLT = WS_LORAT + (size_t)3072 * LK * 2;
constexpr size_t WS_PROJ = WS_WPOOLT + (size_t)1024 * 256 * 2;
constexpr size_t WS_LIN = WS_PROJ + (size_t)M * IN_PAD * 2;
constexpr size_t WS_POOLED = WS_LIN + (size_t)M * LK * 2;
constexpr size_t WS_WDEC = WS_POOLED + (size_t)M * 1024 * 2;
constexpr size_t SZ_F1K = (size_t)M * 1024 * 4;
constexpr size_t WS_LOUT = WS_WDEC + SZ_F1K  , WS_R = WS_LOUT + 3 * SZ_F1K, WS_K2 = WS_R + SZ_F1K, WS_V = WS_K2 + SZ_F1K, WS_KK = WS_V + SZ_F1K, WS_BB = WS_KK + SZ_F1K, WS_Y = WS_BB + SZ_F1K;
constexpr size_t WS_MIXIN = WS_Y + SZ_F1K;
constexpr size_t WS_MIX = WS_MIXIN + (size_t)M * D * 2;
constexpr size_t WS_H = WS_MIX + (size_t)M * D * 4;
constexpr size_t WS_HB = WS_H + (size_t)M * D * 4;
constexpr size_t WS_XS = WS_HB + (size_t)M * D;
constexpr size_t WS_W1T = WS_XS + (size_t)NSLOT_MAX * D;
constexpr size_t WS_W2T = WS_W1T + (size_t)NE * 4096 * D;
constexpr size_t WS_ACT = WS_W2T + (size_t)NE * 2048 * DFF;
constexpr size_t WS_YS = WS_ACT + (size_t)NSLOT_MAX * DFF;
constexpr size_t WS_END = WS_YS + (size_t)NSLOT_MAX * D * 2;

constexpr int RING_BYTES = 131072;
constexpr int LDSCTL_OFF = 159744;
constexpr int LDS_BYTES = 163840;

struct Args { const float* in[26]; float* out; unsigned char* ws; int ph_lo, ph_hi, dup, pad; };

template <bool KFAST = false> __device__ __forceinline__ void tr_load(const float* W, int N, int item, int lane, f32x4 (&v)[16]) {
    const int nblk = N / 64, kb = KFAST ? (item & 31) : item / nblk, nb = KFAST ? (item >> 5) : item % nblk, k0 = 64 * kb, n0 = 64 * nb;
    const int r = lane >> 4, c4 = (lane & 15) * 4;
#pragma unroll
    for (int i = 0; i < 16; ++i) v[i] = *(const GAS f32x4*)(W + (size_t)(k0 + 4 * i + r) * N + n0 + c4);
}
__device__ __forceinline__ void tr_store(const f32x4 (&v)[16], int K, int N, bf16* WT, size_t row_off, LAS float* scr, int item, int lane) {
    const int nblk = N / 64, kb = item / nblk, nb = item % nblk, k0 = 64 * kb, n0 = 64 * nb;
    const int r = lane >> 4, c4 = (lane & 15) * 4;
#pragma unroll
    for (int i = 0; i < 16; ++i) { LAS float* d = scr + (4 * i + r) * 65 + c4; d[0] = v[i].x; d[1] = v[i].y; d[2] = v[i].z; d[3] = v[i].w; }
    LDS_WAIT(); asm volatile("" ::: "memory");
    const int c = lane & 7;
#pragma unroll
    for (int p = 0; p < 8; ++p) { const int n = (lane >> 3) + 8 * p; const LAS float* q = scr + (8 * c) * 65 + n;
        v4u o; o.x = pk2(q[0 * 65], q[1 * 65]); o.y = pk2(q[2 * 65], q[3 * 65]); o.z = pk2(q[4 * 65], q[5 * 65]); o.w = pk2(q[6 * 65], q[7 * 65]);
        *(GAS v4u*)(WT + (row_off + n0 + n) * (size_t)K + k0 + 8 * c) = o; }
    LDS_WAIT(); asm volatile("" ::: "memory");
}
__device__ __forceinline__ unsigned pk4_fp8_nc(float a, float b, float c, float d) { int w = 0; w = __builtin_amdgcn_cvt_pk_fp8_f32(a, b, w, false); w = __builtin_amdgcn_cvt_pk_fp8_f32(c, d, w, true); return (unsigned)w; }
__device__ __forceinline__ void tr_store_fp8(const f32x4 (&v)[16], int K, int N, unsigned char* WT, size_t row_off, LAS float* scr, int item, int lane, float scale) {
    const int nblk = N / 64, kb = item / nblk, nb = item % nblk, k0 = 64 * kb, n0 = 64 * nb;
    const int r = lane >> 4, c4 = (lane & 15) * 4;
#pragma unroll
    for (int i = 0; i < 16; ++i) { const int k = 4 * i + r; *(LAS f32x4*)(scr + k * 64 + (c4 ^ (8 * (i >> 2)))) = v[i] * scale; }
    LDS_WAIT(); asm volatile("" ::: "memory");
    const int c = lane & 3;
#pragma unroll
    for (int p = 0; p < 4; ++p) { const int n = (lane >> 2) + 16 * p; const LAS float* q = scr + (16 * c) * 64 + (n ^ (8 * c));
        float f[16];
#pragma unroll
        for (int jj = 0; jj < 16; ++jj) f[jj] = q[jj * 64];
        v4u o; o.x = pk4_fp8_nc(f[0], f[1], f[2], f[3]); o.y = pk4_fp8_nc(f[4], f[5], f[6], f[7]); o.z = pk4_fp8_nc(f[8], f[9], f[10], f[11]); o.w = pk4_fp8_nc(f[12], f[13], f[14], f[15]);
        *(GAS v4u*)(WT + (row_off + n0 + n) * (size_t)K + k0 + 16 * c) = o; }
    LDS_WAIT(); asm volatile("" ::: "memory");
}
constexpr int NHB = 4;
__device__ __forceinline__ void tr_load2(const float* W, int N, int fl, int hh, int lane, f32x4 (&v)[16]) {
    const int nblk = N / 64, kb = fl / nblk, nb = fl % nblk, k0 = 64 * NHB * kb + 64 * hh, n0 = 64 * nb;
    const int g = lane >> 4, c4 = (lane & 15) * 4;
#pragma unroll
    for (int i = 0; i < 16; ++i) v[i] = *(const GAS f32x4*)(W + (size_t)(k0 + 16 * (i >> 2) + 4 * g + (i & 3)) * N + n0 + c4);
}
__device__ __forceinline__ void tr_half(const f32x4 (&v)[16], int hh, LAS unsigned* img, int lane, float scale) {
    const int g = lane >> 4, m = lane & 15;
#pragma unroll
    for (int j = 0; j < 4; ++j) { const f32x4 a = v[4 * j] * scale, b = v[4 * j + 1] * scale, c = v[4 * j + 2] * scale, d = v[4 * j + 3] * scale;
        const int dwi = (16 * hh + 4 * j + g) ^ ((m & 7) << 2);
        img[(4 * m + 0) * (16 * NHB) + dwi] = pk4_fp8_nc(a.x, b.x, c.x, d.x); img[(4 * m + 1) * (16 * NHB) + dwi] = pk4_fp8_nc(a.y, b.y, c.y, d.y);
        img[(4 * m + 2) * (16 * NHB) + dwi] = pk4_fp8_nc(a.z, b.z, c.z, d.z); img[(4 * m + 3) * (16 * NHB) + dwi] = pk4_fp8_nc(a.w, b.w, c.w, d.w); }
}
__device__ __forceinline__ void tr_flush(LAS unsigned* img, int K, int N, unsigned char* WT, size_t row_off, int fl, int lane) {
    const int nblk = N / 64, kb = fl / nblk, nb = fl % nblk, k0 = 64 * NHB * kb, n0 = 64 * nb;
    LDS_WAIT(); asm volatile("" ::: "memory");
    constexpr int CPR = 4 * NHB, RPP = 64 / CPR;
    const int c = lane % CPR;
#pragma unroll 4
    for (int p = 0; p < CPR; ++p) { const int n = lane / CPR + RPP * p;
        const v4u o = *(const LAS v4u*)(img + n * (16 * NHB) + 4 * (c ^ ((n >> 2) & 7)));
        *(GAS v4u*)(WT + (row_off + n0 + n) * (size_t)K + k0 + 16 * c) = o; }
    LDS_WAIT(); asm volatile("" ::: "memory");
}
__device__ __forceinline__ void transpose_item(const float* W, int K, int N, bf16* WT, size_t row_off, LAS float* scr, int item, int lane) {
    f32x4 v[16]; tr_load(W, N, item, lane, v); tr_store(v, K, N, WT, row_off, scr, item, lane);
}

__global__ void __launch_bounds__(NTHR, 2) mk_fwd(Args args) {
    extern __shared__ __attribute__((aligned(16))) unsigned char lds_raw[];
    LAS unsigned char* lds = (LAS unsigned char*)lds_raw;
    volatile LAS unsigned* MISC = (volatile LAS unsigned*)(lds + LDSCTL_OFF);
    LAS int* PS = (LAS int*)(lds + LDSCTL_OFF + 256);
    const int tid = threadIdx.x, lane = tid & 63, wave = __builtin_amdgcn_readfirstlane(tid >> 6);
    const int G = gridDim.x, bx = blockIdx.x;
    const int vcu = (bx % 8) * (G / 8) + bx / 8;
    const int gw = vcu * NWAVES + wave, NGW = G * NWAVES;
    unsigned char* ws = args.ws;
    gu32* ctl = (gu32*)(ws + WS_CTL);
    const float* x = args.in[0]; const float* w_in = args.in[1]; const float* mu = args.in[2]; const float* w0 = args.in[3]; const float* w2d = args.in[4];
    const float* a0 = args.in[5]; const float* a2 = args.in[6]; const float* g2 = args.in[7]; const float* k_k = args.in[8]; const float* k_a = args.in[9];
    const float* r_k = args.in[10]; const float* lnx_w = args.in[11]; const float* lnx_b = args.in[12]; const float* w_pool = args.in[13]; const float* pool_scale = args.in[14];
    const float* w_out = args.in[15]; const float* ln1_w = args.in[16]; const float* ln1_b = args.in[17]; const float* router_w = args.in[18]; const float* router_b = args.in[19];
    const float* w1 = args.in[20]; const float* b1 = args.in[21]; const float* w2 = args.in[22]; const float* b2 = args.in[23]; const float* ln2_w = args.in[24]; const float* ln2_b = args.in[25];
    float* out = args.out;
    int* CNTWG = (int*)(ws + WS_CTL) + CW_CNT;
    int* slot_tok = (int*)(ws + WS_SLOTTOK); int* TOPI = (int*)(ws + WS_TOPI); float* GATE = (float*)(ws + WS_GATE); int* POS = (int*)(ws + WS_POS); int* SLOT_OF = (int*)(ws + WS_SLOTOF);
    float* BONUS = (float*)(ws + WS_BONUS);
    bf16* XB = (bf16*)(ws + WS_XB); bf16* WINT = (bf16*)(ws + WS_WINT); bf16* WOUTT = (bf16*)(ws + WS_WOUTT); bf16* LORAT = (bf16*)(ws + WS_LORAT); bf16* WPOOLT = (bf16*)(ws + WS_WPOOLT);
    bf16* PROJ = (bf16*)(ws + WS_PROJ); bf16* LIN = (bf16*)(ws + WS_LIN); bf16* POOLED = (bf16*)(ws + WS_POOLED);
    float* WDEC = (float*)(ws + WS_WDEC); float* LOUT = (float*)(ws + WS_LOUT); float* Rr = (float*)(ws + WS_R); float* K2 = (float*)(ws + WS_K2);
    float* Vv = (float*)(ws + WS_V); float* KK = (float*)(ws + WS_KK); float* BB = (float*)(ws + WS_BB); float* Yy = (float*)(ws + WS_Y);
    bf16* MIXIN = (bf16*)(ws + WS_MIXIN); bf16* MIX = (bf16*)(ws + WS_MIX); bf16* H = (bf16*)(ws + WS_H); unsigned char* HQ = (unsigned char*)(ws + WS_HB);
    unsigned char* XS = ws + WS_XS; unsigned char* W1T = ws + WS_W1T; unsigned char* W2T = ws + WS_W2T; unsigned char* ACT = ws + WS_ACT; unsigned char* YS = ws + WS_YS;

    for (int u = tid; u < (LDS_BYTES - LDSCTL_OFF) / 4; u += NTHR) ((LAS unsigned*)(lds + LDSCTL_OFF))[u] = 0u;
    __syncthreads();
    XcdBarrier bar; bar.bar = (unsigned*)(ctl + CW_BAR); bar.x = 0; bar.st = nullptr;
    if (MK_N_LAUNCHES == 1) bar = xcd_barrier_post((unsigned*)(ctl + CW_BAR), MISC + 8);
    const int lo = args.ph_lo, hi = args.ph_hi;
#ifndef PHASE_MASK
#define PHASE_MASK 0xFFFF
#endif
#define IN(k) (((PHASE_MASK >> (k)) & 1) && lo <= (k) && (k) < hi)
#define SEAM(k) do { if (IN(k) && IN((k) + 1)) xcd_barrier(bar); } while (0)

    if (IN(0)) {
        LAS float* scr = (LAS float*)(lds + wave * 16640);
        for (size_t i = (size_t)gw * 64 + lane; i < (size_t)M * D / 8; i += (size_t)NGW * 64) {
            const f32x4 a = *(const GAS f32x4*)(x + i * 8), b = *(const GAS f32x4*)(x + i * 8 + 4);
            v4u o; o.x = pk2(a.x, a.y); o.y = pk2(a.z, a.w); o.z = pk2(b.x, b.y); o.w = pk2(b.z, b.w);
            *(GAS v4u*)(XB + i * 8) = o;
        }
        constexpr int I_IN = (D / 64) * (IN_COLS / 64)  , I_OUT = (D / 64) * (D / 64);
        for (int it = gw; it < I_IN + I_OUT; it += NGW) {
            if (it < I_IN) transpose_item(w_in, D, IN_COLS, WINT, 0, scr, it, lane);
            else transpose_item(w_out, D, D, WOUTT, 0, scr, it - I_IN, lane);
        }
        for (int i = gw * 64 + lane; i < 32 * D; i += NGW * 64) { const int nn = 4352 + (i >> 11), k = i & 2047; WINT[(size_t)nn * D + k] = (bf16)f2bf(w_in[(size_t)k * IN_COLS + nn]); }
        for (size_t i = (size_t)gw * 64 + lane; i < (size_t)(IN_PAD - IN_COLS) * D / 8; i += (size_t)NGW * 64) *(GAS v4u*)(WINT + (size_t)IN_COLS * D + i * 8) = (v4u){0u, 0u, 0u, 0u};
        for (int i = gw * 64 + lane; i < 3072 * LK; i += NGW * 64) {
            const int n = i / LK, k = i % LK; float v = 0.f;
            if (n < 1024) { if (k < 64) v = w2d[k * 1024 + n]; }
            else if (n < 2048) { if (k >= 64 && k < 128) v = a2[(k - 64) * 1024 + (n - 1024)]; }
            else { if (k >= 128 && k < 288) v = g2[(k - 128) * 1024 + (n - 2048)]; }
            LORAT[i] = (bf16)f2bf(v);
        }
        for (int i = gw * 64 + lane; i < 1024 * 256; i += NGW * 64) {
            const int n = i >> 8, c = i & 255, g = n >> 8, d = n & 255;
            WPOOLT[i] = (bf16)f2bf(w_pool[((size_t)g * 256 + c) * 256 + d]);
        }
    }
    SEAM(0);

    if (IN(1)) {
        pg8::Gemm g{XB, WINT, D, D}; pg8::GridOrder S; S.init(M / 256, IN_PAD / 256, G, bx, (size_t)256 * D * 2, 0, (size_t)256 * D * 2);
        pg8::EpiBf16Plain E{PROJ, IN_PAD};
        pg8::gemm_phase<pg8::EpiBf16Plain, pg8::GridOrder, true, true>(lds, g, S, E);
    }
    SEAM(1);

    if (IN(2)) {
        const int m0 = gw * 8, t0 = m0 % SEQ;
        const float mu_l[5] = {mu[3072 + lane], mu[3072 + 64 + lane], mu[3072 + 128 + lane], mu[3072 + 192 + lane], lane < 32 ? mu[3072 + 256 + lane] : 0.f};
        float prevl[5];
#pragma unroll
        for (int q = 0; q < 5; ++q) { const int i = lane + 64 * q; prevl[q] = (i < 288 && t0 > 0) ? ld1bf(PROJ + (size_t)(m0 - 1) * IN_PAD + 3072 + i) : 0.f; }
        f32x4 wsum[4];
#pragma unroll
        for (int q = 0; q < 4; ++q) {
            const int c = 4 * lane + 256 * q, win = 2 << q; f32x4 sacc = (f32x4){0.f, 0.f, 0.f, 0.f};
#pragma unroll
            for (int s = 1; s < (2 << q); ++s) if (s <= t0) sacc += ld4bf(PROJ + (size_t)(m0 - s) * IN_PAD + SHIFT_W + c);
            wsum[q] = sacc; (void)win;
        }
#pragma unroll
        for (int i8 = 0; i8 < 8; ++i8) {
            const int m = m0 + i8, t = t0 + i8;
            const bf16* pr = PROJ + (size_t)m * IN_PAD;
#pragma unroll
            for (int q = 0; q < 6; ++q) {
                const int i = lane + 64 * q; float v = 0.f;
                if (q < 5) { if (i < 288) { const float cur = ld1bf(pr + 3072 + i); const float s_ = cur + (prevl[q] - cur) * mu_l[q]; prevl[q] = cur;
                    v = i < 64 ? tanhf(s_) : (i < 128 ? s_ : 1.0f / (1.0f + __expf(-s_))); } }
                LIN[(size_t)m * LK + i] = (bf16)f2bf(v);
            }
#pragma unroll
            for (int q = 0; q < 4; ++q) {
                const int c = 4 * lane + 256 * q, win = 2 << q; const int n = (t + 1) < win ? (t + 1) : win;
                const f32x4 cur = ld4bf(pr + SHIFT_W + c);
                const f32x4 sum = wsum[q] + cur;
                f32x4 nxt = sum; if (t + 1 >= win) nxt = sum - ld4bf(pr - (size_t)(win - 1) * IN_PAD + SHIFT_W + c);
                wsum[q] = nxt;
                const float inv = 1.0f / (float)n; const f32x4 pv = sum * inv - cur;
                v2u o; o.x = pk2(pv.x, pv.y); o.y = pk2(pv.z, pv.w);
                *(GAS v2u*)(POOLED + (size_t)m * 1024 + c) = o;
            }
        }
    }
    SEAM(2);

    if (IN(3)) {
#ifndef NO_LORA
        { pg8::Gemm g{LIN, LORAT, LK, LK}; pg8::GridOrder S; S.init(M / 256, 12, G, bx, (size_t)256 * LK * 2, 0, (size_t)256 * LK * 2);
          pg8::EpiF32 E{LOUT, 3072};
          pg8::gemm_phase<pg8::EpiF32, pg8::GridOrder, true, true>(lds, g, S, E); }
#endif
#ifndef NO_POOL
        { pg8::Gemm g{POOLED, WPOOLT, 1024, 256}; pg8::GridOrder S; S.init(M / 256, 4, G, bx, (size_t)256 * 1024 * 2, (size_t)256 * 2, (size_t)256 * 256 * 2);
          pg8::EpiPool E{MIXIN, pool_scale};
          pg8::gemm_phase<pg8::EpiPool, pg8::GridOrder, true, true>(lds, g, S, E); }
#endif
    }
    SEAM(3);

    if (IN(4)) {
        constexpr int CH = 16, NCHUNK = SEQ / CH;
        constexpr int PK_PA = 0, PK_PR = 2048, PK_QQ = 4096, PK_TT = 5120, PK_GG = 6144, PK_BK = 7168, PK_VT = 11264, PK_WC = 13312, PK_BON = 13568, PK_BYTES = 16384;
        const int tr = lane & 15, q = lane >> 4;
        for (int arep_ = 0; arep_ < P5A_REPS; ++arep_) {
                const int j = lane;
                LAS bf16* IMG = (LAS bf16*)(lds + wave * 10240);
                LAS float* PTs = (LAS float*)(lds + wave * 10240 + 9216);
                const int pos = (j & 32) | ((j & 12) << 1) | ((j & 16) >> 2) | (j & 3);
#pragma unroll 1
                for (int u = gw; u < 64 * NCHUNK; u += NGW) {
                    const int hd = u >> 8, c = u & 255, b = hd >> 4, h = hd & 15, cj = h * 64 + j;
                    const float mu_r = mu[cj], mu_k = mu[1024 + cj], mu_v = mu[2048 + cj], c_w0 = w0[cj], c_a0 = a0[cj], c_kk = k_k[cj], c_ka = k_a[cj];
                    unsigned char* pk = ws + WS_R + ((size_t)hd * NCHUNK + c) * PK_BYTES;
                    const size_t m0 = (size_t)b * SEQ + (size_t)c * CH;
                    float At[16], Rt[16], Bt[16], Kt[16], Vt[16];
                    float Wc = 1.f, pr_r = 0.f, pr_k = 0.f, pr_v = 0.f;
                    if (c > 0) { const bf16* pp = PROJ + (m0 - 1) * IN_PAD + cj; pr_r = ld1bf(pp); pr_k = ld1bf(pp + 1024); pr_v = ld1bf(pp + 2048); }
#pragma unroll
                    for (int t = 0; t < 16; ++t) {
                        const bf16* prow = PROJ + (m0 + t) * IN_PAD + cj; const float* lrow = LOUT + (m0 + t) * 3072 + cj;
                        const float cr = ld1bf(prow), ck = ld1bf(prow + 1024), cv = ld1bf(prow + 2048), wl = lrow[0] + c_w0, al = lrow[1024] + c_a0;
                        const float r = cr + (pr_r - cr) * mu_r, k = ck + (pr_k - ck) * mu_k, v = cv + (pr_v - cv) * mu_v;
                        pr_r = cr; pr_k = ck; pr_v = cv;
                        const float dec = fast_decay(wl), a = fast_sigmoid(al);
                        float kk = k * c_kk; const float ss = wave_sum_dpp(kk * kk); kk = kk * __builtin_amdgcn_rsqf(fmaxf(ss, 1e-24f));
                        const float k2 = k * (1.0f + (a - 1.0f) * c_ka), bb = kk * a;
                        const float Wprev = Wc; Wc = Wc * dec; const float iw = __builtin_amdgcn_rcpf(Wc);
                        At[t] = -kk * Wprev; Rt[t] = r * Wc; Bt[t] = bb * iw; Kt[t] = k2 * iw; Vt[t] = v;
                    }
#pragma unroll
                    for (int t = 0; t < 16; ++t) {
                        const unsigned ar_ = cvt_pk_bf16_nat(At[t], Rt[t]), bk_ = cvt_pk_bf16_nat(Bt[t], Kt[t]); const bf16 ab = (bf16)ar_, rb = (bf16)(ar_ >> 16);
                        IMG[0 * 1152 + t * 72 + j] = ab; IMG[1 * 1152 + t * 72 + j] = rb; IMG[2 * 1152 + t * 72 + j] = (bf16)bk_; IMG[3 * 1152 + t * 72 + j] = (bf16)(bk_ >> 16);
                        ((GAS bf16*)(pk + PK_PA))[t * 64 + pos] = ab; ((GAS bf16*)(pk + PK_PR))[t * 64 + pos] = rb;
                    }
#pragma unroll
                    for (int qq = 0; qq < 4; ++qq) { v4u o; o.x = pk2(Bt[4 * qq] * Wc, Bt[4 * qq + 1] * Wc); o.y = pk2(Bt[4 * qq + 2] * Wc, Bt[4 * qq + 3] * Wc); o.z = pk2(Kt[4 * qq] * Wc, Kt[4 * qq + 1] * Wc); o.w = pk2(Kt[4 * qq + 2] * Wc, Kt[4 * qq + 3] * Wc);
                        *(GAS v4u*)(pk + PK_BK + j * 64 + qq * 16) = o; }
#pragma unroll
                    for (int g = 0; g < 2; ++g) { v4u o; o.x = pk2(Vt[8 * g], Vt[8 * g + 1]); o.y = pk2(Vt[8 * g + 2], Vt[8 * g + 3]); o.z = pk2(Vt[8 * g + 4], Vt[8 * g + 5]); o.w = pk2(Vt[8 * g + 6], Vt[8 * g + 7]);
                        *(GAS v4u*)(pk + PK_VT + j * 32 + g * 16) = o; }
                    ((GAS float*)(pk + PK_WC))[j] = Wc;
                    asm volatile("s_waitcnt lgkmcnt(0)" ::: "memory");
                    const bf16x8 fa0 = *(const LAS bf16x8*)(IMG + 0 * 1152 + tr * 72 + 8 * q), fa1 = *(const LAS bf16x8*)(IMG + 0 * 1152 + tr * 72 + 32 + 8 * q);
                    const bf16x8 fr0 = *(const LAS bf16x8*)(IMG + 1 * 1152 + tr * 72 + 8 * q), fr1 = *(const LAS bf16x8*)(IMG + 1 * 1152 + tr * 72 + 32 + 8 * q);
                    const bf16x8 fb0 = *(const LAS bf16x8*)(IMG + 2 * 1152 + tr * 72 + 8 * q), fb1 = *(const LAS bf16x8*)(IMG + 2 * 1152 + tr * 72 + 32 + 8 * q);
                    const bf16x8 fk0 = *(const LAS bf16x8*)(IMG + 3 * 1152 + tr * 72 + 8 * q), fk1 = *(const LAS bf16x8*)(IMG + 3 * 1152 + tr * 72 + 32 + 8 * q);
                    const f32x4 z4 = (f32x4){0.f, 0.f, 0.f, 0.f};
                    f32x4 PT = __builtin_amdgcn_mfma_f32_16x16x32_bf16(fa0, fb0, z4, 0, 0, 0); PT = __builtin_amdgcn_mfma_f32_16x16x32_bf16(fa1, fb1, PT, 0, 0, 0);
                    f32x4 QT = __builtin_amdgcn_mfma_f32_16x16x32_bf16(fa0, fk0, z4, 0, 0, 0); QT = __builtin_amdgcn_mfma_f32_16x16x32_bf16(fa1, fk1, QT, 0, 0, 0);
                    f32x4 GB = __builtin_amdgcn_mfma_f32_16x16x32_bf16(fr0, fb0, z4, 0, 0, 0); GB = __builtin_amdgcn_mfma_f32_16x16x32_bf16(fr1, fb1, GB, 0, 0, 0);
                    f32x4 GK = __builtin_amdgcn_mfma_f32_16x16x32_bf16(fr0, fk0, z4, 0, 0, 0); GK = __builtin_amdgcn_mfma_f32_16x16x32_bf16(fr1, fk1, GK, 0, 0, 0);
                    const int s_ = tr, rec = (s_ >> 2) * 8 + (s_ & 3);
#pragma unroll
                    for (int e = 0; e < 4; ++e) { const int t = 4 * q + e;
                        const float pv = s_ < t ? PT[e] : 0.f, qv = s_ < t ? QT[e] : 0.f, gb = s_ <= t ? GB[e] : 0.f, gk = s_ <= t ? GK[e] : 0.f;
                        PTs[t * 16 + s_] = pv;
                        ((GAS bf16*)(pk + PK_QQ))[t * 32 + rec] = (bf16)f2bf(qv); ((GAS bf16*)(pk + PK_QQ))[t * 32 + rec + 4] = (bf16)0;
                        ((GAS bf16*)(pk + PK_GG))[t * 32 + rec] = (bf16)f2bf(gb); ((GAS bf16*)(pk + PK_GG))[t * 32 + rec + 4] = (bf16)f2bf(gk); }
                    asm volatile("s_waitcnt lgkmcnt(0)" ::: "memory");
                    float Tr[16];
#pragma unroll
                    for (int t = 0; t < 16; ++t) { float acc = (t == s_) ? 1.f : 0.f;
#pragma unroll
                        for (int r4_ = 0; r4_ < (t + 3) / 4; ++r4_) { const f32x4 pr4 = *(const LAS f32x4*)(PTs + t * 16 + 4 * r4_);
#pragma unroll
                            for (int e = 0; e < 4; ++e) if (4 * r4_ + e < t) acc += pr4[e] * Tr[4 * r4_ + e]; }
                        Tr[t] = acc; }
                    if (q == 0) {
#pragma unroll
                        for (int t = 0; t < 16; ++t) { ((GAS bf16*)(pk + PK_TT))[t * 32 + rec] = (bf16)f2bf(Tr[t]); ((GAS bf16*)(pk + PK_TT))[t * 32 + rec + 4] = (bf16)0; } }
                    asm volatile("s_waitcnt lgkmcnt(0)" ::: "memory");
                }
            }
    }
    SEAM(4);

    if (IN(5)) {
        constexpr int P5_OPS = 0, P5_VV = 81920, P5_YW = 90112, P5_SC = 98304;
        const int xcd_i = bx % 8, slot_i = bx / 8;
        constexpr int NSCAN_X = 8;
        if (slot_i < NSCAN_X) {
            constexpr int CH = 16, NCHUNK = SEQ / CH, NSLOT = 8, LAG = 3;
            LAS unsigned* ring_ready = (LAS unsigned*)(lds + LDSCTL_OFF + 896); LAS unsigned* ring_done = ring_ready + 4;
            constexpr int PK_PA = 0, PK_PR = 2048, PK_QQ = 4096, PK_TT = 5120, PK_GG = 6144, PK_BK = 7168, PK_VT = 11264, PK_WC = 13312, PK_BON = 13568, PK_BYTES = 16384;
            const int hd = xcd_i * NSCAN_X + slot_i, b = hd >> 4, h = hd & 15;
            const size_t mbase = (size_t)b * SEQ;
            static_assert((size_t)64 * NCHUNK * PK_BYTES <= 4 * SZ_F1K, "packs fit the four unused f32 [M][1024] buffers at WS_R");
            unsigned char* PACK = ws + WS_R + (size_t)hd * NCHUNK * PK_BYTES;
            const int tr = lane & 15, q = lane >> 4;
            if (wave < 4) {
                const int icol = 16 * wave + tr;
                LAS float* YT = (LAS float*)(lds + RING_BYTES);
                LAS unsigned* ywr = ring_ready + 8; LAS unsigned* yrd = ring_ready + 12;
                const int ptok = 4 * wave + (lane >> 4), pcol = 4 * (lane & 15);
                const f32x4 lw4 = *(const GAS f32x4*)(lnx_w + h * 64 + pcol), lb4 = *(const GAS f32x4*)(lnx_b + h * 64 + pcol), rk4 = *(const GAS f32x4*)(r_k + h * 64 + pcol);
                const int ppos = (pcol & 32) | ((pcol & 12) << 1) | ((pcol & 16) >> 2);
                f32x4 H0 = (f32x4){0.f, 0.f, 0.f, 0.f}, H1 = H0, H2 = H0, H3 = H0;
                bf16x8 A_fa0, A_fa1, A_fr0, A_fr1, A_fq, A_ft, A_fg, A_b0, A_b1, A_b2, A_b3; v2u A_v; f32x4 A_w0, A_w1, A_w2, A_w3, A_g;
                bf16x8 B_fa0, B_fa1, B_fr0, B_fr1, B_fq, B_ft, B_fg, B_b0, B_b1, B_b2, B_b3; v2u B_v; f32x4 B_w0, B_w1, B_w2, B_w3, B_g;
#define CK_LOAD(P, c_) do { { unsigned sp_ = 0; for (;;) { const v4u rr_ = *(volatile LAS v4u*)ring_ready; const unsigned mn_ = min(min(rr_.x, rr_.y), min(rr_.z, rr_.w)); if (mn_ >= (unsigned)((c_) + 1)) break; __builtin_amdgcn_s_sleep(0); if (++sp_ > (1u << 26)) break; } } asm volatile("" ::: "memory"); \
                    const LAS unsigned char* pk_ = lds + ((c_) & (NSLOT - 1)) * PK_BYTES; \
                    P##_fa0 = *(const LAS bf16x8*)(pk_ + PK_PA + (tr * 64 + 8 * q) * 2); P##_fa1 = *(const LAS bf16x8*)(pk_ + PK_PA + (tr * 64 + 32 + 8 * q) * 2); \
                    P##_fr0 = *(const LAS bf16x8*)(pk_ + PK_PR + (tr * 64 + 8 * q) * 2); P##_fr1 = *(const LAS bf16x8*)(pk_ + PK_PR + (tr * 64 + 32 + 8 * q) * 2); \
                    P##_fq = *(const LAS bf16x8*)(pk_ + PK_QQ + (tr * 4 + q) * 16); P##_ft = *(const LAS bf16x8*)(pk_ + PK_TT + (tr * 4 + q) * 16); P##_fg = *(const LAS bf16x8*)(pk_ + PK_GG + (tr * 4 + q) * 16); \
                    P##_b0 = *(const LAS bf16x8*)(pk_ + PK_BK + ((0 + tr) * 4 + q) * 16); P##_b1 = *(const LAS bf16x8*)(pk_ + PK_BK + ((16 + tr) * 4 + q) * 16); \
                    P##_b2 = *(const LAS bf16x8*)(pk_ + PK_BK + ((32 + tr) * 4 + q) * 16); P##_b3 = *(const LAS bf16x8*)(pk_ + PK_BK + ((48 + tr) * 4 + q) * 16); \
                    P##_v = *(const LAS v2u*)(pk_ + PK_VT + icol * 32 + q * 8); \
                    P##_g = *(const GAS f32x4*)(LOUT + (mbase + (size_t)(c_) * CH + ptok) * 3072 + 2048 + h * 64 + pcol); \
                    P##_w0 = *(const LAS f32x4*)(pk_ + PK_WC + (0 + 4 * q) * 4); P##_w1 = *(const LAS f32x4*)(pk_ + PK_WC + (16 + 4 * q) * 4); P##_w2 = *(const LAS f32x4*)(pk_ + PK_WC + (32 + 4 * q) * 4); P##_w3 = *(const LAS f32x4*)(pk_ + PK_WC + (48 + 4 * q) * 4); } while (0)
#define CK_MM(a_, b_, c_) __builtin_amdgcn_mfma_f32_16x16x32_bf16(a_, b_, c_, 0, 0, 0)
#define CK_STEP(P, c_) do { const f32x4 z4 = (f32x4){0.f, 0.f, 0.f, 0.f}; \
                    v4u hb0, hb1; hb0.x = cvt_pk_bf16_nat(H0[0], H0[1]); hb0.y = cvt_pk_bf16_nat(H0[2], H0[3]); hb0.z = cvt_pk_bf16_nat(H1[0], H1[1]); hb0.w = cvt_pk_bf16_nat(H1[2], H1[3]); \
                    hb1.x = cvt_pk_bf16_nat(H2[0], H2[1]); hb1.y = cvt_pk_bf16_nat(H2[2], H2[3]); hb1.z = cvt_pk_bf16_nat(H3[0], H3[1]); hb1.w = cvt_pk_bf16_nat(H3[2], H3[3]); \
                    const bf16x8 Hb0 = __builtin_bit_cast(bf16x8, hb0), Hb1 = __builtin_bit_cast(bf16x8, hb1); \
                    v4u vb_; vb_.x = P##_v.x; vb_.y = P##_v.y; vb_.z = P##_v.x; vb_.w = P##_v.y; const bf16x8 Vb = __builtin_bit_cast(bf16x8, vb_); \
                    f32x4 XQ = CK_MM(P##_fa0, Hb0, z4); XQ = CK_MM(P##_fa1, Hb1, XQ); XQ = CK_MM(P##_fq, Vb, XQ); \
                    v4u xb_; xb_.x = cvt_pk_bf16_nat(XQ[0], XQ[1]); xb_.y = cvt_pk_bf16_nat(XQ[2], XQ[3]); xb_.z = 0u; xb_.w = 0u; \
                    const f32x4 U = CK_MM(P##_ft, __builtin_bit_cast(bf16x8, xb_), z4); \
                    v4u ub_; ub_.x = cvt_pk_bf16_nat(U[0], U[1]); ub_.y = cvt_pk_bf16_nat(U[2], U[3]); ub_.z = P##_v.x; ub_.w = P##_v.y; const bf16x8 UVb = __builtin_bit_cast(bf16x8, ub_); \
                    f32x4 Y = CK_MM(P##_fr0, Hb0, z4); Y = CK_MM(P##_fr1, Hb1, Y); Y = CK_MM(P##_fg, UVb, Y); \
                    H0 = CK_MM(P##_b0, UVb, H0 * P##_w0); H1 = CK_MM(P##_b1, UVb, H1 * P##_w1); H2 = CK_MM(P##_b2, UVb, H2 * P##_w2); H3 = CK_MM(P##_b3, UVb, H3 * P##_w3); \
                    { unsigned sp_ = 0; for (;;) { const v4u dd_ = *(volatile LAS v4u*)yrd; if (min(min(dd_.x, dd_.y), min(dd_.z, dd_.w)) + 4u > (unsigned)(c_)) break; __builtin_amdgcn_s_sleep(0); if (++sp_ > (1u << 26)) break; } }     \
                    asm volatile("" ::: "memory"); \
                    { LAS float* yt_ = YT + ((c_) & 3) * 1024 + (4 * q) * 64 + icol; yt_[0] = Y[0]; yt_[64] = Y[1]; yt_[128] = Y[2]; yt_[192] = Y[3]; } \
                    asm volatile("s_waitcnt lgkmcnt(0)" ::: "memory"); if (lane == 0) __hip_atomic_fetch_add(ywr + wave, 1u, __ATOMIC_RELAXED, __HIP_MEMORY_SCOPE_WORKGROUP); } while (0)
#define CK_POST(P, c_) do { { unsigned sp_ = 0; for (;;) { const v4u ww_ = *(volatile LAS v4u*)ywr; if (min(min(ww_.x, ww_.y), min(ww_.z, ww_.w)) >= (unsigned)((c_) + 1)) break; __builtin_amdgcn_s_sleep(0); if (++sp_ > (1u << 26)) break; } } \
                    asm volatile("" ::: "memory"); \
                    const LAS unsigned char* pk_ = lds + ((c_) & (NSLOT - 1)) * PK_BYTES; \
                    const f32x4 y_ = *(const LAS f32x4*)(YT + ((c_) & 3) * 1024 + ptok * 64 + pcol); \
                    const LAS bf16* vt_ = (const LAS bf16*)(pk_ + PK_VT) + pcol * 16 + ptok; \
                    const f32x4 v_ = (f32x4){__builtin_bit_cast(float, (unsigned)vt_[0] << 16), __builtin_bit_cast(float, (unsigned)vt_[16] << 16), __builtin_bit_cast(float, (unsigned)vt_[32] << 16), __builtin_bit_cast(float, (unsigned)vt_[48] << 16)}; \
                    const v2u rr2_ = *(const LAS v2u*)(pk_ + PK_PR + (ptok * 64 + ppos) * 2); const LAS bf16* kh_ = (const LAS bf16*)(pk_ + PK_BK + pcol * 64 + (ptok >> 2) * 16 + 8 + (ptok & 3) * 2); \
                    const f32x4 wc_ = *(const LAS f32x4*)(pk_ + PK_WC + pcol * 4); \
                    const float bon_ = row16_sum(bflo(rr2_.x) * __builtin_bit_cast(float, (unsigned)kh_[0] << 16) * rk4.x * __builtin_amdgcn_rcpf(wc_.x) + bfhi(rr2_.x) * __builtin_bit_cast(float, (unsigned)kh_[32] << 16) * rk4.y * __builtin_amdgcn_rcpf(wc_.y) \
                                                 + bflo(rr2_.y) * __builtin_bit_cast(float, (unsigned)kh_[64] << 16) * rk4.z * __builtin_amdgcn_rcpf(wc_.z) + bfhi(rr2_.y) * __builtin_bit_cast(float, (unsigned)kh_[96] << 16) * rk4.w * __builtin_amdgcn_rcpf(wc_.w));     \
                    const float mean_ = row16_sum(y_.x + y_.y + y_.z + y_.w) * (1.0f / 64.0f); const f32x4 d_ = y_ - mean_; \
                    const float var_ = row16_sum(d_.x * d_.x + d_.y * d_.y + d_.z * d_.z + d_.w * d_.w) * (1.0f / 64.0f); \
                    f32x4 yn_ = d_ * __builtin_amdgcn_rsqf(var_ + GN_EPS) * lw4 + lb4; yn_ = (yn_ + bon_ * v_) * P##_g; \
                    v2u ov_; ov_.x = pk2(yn_.x, yn_.y); ov_.y = pk2(yn_.z, yn_.w); \
                    *(GAS v2u*)(MIXIN + (mbase + (size_t)(c_) * CH + ptok) * 2048 + h * 64 + pcol) = ov_; \
                    asm volatile("s_waitcnt lgkmcnt(0)" ::: "memory"); \
                    if (lane == 0) { __hip_atomic_fetch_add(yrd + wave, 1u, __ATOMIC_RELAXED, __HIP_MEMORY_SCOPE_WORKGROUP); __hip_atomic_fetch_add(ring_done + wave, 1u, __ATOMIC_RELAXED, __HIP_MEMORY_SCOPE_WORKGROUP); } } while (0)
                CK_LOAD(A, 0);
#pragma unroll 1
                for (int c = 0; c < NCHUNK; c += 2) {
                    if (c > 0) CK_POST(B, c - 1);
                    CK_LOAD(B, c + 1); CK_STEP(A, c);
                    CK_POST(A, c);
                    CK_LOAD(A, (c + 2 < NCHUNK ? c + 2 : c)); CK_STEP(B, c + 1);
                }
                CK_POST(B, NCHUNK - 1);
#undef CK_LOAD
#undef CK_MM
#undef CK_STEP
#undef CK_POST
            } else {
                const int lw = wave - 4;
#pragma unroll 1
                for (int c = 0; c < NCHUNK + LAG; ++c) {
                    if (c < NCHUNK) {
                        if (c >= NSLOT) { const unsigned want = (unsigned)(c - NSLOT + 1); unsigned sp_ = 0;
                            for (;;) { const v4u dd_ = *(volatile LAS v4u*)ring_done; if (min(min(dd_.x, dd_.y), min(dd_.z, dd_.w)) >= want) break; __builtin_amdgcn_s_sleep(0); if (++sp_ > (1u << 26)) break; } }
                        asm volatile("" ::: "memory");
                        const unsigned char* src = PACK + (size_t)c * PK_BYTES + lw * 1024 + lane * 16;
                        LAS unsigned char* dst = lds + (c & (NSLOT - 1)) * PK_BYTES + lw * 1024;
#pragma unroll
                        for (int p = 0; p < 3; ++p) __builtin_amdgcn_global_load_lds((const unsigned*)(src + p * 4096), (LAS unsigned*)(dst + p * 4096), 16, 0, 0);
                        if (lw < 2) __builtin_amdgcn_global_load_lds((const unsigned*)(src + 3 * 4096), (LAS unsigned*)(dst + 3 * 4096), 16, 0, 0);
                    }
                    if (c >= LAG) {
                        if (c < NCHUNK) { if (lw < 2) asm volatile("s_waitcnt vmcnt(12)" ::: "memory"); else asm volatile("s_waitcnt vmcnt(9)" ::: "memory"); } else asm volatile("s_waitcnt vmcnt(0)" ::: "memory");
                        if (lane == 0) __hip_atomic_fetch_add(ring_ready + lw, 1u, __ATOMIC_RELAXED, __HIP_MEMORY_SCOPE_WORKGROUP);
                    }
                }
            }
        }
        else for (int crep_ = 0; crep_ < P5_CONV_REPS; ++crep_) {
            LAS unsigned* img = (LAS unsigned*)(lds + wave * (4096 * NHB));
            const int cw = (xcd_i * (32 - NSCAN_X) + slot_i - NSCAN_X) * NWAVES + wave;
            constexpr int F1 = (D / (64 * NHB)) * (4096 / 64), F2 = (DFF / (64 * NHB)) * (D / 64), FPE = F1 + F2, NFULL = NE * FPE, STRIDE = (NWG - 8 * NSCAN_X) * NWAVES;
            const int nhalf = cw < NFULL ? NHB * ((NFULL - cw + STRIDE - 1) / STRIDE) : 0;
            f32x4 va[16], vb2[16], vc[16];
            int s = 0;
#define CONV_LD(ss_, buf_) { const int sc_ = (ss_) < nhalf ? (ss_) : nhalf - 1; const int fi_ = cw + (sc_ / NHB) * STRIDE, e_ = fi_ / FPE, r_ = fi_ % FPE; \
                if (r_ < F1) tr_load2(w1 + (size_t)e_ * D * 4096, 4096, r_, sc_ % NHB, lane, buf_); else tr_load2(w2 + (size_t)e_ * DFF * D, D, r_ - F1, sc_ % NHB, lane, buf_); }
#define CONV_STEP(cur, far) { CONV_LD(s + 2, far);     \
                tr_half(cur, s % NHB, img, lane, pg8::W_SCALE); \
                if (s % NHB == NHB - 1) { const int fi_ = cw + (s / NHB) * STRIDE, e_ = fi_ / FPE, r_ = fi_ % FPE; \
                    if (r_ < F1) tr_flush(img, D, 4096, W1T, (size_t)e_ * 4096, r_, lane); else tr_flush(img, DFF, D, W2T, (size_t)e_ * 2048, r_ - F1, lane); } \
                ++s; }
            if (nhalf > 0) { CONV_LD(0, va); CONV_LD(1, vb2);
                for (;;) { CONV_STEP(va, vc); if (s >= nhalf) break; CONV_STEP(vb2, va); if (s >= nhalf) break; CONV_STEP(vc, vb2); if (s >= nhalf) break; } }
#undef CONV_LD
#undef CONV_STEP
        }
    }
    SEAM(5);


    if (IN(7)) {
        pg8::Gemm g{MIXIN, WOUTT, D, D}; pg8::GridOrder S; S.init(M / 256, D / 256, G, bx, (size_t)256 * D * 2, 0, (size_t)256 * D * 2);
        pg8::EpiBf16Plain E{MIX, D};
        pg8::gemm_phase<pg8::EpiBf16Plain, pg8::GridOrder, true, true>(lds, g, S, E);
    }
    SEAM(7);

    if (IN(8)) {
        constexpr int HROW = 2048 + 32;
        LAS bf16* s_hh = (LAS bf16*)lds; LAS bf16* s_hl = s_hh + 8 * HROW;
        LAS float* s_part = (LAS float*)(lds + 69632);
        LAS float* s_lnw = (LAS float*)(lds + 81920); LAS float* s_lnb = s_lnw + 2048;
        const int re = lane & 15, rq = lane >> 4;
        bf16x8 wh[8][2], wl[8][2];
#pragma unroll
        for (int st = 0; st < 8; ++st)
#pragma unroll
            for (int hf = 0; hf < 2; ++hf) { float w8[8];
#pragma unroll
                for (int j = 0; j < 8; ++j) w8[j] = router_w[(size_t)(256 * wave + 32 * st + 8 * rq + j) * 32 + re + 16 * hf];
                v4u hi, lo;
                hi.x = pk2(w8[0], w8[1]); hi.y = pk2(w8[2], w8[3]); hi.z = pk2(w8[4], w8[5]); hi.w = pk2(w8[6], w8[7]);
                lo.x = pk2(w8[0] - bflo(hi.x), w8[1] - bfhi(hi.x)); lo.y = pk2(w8[2] - bflo(hi.y), w8[3] - bfhi(hi.y)); lo.z = pk2(w8[4] - bflo(hi.z), w8[5] - bfhi(hi.z)); lo.w = pk2(w8[6] - bflo(hi.w), w8[7] - bfhi(hi.w));
                wh[st][hf] = __builtin_bit_cast(bf16x8, hi); wl[st][hf] = __builtin_bit_cast(bf16x8, lo); }
        LAS int* lcnt = (LAS int*)(lds + LDSCTL_OFF + 512);
        if (tid < NE) lcnt[tid] = 0;
        const float rb = router_b[lane & 31];
        *(LAS f32x4*)(s_lnw + 4 * tid) = *(const GAS f32x4*)(ln1_w + 4 * tid); *(LAS f32x4*)(s_lnb + 4 * tid) = *(const GAS f32x4*)(ln1_b + 4 * tid);
        __syncthreads();
        constexpr int NIT = M / (NWG * 8);
        v4u rm[4], rx[4];
#define P8_FETCH(m_) do { _Pragma("unroll") for (int q = 0; q < 4; ++q) { rm[q] = *(const GAS v4u*)(MIX + (size_t)(m_) * D + 8 * lane + 512 * q); rx[q] = *(const GAS v4u*)(XB + (size_t)(m_) * D + 8 * lane + 512 * q); } } while (0)
#define P8_LN(m_) do { f32x4 v[8]; float s = 0.f; \
            _Pragma("unroll") for (int q = 0; q < 4; ++q) { \
                v[2 * q] = ALPHA * (f32x4){bflo(rx[q].x), bfhi(rx[q].x), bflo(rx[q].y), bfhi(rx[q].y)} + (f32x4){bflo(rm[q].x), bfhi(rm[q].x), bflo(rm[q].y), bfhi(rm[q].y)}; \
                v[2 * q + 1] = ALPHA * (f32x4){bflo(rx[q].z), bfhi(rx[q].z), bflo(rx[q].w), bfhi(rx[q].w)} + (f32x4){bflo(rm[q].z), bfhi(rm[q].z), bflo(rm[q].w), bfhi(rm[q].w)}; \
                s += ((v[2 * q].x + v[2 * q].y) + (v[2 * q].z + v[2 * q].w)) + ((v[2 * q + 1].x + v[2 * q + 1].y) + (v[2 * q + 1].z + v[2 * q + 1].w)); } \
            const float mean = wave_sum_dpp(s) * (1.0f / D); float s2 = 0.f; \
            _Pragma("unroll") for (int q = 0; q < 8; ++q) { v[q] = v[q] - mean; s2 += (v[q].x * v[q].x + v[q].y * v[q].y) + (v[q].z * v[q].z + v[q].w * v[q].w); } \
            const float rstd = 1.0f / sqrtf(wave_sum_dpp(s2) * (1.0f / D) + LN_EPS); \
            _Pragma("unroll") for (int q = 0; q < 4; ++q) { const int c = 8 * lane + 512 * q; \
                const f32x4 h0 = v[2 * q] * rstd * *(const LAS f32x4*)(s_lnw + c) + *(const LAS f32x4*)(s_lnb + c), h1 = v[2 * q + 1] * rstd * *(const LAS f32x4*)(s_lnw + c + 4) + *(const LAS f32x4*)(s_lnb + c + 4); \
                v4u hw; hw.x = pk2(h0.x, h0.y); hw.y = pk2(h0.z, h0.w); hw.z = pk2(h1.x, h1.y); hw.w = pk2(h1.z, h1.w); *(GAS v4u*)(H + (size_t)(m_) * D + c) = hw; \
                v4u hl; hl.x = pk2(h0.x - bflo(hw.x), h0.y - bfhi(hw.x)); hl.y = pk2(h0.z - bflo(hw.y), h0.w - bfhi(hw.y)); hl.z = pk2(h1.x - bflo(hw.z), h1.y - bfhi(hw.z)); hl.w = pk2(h1.z - bflo(hw.w), h1.w - bfhi(hw.w)); \
                *(LAS v4u*)(s_hh + wave * HROW + c) = hw; *(LAS v4u*)(s_hl + wave * HROW + c) = hl; \
                { v2u hq; hq.x = pg8::pk4_fp8(h0.x * pg8::XS_SCALE, h0.y * pg8::XS_SCALE, h0.z * pg8::XS_SCALE, h0.w * pg8::XS_SCALE); hq.y = pg8::pk4_fp8(h1.x * pg8::XS_SCALE, h1.y * pg8::XS_SCALE, h1.z * pg8::XS_SCALE, h1.w * pg8::XS_SCALE); \
                  *(GAS v2u*)(HQ + (size_t)(m_) * D + c) = hq; } } } while (0)
#define P8_MM(a_, b_, c_) __builtin_amdgcn_mfma_f32_16x16x32_bf16(a_, b_, c_, 0, 0, 0)
#define P8_ROUTER() do { const LAS bf16* ah_ = s_hh + (lane & 7) * HROW + 256 * wave + 8 * rq; const LAS bf16* al_ = s_hl + (lane & 7) * HROW + 256 * wave + 8 * rq; \
            f32x4 a0_ = (f32x4){0.f, 0.f, 0.f, 0.f}, a1_ = a0_; \
            _Pragma("unroll") for (int st = 0; st < 8; ++st) { const bf16x8 fh_ = *(const LAS bf16x8*)(ah_ + 32 * st), fl_ = *(const LAS bf16x8*)(al_ + 32 * st); \
                a0_ = P8_MM(fh_, wh[st][0], a0_); a1_ = P8_MM(fh_, wh[st][1], a1_); a0_ = P8_MM(fh_, wl[st][0], a0_); a1_ = P8_MM(fh_, wl[st][1], a1_); a0_ = P8_MM(fl_, wh[st][0], a0_); a1_ = P8_MM(fl_, wh[st][1], a1_); } \
            if (lane < 32) { _Pragma("unroll") for (int r = 0; r < 4; ++r) { s_part[(wave * 8 + 4 * rq + r) * 32 + re] = a0_[r]; s_part[(wave * 8 + 4 * rq + r) * 32 + 16 + re] = a1_[r]; } } } while (0)
#define P8_T4STEP(CTRL) do { const float ob = dpp_mov<CTRL>(best); const int oi = __builtin_amdgcn_update_dpp(0, bi, CTRL, 0xF, 0xF, true); const bool take = (ob > best) || (ob == best && oi < bi); best = take ? ob : best; bi = take ? oi : bi; } while (0)
#define P8_TOP4(m_) do { float lg = -3.0e38f; \
            if (lane < 32) { float tp_[8]; _Pragma("unroll") for (int p = 0; p < 8; ++p) tp_[p] = s_part[(p * 8 + wave) * 32 + lane]; \
                lg = rb + (((tp_[0] + tp_[1]) + (tp_[2] + tp_[3])) + ((tp_[4] + tp_[5]) + (tp_[6] + tp_[7]))); \
                lg = (lg == lg) ? fminf(fmaxf(lg, -1.0e30f), 1.0e30f) : -1.0e30f; }        \
            int idx[4]; float val[4]; \
            _Pragma("unroll") for (int k = 0; k < 4; ++k) { float best = lg; int bi = lane; \
                P8_T4STEP(0xB1); P8_T4STEP(0x4E); P8_T4STEP(0x141); P8_T4STEP(0x140); \
                { const float ob = __shfl_xor(best, 16); const int oi = __shfl_xor(bi, 16); const bool take = (ob > best) || (ob == best && oi < bi); best = take ? ob : best; bi = take ? oi : bi; } \
                idx[k] = bi; val[k] = best; if (lane == bi) lg = -3.0e38f; } \
            if (lane == 0) { float ex[4], se = 0.f; \
                _Pragma("unroll") for (int k = 0; k < 4; ++k) { ex[k] = __expf(val[k] - val[0]); se += ex[k]; } \
                const float inv = 1.0f / se; \
                _Pragma("unroll") for (int k = 0; k < 4; ++k) { TOPI[(m_) * 4 + k] = idx[k]; GATE[(m_) * 4 + k] = ex[k] * inv; POS[(m_) * 4 + k] = __hip_atomic_fetch_add(lcnt + idx[k], 1, __ATOMIC_RELAXED, __HIP_MEMORY_SCOPE_WORKGROUP); } } } while (0)
#define P8_SYNC() do { asm volatile("s_waitcnt lgkmcnt(0)" ::: "memory"); __builtin_amdgcn_s_barrier(); asm volatile("" ::: "memory"); } while (0)
        const int mfirst = vcu * 8 + wave;
        P8_FETCH(mfirst);
        P8_LN(mfirst); P8_FETCH(mfirst + G * 8);
        P8_SYNC();
        P8_ROUTER();
        P8_SYNC();
#pragma unroll 1
        for (int it = 1; it < NIT; ++it) {
            const int m = mfirst + it * G * 8;
            P8_LN(m); P8_FETCH(it + 1 < NIT ? m + G * 8 : m);
            P8_TOP4(m - G * 8);
            P8_SYNC();
            P8_ROUTER();
            P8_SYNC();
        }
        P8_TOP4(mfirst + (NIT - 1) * G * 8);
        P8_SYNC();
#undef P8_SYNC
#undef P8_FETCH
#undef P8_LN
#undef P8_MM
#undef P8_ROUTER
#undef P8_T4STEP
#undef P8_TOP4
        if (tid < NE) CNTWG[vcu * NE + tid] = lcnt[tid];
    }
    SEAM(8);

    if (IN(9) || IN(10) || IN(11)) {
        LAS int* s_t = (LAS int*)lds; LAS int* s_p = s_t + 512;
        LAS int* PSB = (LAS int*)(lds + LDSCTL_OFF + 640);
        { const int e = tid & 31, part = tid >> 5; int tsum = 0, psum = 0;
          for (int w = part * 16; w < part * 16 + 16; ++w) { const int cv = CNTWG[w * NE + e]; tsum += cv; psum += (w < vcu) ? cv : 0; }
          s_t[part * 32 + e] = tsum; s_p[part * 32 + e] = psum; }
        __syncthreads();
        if (tid < NE) { int tsum = 0, psum = 0; for (int p = 0; p < 16; ++p) { tsum += s_t[p * 32 + tid]; psum += s_p[p * 32 + tid]; } s_t[tid] = tsum; PSB[tid] = psum; }
        __syncthreads();
        if (tid == 0) { int acc = 0; for (int e = 0; e < NE; ++e) { PS[e] = acc; acc += (s_t[e] + 255) / 256 * 256; } PS[NE] = acc; }
        __syncthreads();
        if (tid < NE) PSB[tid] += PS[tid];
        __syncthreads();
    }
    if (IN(9)) {
        const LAS int* PSB = (const LAS int*)(lds + LDSCTL_OFF + 640);
        for (int m0 = vcu * 8; m0 < M; m0 += G * 8) {
            const int m = m0 + wave;
#pragma unroll
            for (int k = 0; k < 4; ++k) {
                const int a = m * 4 + k, slot = PSB[TOPI[a]] + POS[a];
                if (lane == 0) { slot_tok[slot] = m; SLOT_OF[a] = slot; }
            }
        }
    }
    SEAM(9);

    if (IN(10)) {
        LAS unsigned* TOKS = (LAS unsigned*)(lds + RING_BYTES);
        pg8::Gemm g{(const bf16*)HQ, (const bf16*)W1T, D / 2, D / 2}; pg8::MoeOrderT<true> S; S.ps = PS; S.ntile = 16; S.npan = PS[NE] / 256; S.cprime = vcu; S.a_tstep = (size_t)256 * D; S.b_tstep = (size_t)256 * D; S.toks = TOKS;
        { pg8::Unit u_; for (int i = 0; i < 18 && S.next(i, u_); ++i) if (tid < 256) { const int tk = slot_tok[u_.pm * 256 + tid]; TOKS[i * 256 + tid] = (unsigned)((tk < 0 || tk >= M) ? 0 : tk) * (unsigned)D; }
          __syncthreads(); }
        pg8::EpiSwiglu E{ACT, b1};
        pg8::gemm_phase<pg8::EpiSwiglu, pg8::MoeOrderT<true>, true, true, true>(lds, g, S, E);
    }
    SEAM(10);

    if (IN(11)) {
        pg8::Gemm g{(const bf16*)ACT, (const bf16*)W2T, DFF / 2, DFF / 2}; pg8::MoeOrder S; S.ps = PS; S.ntile = 8; S.npan = PS[NE] / 256; S.cprime = vcu; S.a_tstep = (size_t)256 * DFF; S.b_tstep = (size_t)256 * DFF;
        pg8::EpiBias8 E{YS, b2};
        pg8::gemm_phase<pg8::EpiBias8, pg8::MoeOrder, true, true, true>(lds, g, S, E);
    }
    SEAM(11);

    if (IN(12)) {
        for (int m = gw; m < M; m += NGW) {
            int sl[4]; float gt[4];
#pragma unroll
            for (int k = 0; k < 4; ++k) { sl[k] = SLOT_OF[m * 4 + k]; gt[k] = GATE[m * 4 + k]; }
            f32x4 v[8]; float s = 0.f;
#pragma unroll
            for (int q = 0; q < 8; ++q) { const int c = 4 * lane + 256 * q; f32x4 f = (f32x4){0.f, 0.f, 0.f, 0.f};
#pragma unroll
                for (int k = 0; k < 4; ++k) { const unsigned yv = *(const GAS unsigned*)(YS + (size_t)sl[k] * D + c); const f32x2n lo2 = __builtin_amdgcn_cvt_pk_f32_fp8(yv, false), hi2 = __builtin_amdgcn_cvt_pk_f32_fp8(yv, true); f += (gt[k] * (1.0f / pg8::YS_SCALE)) * (f32x4){lo2.x, lo2.y, hi2.x, hi2.y}; }
                { const v2u hw = *(const GAS v2u*)(H + (size_t)m * D + c); v[q] = ALPHA * (f32x4){bflo(hw.x), bfhi(hw.x), bflo(hw.y), bfhi(hw.y)} + f; } s += (v[q].x + v[q].y) + (v[q].z + v[q].w); }
            const float mean = wave_sum(s) * (1.0f / D); float s2 = 0.f;
#pragma unroll
            for (int q = 0; q < 8; ++q) { v[q] = v[q] - mean; s2 += (v[q].x * v[q].x + v[q].y * v[q].y) + (v[q].z * v[q].z + v[q].w * v[q].w); }
            const float rstd = 1.0f / sqrtf(wave_sum(s2) * (1.0f / D) + LN_EPS);
#pragma unroll
            for (int q = 0; q < 8; ++q) { const int c = 4 * lane + 256 * q; *(GAS f32x4*)(out + (size_t)m * D + c) = v[q] * rstd * *(const GAS f32x4*)(ln2_w + c) + *(const GAS f32x4*)(ln2_b + c); }
        }
    }
#undef IN
#undef SEAM
}

extern "C" void kernel_launch(void* const* d_in, const int* in_sizes, int n_in, void* d_out, int out_size, void* d_ws, size_t ws_size, hipStream_t stream) {
    static int grid = 0;
    if (grid == 0) {
        if (n_in != 26 || out_size != M * D || ws_size < WS_END) { fprintf(stderr, "kernel_launch: unexpected problem (n_in %d, out %d, ws %zu < %zu)\n", n_in, out_size, ws_size, (size_t)WS_END); grid = -1; return; }
        int dev = 0, cus = 0, per_cu = 0;
        if (hipGetDevice(&dev) != hipSuccess || hipDeviceGetAttribute(&cus, hipDeviceAttributeMultiprocessorCount, dev) != hipSuccess) { grid = -1; return; }
        if (hipFuncSetAttribute((const void*)mk_fwd, hipFuncAttributeMaxDynamicSharedMemorySize, LDS_BYTES) != hipSuccess) { fprintf(stderr, "kernel_launch: hipFuncSetAttribute failed\n"); grid = -1; return; }
        if (hipOccupancyMaxActiveBlocksPerMultiprocessor(&per_cu, (const void*)mk_fwd, NTHR, LDS_BYTES) != hipSuccess || per_cu < 1) fprintf(stderr, "kernel_launch: occupancy query reports %d\n", per_cu);
        (void)hipGetLastError();
        if (cus != NWG) { fprintf(stderr, "kernel_launch: built for %d CUs, device has %d\n", NWG, cus); grid = -1; return; }
        grid = NWG;
    }
    if (grid < 0) return;
    (void)hipMemsetAsync((char*)d_ws + WS_CTL, 0, CTL_BYTES, stream);
    Args a{};
    for (int i = 0; i < 26; ++i) a.in[i] = (const float*)d_in[i];
    a.out = (float*)d_out; a.ws = (unsigned char*)d_ws; a.dup = DUP_MASK;
    if (MK_N_LAUNCHES == 1) { a.ph_lo = 0; a.ph_hi = NPHASE; hipLaunchKernelGGL(mk_fwd, dim3(grid), dim3(NTHR), LDS_BYTES, stream, a); }
    else { for (int p = 0; p < NPHASE; ++p) for (int rep = 0; rep <= ((DUP_MASK >> p) & 1); ++rep) { a.ph_lo = p; a.ph_hi = p + 1; hipLaunchKernelGGL(mk_fwd, dim3(grid), dim3(NTHR), LDS_BYTES, stream, a); } }
}
```

```cpp
#include <hip/hip_runtime.h>
#include <stdint.h>
#include <stdio.h>

#ifndef P5_SCAN_REPS
#define P5_SCAN_REPS 1
#endif
#ifndef P5_CONV_REPS
#define P5_CONV_REPS 1
#endif
#ifndef P5A_REPS
#define P5A_REPS 1
#endif
#ifndef P5B_REPS
#define P5B_REPS 1
#endif
#ifndef SCAN_CHUNKED
#define SCAN_CHUNKED 1
#endif
#ifndef DUP_MASK
#define DUP_MASK 0
#endif
#ifndef MK_N_LAUNCHES
#define MK_N_LAUNCHES 1
#endif

constexpr int D = 2048, BATCH = 4, SEQ = 4096, M = BATCH * SEQ;
constexpr int RW = 1024, PW = 1024, NH = 16;
constexpr int SHIFT_W = 3360, IN_COLS = 4384, IN_PAD = 4608;
constexpr int LK = 384;
constexpr int NE = 32, DFF = 2048;
constexpr int NASG = M * 4;
constexpr int NSLOT_MAX = NASG + NE * 256;
constexpr float LN_EPS = 1e-5f, GN_EPS = 64e-5f;
constexpr float ALPHA = 1.189207115002721f;
constexpr int NWG = 256, NWAVES = 8, NTHR = 512;
constexpr int NPHASE = 13;

#define GAS __attribute__((address_space(1)))
#define LAS __attribute__((address_space(3)))
typedef unsigned short bf16;
typedef unsigned v4u __attribute__((ext_vector_type(4)));
typedef unsigned v2u __attribute__((ext_vector_type(2)));
typedef float f32x4 __attribute__((ext_vector_type(4)));
typedef short bf16x8 __attribute__((ext_vector_type(8)));
typedef GAS unsigned gu32;
#define RLX_AGENT __ATOMIC_RELAXED, __HIP_MEMORY_SCOPE_AGENT
#define LDS_WAIT() asm volatile("s_waitcnt lgkmcnt(0)" ::: "memory")
#define VM_WAIT() asm volatile("s_waitcnt vmcnt(0)" ::: "memory")

typedef float f32x2n __attribute__((ext_vector_type(2)));
typedef __bf16 bf16x2n __attribute__((ext_vector_type(2)));
__device__ __forceinline__ unsigned cvt_pk_bf16_nat(float lo, float hi) { const f32x2n v = {lo, hi}; return __builtin_bit_cast(unsigned, __builtin_convertvector(v, bf16x2n)); }
__device__ __forceinline__ unsigned f2bf(float f) { return cvt_pk_bf16_nat(f, 0.f) & 0xffffu; }
__device__ __forceinline__ unsigned pk2(float lo, float hi) { return cvt_pk_bf16_nat(lo, hi); }
__device__ __forceinline__ float bflo(unsigned w) { return __builtin_bit_cast(float, w << 16); }
__device__ __forceinline__ float bfhi(unsigned w) { return __builtin_bit_cast(float, w & 0xffff0000u); }
__device__ __forceinline__ float ld1bf(const bf16* p) { return __builtin_bit_cast(float, (unsigned)(*(const GAS bf16*)p) << 16); }
__device__ __forceinline__ f32x4 ld4bf(const bf16* p) { const v2u w = *(const GAS v2u*)p; return (f32x4){bflo(w.x), bfhi(w.x), bflo(w.y), bfhi(w.y)}; }
__device__ __forceinline__ float wave_sum(float v) {
#pragma unroll
    for (int o = 1; o < 64; o <<= 1) v += __shfl_xor(v, o);
    return v;
}
__device__ __forceinline__ float fast_sigmoid(float x) { return __builtin_amdgcn_rcpf(1.0f + __builtin_amdgcn_exp2f(-1.4426950408889634f * x)); }
__device__ __forceinline__ float fast_decay(float wl) { const float z = -wl; const float sp = fmaxf(z, 0.f) + 0.6931471805599453f * __builtin_amdgcn_logf(1.0f + __builtin_amdgcn_exp2f(-1.4426950408889634f * fabsf(z)));
    return __builtin_amdgcn_exp2f(-1.4426950408889634f * __builtin_amdgcn_exp2f(-1.4426950408889634f * (sp + 0.5f))); }
template <int CTRL> __device__ __forceinline__ float dpp_mov(float x) { return __builtin_bit_cast(float, __builtin_amdgcn_update_dpp(0, __builtin_bit_cast(int, x), CTRL, 0xF, 0xF, true)); }
__device__ __forceinline__ float row16_sum(float x) {
    x += dpp_mov<0xB1>(x);
    x += dpp_mov<0x4E>(x);
    x += dpp_mov<0x141>(x);
    x += dpp_mov<0x140>(x);
    return x;
}

__device__ __forceinline__ float wave_sum_dpp(float x) {
    x = row16_sum(x);
    x += __builtin_bit_cast(float, __builtin_amdgcn_update_dpp(0, __builtin_bit_cast(int, x), 0x142, 0xA, 0xF, false));
    x += __builtin_bit_cast(float, __builtin_amdgcn_update_dpp(0, __builtin_bit_cast(int, x), 0x143, 0xC, 0xF, false));
    return __builtin_bit_cast(float, __builtin_amdgcn_readlane(__builtin_bit_cast(int, x), 63));
}

namespace pg8 {
typedef unsigned short bf16_t;
typedef unsigned u32x4 __attribute__((ext_vector_type(4)));
typedef int v4i_t __attribute__((ext_vector_type(4)));
typedef int v8i_t __attribute__((ext_vector_type(8)));
constexpr int BM = 256, BK = 64, HALF = 128, HTB = HALF * BK * 2, STAGE_BYTES = 8 * HTB, NXCD = 8, WGM = 8;
__host__ __device__ __forceinline__ int lds_byte(int r, int c) { const int st = (r >> 4) * 2 + (c >> 5), rr = r & 15, cc = c & 31, ob = rr * 64 + cc * 2; return st * 1024 + (ob ^ (((ob >> 9) & 1) << 5)); }
__host__ __device__ __forceinline__ void stage_rc(int b, int& R, int& C) { const int st = b / 1024, sb = b % 1024, swz = sb ^ (((sb >> 9) & 1) << 5); R = (st >> 1) * 16 + swz / 64; C = (st & 1) * 32 + (swz % 64) / 2; }
__host__ __device__ __forceinline__ int perm32(int rho) { const int n = rho >> 4, i = rho & 15; return 8 * (i >> 2) + 4 * n + (i & 3); }
__host__ __device__ __forceinline__ int perm128(int R) { return 64 * (R >> 5) + 16 * ((R >> 2) & 3) + 4 * ((R >> 4) & 1) + (R & 3); }
struct Unit { int pm, pn; };
struct Gemm { const bf16_t* A; const bf16_t* Bt; int lda, K; };
__device__ __forceinline__ unsigned cvt_pk_bf16(float lo, float hi) { unsigned r; asm volatile("v_cvt_pk_bf16_f32 %0, %1, %2" : "=v"(r) : "v"(lo), "v"(hi)); return r; }

struct GridOrder {
    static constexpr bool GATHER = false;
    int nM, nN, nwg, G, c; size_t a_tstep, a_pnstep, b_tstep;
    __device__ void init(int nM_, int nN_, int G_, int c_, size_t a_tstep_, size_t a_pnstep_, size_t b_tstep_) { nM = nM_; nN = nN_; nwg = nM * nN; G = G_; c = c_; a_tstep = a_tstep_; a_pnstep = a_pnstep_; b_tstep = b_tstep_; }
    __device__ bool next(int i, Unit& u) const {
        const long L = (long)i * G + c; if (L >= nwg) return false;
        int wgid = (int)L; { const int q = nwg / NXCD, r = nwg % NXCD, xcd = wgid % NXCD, off = wgid / NXCD; wgid = (xcd < r ? xcd * (q + 1) : r * (q + 1) + (xcd - r) * q) + off; }
        const int nig = WGM * nN, gid = wgid / nig, fm = gid * WGM, gsz = (nM - fm) < WGM ? (nM - fm) : WGM;
        u.pm = fm + ((wgid % nig) % gsz); u.pn = (wgid % nig) / gsz; return true;
    }
    __device__ __forceinline__ size_t aoff(const Unit& u) const { return (size_t)u.pm * a_tstep + (size_t)u.pn * a_pnstep; }
    __device__ __forceinline__ size_t boff(const Unit& u) const { return (size_t)u.pn * b_tstep; }
};
template <bool GATHER_> struct MoeOrderT {
    static constexpr bool GATHER = GATHER_;
    const LAS int* ut; size_t a_tstep, b_tstep; const LAS unsigned* toks;
    __device__ bool next(int i, Unit& u) const {
        if (i > 18) return false;
        const int v = ut[i]; if (v < 0) return false;
        u.pm = v & 0xffff; u.pn = v >> 16; return true;
    }
    __device__ __forceinline__ size_t aoff(const Unit& u) const { return GATHER ? (size_t)0 : (size_t)u.pm * a_tstep; }
    __device__ __forceinline__ size_t boff(const Unit& u) const { return (size_t)u.pn * b_tstep; }
};
__device__ __forceinline__ void moe_unit_table(LAS int* ut, const LAS int* ps, int ntile, int cprime, int tid) {
    if (tid < 19) { int v = -1;
        if (tid < 18) { const int U = tid * NWG + cprime, p = U / ntile;
            if (p < ps[NE] / 256) { const int row = p * 256; int e = 0;
                for (int q = 1; q < NE; ++q) e = (row >= ps[q]) ? q : e;
                v = p | ((e * ntile + U % ntile) << 16); } }
        ut[tid] = v; }
    __syncthreads();
}
typedef MoeOrderT<false> MoeOrder;

template <class Epi, class Sched, bool ALIGN_EPI, bool SP2, bool FP8 = false>
__device__ __forceinline__ void gemm_phase(LAS unsigned char* lds, const Gemm g, const Sched& S, const Epi& E) {
    int tid_ = threadIdx.x; asm volatile("" : "+v"(tid_));
    const int tid = tid_, wid = __builtin_amdgcn_readfirstlane(tid >> 6), lane = tid & 63, wr = wid >> 2, wc = wid & 3, fr = lane & 15, fq = lane >> 4;
    const int K = g.K, nt = K / BK;
    constexpr bool GATHER = Sched::GATHER; static_assert(!GATHER || SP2, "gathered A rows: SP2 loop only");
    unsigned voffA[2], voffB[2]; int rowA[2]; unsigned colA[2];
#pragma unroll
    for (int i = 0; i < 2; ++i) { int R, C; stage_rc(tid * 16 + i * 8192, R, C); const int Rb = Epi::PERM == 2 ? perm128(R) : (Epi::PERM ? ((R & ~31) + perm32(R & 31)) : R);
        voffA[i] = (unsigned)(R * g.lda + C) * 2u; voffB[i] = (unsigned)(Rb * K + C) * 2u; rowA[i] = R; colA[i] = (unsigned)C * 2u; }
    unsigned cG0[2] = {0u, 0u}, cG1[2] = {0u, 0u}, nG0[2] = {0u, 0u}, nG1[2] = {0u, 0u};
#define PG8_GLOAD(dst0, dst1, lu) do { if constexpr (GATHER) { _Pragma("unroll") for (int _i = 0; _i < 2; ++_i) { dst0[_i] = S.toks[(lu) * 256 + rowA[_i]] + colA[_i]; dst1[_i] = S.toks[(lu) * 256 + 128 + rowA[_i]] + colA[_i]; } } } while (0)
#define PG8_STAGE_A(bufoff, gbase, half, usenext) do { if constexpr (GATHER) { if (usenext) { if (half) PG8_STAGE(bufoff, gbase, nG1); else PG8_STAGE(bufoff, gbase, nG0); } else { if (half) PG8_STAGE(bufoff, gbase, cG1); else PG8_STAGE(bufoff, gbase, cG0); } } \
        else PG8_STAGE(bufoff, (gbase) + ((half) ? hstepA : (size_t)0), voffA); } while (0)
    const size_t kstep = (size_t)(BK * 2);
    const size_t hstepA = (size_t)HALF * g.lda * 2, hstepB = (size_t)(Epi::PERM == 2 ? 8 : HALF) * K * 2;
    const unsigned ldsw = (unsigned)wid * 1024u;
    const int aoff = lds_byte(wr * 64 + fr, fq * 8), boff = lds_byte(wc * 32 + fr, fq * 8);
#define PG8_SA(b, h) (((b) * 2 + (h)) * HTB)
#define PG8_SB(b, h) ((4 + (b) * 2 + (h)) * HTB)
#define PG8_STAGE(bufoff, gbase, voff) do { _Pragma("unroll") for (int _i = 0; _i < 2; ++_i) \
        __builtin_amdgcn_global_load_lds((const unsigned*)((const char*)(gbase) + (voff)[_i]), (LAS unsigned*)(lds + (bufoff) + ldsw + _i * 8192), 16, 0, 0); } while (0)
#define PG8_LDA(dst, b, h) do { _Pragma("unroll") for (int m = 0; m < 4; ++m) { if constexpr (FP8) { const v4i_t l_ = *(const LAS v4i_t*)(lds + PG8_SA(b, h) + aoff + m * 2048), h_ = *(const LAS v4i_t*)(lds + PG8_SA(b, h) + aoff + m * 2048 + 1024); dst##8[m] = __builtin_shufflevector(l_, h_, 0, 1, 2, 3, 4, 5, 6, 7); } \
        else { _Pragma("unroll") for (int k = 0; k < 2; ++k) dst[m][k] = *(const LAS bf16x8*)(lds + PG8_SA(b, h) + aoff + m * 2048 + k * 1024); } } } while (0)
#define PG8_LDB(dst, b, h) do { _Pragma("unroll") for (int n = 0; n < 2; ++n) { if constexpr (FP8) { const v4i_t l_ = *(const LAS v4i_t*)(lds + PG8_SB(b, h) + boff + n * 2048), h_ = *(const LAS v4i_t*)(lds + PG8_SB(b, h) + boff + n * 2048 + 1024); dst##8[n] = __builtin_shufflevector(l_, h_, 0, 1, 2, 3, 4, 5, 6, 7); } \
        else { _Pragma("unroll") for (int k = 0; k < 2; ++k) dst[n][k] = *(const LAS bf16x8*)(lds + PG8_SB(b, h) + boff + n * 2048 + k * 1024); } } } while (0)
#define PG8_MMA(ai, bj, At, Bt) do { __builtin_amdgcn_s_setprio(1); _Pragma("unroll") for (int m = 0; m < 4; ++m) _Pragma("unroll") for (int n = 0; n < 2; ++n) { \
        if constexpr (FP8) asm volatile("v_mfma_scale_f32_16x16x128_f8f6f4 %0, %1, %2, %0, %3, %3 op_sel_hi:[0,0,0]" : "+v"(acc[ai][bj][m][n]) : "v"(Bt##8[n]), "v"(At##8[m]), "v"(scale1_)); \
        else { _Pragma("unroll") for (int k = 0; k < 2; ++k) acc[ai][bj][m][n] = __builtin_amdgcn_mfma_f32_16x16x32_bf16(Bt[n][k], At[m][k], acc[ai][bj][m][n], 0, 0, 0); } } \
        __builtin_amdgcn_s_setprio(0); } while (0)
#define PG8_WAIT_V(n) asm volatile("s_waitcnt vmcnt(" #n ")" ::: "memory")
#define PG8_WAIT_L(n) asm volatile("s_waitcnt lgkmcnt(" #n ")" ::: "memory")
#define PG8_BAR __builtin_amdgcn_s_barrier()
#define PG8_SCHED __builtin_amdgcn_sched_barrier(0)
    Unit cur, nxt; int ui = 0;
    if (!S.next(0, cur)) return;
    constexpr int BIAS_OFF = 151552;
#define PG8_BIAS(u_, ui_) do { if constexpr (Epi::LDSBIAS) { if (wid == 0) __builtin_amdgcn_global_load_lds((const unsigned*)(E.bias_ptr(u_) + 4 * lane), (LAS unsigned*)(lds + BIAS_OFF + ((ui_) & 1) * 1024), 16, 0, 0); } } while (0)
    PG8_BIAS(cur, 0);
    f32x4 acc[2][2][4][2];
#pragma unroll
    for (int a = 0; a < 2; ++a)
#pragma unroll
        for (int b = 0; b < 2; ++b)
#pragma unroll
            for (int m = 0; m < 4; ++m)
#pragma unroll
                for (int n = 0; n < 2; ++n) acc[a][b][m][n] = (f32x4){0.f, 0.f, 0.f, 0.f};
    int scale1_ = 0x7F7F7F7F; asm volatile("" : "+v"(scale1_));
    bf16x8 At[4][2], B0[2][2], B1[2][2];
    v8i_t At8[4], B08[2], B18[2];
    const char* cA = (const char*)g.A + S.aoff(cur); const char* cB = (const char*)g.Bt + S.boff(cur);
    if constexpr (SP2) {
        PG8_GLOAD(cG0, cG1, 0);
        PG8_STAGE(PG8_SB(0, 0), cB, voffB); PG8_STAGE(PG8_SB(0, 1), cB + hstepB, voffB); PG8_STAGE_A(PG8_SA(0, 0), cA, 0, false); PG8_STAGE_A(PG8_SA(0, 1), cA, 1, false);
        if (wr == 1) PG8_BAR;
        PG8_WAIT_V(2); PG8_BAR;
        PG8_STAGE(PG8_SB(1, 0), cB + kstep, voffB); PG8_STAGE_A(PG8_SA(1, 0), cA + kstep, 0, false); PG8_STAGE(PG8_SB(1, 1), cB + hstepB + kstep, voffB);
        PG8_WAIT_V(6); PG8_BAR;
    } else {
        PG8_STAGE(PG8_SB(0, 0), cB, voffB); PG8_STAGE(PG8_SA(0, 0), cA, voffA); PG8_STAGE(PG8_SB(0, 1), cB + hstepB, voffB); PG8_STAGE(PG8_SA(0, 1), cA + hstepA, voffA);
        if (wr == 1) PG8_BAR;
        PG8_WAIT_V(4); PG8_BAR;
        PG8_STAGE(PG8_SB(1, 0), cB + kstep, voffB); PG8_STAGE(PG8_SA(1, 0), cA + kstep, voffA); PG8_STAGE(PG8_SB(1, 1), cB + hstepB + kstep, voffB);
        PG8_WAIT_V(6); PG8_BAR;
    }
    for (;;) {
        const bool has_next = S.next(ui + 1, nxt);
        const char* nA = has_next ? (const char*)g.A + S.aoff(nxt) : cA; const char* nB = has_next ? (const char*)g.Bt + S.boff(nxt) : cB;
        if constexpr (GATHER) { if (has_next) PG8_GLOAD(nG0, nG1, ui + 1); else { nG0[0] = cG0[0]; nG0[1] = cG0[1]; nG1[0] = cG1[0]; nG1[1] = cG1[1]; } }
#pragma unroll 1
        for (int t = 0; t < nt; t += 2) {
            const bool last = (t == nt - 2);
            const char* a1 = cA + (size_t)(t + 1) * kstep;
            const char* a2 = last ? nA : cA + (size_t)(t + 2) * kstep; const char* b2 = last ? nB : cB + (size_t)(t + 2) * kstep;
            const char* a3 = a2 + kstep; const char* b3 = b2 + kstep;
            if constexpr (SP2) {
            PG8_LDB(B0, 0, 0); PG8_LDB(B1, 0, 1); PG8_SCHED; PG8_LDA(At, 0, 0); PG8_STAGE_A(PG8_SA(1, 1), a1, 1, false);
            PG8_WAIT_V(8); PG8_WAIT_L(0); PG8_BAR; PG8_MMA(0, 0, At, B0); PG8_MMA(0, 1, At, B1); PG8_BAR; PG8_SCHED;
            PG8_LDA(At, 0, 1); PG8_STAGE(PG8_SB(0, 0), b2, voffB); PG8_STAGE(PG8_SB(0, 1), b2 + hstepB, voffB); PG8_STAGE_A(PG8_SA(0, 0), a2, 0, last);
            PG8_WAIT_V(8); PG8_WAIT_L(0); PG8_BAR; PG8_MMA(1, 0, At, B0); PG8_MMA(1, 1, At, B1); PG8_BAR; PG8_SCHED;
            PG8_LDB(B0, 1, 0); PG8_LDB(B1, 1, 1); PG8_SCHED; PG8_LDA(At, 1, 0); PG8_STAGE_A(PG8_SA(0, 1), a2, 1, last);
            PG8_WAIT_V(8); PG8_WAIT_L(0); PG8_BAR; PG8_MMA(0, 0, At, B0); PG8_MMA(0, 1, At, B1); PG8_BAR; PG8_SCHED;
            PG8_LDA(At, 1, 1); PG8_STAGE(PG8_SB(1, 0), b3, voffB); PG8_STAGE(PG8_SB(1, 1), b3 + hstepB, voffB); PG8_STAGE_A(PG8_SA(1, 0), a3, 0, last);
            PG8_WAIT_V(8); PG8_WAIT_L(0); PG8_BAR; PG8_MMA(1, 0, At, B0); PG8_MMA(1, 1, At, B1); PG8_BAR; PG8_SCHED;
            } else {
            PG8_LDB(B0, 0, 0); PG8_SCHED; PG8_LDA(At, 0, 0); PG8_STAGE(PG8_SA(1, 1), a1 + hstepA, voffA);
            PG8_WAIT_L(8); PG8_BAR; PG8_WAIT_L(0); PG8_MMA(0, 0, At, B0); PG8_BAR; PG8_SCHED;
            PG8_LDB(B1, 0, 1); PG8_STAGE(PG8_SB(0, 0), b2, voffB);
            PG8_BAR; PG8_WAIT_L(0); PG8_MMA(0, 1, At, B1); PG8_BAR;
            PG8_LDA(At, 0, 1); PG8_STAGE(PG8_SA(0, 0), a2, voffA);
            PG8_BAR; PG8_WAIT_L(0); PG8_MMA(1, 0, At, B0); PG8_BAR; PG8_SCHED;
            PG8_STAGE(PG8_SB(0, 1), b2 + hstepB, voffB);
            PG8_WAIT_V(6); PG8_BAR; PG8_MMA(1, 1, At, B1); PG8_BAR;
            PG8_LDB(B0, 1, 0); PG8_SCHED; PG8_LDA(At, 1, 0); PG8_STAGE(PG8_SA(0, 1), a2 + hstepA, voffA);
            PG8_WAIT_L(8); PG8_BAR; PG8_WAIT_L(0); PG8_MMA(0, 0, At, B0); PG8_BAR; PG8_SCHED;
            PG8_LDB(B1, 1, 1); PG8_STAGE(PG8_SB(1, 0), b3, voffB);
            PG8_BAR; PG8_WAIT_L(0); PG8_MMA(0, 1, At, B1); PG8_BAR;
            PG8_LDA(At, 1, 1); PG8_STAGE(PG8_SA(1, 0), a3, voffA);
            PG8_BAR; PG8_WAIT_L(0); PG8_MMA(1, 0, At, B0); PG8_BAR; PG8_SCHED;
            PG8_STAGE(PG8_SB(1, 1), b3 + hstepB, voffB);
            PG8_WAIT_V(6); PG8_BAR; PG8_MMA(1, 1, At, B1); PG8_BAR;
            }
        }
        if constexpr (ALIGN_EPI) { if (wr == 0) PG8_BAR; }
        if constexpr (FP8) asm volatile("s_nop 15\n\ts_nop 15" ::: "memory");
        if constexpr (Epi::LDSBIAS) E(acc, cur, wr, wc, fr, fq, (const LAS float*)(lds + BIAS_OFF + (ui & 1) * 1024)); else E(acc, cur, wr, wc, fr, fq);
        if (!has_next) break;
#pragma unroll
        for (int a = 0; a < 2; ++a)
#pragma unroll
            for (int b = 0; b < 2; ++b)
#pragma unroll
                for (int m = 0; m < 4; ++m)
#pragma unroll
                    for (int n = 0; n < 2; ++n) acc[a][b][m][n] = (f32x4){0.f, 0.f, 0.f, 0.f};
        cur = nxt; cA = nA; cB = nB; ++ui; PG8_BIAS(cur, ui);
        if constexpr (GATHER) { cG0[0] = nG0[0]; cG0[1] = nG0[1]; cG1[0] = nG1[0]; cG1[1] = nG1[1]; }
        if constexpr (ALIGN_EPI) { if (wr == 1) PG8_BAR; }
    }
    PG8_WAIT_V(0);
    if constexpr (!ALIGN_EPI) { if (wr == 0) PG8_BAR; }
    PG8_BAR;
#undef PG8_SA
#undef PG8_SB
#undef PG8_STAGE
#undef PG8_STAGE_A
#undef PG8_GLOAD
#undef PG8_LDA
#undef PG8_LDB
#undef PG8_MMA
#undef PG8_WAIT_V
#undef PG8_WAIT_L
#undef PG8_BIAS
#undef PG8_BAR
#undef PG8_SCHED
}

struct EpiF32 {
    static constexpr int PERM = 0;
    static constexpr bool LDSBIAS = false;
    float* C; int ldc;
    __device__ __forceinline__ void operator()(const f32x4 (&acc)[2][2][4][2], const Unit& u, int wr, int wc, int fr, int fq) const {
        const int row0 = u.pm * BM + wr * 64 + fr, col0 = u.pn * BM + wc * 32 + 4 * fq;
#pragma unroll
        for (int ai = 0; ai < 2; ++ai)
#pragma unroll
            for (int m = 0; m < 4; ++m) { float* rowp = C + (size_t)(row0 + ai * HALF + m * 16) * ldc + col0;
#pragma unroll
                for (int bj = 0; bj < 2; ++bj)
#pragma unroll
                    for (int n = 0; n < 2; ++n) *(f32x4*)(rowp + bj * HALF + n * 16) = acc[ai][bj][m][n]; }
    }
};
struct EpiBf16Plain {
    static constexpr int PERM = 2;
    static constexpr bool LDSBIAS = false;
    bf16_t* O; int ldc;
    __device__ __forceinline__ void operator()(const f32x4 (&acc)[2][2][4][2], const Unit& u, int wr, int wc, int fr, int fq) const {
        const int row0 = u.pm * BM + wr * 64 + fr, col0 = u.pn * BM + wc * 64 + 16 * fq;
#pragma unroll
        for (int ai = 0; ai < 2; ++ai)
#pragma unroll
            for (int m = 0; m < 4; ++m) { bf16_t* rowp = O + (size_t)(row0 + ai * HALF + m * 16) * ldc + col0;
#pragma unroll
                for (int bj = 0; bj < 2; ++bj) { const f32x4 v0 = acc[ai][bj][m][0], v1 = acc[ai][bj][m][1];
                    u32x4 w; w.x = cvt_pk_bf16(v0[0], v0[1]); w.y = cvt_pk_bf16(v0[2], v0[3]); w.z = cvt_pk_bf16(v1[0], v1[1]); w.w = cvt_pk_bf16(v1[2], v1[3]);
                    *(u32x4*)(rowp + bj * 8) = w; } }
    }
};
struct EpiPool {
    static constexpr int PERM = 2;
    static constexpr bool LDSBIAS = false;
    bf16_t* O; const float* scale;
    __device__ __forceinline__ void operator()(const f32x4 (&acc)[2][2][4][2], const Unit& u, int wr, int wc, int fr, int fq) const {
        const int row0 = u.pm * BM + wr * 64 + fr; int col0 = u.pn * BM + wc * 64 + 16 * fq;
        asm volatile("" : "+v"(col0));
        f32x4 sv[2][2];
#pragma unroll
        for (int bj = 0; bj < 2; ++bj)
#pragma unroll
            for (int n = 0; n < 2; ++n) sv[bj][n] = *(const f32x4*)(scale + col0 + 8 * bj + 4 * n);
#pragma unroll
        for (int ai = 0; ai < 2; ++ai)
#pragma unroll
            for (int m = 0; m < 4; ++m) { bf16_t* rowp = O + (size_t)(row0 + ai * HALF + m * 16) * 2048 + 1024 + col0;
#pragma unroll
                for (int bj = 0; bj < 2; ++bj) { const f32x4 v0 = acc[ai][bj][m][0] * sv[bj][0], v1 = acc[ai][bj][m][1] * sv[bj][1];
                    u32x4 w; w.x = cvt_pk_bf16(v0[0], v0[1]); w.y = cvt_pk_bf16(v0[2], v0[3]); w.z = cvt_pk_bf16(v1[0], v1[1]); w.w = cvt_pk_bf16(v1[2], v1[3]);
                    *(u32x4*)(rowp + bj * 8) = w; } }
    }
};
constexpr float XS_SCALE = 8.0f, W_SCALE = 256.0f, ACT_SCALE = 8.0f, DESCALE = 1.0f / 2048.0f;
__device__ __forceinline__ unsigned pk4_fp8(float a, float b, float c, float d) {
    a = __builtin_amdgcn_fmed3f(a, -448.f, 448.f); b = __builtin_amdgcn_fmed3f(b, -448.f, 448.f); c = __builtin_amdgcn_fmed3f(c, -448.f, 448.f); d = __builtin_amdgcn_fmed3f(d, -448.f, 448.f);
    int w = 0; w = __builtin_amdgcn_cvt_pk_fp8_f32(a, b, w, false); w = __builtin_amdgcn_cvt_pk_fp8_f32(c, d, w, true); return (unsigned)w;
}
struct EpiSwiglu {
    static constexpr int PERM = 2;
    static constexpr bool LDSBIAS = true;
    unsigned char* O; const float* b1;
    __device__ __forceinline__ const float* bias_ptr(const Unit& u) const { return b1 + (size_t)(u.pn >> 4) * 4096 + (u.pn & 15) * BM; }
    __device__ __forceinline__ void operator()(const f32x4 (&acc)[2][2][4][2], const Unit& u, int wr, int wc, int fr, int fq, const LAS float* bl) const {
        const int nt = u.pn & 15;
        const int row0 = u.pm * BM + wr * 64 + fr; int col0 = nt * BM + wc * 64 + 16 * fq;
        asm volatile("" : "+v"(col0));
        f32x4 bv[2][2];
#pragma unroll
        for (int bj = 0; bj < 2; ++bj)
#pragma unroll
            for (int n = 0; n < 2; ++n) bv[bj][n] = *(const LAS f32x4*)(bl + (col0 & 255) + 8 * bj + 4 * n);
#pragma unroll
        for (int ai = 0; ai < 2; ++ai)
#pragma unroll
            for (int m = 0; m < 4; ++m) { unsigned char* rowp = O + (size_t)(row0 + ai * HALF + m * 16) * 2048 + (col0 >> 1);
                v2u wv;
#pragma unroll
                for (int bj = 0; bj < 2; ++bj) { const f32x4 v0 = acc[ai][bj][m][0] * DESCALE + bv[bj][0], v1 = acc[ai][bj][m][1] * DESCALE + bv[bj][1];
                    const f32x2n g01 = {fminf(v0[0], 7.0f), fminf(v0[2], 7.0f)}, g23 = {fminf(v1[0], 7.0f), fminf(v1[2], 7.0f)};
                    const f32x2n l01 = {__builtin_amdgcn_fmed3f(v0[1], -7.0f, 7.0f), __builtin_amdgcn_fmed3f(v0[3], -7.0f, 7.0f)}, l23 = {__builtin_amdgcn_fmed3f(v1[1], -7.0f, 7.0f), __builtin_amdgcn_fmed3f(v1[3], -7.0f, 7.0f)};
                    const f32x2n t01 = g01 * (-1.702f * 1.4426950408889634f), t23 = g23 * (-1.702f * 1.4426950408889634f);
                    const f32x2n d01 = (f32x2n){__builtin_amdgcn_exp2f(t01.x), __builtin_amdgcn_exp2f(t01.y)} + 1.0f, d23 = (f32x2n){__builtin_amdgcn_exp2f(t23.x), __builtin_amdgcn_exp2f(t23.y)} + 1.0f;
                    const f32x2n a01 = (g01 * (f32x2n){__builtin_amdgcn_rcpf(d01.x), __builtin_amdgcn_rcpf(d01.y)}) * (l01 * ACT_SCALE + ACT_SCALE), a23 = (g23 * (f32x2n){__builtin_amdgcn_rcpf(d23.x), __builtin_amdgcn_rcpf(d23.y)}) * (l23 * ACT_SCALE + ACT_SCALE);
                    int w = 0; w = __builtin_amdgcn_cvt_pk_fp8_f32(a01.x, a01.y, w, false); w = __builtin_amdgcn_cvt_pk_fp8_f32(a23.x, a23.y, w, true);
                    if (bj == 0) wv.x = (unsigned)w; else wv.y = (unsigned)w; }
                *(v2u*)rowp = wv; }
    }
};
constexpr float YS_SCALE = 16.0f;
struct EpiBias8 {
    static constexpr int PERM = 2;
    static constexpr bool LDSBIAS = true;
    unsigned char* O; const float* b2;
    __device__ __forceinline__ const float* bias_ptr(const Unit& u) const { return b2 + (size_t)(u.pn >> 3) * 2048 + (u.pn & 7) * BM; }
    __device__ __forceinline__ void operator()(const f32x4 (&acc)[2][2][4][2], const Unit& u, int wr, int wc, int fr, int fq, const LAS float* bl) const {
        const int nt = u.pn & 7;
        const int row0 = u.pm * BM + wr * 64 + fr; int col0 = nt * BM + wc * 64 + 16 * fq;
        asm volatile("" : "+v"(col0));
        f32x4 bv[2][2];
#pragma unroll
        for (int bj = 0; bj < 2; ++bj)
#pragma unroll
            for (int n = 0; n < 2; ++n) bv[bj][n] = *(const LAS f32x4*)(bl + (col0 & 255) + 8 * bj + 4 * n) * YS_SCALE;
#pragma unroll
        for (int ai = 0; ai < 2; ++ai)
#pragma unroll
            for (int m = 0; m < 4; ++m) { unsigned char* rowp = O + (size_t)(row0 + ai * HALF + m * 16) * 2048 + col0;
                const f32x4 v00 = acc[ai][0][m][0] * (DESCALE * YS_SCALE) + bv[0][0], v01 = acc[ai][0][m][1] * (DESCALE * YS_SCALE) + bv[0][1];
                const f32x4 v10 = acc[ai][1][m][0] * (DESCALE * YS_SCALE) + bv[1][0], v11 = acc[ai][1][m][1] * (DESCALE * YS_SCALE) + bv[1][1];
                u32x4 w; w.x = pk4_fp8(v00[0], v00[1], v00[2], v00[3]); w.y = pk4_fp8(v01[0], v01[1], v01[2], v01[3]); w.z = pk4_fp8(v10[0], v10[1], v10[2], v10[3]); w.w = pk4_fp8(v11[0], v11[1], v11[2], v11[3]);
                *(u32x4*)rowp = w; }
    }
};
}

#define XB_TMO      128
#define XB_XCNT(j)  (256  + 64 * (j))
#define XB_XSUB(j)  (1280 + 64 * (j))
#define XB_XGEN(j)  (2304 + 64 * (j))
#define XB_TOP      3328
#define XB_TOPGEN   3392
#define XCD_BAR_WORDS 3456
#define XB_SPIN_CAP (1u << 22)
__device__ __forceinline__ unsigned xb_ld(unsigned* p)              { return __hip_atomic_load(p, __ATOMIC_RELAXED, __HIP_MEMORY_SCOPE_AGENT); }
__device__ __forceinline__ unsigned xb_add(unsigned* p, unsigned v) { return __hip_atomic_fetch_add(p, v, __ATOMIC_RELAXED, __HIP_MEMORY_SCOPE_AGENT); }
__device__ __forceinline__ unsigned xb_xcc_id() { return (unsigned)__builtin_amdgcn_s_getreg((3 << 11) | 20) & 0xFu; }
#define XB_SPIN(cond, bar) do { unsigned _sp = 0; while (cond) { __builtin_amdgcn_s_sleep(1); \
    if ((++_sp & 255u) == 0u) { if (xb_ld(&(bar)[XB_TMO])) break; if (_sp > XB_SPIN_CAP) { atomicAdd(&(bar)[XB_TMO], 1u); break; } } } } while (0)
struct XcdBarrier { unsigned* bar; unsigned x; volatile LAS unsigned* st; };
__device__ __forceinline__ XcdBarrier xcd_barrier_post(unsigned* bar, volatile LAS unsigned* st) {
    XcdBarrier b; b.bar = bar; b.x = xb_xcc_id(); b.st = st;
    if (threadIdx.x == 0) (void)xb_add(&bar[XB_XCNT(b.x)], 1u);
    return b;
}
__device__ __forceinline__ void xcd_barrier_complete(unsigned* bar, unsigned x, unsigned& nloc, unsigned& nx) {
    const unsigned G = gridDim.x * gridDim.y * gridDim.z;
    unsigned sum, cnt, mine, sp = 0u;
    for (;;) {
        sum = 0u; cnt = 0u; mine = 0u;
#pragma unroll
        for (unsigned j = 0; j < 16; ++j) { const unsigned c = xb_ld(&bar[XB_XCNT(j)]); sum += c; cnt += (c > 0u) ? 1u : 0u; mine = (j == x) ? c : mine; }
        if (sum == G) break;
        __builtin_amdgcn_s_sleep(1);
        if ((++sp & 255u) == 0u) { if (xb_ld(&bar[XB_TMO])) break; if (sp > XB_SPIN_CAP) { atomicAdd(&bar[XB_TMO], 1u); break; } }
    }
    nloc = mine > 0u ? mine : 1u; nx = cnt > 0u ? cnt : 1u;
}
__device__ __forceinline__ void xcd_barrier(const XcdBarrier& b) {
    asm volatile("s_waitcnt vmcnt(0)" ::: "memory");
    __syncthreads();
    if (threadIdx.x == 0) {
        unsigned* bar = b.bar;
        __builtin_amdgcn_s_waitcnt(0);
        unsigned nloc = b.st[0], nx = b.st[1];
        if (nloc == 0u) { xcd_barrier_complete(bar, b.x, nloc, nx); b.st[0] = nloc; b.st[1] = nx; }
        const unsigned old = xb_add(&bar[XB_XSUB(b.x)], 1u);
        const unsigned gen = old / nloc;
        if (old + 1u == (gen + 1u) * nloc) {
            __builtin_amdgcn_fence(__ATOMIC_RELEASE, "agent");
            asm volatile("s_waitcnt vmcnt(0)" ::: "memory");
            const unsigned og = xb_add(&bar[XB_TOP], 1u);
            const unsigned tg = og / nx;
            if (og + 1u == (tg + 1u) * nx) xb_add(&bar[XB_TOPGEN], 1u);
            else XB_SPIN(xb_ld(&bar[XB_TOPGEN]) == tg, bar);
            __builtin_amdgcn_fence(__ATOMIC_ACQUIRE, "agent");
            xb_add(&bar[XB_XGEN(b.x)], 1u);
            asm volatile("s_waitcnt vmcnt(0)" ::: "memory");
        } else {
            XB_SPIN(xb_ld(&bar[XB_XGEN(b.x)]) == gen, bar);
            __builtin_amdgcn_fence(__ATOMIC_ACQUIRE, "agent");
            asm volatile("s_waitcnt vmcnt(0)" ::: "memory");
        }
    }
    __syncthreads();
}

constexpr size_t al256(size_t x) { return (x + 255) & ~(size_t)255; }
constexpr size_t WS_CTL = 0, CTL_BYTES = 1u << 20;
constexpr int CW_BAR = 4096;
static_assert((CW_BAR + XCD_BAR_WORDS) * 4 <= 32768, "barrier words inside the zeroed prefix");
constexpr int CW_CNT = 16384;
constexpr size_t WS_SLOTTOK = WS_CTL + CTL_BYTES;
constexpr size_t WS_TOPI = WS_SLOTTOK + al256((size_t)NSLOT_MAX * 4);
constexpr size_t WS_GATE = WS_TOPI + (size_t)NASG * 4;
constexpr size_t WS_POS = WS_GATE + (size_t)NASG * 4;
constexpr size_t WS_SLOTOF = WS_POS + (size_t)NASG * 4;
constexpr size_t WS_BONUS = WS_SLOTOF + (size_t)NASG * 4;
constexpr size_t WS_XB = WS_BONUS + (size_t)M * 16 * 4;
constexpr size_t WS_WINT = WS_XB + (size_t)M * D * 2;
constexpr size_t WS_WOUTT = WS_WINT + (size_t)IN_PAD * D * 2;
constexpr size_t WS_LORAT = WS_WOUTT + (size_t)D * D * 2;
constexpr size_t WS_WPOOLT = WS_LORAT + (size_t)3072 * LK * 2;
constexpr size_t WS_PROJ = WS_WPOOLT + (size_t)1024 * 256 * 2;
constexpr size_t WS_LIN = WS_PROJ + (size_t)M * IN_PAD * 2;
constexpr size_t WS_POOLED = WS_LIN + (size_t)M * LK * 2;
constexpr size_t WS_WDEC = WS_POOLED + (size_t)M * 1024 * 2;
constexpr size_t SZ_F1K = (size_t)M * 1024 * 4;
constexpr size_t WS_LOUT = WS_WDEC + SZ_F1K  , WS_R = WS_LOUT + 3 * SZ_F1K, WS_K2 = WS_R + SZ_F1K, WS_V = WS_K2 + SZ_F1K, WS_KK = WS_V + SZ_F1K, WS_BB = WS_KK + SZ_F1K, WS_Y = WS_BB + SZ_F1K;
constexpr size_t WS_MIXIN = WS_Y + SZ_F1K;
constexpr size_t WS_MIX = WS_MIXIN + (size_t)M * D * 2;
constexpr size_t WS_H = WS_MIX + (size_t)M * D * 4;
constexpr size_t WS_HB = WS_H + (size_t)M * D * 4;
constexpr size_t WS_XS = WS_HB + (size_t)M * D;
constexpr size_t WS_W1T = WS_XS + (size_t)NSLOT_MAX * D;
constexpr size_t WS_W2T = WS_W1T + (size_t)NE * 4096 * D;
constexpr size_t WS_ACT = WS_W2T + (size_t)NE * 2048 * DFF;
constexpr size_t WS_YS = WS_ACT + (size_t)NSLOT_MAX * DFF;
constexpr size_t WS_END = WS_YS + (size_t)NSLOT_MAX * D * 2;

constexpr int RING_BYTES = 131072;
constexpr int LDSCTL_OFF = 159744;
constexpr int LDS_BYTES = 163840;

struct Args { const float* in[26]; float* out; unsigned char* ws; int ph_lo, ph_hi, dup, pad; };

template <bool KFAST = false> __device__ __forceinline__ void tr_load(const float* W, int N, int item, int lane, f32x4 (&v)[16]) {
    const int nblk = N / 64, kb = KFAST ? (item & 31) : item / nblk, nb = KFAST ? (item >> 5) : item % nblk, k0 = 64 * kb, n0 = 64 * nb;
    const int r = lane >> 4, c4 = (lane & 15) * 4;
#pragma unroll
    for (int i = 0; i < 16; ++i) v[i] = *(const GAS f32x4*)(W + (size_t)(k0 + 4 * i + r) * N + n0 + c4);
}
__device__ __forceinline__ void tr_store(const f32x4 (&v)[16], int K, int N, bf16* WT, size_t row_off, LAS float* scr, int item, int lane) {
    const int nblk = N / 64, kb = item / nblk, nb = item % nblk, k0 = 64 * kb, n0 = 64 * nb;
    const int r = lane >> 4, c4 = (lane & 15) * 4;
#pragma unroll
    for (int i = 0; i < 16; ++i) { LAS float* d = scr + (4 * i + r) * 65 + c4; d[0] = v[i].x; d[1] = v[i].y; d[2] = v[i].z; d[3] = v[i].w; }
    LDS_WAIT(); asm volatile("" ::: "memory");
    const int c = lane & 7;
#pragma unroll
    for (int p = 0; p < 8; ++p) { const int n = (lane >> 3) + 8 * p; const LAS float* q = scr + (8 * c) * 65 + n;
        v4u o; o.x = pk2(q[0 * 65], q[1 * 65]); o.y = pk2(q[2 * 65], q[3 * 65]); o.z = pk2(q[4 * 65], q[5 * 65]); o.w = pk2(q[6 * 65], q[7 * 65]);
        *(GAS v4u*)(WT + (row_off + n0 + n) * (size_t)K + k0 + 8 * c) = o; }
    LDS_WAIT(); asm volatile("" ::: "memory");
}
__device__ __forceinline__ unsigned pk4_fp8_nc(float a, float b, float c, float d) { int w = 0; w = __builtin_amdgcn_cvt_pk_fp8_f32(a, b, w, false); w = __builtin_amdgcn_cvt_pk_fp8_f32(c, d, w, true); return (unsigned)w; }
__device__ __forceinline__ void tr_store_fp8(const f32x4 (&v)[16], int K, int N, unsigned char* WT, size_t row_off, LAS float* scr, int item, int lane, float scale) {
    const int nblk = N / 64, kb = item / nblk, nb = item % nblk, k0 = 64 * kb, n0 = 64 * nb;
    const int r = lane >> 4, c4 = (lane & 15) * 4;
#pragma unroll
    for (int i = 0; i < 16; ++i) { const int k = 4 * i + r; *(LAS f32x4*)(scr + k * 64 + (c4 ^ (8 * (i >> 2)))) = v[i] * scale; }
    LDS_WAIT(); asm volatile("" ::: "memory");
    const int c = lane & 3;
#pragma unroll
    for (int p = 0; p < 4; ++p) { const int n = (lane >> 2) + 16 * p; const LAS float* q = scr + (16 * c) * 64 + (n ^ (8 * c));
        float f[16];
#pragma unroll
        for (int jj = 0; jj < 16; ++jj) f[jj] = q[jj * 64];
        v4u o; o.x = pk4_fp8_nc(f[0], f[1], f[2], f[3]); o.y = pk4_fp8_nc(f[4], f[5], f[6], f[7]); o.z = pk4_fp8_nc(f[8], f[9], f[10], f[11]); o.w = pk4_fp8_nc(f[12], f[13], f[14], f[15]);
        *(GAS v4u*)(WT + (row_off + n0 + n) * (size_t)K + k0 + 16 * c) = o; }
    LDS_WAIT(); asm volatile("" ::: "memory");
}
constexpr int NHB = 4;
__device__ __forceinline__ void tr_load2(const float* W, int N, int fl, int hh, int lane, f32x4 (&v)[16]) {
    const int nblk = N / 64, kb = fl / nblk, nb = fl % nblk, k0 = 64 * NHB * kb + 64 * hh, n0 = 64 * nb;
    const int g = lane >> 4, c4 = (lane & 15) * 4;
#pragma unroll
    for (int i = 0; i < 16; ++i) v[i] = *(const GAS f32x4*)(W + (size_t)(k0 + 16 * (i >> 2) + 4 * g + (i & 3)) * N + n0 + c4);
}
__device__ __forceinline__ void tr_half(const f32x4 (&v)[16], int hh, LAS unsigned* img, int lane, float scale) {
    const int g = lane >> 4, m = lane & 15;
#pragma unroll
    for (int j = 0; j < 4; ++j) { const f32x4 a = v[4 * j] * scale, b = v[4 * j + 1] * scale, c = v[4 * j + 2] * scale, d = v[4 * j + 3] * scale;
        const int dwi = (16 * hh + 4 * j + g) ^ ((m & 7) << 2);
        img[(4 * m + 0) * (16 * NHB) + dwi] = pk4_fp8_nc(a.x, b.x, c.x, d.x); img[(4 * m + 1) * (16 * NHB) + dwi] = pk4_fp8_nc(a.y, b.y, c.y, d.y);
        img[(4 * m + 2) * (16 * NHB) + dwi] = pk4_fp8_nc(a.z, b.z, c.z, d.z); img[(4 * m + 3) * (16 * NHB) + dwi] = pk4_fp8_nc(a.w, b.w, c.w, d.w); }
}
__device__ __forceinline__ void tr_flush(LAS unsigned* img, int K, int N, unsigned char* WT, size_t row_off, int fl, int lane) {
    const int nblk = N / 64, kb = fl / nblk, nb = fl % nblk, k0 = 64 * NHB * kb, n0 = 64 * nb;
    LDS_WAIT(); asm volatile("" ::: "memory");
    constexpr int CPR = 4 * NHB, RPP = 64 / CPR;
    const int c = lane % CPR;
#pragma unroll 4
    for (int p = 0; p < CPR; ++p) { const int n = lane / CPR + RPP * p;
        const v4u o = *(const LAS v4u*)(img + n * (16 * NHB) + 4 * (c ^ ((n >> 2) & 7)));
        *(GAS v4u*)(WT + (row_off + n0 + n) * (size_t)K + k0 + 16 * c) = o; }
    LDS_WAIT(); asm volatile("" ::: "memory");
}
__device__ __forceinline__ void transpose_item(const float* W, int K, int N, bf16* WT, size_t row_off, LAS float* scr, int item, int lane) {
    f32x4 v[16]; tr_load(W, N, item, lane, v); tr_store(v, K, N, WT, row_off, scr, item, lane);
}

__global__ void __launch_bounds__(NTHR, 2) mk_fwd(Args args) {
    extern __shared__ __attribute__((aligned(16))) unsigned char lds_raw[];
    LAS unsigned char* lds = (LAS unsigned char*)lds_raw;
    volatile LAS unsigned* MISC = (volatile LAS unsigned*)(lds + LDSCTL_OFF);
    LAS int* PS = (LAS int*)(lds + LDSCTL_OFF + 256);
    const int tid = threadIdx.x, lane = tid & 63, wave = __builtin_amdgcn_readfirstlane(tid >> 6);
    const int G = gridDim.x, bx = blockIdx.x;
    const int vcu = (bx % 8) * (G / 8) + bx / 8;
    const int gw = vcu * NWAVES + wave, NGW = G * NWAVES;
    unsigned char* ws = args.ws;
    gu32* ctl = (gu32*)(ws + WS_CTL);
    const float* x = args.in[0]; const float* w_in = args.in[1]; const float* mu = args.in[2]; const float* w0 = args.in[3]; const float* w2d = args.in[4];
    const float* a0 = args.in[5]; const float* a2 = args.in[6]; const float* g2 = args.in[7]; const float* k_k = args.in[8]; const float* k_a = args.in[9];
    const float* r_k = args.in[10]; const float* lnx_w = args.in[11]; const float* lnx_b = args.in[12]; const float* w_pool = args.in[13]; const float* pool_scale = args.in[14];
    const float* w_out = args.in[15]; const float* ln1_w = args.in[16]; const float* ln1_b = args.in[17]; const float* router_w = args.in[18]; const float* router_b = args.in[19];
    const float* w1 = args.in[20]; const float* b1 = args.in[21]; const float* w2 = args.in[22]; const float* b2 = args.in[23]; const float* ln2_w = args.in[24]; const float* ln2_b = args.in[25];
    float* out = args.out;
    int* CNTWG = (int*)(ws + WS_CTL) + CW_CNT;
    int* slot_tok = (int*)(ws + WS_SLOTTOK); int* TOPI = (int*)(ws + WS_TOPI); float* GATE = (float*)(ws + WS_GATE); int* POS = (int*)(ws + WS_POS); int* SLOT_OF = (int*)(ws + WS_SLOTOF);
    float* BONUS = (float*)(ws + WS_BONUS);
    bf16* XB = (bf16*)(ws + WS_XB); bf16* WINT = (bf16*)(ws + WS_WINT); bf16* WOUTT = (bf16*)(ws + WS_WOUTT); bf16* LORAT = (bf16*)(ws + WS_LORAT); bf16* WPOOLT = (bf16*)(ws + WS_WPOOLT);
    bf16* PROJ = (bf16*)(ws + WS_PROJ); bf16* LIN = (bf16*)(ws + WS_LIN); bf16* POOLED = (bf16*)(ws + WS_POOLED);
    float* WDEC = (float*)(ws + WS_WDEC); float* LOUT = (float*)(ws + WS_LOUT); bf16* LOUTB = (bf16*)(ws + WS_LOUT);
    float* Vv = (float*)(ws + WS_V); float* KK = (float*)(ws + WS_KK); float* BB = (float*)(ws + WS_BB); float* Yy = (float*)(ws + WS_Y);
    bf16* MIXIN = (bf16*)(ws + WS_MIXIN); bf16* MIX = (bf16*)(ws + WS_MIX); bf16* H = (bf16*)(ws + WS_H); unsigned char* HQ = (unsigned char*)(ws + WS_HB);
    unsigned char* XS = ws + WS_XS; unsigned char* W1T = ws + WS_W1T; unsigned char* W2T = ws + WS_W2T; unsigned char* ACT = ws + WS_ACT; unsigned char* YS = ws + WS_YS;

    for (int u = tid; u < (LDS_BYTES - LDSCTL_OFF) / 4; u += NTHR) ((LAS unsigned*)(lds + LDSCTL_OFF))[u] = 0u;
    __syncthreads();
    XcdBarrier bar; bar.bar = (unsigned*)(ctl + CW_BAR); bar.x = 0; bar.st = nullptr;
    if (MK_N_LAUNCHES == 1) bar = xcd_barrier_post((unsigned*)(ctl + CW_BAR), MISC + 8);
    const int lo = args.ph_lo, hi = args.ph_hi;
#ifndef PHASE_MASK
#define PHASE_MASK 0xFFFF
#endif
#define IN(k) (((PHASE_MASK >> (k)) & 1) && lo <= (k) && (k) < hi)
#define SEAM(k) do { if (IN(k) && IN((k) + 1)) xcd_barrier(bar); } while (0)

    if (IN(0)) {
        LAS float* scr = (LAS float*)(lds + wave * 16640);
        for (size_t i = (size_t)gw * 64 + lane; i < (size_t)M * D / 8; i += (size_t)NGW * 64) {
            const f32x4 a = *(const GAS f32x4*)(x + i * 8), b = *(const GAS f32x4*)(x + i * 8 + 4);
            v4u o; o.x = pk2(a.x, a.y); o.y = pk2(a.z, a.w); o.z = pk2(b.x, b.y); o.w = pk2(b.z, b.w);
            *(GAS v4u*)(XB + i * 8) = o;
        }
        constexpr int I_IN = (D / 64) * (IN_COLS / 64)  , I_OUT = (D / 64) * (D / 64);
        for (int it = gw; it < I_IN; it += NGW) transpose_item(w_in, D, IN_COLS, WINT, 0, scr, it, lane);
        (void)I_OUT;
        for (int i = gw * 64 + lane; i < 32 * D; i += NGW * 64) { const int nn = 4352 + (i >> 11), k = i & 2047; WINT[(size_t)nn * D + k] = (bf16)f2bf(w_in[(size_t)k * IN_COLS + nn]); }
        for (size_t i = (size_t)gw * 64 + lane; i < (size_t)(IN_PAD - IN_COLS) * D / 8; i += (size_t)NGW * 64) *(GAS v4u*)(WINT + (size_t)IN_COLS * D + i * 8) = (v4u){0u, 0u, 0u, 0u};
    }
    SEAM(0);

    if (IN(1)) {
        pg8::Gemm g{XB, WINT, D, D}; pg8::GridOrder S; S.init(M / 256, IN_PAD / 256, G, bx, (size_t)256 * D * 2, 0, (size_t)256 * D * 2);
        pg8::EpiBf16Plain E{PROJ, IN_PAD};
        pg8::gemm_phase<pg8::EpiBf16Plain, pg8::GridOrder, true, true>(lds, g, S, E);
        if (bx >= NWG / 2) {
            LAS float* scr = (LAS float*)(lds + wave * 16640);
            const int hw = (bx - NWG / 2) * NWAVES + wave; constexpr int HW = (NWG / 2) * NWAVES;
            for (int it = hw; it < (D / 64) * (D / 64); it += HW) transpose_item(w_out, D, D, WOUTT, 0, scr, it, lane);
        for (int i = hw * 64 + lane; i < 3072 * LK; i += HW * 64) {
            const int n = i / LK, k = i % LK; float v = 0.f;
            if (n < 1024) { if (k < 64) v = w2d[k * 1024 + n]; }
            else if (n < 2048) { if (k >= 64 && k < 128) v = a2[(k - 64) * 1024 + (n - 1024)]; }
            else { if (k >= 128 && k < 288) v = g2[(k - 128) * 1024 + (n - 2048)]; }
            LORAT[i] = (bf16)f2bf(v);
        }
        for (int i = hw * 64 + lane; i < 1024 * 256; i += HW * 64) {
            const int n = i >> 8, c = i & 255, g = n >> 8, d = n & 255;
            WPOOLT[i] = (bf16)f2bf(w_pool[((size_t)g * 256 + c) * 256 + d]);
        }
        }
    }
    SEAM(1);

    if (IN(2)) {
        const int m0 = gw * 8, t0 = m0 % SEQ;
        const float mu_l[5] = {mu[3072 + lane], mu[3072 + 64 + lane], mu[3072 + 128 + lane], mu[3072 + 192 + lane], lane < 32 ? mu[3072 + 256 + lane] : 0.f};
        float prevl[5]; bf16 rl[8][5]; v2u rc[8][4], pre[4][15];
#pragma unroll
        for (int q = 0; q < 5; ++q) { const int i = lane + 64 * q; prevl[q] = (i < 288 && t0 > 0) ? ld1bf(PROJ + (size_t)(m0 - 1) * IN_PAD + 3072 + i) : 0.f; }
#pragma unroll
        for (int i8 = 0; i8 < 8; ++i8) {
#pragma unroll
            for (int q = 0; q < 5; ++q) { const int i = lane + 64 * q; rl[i8][q] = i < 288 ? *(const GAS bf16*)(PROJ + (size_t)(m0 + i8) * IN_PAD + 3072 + i) : (bf16)0; }
#pragma unroll
            for (int q = 0; q < 4; ++q) rc[i8][q] = *(const GAS v2u*)(PROJ + (size_t)(m0 + i8) * IN_PAD + SHIFT_W + 4 * lane + 256 * q);
        }
#pragma unroll
        for (int q = 0; q < 4; ++q)
#pragma unroll
            for (int s = 1; s < (2 << q); ++s) pre[q][s - 1] = s <= t0 ? *(const GAS v2u*)(PROJ + (size_t)(m0 - s) * IN_PAD + SHIFT_W + 4 * lane + 256 * q) : (v2u){0u, 0u};
#define P2_UNPK(w_) ((f32x4){bflo((w_).x), bfhi((w_).x), bflo((w_).y), bfhi((w_).y)})
        f32x4 wsum[4];
#pragma unroll
        for (int q = 0; q < 4; ++q) { f32x4 sacc = (f32x4){0.f, 0.f, 0.f, 0.f};
#pragma unroll
            for (int s = 1; s < (2 << q); ++s) sacc += P2_UNPK(pre[q][s - 1]);
            wsum[q] = sacc; }
#pragma unroll
        for (int i8 = 0; i8 < 8; ++i8) {
            const int m = m0 + i8, t = t0 + i8;
#pragma unroll
            for (int q = 0; q < 6; ++q) {
                const int i = lane + 64 * q; float v = 0.f;
                if (q < 5) { if (i < 288) { const float cur = __builtin_bit_cast(float, (unsigned)rl[i8][q < 5 ? q : 0] << 16); const float s_ = cur + (prevl[q < 5 ? q : 0] - cur) * mu_l[q < 5 ? q : 0]; prevl[q < 5 ? q : 0] = cur;
                    v = i < 64 ? tanhf(s_) : (i < 128 ? s_ : 1.0f / (1.0f + __expf(-s_))); } }
                LIN[(size_t)m * LK + i] = (bf16)f2bf(v);
            }
#pragma unroll
            for (int q = 0; q < 4; ++q) {
                const int c = 4 * lane + 256 * q, win = 2 << q; const int n = (t + 1) < win ? (t + 1) : win;
                const f32x4 cur = P2_UNPK(rc[i8][q]);
                const f32x4 sum = wsum[q] + cur;
                const int d = i8 - win + 1;
                const f32x4 drop = d >= 0 ? P2_UNPK(rc[d >= 0 ? d : 0][q]) : P2_UNPK(pre[q][d < 0 ? -d - 1 : 0]);
                f32x4 nxt = sum; if (t + 1 >= win) nxt = sum - drop;
                wsum[q] = nxt;
                const float inv = 1.0f / (float)n; const f32x4 pv = sum * inv - cur;
                v2u o; o.x = pk2(pv.x, pv.y); o.y = pk2(pv.z, pv.w);
                *(GAS v2u*)(POOLED + (size_t)m * 1024 + c) = o;
            }
        }
#undef P2_UNPK
    }
    SEAM(2);

    if (IN(3)) {
#ifndef NO_LORA
        { pg8::Gemm g{LIN, LORAT, LK, LK}; pg8::GridOrder S; S.init(M / 256, 12, G, bx, (size_t)256 * LK * 2, 0, (size_t)256 * LK * 2);
          pg8::EpiBf16Plain E{LOUTB, 3072};
          pg8::gemm_phase<pg8::EpiBf16Plain, pg8::GridOrder, true, true>(lds, g, S, E); }
#endif
#ifndef NO_POOL
        { pg8::Gemm g{POOLED, WPOOLT, 1024, 256}; pg8::GridOrder S; S.init(M / 256, 4, G, bx, (size_t)256 * 1024 * 2, (size_t)256 * 2, (size_t)256 * 256 * 2);
          pg8::EpiPool E{MIXIN, pool_scale};
          pg8::gemm_phase<pg8::EpiPool, pg8::GridOrder, true, true>(lds, g, S, E); }
#endif
    }
    SEAM(3);

    if (IN(4)) {
        constexpr int CH = 16, NCHUNK = SEQ / CH;
        constexpr int PK_PA = 0, PK_PR = 2048, PK_QQ = 4096, PK_TT = 5120, PK_GG = 6144, PK_BK = 7168, PK_VT = 11264, PK_WC = 13312, PK_BON = 13568, PK_BYTES = 16384;
        const int tr = lane & 15, q = lane >> 4;
        for (int arep_ = 0; arep_ < P5A_REPS; ++arep_) {
                const int j = lane;
                LAS bf16* IMG = (LAS bf16*)(lds + wave * 13312);
                LAS bf16* QGT = (LAS bf16*)(lds + wave * 13312 + 10240);
                for (int i = lane; i < 768; i += 64) ((LAS unsigned*)QGT)[i] = 0u;
                const int pos = (j & 32) | ((j & 12) << 1) | ((j & 16) >> 2) | (j & 3);
                bf16 nr_[17], nk_[17], nv_[17], nwl_[16], nal_[16]; float ncst_[7];
#define P4_FETCH(u_) do { const int h_ = (u_) & 15, c_ = ((u_) >> 4) & 255, b_ = (u_) >> 12; const size_t m0_ = (size_t)b_ * SEQ + (size_t)c_ * CH; \
                    _Pragma("unroll") for (int t = 0; t < 17; ++t) { const size_t row_ = (t == 0 && c_ == 0) ? m0_ : m0_ + t - 1;            \
                        const GAS bf16* p_ = (const GAS bf16*)PROJ + row_ * IN_PAD + h_ * 64 + j; nr_[t] = p_[0]; nk_[t] = p_[1024]; nv_[t] = p_[2048]; } \
                    _Pragma("unroll") for (int t = 0; t < 16; ++t) { const GAS bf16* l_ = (const GAS bf16*)LOUTB + (m0_ + t) * 3072 + h_ * 64 + j; nwl_[t] = l_[0]; nal_[t] = l_[1024]; } \
                    { const int cj_ = h_ * 64 + j; ncst_[0] = mu[cj_]; ncst_[1] = mu[1024 + cj_]; ncst_[2] = mu[2048 + cj_]; ncst_[3] = w0[cj_]; ncst_[4] = a0[cj_]; ncst_[5] = k_k[cj_]; ncst_[6] = k_a[cj_]; } } while (0)
                if (gw < 64 * NCHUNK) P4_FETCH(gw);
#pragma unroll 1
                for (int u = gw; u < 64 * NCHUNK; u += NGW) {
                    const int h = u & 15, c = (u >> 4) & 255, b = u >> 12, hd = b * 16 + h;
                    const float mu_r = ncst_[0], mu_k = ncst_[1], mu_v = ncst_[2], c_w0 = ncst_[3], c_a0 = ncst_[4], c_kk = ncst_[5], c_ka = ncst_[6];
                    unsigned char* pk = ws + WS_R + ((size_t)hd * NCHUNK + c) * PK_BYTES;
                    float At[16], Rt[16], Bt[16], Kt[16], Vt[16];
                    float xr_[17], xk_[17], xv_[17], xwl_[16], xal_[16];
#pragma unroll
                    for (int t = 0; t < 17; ++t) { xr_[t] = __builtin_bit_cast(float, (unsigned)nr_[t] << 16); xk_[t] = __builtin_bit_cast(float, (unsigned)nk_[t] << 16); xv_[t] = __builtin_bit_cast(float, (unsigned)nv_[t] << 16); }
#pragma unroll
                    for (int t = 0; t < 16; ++t) { xwl_[t] = __builtin_bit_cast(float, (unsigned)nwl_[t] << 16); xal_[t] = __builtin_bit_cast(float, (unsigned)nal_[t] << 16); }
                    if (c == 0) { xr_[0] = 0.f; xk_[0] = 0.f; xv_[0] = 0.f; }
                    asm volatile("" ::: "memory");
                    if (u + NGW < 64 * NCHUNK) P4_FETCH(u + NGW);
                    float Wc = 1.f;
#pragma unroll
                    for (int t = 0; t < 16; ++t) {
                        const float cr = xr_[t + 1], ck = xk_[t + 1], cv = xv_[t + 1], wl = xwl_[t] + c_w0, al = xal_[t] + c_a0;
                        const float pr_r = xr_[t], pr_k = xk_[t], pr_v = xv_[t];
                        const float r = cr + (pr_r - cr) * mu_r, k = ck + (pr_k - ck) * mu_k, v = cv + (pr_v - cv) * mu_v;
                        const float dec = fast_decay(wl), a = fast_sigmoid(al);
                        float kk = k * c_kk; const float ss = wave_sum_dpp(kk * kk); kk = kk * __builtin_amdgcn_rsqf(fmaxf(ss, 1e-24f));
                        const float k2 = k * (1.0f + (a - 1.0f) * c_ka), bb = kk * a;
                        const float Wprev = Wc; Wc = Wc * dec; const float iw = __builtin_amdgcn_rcpf(Wc);
                        At[t] = -kk * Wprev; Rt[t] = r * Wc; Bt[t] = bb * iw; Kt[t] = k2 * iw; Vt[t] = v;
                    }
#pragma unroll
                    for (int t = 0; t < 16; ++t) {
                        const unsigned ar_ = cvt_pk_bf16_nat(At[t], Rt[t]), bk_ = cvt_pk_bf16_nat(Bt[t], Kt[t]); const bf16 ab = (bf16)ar_, rb = (bf16)(ar_ >> 16);
                        IMG[0 * 1152 + t * 72 + pos] = ab; IMG[1 * 1152 + t * 72 + pos] = rb; IMG[2 * 1152 + t * 72 + pos] = (bf16)bk_; IMG[3 * 1152 + t * 72 + pos] = (bf16)(bk_ >> 16);
                    }
#pragma unroll
                    for (int qq = 0; qq < 4; ++qq) { v4u o; o.x = pk2(Bt[4 * qq] * Wc, Bt[4 * qq + 1] * Wc); o.y = pk2(Bt[4 * qq + 2] * Wc, Bt[4 * qq + 3] * Wc); o.z = pk2(Kt[4 * qq] * Wc, Kt[4 * qq + 1] * Wc); o.w = pk2(Kt[4 * qq + 2] * Wc, Kt[4 * qq + 3] * Wc);
                        *(GAS v4u*)(pk + PK_BK + j * 64 + qq * 16) = o; }
#pragma unroll
                    for (int g = 0; g < 2; ++g) { v4u o; o.x = pk2(Vt[8 * g], Vt[8 * g + 1]); o.y = pk2(Vt[8 * g + 2], Vt[8 * g + 3]); o.z = pk2(Vt[8 * g + 4], Vt[8 * g + 5]); o.w = pk2(Vt[8 * g + 6], Vt[8 * g + 7]);
                        *(GAS v4u*)(pk + PK_VT + j * 32 + g * 16) = o; }
                    ((GAS float*)(pk + PK_WC))[j] = Wc;
                    asm volatile("s_waitcnt lgkmcnt(0)" ::: "memory");
#pragma unroll
                    for (int i = 0; i < 2; ++i) { const int p_ = lane + 64 * i, off_ = (p_ >> 3) * 72 + (p_ & 7) * 8;
                        *(GAS v4u*)(pk + PK_PA + p_ * 16) = *(const LAS v4u*)(IMG + 0 * 1152 + off_); *(GAS v4u*)(pk + PK_PR + p_ * 16) = *(const LAS v4u*)(IMG + 1 * 1152 + off_); }
                    const bf16x8 fa0 = *(const LAS bf16x8*)(IMG + 0 * 1152 + tr * 72 + 8 * q), fa1 = *(const LAS bf16x8*)(IMG + 0 * 1152 + tr * 72 + 32 + 8 * q);
                    const bf16x8 fr0 = *(const LAS bf16x8*)(IMG + 1 * 1152 + tr * 72 + 8 * q), fr1 = *(const LAS bf16x8*)(IMG + 1 * 1152 + tr * 72 + 32 + 8 * q);
                    const bf16x8 fb0 = *(const LAS bf16x8*)(IMG + 2 * 1152 + tr * 72 + 8 * q), fb1 = *(const LAS bf16x8*)(IMG + 2 * 1152 + tr * 72 + 32 + 8 * q);
                    const bf16x8 fk0 = *(const LAS bf16x8*)(IMG + 3 * 1152 + tr * 72 + 8 * q), fk1 = *(const LAS bf16x8*)(IMG + 3 * 1152 + tr * 72 + 32 + 8 * q);
                    const f32x4 z4 = (f32x4){0.f, 0.f, 0.f, 0.f};
                    f32x4 PT = __builtin_amdgcn_mfma_f32_16x16x32_bf16(fa0, fb0, z4, 0, 0, 0); PT = __builtin_amdgcn_mfma_f32_16x16x32_bf16(fa1, fb1, PT, 0, 0, 0);
                    f32x4 QT = __builtin_amdgcn_mfma_f32_16x16x32_bf16(fa0, fk0, z4, 0, 0, 0); QT = __builtin_amdgcn_mfma_f32_16x16x32_bf16(fa1, fk1, QT, 0, 0, 0);
                    f32x4 GB = __builtin_amdgcn_mfma_f32_16x16x32_bf16(fr0, fb0, z4, 0, 0, 0); GB = __builtin_amdgcn_mfma_f32_16x16x32_bf16(fr1, fb1, GB, 0, 0, 0);
                    f32x4 GK = __builtin_amdgcn_mfma_f32_16x16x32_bf16(fr0, fk0, z4, 0, 0, 0); GK = __builtin_amdgcn_mfma_f32_16x16x32_bf16(fr1, fk1, GK, 0, 0, 0);
                    const int s_ = tr, rec = (s_ >> 2) * 8 + (s_ & 3);
#pragma unroll
                    for (int e = 0; e < 4; ++e) { const int t = 4 * q + e;
                        const float qv = s_ < t ? QT[e] : 0.f, gb = s_ <= t ? GB[e] : 0.f, gk = s_ <= t ? GK[e] : 0.f;
                        QGT[t * 32 + rec] = (bf16)f2bf(qv);
                        QGT[512 + t * 32 + rec] = (bf16)f2bf(gb); QGT[512 + t * 32 + rec + 4] = (bf16)f2bf(gk); }
                    float Tr[16]; const pg8::v4i_t PTi = __builtin_bit_cast(pg8::v4i_t, PT);
#pragma unroll
                    for (int t = 0; t < 16; ++t) { float acc = (t == s_) ? 1.f : 0.f;
                        int zt_ = 0; { const float dep_ = t > 0 ? Tr[t > 0 ? t - 1 : 0] : 0.f; asm volatile("" : "+s"(zt_) : "v"(dep_)); }
#pragma unroll
                        for (int r = 0; r < t; ++r) acc = __builtin_fmaf(__int_as_float(__builtin_amdgcn_readlane(PTi[t & 3], 16 * (t >> 2) + r + zt_)), Tr[r], acc);
                        Tr[t] = acc; }
                    if (q == 0) {
#pragma unroll
                        for (int t = 0; t < 16; ++t) QGT[1024 + t * 32 + rec] = (bf16)f2bf(Tr[t]); }
                    asm volatile("s_waitcnt lgkmcnt(0)" ::: "memory");
                    { const v4u q_ = *(const LAS v4u*)(QGT + lane * 8), g_ = *(const LAS v4u*)(QGT + 512 + lane * 8), t_ = *(const LAS v4u*)(QGT + 1024 + lane * 8);
                      *(GAS v4u*)(pk + PK_QQ + lane * 16) = q_; *(GAS v4u*)(pk + PK_GG + lane * 16) = g_; *(GAS v4u*)(pk + PK_TT + lane * 16) = t_; }
                    asm volatile("s_waitcnt lgkmcnt(0)" ::: "memory");
                }
            }
    }
#undef P4_FETCH
    SEAM(4);

    if (IN(5)) {
        constexpr int P5_OPS = 0, P5_VV = 81920, P5_YW = 90112, P5_SC = 98304;
        const int xcd_i = bx % 8, slot_i = bx / 8;
        constexpr int NSCAN_X = 8;
        if (slot_i < NSCAN_X) {
            constexpr int CH = 16, NCHUNK = SEQ / CH, NSLOT = 8, LAG = 3;
            LAS unsigned* ring_ready = (LAS unsigned*)(lds + LDSCTL_OFF + 896); LAS unsigned* ring_done = ring_ready + 4;
            constexpr int PK_PA = 0, PK_PR = 2048, PK_QQ = 4096, PK_TT = 5120, PK_GG = 6144, PK_BK = 7168, PK_VT = 11264, PK_WC = 13312, PK_BON = 13568, PK_BYTES = 16384;
            const int hd = xcd_i * NSCAN_X + slot_i, b = hd >> 4, h = hd & 15;
            const size_t mbase = (size_t)b * SEQ;
            static_assert((size_t)64 * NCHUNK * PK_BYTES <= 4 * SZ_F1K, "packs fit the four unused f32 [M][1024] buffers at WS_R");
            unsigned char* PACK = ws + WS_R + (size_t)hd * NCHUNK * PK_BYTES;
            const int tr = lane & 15, q = lane >> 4;
            if (wave < 4) {
                const int icol = 16 * wave + tr;
                LAS float* YT = (LAS float*)(lds + RING_BYTES);
                LAS unsigned* ywr = ring_ready + 8; LAS unsigned* yrd = ring_ready + 12;
                const int ptok = 4 * wave + (lane >> 4), pcol = 4 * (lane & 15);
                const f32x4 lw4 = *(const GAS f32x4*)(lnx_w + h * 64 + pcol), lb4 = *(const GAS f32x4*)(lnx_b + h * 64 + pcol), rk4 = *(const GAS f32x4*)(r_k + h * 64 + pcol);
                const int ppos = (pcol & 32) | ((pcol & 12) << 1) | ((pcol & 16) >> 2);
                f32x4 H0 = (f32x4){0.f, 0.f, 0.f, 0.f}, H1 = H0, H2 = H0, H3 = H0;
                bf16x8 A_fa0, A_fa1, A_fr0, A_fr1, A_fq, A_ft, A_fg, A_b0, A_b1, A_b2, A_b3; v2u A_v, A_g; f32x4 A_w0, A_w1, A_w2, A_w3;
                bf16x8 B_fa0, B_fa1, B_fr0, B_fr1, B_fq, B_ft, B_fg, B_b0, B_b1, B_b2, B_b3; v2u B_v, B_g; f32x4 B_w0, B_w1, B_w2, B_w3;
#define CK_LOAD(P, c_) do { { unsigned sp_ = 0; for (;;) { const v4u rr_ = *(volatile LAS v4u*)ring_ready; const unsigned mn_ = min(min(rr_.x, rr_.y), min(rr_.z, rr_.w)); if (mn_ >= (unsigned)((c_) + 1)) break; __builtin_amdgcn_s_sleep(0); if (++sp_ > (1u << 26)) break; } } asm volatile("" ::: "memory"); \
                    const LAS unsigned char* pk_ = lds + ((c_) & (NSLOT - 1)) * PK_BYTES; \
                    P##_fa0 = *(const LAS bf16x8*)(pk_ + PK_PA + (tr * 64 + 8 * q) * 2); P##_fa1 = *(const LAS bf16x8*)(pk_ + PK_PA + (tr * 64 + 32 + 8 * q) * 2); \
                    P##_fr0 = *(const LAS bf16x8*)(pk_ + PK_PR + (tr * 64 + 8 * q) * 2); P##_fr1 = *(const LAS bf16x8*)(pk_ + PK_PR + (tr * 64 + 32 + 8 * q) * 2); \
                    P##_fq = *(const LAS bf16x8*)(pk_ + PK_QQ + (tr * 4 + q) * 16); P##_ft = *(const LAS bf16x8*)(pk_ + PK_TT + (tr * 4 + q) * 16); P##_fg = *(const LAS bf16x8*)(pk_ + PK_GG + (tr * 4 + q) * 16); \
                    P##_b0 = *(const LAS bf16x8*)(pk_ + PK_BK + ((0 + tr) * 4 + q) * 16); P##_b1 = *(const LAS bf16x8*)(pk_ + PK_BK + ((16 + tr) * 4 + q) * 16); \
                    P##_b2 = *(const LAS bf16x8*)(pk_ + PK_BK + ((32 + tr) * 4 + q) * 16); P##_b3 = *(const LAS bf16x8*)(pk_ + PK_BK + ((48 + tr) * 4 + q) * 16); \
                    P##_v = *(const LAS v2u*)(pk_ + PK_VT + icol * 32 + q * 8); \
                    P##_g = *(const GAS v2u*)(LOUTB + (mbase + (size_t)(c_) * CH + ptok) * 3072 + 2048 + h * 64 + pcol); \
                    P##_w0 = *(const LAS f32x4*)(pk_ + PK_WC + (0 + 4 * q) * 4); P##_w1 = *(const LAS f32x4*)(pk_ + PK_WC + (16 + 4 * q) * 4); P##_w2 = *(const LAS f32x4*)(pk_ + PK_WC + (32 + 4 * q) * 4); P##_w3 = *(const LAS f32x4*)(pk_ + PK_WC + (48 + 4 * q) * 4); } while (0)
#define CK_MM(a_, b_, c_) __builtin_amdgcn_mfma_f32_16x16x32_bf16(a_, b_, c_, 0, 0, 0)
#define CK_STEP(P, c_) do { const f32x4 z4 = (f32x4){0.f, 0.f, 0.f, 0.f}; \
                    v4u hb0, hb1; hb0.x = cvt_pk_bf16_nat(H0[0], H0[1]); hb0.y = cvt_pk_bf16_nat(H0[2], H0[3]); hb0.z = cvt_pk_bf16_nat(H1[0], H1[1]); hb0.w = cvt_pk_bf16_nat(H1[2], H1[3]); \
                    hb1.x = cvt_pk_bf16_nat(H2[0], H2[1]); hb1.y = cvt_pk_bf16_nat(H2[2], H2[3]); hb1.z = cvt_pk_bf16_nat(H3[0], H3[1]); hb1.w = cvt_pk_bf16_nat(H3[2], H3[3]); \
                    const bf16x8 Hb0 = __builtin_bit_cast(bf16x8, hb0), Hb1 = __builtin_bit_cast(bf16x8, hb1); \
                    v4u vb_; vb_.x = P##_v.x; vb_.y = P##_v.y; vb_.z = P##_v.x; vb_.w = P##_v.y; const bf16x8 Vb = __builtin_bit_cast(bf16x8, vb_); \
                    f32x4 XQ = CK_MM(P##_fa0, Hb0, z4); XQ = CK_MM(P##_fa1, Hb1, XQ); XQ = CK_MM(P##_fq, Vb, XQ); \
                    v4u xb_; xb_.x = cvt_pk_bf16_nat(XQ[0], XQ[1]); xb_.y = cvt_pk_bf16_nat(XQ[2], XQ[3]); xb_.z = 0u; xb_.w = 0u; \
                    const f32x4 U = CK_MM(P##_ft, __builtin_bit_cast(bf16x8, xb_), z4); \
                    v4u ub_; ub_.x = cvt_pk_bf16_nat(U[0], U[1]); ub_.y = cvt_pk_bf16_nat(U[2], U[3]); ub_.z = P##_v.x; ub_.w = P##_v.y; const bf16x8 UVb = __builtin_bit_cast(bf16x8, ub_); \
                    f32x4 Y = CK_MM(P##_fr0, Hb0, z4); Y = CK_MM(P##_fr1, Hb1, Y); Y = CK_MM(P##_fg, UVb, Y); \
                    H0 = CK_MM(P##_b0, UVb, H0 * P##_w0); H1 = CK_MM(P##_b1, UVb, H1 * P##_w1); H2 = CK_MM(P##_b2, UVb, H2 * P##_w2); H3 = CK_MM(P##_b3, UVb, H3 * P##_w3); \
                    { unsigned sp_ = 0; for (;;) { const v4u dd_ = *(volatile LAS v4u*)yrd; if (min(min(dd_.x, dd_.y), min(dd_.z, dd_.w)) + 4u > (unsigned)(c_)) break; __builtin_amdgcn_s_sleep(0); if (++sp_ > (1u << 26)) break; } }     \
                    asm volatile("" ::: "memory"); \
                    { LAS float* yt_ = YT + ((c_) & 3) * 1024 + (4 * q) * 64 + icol; yt_[0] = Y[0]; yt_[64] = Y[1]; yt_[128] = Y[2]; yt_[192] = Y[3]; } \
                    asm volatile("s_waitcnt lgkmcnt(0)" ::: "memory"); if (lane == 0) __hip_atomic_fetch_add(ywr + wave, 1u, __ATOMIC_RELAXED, __HIP_MEMORY_SCOPE_WORKGROUP); } while (0)
#define CK_POST(P, c_) do { { unsigned sp_ = 0; for (;;) { const v4u ww_ = *(volatile LAS v4u*)ywr; if (min(min(ww_.x, ww_.y), min(ww_.z, ww_.w)) >= (unsigned)((c_) + 1)) break; __builtin_amdgcn_s_sleep(0); if (++sp_ > (1u << 26)) break; } } \
                    asm volatile("" ::: "memory"); \
                    const LAS unsigned char* pk_ = lds + ((c_) & (NSLOT - 1)) * PK_BYTES; \
                    const f32x4 y_ = *(const LAS f32x4*)(YT + ((c_) & 3) * 1024 + ptok * 64 + pcol); \
                    const LAS bf16* vt_ = (const LAS bf16*)(pk_ + PK_VT) + pcol * 16 + ptok; \
                    const f32x4 v_ = (f32x4){__builtin_bit_cast(float, (unsigned)vt_[0] << 16), __builtin_bit_cast(float, (unsigned)vt_[16] << 16), __builtin_bit_cast(float, (unsigned)vt_[32] << 16), __builtin_bit_cast(float, (unsigned)vt_[48] << 16)}; \
                    const v2u rr2_ = *(const LAS v2u*)(pk_ + PK_PR + (ptok * 64 + ppos) * 2); const LAS bf16* kh_ = (const LAS bf16*)(pk_ + PK_BK + pcol * 64 + (ptok >> 2) * 16 + 8 + (ptok & 3) * 2); \
                    const f32x4 wc_ = *(const LAS f32x4*)(pk_ + PK_WC + pcol * 4); \
                    const float bon_ = row16_sum(bflo(rr2_.x) * __builtin_bit_cast(float, (unsigned)kh_[0] << 16) * rk4.x * __builtin_amdgcn_rcpf(wc_.x) + bfhi(rr2_.x) * __builtin_bit_cast(float, (unsigned)kh_[32] << 16) * rk4.y * __builtin_amdgcn_rcpf(wc_.y) \
                                                 + bflo(rr2_.y) * __builtin_bit_cast(float, (unsigned)kh_[64] << 16) * rk4.z * __builtin_amdgcn_rcpf(wc_.z) + bfhi(rr2_.y) * __builtin_bit_cast(float, (unsigned)kh_[96] << 16) * rk4.w * __builtin_amdgcn_rcpf(wc_.w));     \
                    const float mean_ = row16_sum(y_.x + y_.y + y_.z + y_.w) * (1.0f / 64.0f); const f32x4 d_ = y_ - mean_; \
                    const float var_ = row16_sum(d_.x * d_.x + d_.y * d_.y + d_.z * d_.z + d_.w * d_.w) * (1.0f / 64.0f); \
                    f32x4 yn_ = d_ * __builtin_amdgcn_rsqf(var_ + GN_EPS) * lw4 + lb4; yn_ = (yn_ + bon_ * v_) * (f32x4){bflo(P##_g.x), bfhi(P##_g.x), bflo(P##_g.y), bfhi(P##_g.y)}; \
                    v2u ov_; ov_.x = pk2(yn_.x, yn_.y); ov_.y = pk2(yn_.z, yn_.w); \
                    *(GAS v2u*)(MIXIN + (mbase + (size_t)(c_) * CH + ptok) * 2048 + h * 64 + pcol) = ov_; \
                    asm volatile("s_waitcnt lgkmcnt(0)" ::: "memory"); \
                    if (lane == 0) { __hip_atomic_fetch_add(yrd + wave, 1u, __ATOMIC_RELAXED, __HIP_MEMORY_SCOPE_WORKGROUP); __hip_atomic_fetch_add(ring_done + wave, 1u, __ATOMIC_RELAXED, __HIP_MEMORY_SCOPE_WORKGROUP); } } while (0)
                CK_LOAD(A, 0);
#pragma unroll 1
                for (int c = 0; c < NCHUNK; c += 2) {
                    if (c > 0) CK_POST(B, c - 1);
                    CK_LOAD(B, c + 1); CK_STEP(A, c);
                    CK_POST(A, c);
                    CK_LOAD(A, (c + 2 < NCHUNK ? c + 2 : c)); CK_STEP(B, c + 1);
                }
                CK_POST(B, NCHUNK - 1);
#undef CK_LOAD
#undef CK_MM
#undef CK_STEP
#undef CK_POST
            } else {
                const int lw = wave - 4;
#pragma unroll 1
                for (int c = 0; c < NCHUNK + LAG; ++c) {
                    if (c < NCHUNK) {
                        if (c >= NSLOT) { const unsigned want = (unsigned)(c - NSLOT + 1); unsigned sp_ = 0;
                            for (;;) { const v4u dd_ = *(volatile LAS v4u*)ring_done; if (min(min(dd_.x, dd_.y), min(dd_.z, dd_.w)) >= want) break; __builtin_amdgcn_s_sleep(0); if (++sp_ > (1u << 26)) break; } }
                        asm volatile("" ::: "memory");
                        const unsigned char* src = PACK + (size_t)c * PK_BYTES + lw * 1024 + lane * 16;
                        LAS unsigned char* dst = lds + (c & (NSLOT - 1)) * PK_BYTES + lw * 1024;
#pragma unroll
                        for (int p = 0; p < 3; ++p) __builtin_amdgcn_global_load_lds((const unsigned*)(src + p * 4096), (LAS unsigned*)(dst + p * 4096), 16, 0, 0);
                        if (lw < 2) __builtin_amdgcn_global_load_lds((const unsigned*)(src + 3 * 4096), (LAS unsigned*)(dst + 3 * 4096), 16, 0, 0);
                    }
                    if (c >= LAG) {
                        if (c < NCHUNK) { if (lw < 2) asm volatile("s_waitcnt vmcnt(12)" ::: "memory"); else asm volatile("s_waitcnt vmcnt(9)" ::: "memory"); } else asm volatile("s_waitcnt vmcnt(0)" ::: "memory");
                        if (lane == 0) __hip_atomic_fetch_add(ring_ready + lw, 1u, __ATOMIC_RELAXED, __HIP_MEMORY_SCOPE_WORKGROUP);
                    }
                }
            }
        }
        else for (int crep_ = 0; crep_ < P5_CONV_REPS; ++crep_) {
            LAS unsigned* img = (LAS unsigned*)(lds + wave * (4096 * NHB));
            const int cw = (xcd_i * (32 - NSCAN_X) + slot_i - NSCAN_X) * NWAVES + wave;
            constexpr int F1 = (D / (64 * NHB)) * (4096 / 64), F2 = (DFF / (64 * NHB)) * (D / 64), FPE = F1 + F2, NFULL = NE * FPE, STRIDE = (NWG - 8 * NSCAN_X) * NWAVES;
            const int nhalf = cw < NFULL ? NHB * ((NFULL - cw + STRIDE - 1) / STRIDE) : 0;
            f32x4 va[16], vb2[16], vc[16];
            int s = 0;
#define CONV_LD(ss_, buf_) { const int sc_ = (ss_) < nhalf ? (ss_) : nhalf - 1; const int fi_ = cw + (sc_ / NHB) * STRIDE, e_ = fi_ / FPE, r_ = fi_ % FPE; \
                if (r_ < F1) tr_load2(w1 + (size_t)e_ * D * 4096, 4096, r_, sc_ % NHB, lane, buf_); else tr_load2(w2 + (size_t)e_ * DFF * D, D, r_ - F1, sc_ % NHB, lane, buf_); }
#define CONV_STEP(cur, far) { CONV_LD(s + 2, far);     \
                tr_half(cur, s % NHB, img, lane, pg8::W_SCALE); \
                if (s % NHB == NHB - 1) { const int fi_ = cw + (s / NHB) * STRIDE, e_ = fi_ / FPE, r_ = fi_ % FPE; \
                    if (r_ < F1) tr_flush(img, D, 4096, W1T, (size_t)e_ * 4096, r_, lane); else tr_flush(img, DFF, D, W2T, (size_t)e_ * 2048, r_ - F1, lane); } \
                ++s; }
            if (nhalf > 0) { CONV_LD(0, va); CONV_LD(1, vb2);
                for (;;) { CONV_STEP(va, vc); if (s >= nhalf) break; CONV_STEP(vb2, va); if (s >= nhalf) break; CONV_STEP(vc, vb2); if (s >= nhalf) break; } }
#undef CONV_LD
#undef CONV_STEP
        }
    }
    SEAM(5);


    if (IN(7)) {
        pg8::Gemm g{MIXIN, WOUTT, D, D}; pg8::GridOrder S; S.init(M / 256, D / 256, G, bx, (size_t)256 * D * 2, 0, (size_t)256 * D * 2);
        pg8::EpiBf16Plain E{MIX, D};
        pg8::gemm_phase<pg8::EpiBf16Plain, pg8::GridOrder, true, true>(lds, g, S, E);
    }
    SEAM(7);

    if (IN(8)) {
        constexpr int HROW = 2048 + 32;
        LAS bf16* s_hh = (LAS bf16*)lds; LAS bf16* s_hl = s_hh + 8 * HROW;
        LAS float* s_part = (LAS float*)(lds + 69632);
        LAS float* s_lnw = (LAS float*)(lds + 81920); LAS float* s_lnb = s_lnw + 2048;
        const int re = lane & 15, rq = lane >> 4;
        bf16x8 wh[8][2], wl[8][2];
#pragma unroll
        for (int st = 0; st < 8; ++st)
#pragma unroll
            for (int hf = 0; hf < 2; ++hf) { float w8[8];
#pragma unroll
                for (int j = 0; j < 8; ++j) w8[j] = router_w[(size_t)(256 * wave + 32 * st + 8 * rq + j) * 32 + re + 16 * hf];
                v4u hi, lo;
                hi.x = pk2(w8[0], w8[1]); hi.y = pk2(w8[2], w8[3]); hi.z = pk2(w8[4], w8[5]); hi.w = pk2(w8[6], w8[7]);
                lo.x = pk2(w8[0] - bflo(hi.x), w8[1] - bfhi(hi.x)); lo.y = pk2(w8[2] - bflo(hi.y), w8[3] - bfhi(hi.y)); lo.z = pk2(w8[4] - bflo(hi.z), w8[5] - bfhi(hi.z)); lo.w = pk2(w8[6] - bflo(hi.w), w8[7] - bfhi(hi.w));
                wh[st][hf] = __builtin_bit_cast(bf16x8, hi); wl[st][hf] = __builtin_bit_cast(bf16x8, lo); }
        LAS int* lcnt = (LAS int*)(lds + LDSCTL_OFF + 512);
        if (tid < NE) lcnt[tid] = 0;
        const float rb = router_b[lane & 31];
        *(LAS f32x4*)(s_lnw + 4 * tid) = *(const GAS f32x4*)(ln1_w + 4 * tid); *(LAS f32x4*)(s_lnb + 4 * tid) = *(const GAS f32x4*)(ln1_b + 4 * tid);
        __syncthreads();
        constexpr int NIT = M / (NWG * 8);
        v4u rm[4], rx[4];
#define P8_FETCH(m_) do { _Pragma("unroll") for (int q = 0; q < 4; ++q) { rm[q] = *(const GAS v4u*)(MIX + (size_t)(m_) * D + 8 * lane + 512 * q); rx[q] = *(const GAS v4u*)(XB + (size_t)(m_) * D + 8 * lane + 512 * q); } } while (0)
#define P8_LN(m_) do { f32x4 v[8]; float s = 0.f; \
            _Pragma("unroll") for (int q = 0; q < 4; ++q) { \
                v[2 * q] = ALPHA * (f32x4){bflo(rx[q].x), bfhi(rx[q].x), bflo(rx[q].y), bfhi(rx[q].y)} + (f32x4){bflo(rm[q].x), bfhi(rm[q].x), bflo(rm[q].y), bfhi(rm[q].y)}; \
                v[2 * q + 1] = ALPHA * (f32x4){bflo(rx[q].z), bfhi(rx[q].z), bflo(rx[q].w), bfhi(rx[q].w)} + (f32x4){bflo(rm[q].z), bfhi(rm[q].z), bflo(rm[q].w), bfhi(rm[q].w)}; \
                s += ((v[2 * q].x + v[2 * q].y) + (v[2 * q].z + v[2 * q].w)) + ((v[2 * q + 1].x + v[2 * q + 1].y) + (v[2 * q + 1].z + v[2 * q + 1].w)); } \
            const float mean = wave_sum_dpp(s) * (1.0f / D); float s2 = 0.f; \
            _Pragma("unroll") for (int q = 0; q < 8; ++q) { v[q] = v[q] - mean; s2 += (v[q].x * v[q].x + v[q].y * v[q].y) + (v[q].z * v[q].z + v[q].w * v[q].w); } \
            const float rstd = 1.0f / sqrtf(wave_sum_dpp(s2) * (1.0f / D) + LN_EPS); \
            _Pragma("unroll") for (int q = 0; q < 4; ++q) { const int c = 8 * lane + 512 * q; \
                const f32x4 h0 = v[2 * q] * rstd * *(const LAS f32x4*)(s_lnw + c) + *(const LAS f32x4*)(s_lnb + c), h1 = v[2 * q + 1] * rstd * *(const LAS f32x4*)(s_lnw + c + 4) + *(const LAS f32x4*)(s_lnb + c + 4); \
                v4u hw; hw.x = pk2(h0.x, h0.y); hw.y = pk2(h0.z, h0.w); hw.z = pk2(h1.x, h1.y); hw.w = pk2(h1.z, h1.w); *(GAS v4u*)(H + (size_t)(m_) * D + c) = hw; \
                v4u hl; hl.x = pk2(h0.x - bflo(hw.x), h0.y - bfhi(hw.x)); hl.y = pk2(h0.z - bflo(hw.y), h0.w - bfhi(hw.y)); hl.z = pk2(h1.x - bflo(hw.z), h1.y - bfhi(hw.z)); hl.w = pk2(h1.z - bflo(hw.w), h1.w - bfhi(hw.w)); \
                *(LAS v4u*)(s_hh + wave * HROW + c) = hw; *(LAS v4u*)(s_hl + wave * HROW + c) = hl; \
                { v2u hq; hq.x = pg8::pk4_fp8(h0.x * pg8::XS_SCALE, h0.y * pg8::XS_SCALE, h0.z * pg8::XS_SCALE, h0.w * pg8::XS_SCALE); hq.y = pg8::pk4_fp8(h1.x * pg8::XS_SCALE, h1.y * pg8::XS_SCALE, h1.z * pg8::XS_SCALE, h1.w * pg8::XS_SCALE); \
                  *(GAS v2u*)(HQ + (size_t)(m_) * D + c) = hq; } } } while (0)
#define P8_MM(a_, b_, c_) __builtin_amdgcn_mfma_f32_16x16x32_bf16(a_, b_, c_, 0, 0, 0)
#define P8_ROUTER() do { const LAS bf16* ah_ = s_hh + (lane & 7) * HROW + 256 * wave + 8 * rq; const LAS bf16* al_ = s_hl + (lane & 7) * HROW + 256 * wave + 8 * rq; \
            f32x4 a0_ = (f32x4){0.f, 0.f, 0.f, 0.f}, a1_ = a0_; \
            _Pragma("unroll") for (int st = 0; st < 8; ++st) { const bf16x8 fh_ = *(const LAS bf16x8*)(ah_ + 32 * st), fl_ = *(const LAS bf16x8*)(al_ + 32 * st); \
                a0_ = P8_MM(fh_, wh[st][0], a0_); a1_ = P8_MM(fh_, wh[st][1], a1_); a0_ = P8_MM(fh_, wl[st][0], a0_); a1_ = P8_MM(fh_, wl[st][1], a1_); a0_ = P8_MM(fl_, wh[st][0], a0_); a1_ = P8_MM(fl_, wh[st][1], a1_); } \
            if (lane < 32) { _Pragma("unroll") for (int r = 0; r < 4; ++r) { s_part[(wave * 8 + 4 * rq + r) * 32 + re] = a0_[r]; s_part[(wave * 8 + 4 * rq + r) * 32 + 16 + re] = a1_[r]; } } } while (0)
#define P8_T4STEP(CTRL) do { const float ob = dpp_mov<CTRL>(best); const int oi = __builtin_amdgcn_update_dpp(0, bi, CTRL, 0xF, 0xF, true); const bool take = (ob > best) || (ob == best && oi < bi); best = take ? ob : best; bi = take ? oi : bi; } while (0)
#define P8_TOP4(m_) do { float lg = -3.0e38f; \
            if (lane < 32) { float tp_[8]; _Pragma("unroll") for (int p = 0; p < 8; ++p) tp_[p] = s_part[(p * 8 + wave) * 32 + lane]; \
                lg = rb + (((tp_[0] + tp_[1]) + (tp_[2] + tp_[3])) + ((tp_[4] + tp_[5]) + (tp_[6] + tp_[7]))); \
                lg = (lg == lg) ? fminf(fmaxf(lg, -1.0e30f), 1.0e30f) : -1.0e30f; }        \
            int idx[4]; float val[4]; \
            _Pragma("unroll") for (int k = 0; k < 4; ++k) { float best = lg; int bi = lane; \
                P8_T4STEP(0xB1); P8_T4STEP(0x4E); P8_T4STEP(0x141); P8_T4STEP(0x140); \
                { const float ob = __shfl_xor(best, 16); const int oi = __shfl_xor(bi, 16); const bool take = (ob > best) || (ob == best && oi < bi); best = take ? ob : best; bi = take ? oi : bi; } \
                idx[k] = bi; val[k] = best; if (lane == bi) lg = -3.0e38f; } \
            if (lane == 0) { float ex[4], se = 0.f; \
                _Pragma("unroll") for (int k = 0; k < 4; ++k) { ex[k] = __expf(val[k] - val[0]); se += ex[k]; } \
                const float inv = 1.0f / se; \
                _Pragma("unroll") for (int k = 0; k < 4; ++k) { TOPI[(m_) * 4 + k] = idx[k]; GATE[(m_) * 4 + k] = ex[k] * inv; POS[(m_) * 4 + k] = __hip_atomic_fetch_add(lcnt + idx[k], 1, __ATOMIC_RELAXED, __HIP_MEMORY_SCOPE_WORKGROUP); } } } while (0)
#define P8_SYNC() do { asm volatile("s_waitcnt lgkmcnt(0)" ::: "memory"); __builtin_amdgcn_s_barrier(); asm volatile("" ::: "memory"); } while (0)
        const int mfirst = vcu * 8 + wave;
        P8_FETCH(mfirst);
        P8_LN(mfirst); P8_FETCH(mfirst + G * 8);
        P8_SYNC();
        P8_ROUTER();
        P8_SYNC();
#pragma unroll 1
        for (int it = 1; it < NIT; ++it) {
            const int m = mfirst + it * G * 8;
            P8_LN(m); P8_FETCH(it + 1 < NIT ? m + G * 8 : m);
            P8_TOP4(m - G * 8);
            P8_SYNC();
            P8_ROUTER();
            P8_SYNC();
        }
        P8_TOP4(mfirst + (NIT - 1) * G * 8);
        P8_SYNC();
#undef P8_SYNC
#undef P8_FETCH
#undef P8_LN
#undef P8_MM
#undef P8_ROUTER
#undef P8_T4STEP
#undef P8_TOP4
        if (tid < NE) CNTWG[vcu * NE + tid] = lcnt[tid];
    }
    SEAM(8);

    if (IN(9) || IN(10) || IN(11)) {
        LAS int* s_t = (LAS int*)lds; LAS int* s_p = s_t + 512;
        LAS int* PSB = (LAS int*)(lds + LDSCTL_OFF + 640);
        { const int e = tid & 31, part = tid >> 5; int tsum = 0, psum = 0;
          for (int w = part * 16; w < part * 16 + 16; ++w) { const int cv = CNTWG[w * NE + e]; tsum += cv; psum += (w < vcu) ? cv : 0; }
          s_t[part * 32 + e] = tsum; s_p[part * 32 + e] = psum; }
        __syncthreads();
        if (tid < NE) { int tsum = 0, psum = 0; for (int p = 0; p < 16; ++p) { tsum += s_t[p * 32 + tid]; psum += s_p[p * 32 + tid]; } s_t[tid] = tsum; PSB[tid] = psum; }
        __syncthreads();
        if (tid == 0) { int acc = 0; for (int e = 0; e < NE; ++e) { PS[e] = acc; acc += (s_t[e] + 255) / 256 * 256; } PS[NE] = acc; }
        __syncthreads();
        if (tid < NE) PSB[tid] += PS[tid];
        __syncthreads();
    }
    if (IN(9)) {
        const LAS int* PSB = (const LAS int*)(lds + LDSCTL_OFF + 640);
        if (lane < 4 * (M / (NWG * 8))) {
            const int m = vcu * 8 + (lane >> 2) * G * 8 + wave, a = m * 4 + (lane & 3), slot = PSB[TOPI[a]] + POS[a];
            slot_tok[slot] = m; SLOT_OF[a] = slot;
        }
    }
    SEAM(9);

    if (IN(10)) {
        LAS int* UT = (LAS int*)(lds + LDSCTL_OFF + 768);
        LAS unsigned* TOKS = (LAS unsigned*)(lds + RING_BYTES);
        pg8::Gemm g{(const bf16*)HQ, (const bf16*)W1T, D / 2, D / 2}; pg8::MoeOrderT<true> S; S.ut = UT; S.a_tstep = (size_t)256 * D; S.b_tstep = (size_t)256 * D; S.toks = TOKS;
        pg8::moe_unit_table(UT, PS, 16, vcu, tid);
        { int tkv[9];
#pragma unroll
          for (int r = 0; r < 9; ++r) { const int idx = r * 512 + tid, v = UT[idx >> 8]; tkv[r] = v < 0 ? 0 : slot_tok[(v & 0xffff) * 256 + (idx & 255)]; }
#pragma unroll
          for (int r = 0; r < 9; ++r) { const int tk = tkv[r]; TOKS[r * 512 + tid] = (unsigned)((tk < 0 || tk >= M) ? 0 : tk) * (unsigned)D; }
          __syncthreads(); }
        pg8::EpiSwiglu E{ACT, b1};
        pg8::gemm_phase<pg8::EpiSwiglu, pg8::MoeOrderT<true>, true, true, true>(lds, g, S, E);
    }
    SEAM(10);

    if (IN(11)) {
        pg8::Gemm g{(const bf16*)ACT, (const bf16*)W2T, DFF / 2, DFF / 2}; LAS int* UT = (LAS int*)(lds + LDSCTL_OFF + 768); pg8::moe_unit_table(UT, PS, 8, vcu, tid);
        pg8::MoeOrder S; S.ut = UT; S.a_tstep = (size_t)256 * DFF; S.b_tstep = (size_t)256 * DFF; S.toks = nullptr;
        pg8::EpiBias8 E{YS, b2};
        pg8::gemm_phase<pg8::EpiBias8, pg8::MoeOrder, true, true, true>(lds, g, S, E);
    }
    SEAM(11);

    if (IN(12)) {
        LAS float* s_lnw = (LAS float*)lds; LAS float* s_lnb = s_lnw + 2048;
        *(LAS f32x4*)(s_lnw + 4 * tid) = *(const GAS f32x4*)(ln2_w + 4 * tid); *(LAS f32x4*)(s_lnb + 4 * tid) = *(const GAS f32x4*)(ln2_b + 4 * tid);
        __syncthreads();
        int nsl[4]; float ngt[4];
#pragma unroll
        for (int k = 0; k < 4; ++k) { nsl[k] = SLOT_OF[gw * 4 + k]; ngt[k] = GATE[gw * 4 + k]; }
#pragma unroll 1
        for (int m = gw; m < M; m += NGW) {
            int sl[4]; float gt[4];
#pragma unroll
            for (int k = 0; k < 4; ++k) { sl[k] = nsl[k]; gt[k] = ngt[k]; }
            { const int mn = m + NGW < M ? m + NGW : m;
#pragma unroll
              for (int k = 0; k < 4; ++k) { nsl[k] = SLOT_OF[mn * 4 + k]; ngt[k] = GATE[mn * 4 + k]; } }
            f32x4 v[8]; float s = 0.f;
#pragma unroll
            for (int q = 0; q < 8; ++q) { const int c = 4 * lane + 256 * q; f32x4 f = (f32x4){0.f, 0.f, 0.f, 0.f};
#pragma unroll
                for (int k = 0; k < 4; ++k) { const unsigned yv = *(const GAS unsigned*)(YS + (size_t)sl[k] * D + c); const f32x2n lo2 = __builtin_amdgcn_cvt_pk_f32_fp8(yv, false), hi2 = __builtin_amdgcn_cvt_pk_f32_fp8(yv, true); f += (gt[k] * (1.0f / pg8::YS_SCALE)) * (f32x4){lo2.x, lo2.y, hi2.x, hi2.y}; }
                { const v2u hw = *(const GAS v2u*)(H + (size_t)m * D + c); v[q] = ALPHA * (f32x4){bflo(hw.x), bfhi(hw.x), bflo(hw.y), bfhi(hw.y)} + f; } s += (v[q].x + v[q].y) + (v[q].z + v[q].w); }
            const float mean = wave_sum_dpp(s) * (1.0f / D); float s2 = 0.f;
#pragma unroll
            for (int q = 0; q < 8; ++q) { v[q] = v[q] - mean; s2 += (v[q].x * v[q].x + v[q].y * v[q].y) + (v[q].z * v[q].z + v[q].w * v[q].w); }
            const float rstd = 1.0f / sqrtf(wave_sum_dpp(s2) * (1.0f / D) + LN_EPS);
#pragma unroll
            for (int q = 0; q < 8; ++q) { const int c = 4 * lane + 256 * q; *(GAS f32x4*)(out + (size_t)m * D + c) = v[q] * rstd * *(const LAS f32x4*)(s_lnw + c) + *(const LAS f32x4*)(s_lnb + c); }
        }
    }
#undef IN
#undef SEAM
}

extern "C" void kernel_launch(void* const* d_in, const int* in_sizes, int n_in, void* d_out, int out_size, void* d_ws, size_t ws_size, hipStream_t stream) {
    static int grid = 0;
    if (grid == 0) {
        if (n_in != 26 || out_size != M * D || ws_size < WS_END) { fprintf(stderr, "kernel_launch: unexpected problem (n_in %d, out %d, ws %zu < %zu)\n", n_in, out_size, ws_size, (size_t)WS_END); grid = -1; return; }
        int dev = 0, cus = 0, per_cu = 0;
        if (hipGetDevice(&dev) != hipSuccess || hipDeviceGetAttribute(&cus, hipDeviceAttributeMultiprocessorCount, dev) != hipSuccess) { grid = -1; return; }
        if (hipFuncSetAttribute((const void*)mk_fwd, hipFuncAttributeMaxDynamicSharedMemorySize, LDS_BYTES) != hipSuccess) { fprintf(stderr, "kernel_launch: hipFuncSetAttribute failed\n"); grid = -1; return; }
        if (hipOccupancyMaxActiveBlocksPerMultiprocessor(&per_cu, (const void*)mk_fwd, NTHR, LDS_BYTES) != hipSuccess || per_cu < 1) fprintf(stderr, "kernel_launch: occupancy query reports %d\n", per_cu);
        (void)hipGetLastError();
        if (cus != NWG) { fprintf(stderr, "kernel_launch: built for %d CUs, device has %d\n", NWG, cus); grid = -1; return; }
        grid = NWG;
    }
    if (grid < 0) return;
    (void)hipMemsetAsync((char*)d_ws + WS_CTL, 0, 32768, stream);
    Args a{};
    for (int i = 0; i < 26; ++i) a.in[i] = (const float*)d_in[i];
    a.out = (float*)d_out; a.ws = (unsigned char*)d_ws; a.dup = DUP_MASK;
    if (MK_N_LAUNCHES == 1) { a.ph_lo = 0; a.ph_hi = NPHASE; hipLaunchKernelGGL(mk_fwd, dim3(grid), dim3(NTHR), LDS_BYTES, stream, a); }
    else { for (int p = 0; p < NPHASE; ++p) for (int rep = 0; rep <= ((DUP_MASK >> p) & 1); ++rep) { a.ph_lo = p; a.ph_hi = p + 1; hipLaunchKernelGGL(mk_fwd, dim3(grid), dim3(NTHR), LDS_BYTES, stream, a); } }
}
```
